# Optimizing an MI355X kernel written in HIP

```python
import jax, jax.numpy as jnp
from jax import lax
import numpy as np

D_MODEL = 2048
BATCH = 1
SEQ = 16384
DEPTH = 1

HEAD_DIM = 64
N_Q_HEADS = 16
N_KV_HEADS = 4
Q_PER_KV = N_Q_HEADS // N_KV_HEADS
ATTN_WIDTH = N_Q_HEADS * HEAD_DIM
KV_WIDTH = N_KV_HEADS * HEAD_DIM
WINDOW = 128
BLOCK = 128
ROPE_THETA = 500000.0
ROT_DIM = HEAD_DIM // 4

CONV_WIDTH = D_MODEL // 2
CONV_K = 3

N_MEM = 256
X_HEADS = 4
X_HEAD_DIM = 128
X_WIDTH = X_HEADS * X_HEAD_DIM

D_FF = -(-8 * D_MODEL // (3 * 256)) * 256

IN_SIZES = (ATTN_WIDTH, KV_WIDTH, KV_WIDTH, CONV_WIDTH, CONV_WIDTH, CONV_WIDTH, D_MODEL, D_MODEL)
IN_WIDTH = sum(IN_SIZES)

EPS = 1e-6

kernel_name = "hybrid_swa_sink_shortconv_gated_merge"


def rms_norm(x, g):
    xf = x.astype(jnp.float32)
    y = xf * lax.rsqrt(jnp.mean(xf * xf, axis=-1, keepdims=True) + EPS)
    return (y * g.astype(jnp.float32)).astype(x.dtype)


def partial_rope(t, pos):
    half = ROT_DIM // 2
    inv_freq = ROPE_THETA ** (-jnp.arange(0, ROT_DIM, 2, dtype=jnp.float32) / ROT_DIM)
    ang = pos.astype(jnp.float32)[:, None] * inv_freq[None, :]
    cos = jnp.cos(ang)[None, :, None, :]
    sin = jnp.sin(ang)[None, :, None, :]
    tr = t[..., :ROT_DIM].astype(jnp.float32)
    t1, t2 = tr[..., :half], tr[..., half:]
    rot = jnp.concatenate([t1 * cos - t2 * sin, t2 * cos + t1 * sin], axis=-1).astype(t.dtype)
    return jnp.concatenate([rot, t[..., ROT_DIM:]], axis=-1)


def sliding_window_sink_attention(q, k, v, sinks):
    B, S = q.shape[0], q.shape[1]
    nb = S // BLOCK
    qb = q.reshape(B, nb, BLOCK, N_KV_HEADS, Q_PER_KV, HEAD_DIM)

    def with_prev(t):
        tb = t.reshape(B, nb, BLOCK, N_KV_HEADS, HEAD_DIM)
        prev = jnp.pad(tb[:, :-1], ((0, 0), (1, 0), (0, 0), (0, 0), (0, 0)))
        return jnp.concatenate([prev, tb], axis=2)

    kb, vb = with_prev(k), with_prev(v)
    scale = HEAD_DIM ** -0.5
    s = jnp.einsum('bnqkgd,bnckd->bkgnqc', qb, kb).astype(jnp.float32) * scale
    qi = jnp.arange(BLOCK)[:, None]
    c = jnp.arange(2 * BLOCK)[None, :]
    rel = qi + BLOCK - c
    band = (rel >= 0) & (rel < WINDOW)
    not_first = (jnp.arange(nb) > 0)[:, None, None]
    valid = band[None] & (not_first | (c >= BLOCK)[None])
    s = jnp.where(valid, s, -jnp.inf)
    sink = sinks.astype(jnp.float32).reshape(N_KV_HEADS, Q_PER_KV)[None, :, :, None, None, None]
    m = jnp.maximum(jnp.max(s, axis=-1, keepdims=True), sink)
    p = jnp.exp(s - m)
    denom = jnp.sum(p, axis=-1, keepdims=True) + jnp.exp(sink - m)
    w = (p / denom).astype(v.dtype)
    o = jnp.einsum('bkgnqc,bnckd->bnqkgd', w, vb)
    return o.reshape(B, S, ATTN_WIDTH)


def gated_short_conv(u, b_gate, c_gate, conv_w):
    S = u.shape[1]
    v = c_gate * u
    vp = jnp.pad(v, ((0, 0), (CONV_K - 1, 0), (0, 0)))
    y = conv_w[0] * vp[:, 0:S]
    for tap in range(1, CONV_K):
        y = y + conv_w[tap] * vp[:, tap:tap + S]
    return b_gate * y


def memory_cross_attention(h, mem_n, w_xq, w_xkv, w_xo):
    B, S = h.shape[0], h.shape[1]
    q = (h @ w_xq).reshape(B, S, X_HEADS, X_HEAD_DIM)
    kv = mem_n @ w_xkv
    k = kv[..., :X_WIDTH].reshape(B, -1, X_HEADS, X_HEAD_DIM)
    v = kv[..., X_WIDTH:].reshape(B, -1, X_HEADS, X_HEAD_DIM)
    s = jnp.einsum('bshd,bmhd->bhsm', q, k).astype(jnp.float32) * (X_HEAD_DIM ** -0.5)
    p = jax.nn.softmax(s, axis=-1).astype(v.dtype)
    o = jnp.einsum('bhsm,bmhd->bshd', p, v).reshape(B, S, X_WIDTH)
    return o @ w_xo


def swiglu(h, w_gate_up, w_down):
    gu = h @ w_gate_up
    g, u = gu[..., :D_FF], gu[..., D_FF:]
    return (jax.nn.silu(g) * u) @ w_down


def setup_inputs(seed: int = 0) -> dict:
    key = jax.random.key(seed)
    ks = jax.random.split(key, 20)
    f32 = jnp.float32

    def nrm(k, shape, scale):
        return jax.random.normal(k, shape, f32) * scale

    L, D = DEPTH, D_MODEL
    return {
        "x": nrm(ks[0], (BATCH, SEQ, D), 1.0),
        "mem": nrm(ks[1], (BATCH, N_MEM, D), 1.0),
        "g_mix": 1.0 + nrm(ks[2], (L, D), 0.02),
        "w_in": nrm(ks[3], (L, D, IN_WIDTH), D ** -0.5),
        "conv_w": nrm(ks[4], (L, CONV_K, CONV_WIDTH), CONV_K ** -0.5),
        "sinks": nrm(ks[5], (L, N_Q_HEADS), 0.5),
        "w_attn_o": nrm(ks[6], (L, ATTN_WIDTH, D), ATTN_WIDTH ** -0.5),
        "w_conv_o": nrm(ks[7], (L, CONV_WIDTH, D), CONV_WIDTH ** -0.5),
        "w_out": nrm(ks[8], (L, D, D), D ** -0.5),
        "g_xattn": 1.0 + nrm(ks[9], (L, D), 0.02),
        "g_mem": 1.0 + nrm(ks[10], (L, D), 0.02),
        "w_xq": nrm(ks[11], (L, D, X_WIDTH), D ** -0.5),
        "w_xkv": nrm(ks[12], (L, D, 2 * X_WIDTH), D ** -0.5),
        "w_xo": nrm(ks[13], (L, X_WIDTH, D), X_WIDTH ** -0.5),
        "g_ffn": 1.0 + nrm(ks[14], (L, D), 0.02),
        "w_gate_up": nrm(ks[15], (L, D, 2 * D_FF), D ** -0.5),
        "w_down": nrm(ks[16], (L, D_FF, D), D_FF ** -0.5),
        "g_final": 1.0 + nrm(ks[17], (D,), 0.02),
    }


def reference(x, mem, g_mix, w_in, conv_w, sinks, w_attn_o, w_conv_o, w_out,
              g_xattn, g_mem, w_xq, w_xkv, w_xo, g_ffn, w_gate_up, w_down, g_final):
    B, S = x.shape[0], x.shape[1]
    pos = jnp.arange(S, dtype=jnp.int32)
    h = x
    for l in range(DEPTH):
        n = rms_norm(h, g_mix[l])
        z = n @ w_in[l]
        parts = []
        off = 0
        for size in IN_SIZES:
            parts.append(z[..., off:off + size])
            off += size
        q, k, v, cb, cc, ch, ga, gc = parts
        q = partial_rope(q.reshape(B, S, N_Q_HEADS, HEAD_DIM), pos)
        k = partial_rope(k.reshape(B, S, N_KV_HEADS, HEAD_DIM), pos)
        v = v.reshape(B, S, N_KV_HEADS, HEAD_DIM)
        y_attn = sliding_window_sink_attention(q, k, v, sinks[l]) @ w_attn_o[l]
        y_conv = gated_short_conv(ch, cb, cc, conv_w[l]) @ w_conv_o[l]
        merged = jax.nn.sigmoid(ga) * y_attn + jax.nn.sigmoid(gc) * y_conv
        h = h + merged @ w_out[l]
        mem_n = rms_norm(mem, g_mem[l])
        h = h + memory_cross_attention(rms_norm(h, g_xattn[l]), mem_n, w_xq[l], w_xkv[l], w_xo[l])
        h = h + swiglu(rms_norm(h, g_ffn[l]), w_gate_up[l], w_down[l])
    return rms_norm(h, g_final)
```

```cpp
#include <hip/hip_runtime.h>
#include <cstdio>
#include <cstdint>

#ifndef MK_N_LAUNCHES
#define MK_N_LAUNCHES 1
#endif

#define GAS __attribute__((address_space(1)))
#define LAS __attribute__((address_space(3)))
typedef unsigned short bf16;
typedef unsigned v4u __attribute__((ext_vector_type(4)));
typedef unsigned v2u __attribute__((ext_vector_type(2)));
typedef float f32x4 __attribute__((ext_vector_type(4)));
typedef float f32x16 __attribute__((ext_vector_type(16)));
typedef short bf16x8 __attribute__((ext_vector_type(8)));
typedef short s16x4 __attribute__((ext_vector_type(4)));

constexpr int SEQ = 16384, DM = 2048, NIN = 8704, AW = 1024, KVW = 256, CW = 1024, XW = 512, NMEM = 256, DFF = 5632;
constexpr float EPS = 1e-6f;
constexpr float LOG2E = 1.4426950408889634f;
constexpr float QSCALE = 0.125f * 1.4426950408889634f;
constexpr float C2X = 0.08838834764831845f * 1.4426950408889634f;

constexpr size_t MiB = 1u << 20;
constexpr size_t WS_CTL = 0, CTL_ZERO_BYTES = 1 * MiB;
constexpr size_t WS_SS = 1 * MiB;
constexpr size_t WS_CS = 2 * MiB;
constexpr size_t WS_KVB = 3 * MiB;
constexpr size_t WS_MEMN = 4 * MiB;
constexpr size_t WS_WXQ = 5 * MiB;
constexpr size_t WS_WXOT = 7 * MiB;
constexpr size_t WS_WGUT = 16 * MiB;
constexpr size_t WS_WDT = 60 * MiB;
constexpr size_t WS_XN = 82 * MiB;
constexpr size_t WS_H = 146 * MiB;
constexpr size_t WS_WINT = 274 * MiB;
constexpr size_t WS_WACT = 308 * MiB;
constexpr size_t WS_WOUTT = 316 * MiB;
constexpr size_t WS_WXKVT = 324 * MiB;
constexpr size_t WS_WQKT = 328 * MiB;
constexpr size_t WS_VWOT = 332 * MiB;
constexpr size_t WS_BIG = 336 * MiB;
constexpr size_t WS_Q = WS_BIG, WS_K = WS_BIG + 32 * MiB, WS_V = WS_BIG + 40 * MiB, WS_ZC = WS_BIG + 48 * MiB;
constexpr size_t WS_MERGED = WS_ZC, WS_P = WS_Q;
constexpr size_t WS_ACT = WS_WINT;
constexpr size_t WS_END = 480 * MiB;
static_assert(WS_ACT + (size_t)SEQ * DFF * 2 <= WS_END, "act fits");

constexpr int CW_BAR = 4096;

constexpr int RING_BYTES = 131072;
constexpr int LDSCTL_OFF = RING_BYTES, MISC_OFF = LDSCTL_OFF + 320;
constexpr int LDS_BYTES = 147456;

#define RLX_AGENT __ATOMIC_RELAXED, __HIP_MEMORY_SCOPE_AGENT
#define LDS_WAIT() asm volatile("s_waitcnt lgkmcnt(0)" ::: "memory")
#define VM_WAIT() asm volatile("s_waitcnt vmcnt(0)" ::: "memory")

typedef float f32x2_t __attribute__((ext_vector_type(2))); typedef __bf16 bf16x2_t __attribute__((ext_vector_type(2)));
__device__ __forceinline__ unsigned cvt_pk_bf16(float lo, float hi) { f32x2_t v = {lo, hi}; bf16x2_t b = __builtin_convertvector(v, bf16x2_t); return __builtin_bit_cast(unsigned, b); }
__device__ __forceinline__ float bf_lo(unsigned u) { return __builtin_bit_cast(float, u << 16); }
__device__ __forceinline__ float bf_hi(unsigned u) { return __builtin_bit_cast(float, u & 0xffff0000u); }
__device__ __forceinline__ float fast_exp2(float x) { return __builtin_amdgcn_exp2f(x); }
__device__ __forceinline__ float fast_rcp(float x) { return __builtin_amdgcn_rcpf(x); }

namespace pg8 {
typedef unsigned short bf16_t;
constexpr int BM = 256, BK = 64, HALF = 128, HTB = HALF * BK * 2, STAGE_BYTES = 8 * HTB, NXCD = 8, WGM = 8;

__host__ __device__ __forceinline__ int lds_byte(int r, int c) { const int st = (r >> 4) * 2 + (c >> 5), rr = r & 15, cc = c & 31, ob = rr * 64 + cc * 2; return st * 1024 + (ob ^ (((ob >> 9) & 1) << 5)); }
__host__ __device__ __forceinline__ void stage_rc(int b, int& R, int& C) { const int st = b / 1024, sb = b % 1024, swz = sb ^ (((sb >> 9) & 1) << 5); R = (st >> 1) * 16 + swz / 64; C = (st & 1) * 32 + (swz % 64) / 2; }
__host__ __device__ __forceinline__ int perm32(int rho) { const int n = rho >> 4, i = rho & 15; return 8 * (i >> 2) + 4 * n + (i & 3); }

struct Unit { int pm, pn, z; };
struct Prob {
    const bf16_t* A; const bf16_t* Bt; int lda, ldb, K, zoff;
    __device__ __forceinline__ const char* a_ptr(const Unit& u) const { return (const char*)(A + (size_t)u.pm * BM * lda + (size_t)u.z * zoff); }
    __device__ __forceinline__ const char* b_ptr(const Unit& u) const { return (const char*)(Bt + (size_t)u.pn * BM * ldb + (size_t)u.z * zoff); }
};

__device__ __forceinline__ bool tile_of(long L, int nM, int nN, int& pm, int& pn) {
    const int nwg = nM * nN; if (L >= nwg) return false;
    int wgid = (int)L; { const int q = nwg / NXCD, r = nwg % NXCD, xcd = wgid % NXCD, off = wgid / NXCD; wgid = (xcd < r ? xcd * (q + 1) : r * (q + 1) + (xcd - r) * q) + off; }
    const int nig = WGM * nN, gid = wgid / nig, fm = gid * WGM, gsz = (nM - fm) < WGM ? (nM - fm) : WGM;
    pm = fm + ((wgid % nig) % gsz); pn = (wgid % nig) / gsz; return true;
}
struct StaticOrder {
    int nM, nN, G, c, ZS;
    __device__ __forceinline__ void init(int M, int N, int G_, int c_, int ZS_ = 1) { nM = M / BM; nN = N / BM; G = G_; c = c_; ZS = ZS_; }
    __device__ __forceinline__ bool next(int i, Unit& u) const {
        if (c < 0) return false;
        const int ti = (ZS == 2) ? (i >> 1) : i; u.z = (ZS == 2) ? (i & 1) : 0;
        return tile_of((long)ti * G + c, nM, nN, u.pm, u.pn);
    }
};

template <class Epi, class Sched, bool ALIGN_EPI = false, bool SP2 = false>
__device__ __forceinline__ void gemm_phase(LAS unsigned char* lds, const Prob g, const Sched& S, const Epi& E) {
    const int tid = threadIdx.x, wid = __builtin_amdgcn_readfirstlane(tid >> 6), lane = tid & 63, wr = wid >> 2, wc = wid & 3, fr = lane & 15, fq = lane >> 4;
    const int K = g.K, nt = K / BK;
    unsigned voffA[2], voffB[2];
#pragma unroll
    for (int i = 0; i < 2; ++i) { int R, C; stage_rc(tid * 16 + i * 8192, R, C); const int Rb = Epi::PERM ? ((R & ~31) + perm32(R & 31)) : R;
        voffA[i] = (unsigned)(R * g.lda + C) * 2u; voffB[i] = (unsigned)(Rb * g.ldb + C) * 2u; }
    const size_t kstep = (size_t)(BK * 2);
    const size_t hstepA = (size_t)HALF * g.lda * 2, hstepB = (size_t)HALF * g.ldb * 2;
    const unsigned ldsw = (unsigned)wid * 1024u;
    const int aoff = lds_byte(wr * 64 + fr, fq * 8), boff = lds_byte(wc * 32 + fr, fq * 8);
#define PG8_SA(b, h) (((b) * 2 + (h)) * HTB)
#define PG8_SB(b, h) ((4 + (b) * 2 + (h)) * HTB)
#define PG8_STAGE(bufoff, gbase, voff) do { _Pragma("unroll") for (int _i = 0; _i < 2; ++_i) \
        __builtin_amdgcn_global_load_lds((const unsigned*)((const char*)(gbase) + (voff)[_i]), (LAS unsigned*)(lds + (bufoff) + ldsw + _i * 8192), 16, 0, 0); } while (0)
#define PG8_LDA(dst, b, h) do { _Pragma("unroll") for (int m = 0; m < 4; ++m) _Pragma("unroll") for (int k = 0; k < 2; ++k) dst[m][k] = *(const LAS bf16x8*)(lds + PG8_SA(b, h) + aoff + m * 2048 + k * 1024); } while (0)
#define PG8_LDB(dst, b, h) do { _Pragma("unroll") for (int n = 0; n < 2; ++n) _Pragma("unroll") for (int k = 0; k < 2; ++k) dst[n][k] = *(const LAS bf16x8*)(lds + PG8_SB(b, h) + boff + n * 2048 + k * 1024); } while (0)
#define PG8_MMA(ai, bj, At, Bt) do { __builtin_amdgcn_s_setprio(1); _Pragma("unroll") for (int m = 0; m < 4; ++m) _Pragma("unroll") for (int n = 0; n < 2; ++n) _Pragma("unroll") for (int k = 0; k < 2; ++k) \
        acc[ai][bj][m][n] = __builtin_amdgcn_mfma_f32_16x16x32_bf16(Bt[n][k], At[m][k], acc[ai][bj][m][n], 0, 0, 0); __builtin_amdgcn_s_setprio(0); } while (0)
#define PG8_WAIT_V(n) asm volatile("s_waitcnt vmcnt(" #n ")" ::: "memory")
#define PG8_WAIT_L(n) asm volatile("s_waitcnt lgkmcnt(" #n ")" ::: "memory")
#define PG8_BAR __builtin_amdgcn_s_barrier()
#define PG8_SCHED __builtin_amdgcn_sched_barrier(0)
    Unit cur, nxt; int ui = 0;
    if (!S.next(0, cur)) return;
    f32x4 acc[2][2][4][2];
#pragma unroll
    for (int a = 0; a < 2; ++a)
#pragma unroll
        for (int b = 0; b < 2; ++b)
#pragma unroll
            for (int m = 0; m < 4; ++m)
#pragma unroll
                for (int n = 0; n < 2; ++n) acc[a][b][m][n] = (f32x4){0.f, 0.f, 0.f, 0.f};
    bf16x8 At[4][2], B0[2][2], B1[2][2];
    const char* cA = g.a_ptr(cur); const char* cB = g.b_ptr(cur);
    if constexpr (SP2) {
        PG8_STAGE(PG8_SB(0, 0), cB, voffB); PG8_STAGE(PG8_SB(0, 1), cB + hstepB, voffB); PG8_STAGE(PG8_SA(0, 0), cA, voffA); PG8_STAGE(PG8_SA(0, 1), cA + hstepA, voffA);
        if (wr == 1) PG8_BAR;
        PG8_WAIT_V(2); PG8_BAR;
        PG8_STAGE(PG8_SB(1, 0), cB + kstep, voffB); PG8_STAGE(PG8_SA(1, 0), cA + kstep, voffA); PG8_STAGE(PG8_SB(1, 1), cB + hstepB + kstep, voffB);
        PG8_WAIT_V(6); PG8_BAR;
    } else {
        PG8_STAGE(PG8_SB(0, 0), cB, voffB); PG8_STAGE(PG8_SA(0, 0), cA, voffA); PG8_STAGE(PG8_SB(0, 1), cB + hstepB, voffB); PG8_STAGE(PG8_SA(0, 1), cA + hstepA, voffA);
        if (wr == 1) PG8_BAR;
        PG8_WAIT_V(4); PG8_BAR;
        PG8_STAGE(PG8_SB(1, 0), cB + kstep, voffB); PG8_STAGE(PG8_SA(1, 0), cA + kstep, voffA); PG8_STAGE(PG8_SB(1, 1), cB + hstepB + kstep, voffB);
        PG8_WAIT_V(6); PG8_BAR;
    }
    for (;;) {
        const bool has_next = S.next(ui + 1, nxt);
        const char* nA = has_next ? g.a_ptr(nxt) : cA; const char* nB = has_next ? g.b_ptr(nxt) : cB;
        for (int t = 0; t < nt; t += 2) {
            const bool last = (t == nt - 2);
            const char* a1 = cA + (size_t)(t + 1) * kstep;
            const char* a2 = last ? nA : cA + (size_t)(t + 2) * kstep; const char* b2 = last ? nB : cB + (size_t)(t + 2) * kstep;
            const char* a3 = a2 + kstep; const char* b3 = b2 + kstep;
            if constexpr (SP2) {
            PG8_LDB(B0, 0, 0); PG8_LDB(B1, 0, 1); PG8_SCHED; PG8_LDA(At, 0, 0); PG8_STAGE(PG8_SA(1, 1), a1 + hstepA, voffA);
            PG8_WAIT_V(8); PG8_WAIT_L(0); PG8_BAR; PG8_MMA(0, 0, At, B0); PG8_MMA(0, 1, At, B1); PG8_BAR; PG8_SCHED;
            PG8_LDA(At, 0, 1); PG8_STAGE(PG8_SB(0, 0), b2, voffB); PG8_STAGE(PG8_SB(0, 1), b2 + hstepB, voffB); PG8_STAGE(PG8_SA(0, 0), a2, voffA);
            PG8_WAIT_V(8); PG8_WAIT_L(0); PG8_BAR; PG8_MMA(1, 0, At, B0); PG8_MMA(1, 1, At, B1); PG8_BAR; PG8_SCHED;
            PG8_LDB(B0, 1, 0); PG8_LDB(B1, 1, 1); PG8_SCHED; PG8_LDA(At, 1, 0); PG8_STAGE(PG8_SA(0, 1), a2 + hstepA, voffA);
            PG8_WAIT_V(8); PG8_WAIT_L(0); PG8_BAR; PG8_MMA(0, 0, At, B0); PG8_MMA(0, 1, At, B1); PG8_BAR; PG8_SCHED;
            PG8_LDA(At, 1, 1); PG8_STAGE(PG8_SB(1, 0), b3, voffB); PG8_STAGE(PG8_SB(1, 1), b3 + hstepB, voffB); PG8_STAGE(PG8_SA(1, 0), a3, voffA);
            PG8_WAIT_V(8); PG8_WAIT_L(0); PG8_BAR; PG8_MMA(1, 0, At, B0); PG8_MMA(1, 1, At, B1); PG8_BAR; PG8_SCHED;
            } else {
            PG8_LDB(B0, 0, 0); PG8_SCHED; PG8_LDA(At, 0, 0); PG8_STAGE(PG8_SA(1, 1), a1 + hstepA, voffA);
            PG8_WAIT_L(8); PG8_BAR; PG8_WAIT_L(0); PG8_MMA(0, 0, At, B0); PG8_BAR; PG8_SCHED;
            PG8_LDB(B1, 0, 1); PG8_STAGE(PG8_SB(0, 0), b2, voffB);
            PG8_BAR; PG8_WAIT_L(0); PG8_MMA(0, 1, At, B1); PG8_BAR;
            PG8_LDA(At, 0, 1); PG8_STAGE(PG8_SA(0, 0), a2, voffA);
            PG8_BAR; PG8_WAIT_L(0); PG8_MMA(1, 0, At, B0); PG8_BAR; PG8_SCHED;
            PG8_STAGE(PG8_SB(0, 1), b2 + hstepB, voffB);
            PG8_WAIT_V(6); PG8_BAR; PG8_MMA(1, 1, At, B1); PG8_BAR;
            PG8_LDB(B0, 1, 0); PG8_SCHED; PG8_LDA(At, 1, 0); PG8_STAGE(PG8_SA(0, 1), a2 + hstepA, voffA);
            PG8_WAIT_L(8); PG8_BAR; PG8_WAIT_L(0); PG8_MMA(0, 0, At, B0); PG8_BAR; PG8_SCHED;
            PG8_LDB(B1, 1, 1); PG8_STAGE(PG8_SB(1, 0), b3, voffB);
            PG8_BAR; PG8_WAIT_L(0); PG8_MMA(0, 1, At, B1); PG8_BAR;
            PG8_LDA(At, 1, 1); PG8_STAGE(PG8_SA(1, 0), a3, voffA);
            PG8_BAR; PG8_WAIT_L(0); PG8_MMA(1, 0, At, B0); PG8_BAR; PG8_SCHED;
            PG8_STAGE(PG8_SB(1, 1), b3 + hstepB, voffB);
            PG8_WAIT_V(6); PG8_BAR; PG8_MMA(1, 1, At, B1); PG8_BAR;
            }
        }
        if constexpr (ALIGN_EPI) { if (wr == 0) PG8_BAR; }
        if constexpr (!Epi::AFTER_DRAIN) { E(acc, cur, wr, wc, fr, fq); }
        if (!has_next) break;
        if (!E.keep(cur)) {
#pragma unroll
        for (int a = 0; a < 2; ++a)
#pragma unroll
            for (int b = 0; b < 2; ++b)
#pragma unroll
                for (int m = 0; m < 4; ++m)
#pragma unroll
                    for (int n = 0; n < 2; ++n) acc[a][b][m][n] = (f32x4){0.f, 0.f, 0.f, 0.f};
        }
        cur = nxt; cA = nA; cB = nB; ++ui;
        if constexpr (ALIGN_EPI) { if (wr == 1) PG8_BAR; }
    }
    PG8_WAIT_V(0);
    if constexpr (!ALIGN_EPI) { if (wr == 0) PG8_BAR; }
    PG8_BAR;
    if constexpr (Epi::AFTER_DRAIN) { E.fused(acc, cur, wr, wc, fr, fq, lds, wid, lane); }
#undef PG8_SA
#undef PG8_SB
#undef PG8_STAGE
#undef PG8_LDA
#undef PG8_LDB
#undef PG8_MMA
#undef PG8_WAIT_V
#undef PG8_WAIT_L
#undef PG8_BAR
#undef PG8_SCHED
}
}

#ifndef PG8_SP2
#define PG8_SP2 true
#endif
#ifndef PG8_ALIGN
#define PG8_ALIGN true
#endif

typedef f32x4 Acc[2][2][4][2];

__device__ __forceinline__ v4u pack8(f32x4 v0, f32x4 v1) { v4u w; w.x = cvt_pk_bf16(v0[0], v0[1]); w.y = cvt_pk_bf16(v0[2], v0[3]); w.z = cvt_pk_bf16(v1[0], v1[1]); w.w = cvt_pk_bf16(v1[2], v1[3]); return w; }
__device__ __forceinline__ void unpack8(v4u w, f32x4& v0, f32x4& v1) { v0 = (f32x4){bf_lo(w.x), bf_hi(w.x), bf_lo(w.y), bf_hi(w.y)}; v1 = (f32x4){bf_lo(w.z), bf_hi(w.z), bf_lo(w.w), bf_hi(w.w)}; }

struct EpiInProj {
    static constexpr bool PERM = true, AFTER_DRAIN = false;
    bf16 *q, *k, *v, *zc, *sgr, *sgc; const float* cs;
    __device__ __forceinline__ bool keep(const pg8::Unit&) const { return false; }
    __device__ __forceinline__ void operator()(Acc& acc, const pg8::Unit& u, int wr, int wc, int fr, int fq) const {
        const int row0 = u.pm * 256 + wr * 64 + fr, ct = wc * 32 + 8 * fq;
        if (u.pn < 5) {
            const bool isq = u.pn < 4; bf16* base = isq ? q + u.pn * 256 : k; const int ld = isq ? AW : KVW; const float sc = isq ? QSCALE : 1.f;
            const bool rl = ((wc & 1) == 0) && (fq < 2);
#pragma unroll
            for (int ai = 0; ai < 2; ++ai)
#pragma unroll
                for (int m = 0; m < 4; ++m) { const int row = row0 + ai * 128 + m * 16;
                    f32x4 c4 = (f32x4){1.f, 1.f, 1.f, 1.f}, s4 = (f32x4){0.f, 0.f, 0.f, 0.f};
                    if (rl) { c4 = *(const f32x4*)(cs + (size_t)row * 16 + 4 * fq); s4 = *(const f32x4*)(cs + (size_t)row * 16 + 8 + 4 * fq); }
#pragma unroll
                    for (int bj = 0; bj < 2; ++bj) { const f32x4 t1 = acc[ai][bj][m][0], t2 = acc[ai][bj][m][1];
                        const f32x4 v0 = (t1 * c4 - t2 * s4) * sc, v1 = (t2 * c4 + t1 * s4) * sc;
                        *(v4u*)(base + (size_t)row * ld + bj * 128 + ct) = pack8(v0, v1); } }
        } else if (u.pn < 18) {
            bf16* base = (u.pn == 5) ? v : zc + (u.pn - 6) * 256; const int ld = (u.pn == 5) ? KVW : 3 * CW;
#pragma unroll
            for (int ai = 0; ai < 2; ++ai)
#pragma unroll
                for (int m = 0; m < 4; ++m) { const int row = row0 + ai * 128 + m * 16;
#pragma unroll
                    for (int bj = 0; bj < 2; ++bj) *(v4u*)(base + (size_t)row * ld + bj * 128 + ct) = pack8(acc[ai][bj][m][0], acc[ai][bj][m][1]); }
        } else {
            const int t = u.pn - 18;
#pragma unroll
            for (int ai = 0; ai < 2; ++ai)
#pragma unroll
                for (int m = 0; m < 4; ++m) { const int row = row0 + ai * 128 + m * 16; f32x4 rr[2], ss[2];
#pragma unroll
                    for (int n = 0; n < 2; ++n)
#pragma unroll
                        for (int e = 0; e < 4; ++e) { const float ga = acc[ai][0][m][n][e], gc = acc[ai][1][m][n][e];
                            const float ea = fast_exp2(fminf(-ga * LOG2E, 80.f)), ec = fast_exp2(fminf(-gc * LOG2E, 80.f));
                            const float ia = fast_rcp(1.f + ea), ic = fast_rcp(1.f + ec);
                            rr[n][e] = (1.f + ec) * ia; ss[n][e] = ic; }
                    *(v4u*)(sgr + (size_t)row * DM + t * 128 + ct) = pack8(rr[0], rr[1]);
                    *(v4u*)(sgc + (size_t)row * DM + t * 128 + ct) = pack8(ss[0], ss[1]); }
        }
    }
};
struct EpiStoreBf16 {
    static constexpr bool PERM = true, AFTER_DRAIN = false;
    bf16* O; int ldc;
    __device__ __forceinline__ bool keep(const pg8::Unit&) const { return false; }
    __device__ __forceinline__ void operator()(Acc& acc, const pg8::Unit& u, int wr, int wc, int fr, int fq) const {
        const int row0 = u.pm * 256 + wr * 64 + fr, col0 = u.pn * 256 + wc * 32 + 8 * fq;
#pragma unroll
        for (int ai = 0; ai < 2; ++ai)
#pragma unroll
            for (int m = 0; m < 4; ++m) { const int row = row0 + ai * 128 + m * 16;
#pragma unroll
                for (int bj = 0; bj < 2; ++bj) *(v4u*)(O + (size_t)row * ldc + col0 + bj * 128) = pack8(acc[ai][bj][m][0], acc[ai][bj][m][1]); }
    }
};
struct EpiMerge {
    static constexpr bool PERM = true, AFTER_DRAIN = false;
    const bf16 *sgr, *sgc; bf16* merged;
    __device__ __forceinline__ bool keep(const pg8::Unit& u) const { return u.z == 0; }
    __device__ __forceinline__ void operator()(Acc& acc, const pg8::Unit& u, int wr, int wc, int fr, int fq) const {
        const int row0 = u.pm * 256 + wr * 64 + fr, col0 = u.pn * 256 + wc * 32 + 8 * fq;
        const bf16* gsrc = (u.z == 0) ? sgr : sgc;
#pragma unroll
        for (int ai = 0; ai < 2; ++ai)
#pragma unroll
            for (int m = 0; m < 4; ++m) { const int row = row0 + ai * 128 + m * 16;
#pragma unroll
                for (int bj = 0; bj < 2; ++bj) { const v4u w = *(const v4u*)(gsrc + (size_t)row * DM + col0 + bj * 128); f32x4 g0, g1; unpack8(w, g0, g1);
                    const f32x4 v0 = acc[ai][bj][m][0] * g0, v1 = acc[ai][bj][m][1] * g1;
                    if (u.z == 0) { acc[ai][bj][m][0] = v0; acc[ai][bj][m][1] = v1; }
                    else *(v4u*)(merged + (size_t)row * DM + col0 + bj * 128) = pack8(v0, v1); } }
    }
};
struct EpiResid {
    static constexpr bool PERM = true, AFTER_DRAIN = false;
    const float* base; float* outf; bf16* outb; float* ss;
    __device__ __forceinline__ bool keep(const pg8::Unit&) const { return false; }
    __device__ __forceinline__ void operator()(Acc& acc, const pg8::Unit& u, int wr, int wc, int fr, int fq) const {
        const int row0 = u.pm * 256 + wr * 64 + fr, col0 = u.pn * 256 + wc * 32 + 8 * fq;
#pragma unroll
        for (int ai = 0; ai < 2; ++ai)
#pragma unroll
            for (int m = 0; m < 4; ++m) { const int row = row0 + ai * 128 + m * 16; float sq = 0.f;
#pragma unroll
                for (int bj = 0; bj < 2; ++bj) { const size_t off = (size_t)row * DM + col0 + bj * 128;
                    const f32x4 b0 = *(const f32x4*)(base + off), b1 = *(const f32x4*)(base + off + 4);
                    const f32x4 v0 = acc[ai][bj][m][0] + b0, v1 = acc[ai][bj][m][1] + b1;
                    *(f32x4*)(outf + off) = v0; *(f32x4*)(outf + off + 4) = v1;
                    if (outb) *(v4u*)(outb + off) = pack8(v0, v1);
                    sq += (v0[0] * v0[0] + v0[1] * v0[1]) + (v0[2] * v0[2] + v0[3] * v0[3]) + (v1[0] * v1[0] + v1[1] * v1[1]) + (v1[2] * v1[2] + v1[3] * v1[3]); }
                sq += __shfl_xor(sq, 16); sq += __shfl_xor(sq, 32);
                if (fq == 0) atomicAdd(ss + row, sq);
                asm volatile("" ::: "memory"); }
    }
};
struct EpiSoftmax {
    static constexpr bool PERM = true, AFTER_DRAIN = true;
    const float* ss; bf16* P;
    __device__ __forceinline__ bool keep(const pg8::Unit&) const { return false; }
    __device__ __forceinline__ void fused(Acc& acc, const pg8::Unit& u, int wr, int wc, int fr, int fq, LAS unsigned char* lds, int wid, int lane) const {
        LAS float* Pm = (LAS float*)lds; LAS float* Ps = (LAS float*)(lds + 4096);
        const int rl0 = wr * 64 + fr, col0 = u.pn * 256 + wc * 32 + 8 * fq;
#pragma unroll
        for (int ai = 0; ai < 2; ++ai)
#pragma unroll
            for (int m = 0; m < 4; ++m) { const int rl = rl0 + ai * 128 + m * 16; const float rs = 1.0f / sqrtf(ss[u.pm * 256 + rl] * (1.0f / DM) + EPS); float mx = -3.0e38f;
#pragma unroll
                for (int bj = 0; bj < 2; ++bj)
#pragma unroll
                    for (int n = 0; n < 2; ++n) { f32x4 s = acc[ai][bj][m][n] * rs; acc[ai][bj][m][n] = s; mx = fmaxf(mx, fmaxf(fmaxf(s[0], s[1]), fmaxf(s[2], s[3]))); }
                mx = fmaxf(mx, __shfl_xor(mx, 16)); mx = fmaxf(mx, __shfl_xor(mx, 32));
                if (fq == 0) Pm[rl * 4 + wc] = mx; }
        asm volatile("s_waitcnt lgkmcnt(0)" ::: "memory"); __builtin_amdgcn_s_barrier(); asm volatile("" ::: "memory");
#pragma unroll
        for (int ai = 0; ai < 2; ++ai)
#pragma unroll
            for (int m = 0; m < 4; ++m) { const int rl = rl0 + ai * 128 + m * 16; const f32x4 pm4 = *(const LAS f32x4*)(Pm + rl * 4);
                const float mx = fmaxf(fmaxf(pm4[0], pm4[1]), fmaxf(pm4[2], pm4[3])); float sm = 0.f;
#pragma unroll
                for (int bj = 0; bj < 2; ++bj)
#pragma unroll
                    for (int n = 0; n < 2; ++n) { f32x4 s = acc[ai][bj][m][n];
#pragma unroll
                        for (int e = 0; e < 4; ++e) { s[e] = fast_exp2(s[e] - mx); sm += s[e]; }
                        acc[ai][bj][m][n] = s; }
                sm += __shfl_xor(sm, 16); sm += __shfl_xor(sm, 32);
                if (fq == 0) Ps[rl * 4 + wc] = sm; }
        asm volatile("s_waitcnt lgkmcnt(0)" ::: "memory"); __builtin_amdgcn_s_barrier(); asm volatile("" ::: "memory");
#pragma unroll
        for (int ai = 0; ai < 2; ++ai)
#pragma unroll
            for (int m = 0; m < 4; ++m) { const int rl = rl0 + ai * 128 + m * 16; const f32x4 ps4 = *(const LAS f32x4*)(Ps + rl * 4);
                const float inv = 1.0f / ((ps4[0] + ps4[1]) + (ps4[2] + ps4[3])); const size_t rowoff = (size_t)(u.pm * 256 + rl) * (4 * NMEM) + col0;
#pragma unroll
                for (int bj = 0; bj < 2; ++bj) *(v4u*)(P + rowoff + bj * 128) = pack8(acc[ai][bj][m][0] * inv, acc[ai][bj][m][1] * inv); }
    }
};
struct EpiSwiGLU {
    static constexpr bool PERM = true, AFTER_DRAIN = false;
    const float* ss; bf16* act;
    __device__ __forceinline__ bool keep(const pg8::Unit&) const { return false; }
    __device__ __forceinline__ void operator()(Acc& acc, const pg8::Unit& u, int wr, int wc, int fr, int fq) const {
        const int row0 = u.pm * 256 + wr * 64 + fr, col0 = u.pn * 128 + wc * 32 + 8 * fq;
#pragma unroll
        for (int ai = 0; ai < 2; ++ai)
#pragma unroll
            for (int m = 0; m < 4; ++m) { const int row = row0 + ai * 128 + m * 16; const float rs = 1.0f / sqrtf(ss[row] * (1.0f / DM) + EPS); f32x4 o[2];
#pragma unroll
                for (int n = 0; n < 2; ++n)
#pragma unroll
                    for (int e = 0; e < 4; ++e) { const float gv = acc[ai][0][m][n][e] * rs, uv = acc[ai][1][m][n][e] * rs;
                        o[n][e] = gv * uv * fast_rcp(1.f + fast_exp2(fminf(-gv * LOG2E, 80.f))); }
                *(v4u*)(act + (size_t)row * DFF + col0) = pack8(o[0], o[1]); }
    }
};

#define XB_TMO      128
#define XB_XCNT(j)  (256  + 64 * (j))
#define XB_XSUB(j)  (1280 + 64 * (j))
#define XB_XGEN(j)  (2304 + 64 * (j))
#define XB_TOP      3328
#define XB_TOPGEN   3392
#define XCD_BAR_WORDS 3456
#define XB_SPIN_CAP (1u << 18)

__device__ __forceinline__ unsigned xb_ld(unsigned* p)              { return __hip_atomic_load(p, __ATOMIC_RELAXED, __HIP_MEMORY_SCOPE_AGENT); }
__device__ __forceinline__ unsigned xb_add(unsigned* p, unsigned v) { return __hip_atomic_fetch_add(p, v, __ATOMIC_RELAXED, __HIP_MEMORY_SCOPE_AGENT); }
__device__ __forceinline__ unsigned xb_xcc_id() { return (unsigned)__builtin_amdgcn_s_getreg((3 << 11) | 20) & 0xFu; }
#define XB_SPIN(cond, bar) do { unsigned _sp = 0; while (cond) { __builtin_amdgcn_s_sleep(1); \
    if ((++_sp & 255u) == 0u) { if (xb_ld(&(bar)[XB_TMO])) break; if (_sp > XB_SPIN_CAP) { atomicAdd(&(bar)[XB_TMO], 1u); break; } } } } while (0)

struct XcdBarrier { unsigned* bar; unsigned x; volatile LAS unsigned* st; };

__device__ __forceinline__ XcdBarrier xcd_barrier_post(unsigned* bar, volatile LAS unsigned* st) {
    XcdBarrier b; b.bar = bar; b.x = xb_xcc_id(); b.st = st;
    if (threadIdx.x == 0) (void)xb_add(&bar[XB_XCNT(b.x)], 1u);
    return b;
}
__device__ __forceinline__ void xcd_barrier_complete(unsigned* bar, unsigned x, unsigned& nloc, unsigned& nx) {
    const unsigned G = gridDim.x * gridDim.y * gridDim.z;
    unsigned sum, cnt, mine, sp = 0u;
    for (;;) {
        sum = 0u; cnt = 0u; mine = 0u;
#pragma unroll
        for (unsigned j = 0; j < 16; ++j) { const unsigned c = xb_ld(&bar[XB_XCNT(j)]); sum += c; cnt += (c > 0u) ? 1u : 0u; mine = (j == x) ? c : mine; }
        if (sum == G) break;
        __builtin_amdgcn_s_sleep(1);
        if ((++sp & 255u) == 0u) { if (xb_ld(&bar[XB_TMO])) break; if (sp > XB_SPIN_CAP) { atomicAdd(&bar[XB_TMO], 1u); break; } }
    }
    nloc = mine > 0u ? mine : 1u; nx = cnt > 0u ? cnt : 1u;
}
__device__ __forceinline__ void xcd_barrier(const XcdBarrier& b) {
    asm volatile("s_waitcnt vmcnt(0)" ::: "memory");
    __syncthreads();
    if (threadIdx.x == 0) {
        unsigned* bar = b.bar;
        __builtin_amdgcn_s_waitcnt(0);
        unsigned nloc = b.st[0], nx = b.st[1];
        if (nloc == 0u) { xcd_barrier_complete(bar, b.x, nloc, nx); b.st[0] = nloc; b.st[1] = nx; }
        const unsigned old = xb_add(&bar[XB_XSUB(b.x)], 1u);
        const unsigned gen = old / nloc;
        if (old + 1u == (gen + 1u) * nloc) {
            __builtin_amdgcn_fence(__ATOMIC_RELEASE, "agent");
            asm volatile("s_waitcnt vmcnt(0)" ::: "memory");
            const unsigned og = xb_add(&bar[XB_TOP], 1u);
            const unsigned tg = og / nx;
            if (og + 1u == (tg + 1u) * nx) xb_add(&bar[XB_TOPGEN], 1u);
            else XB_SPIN(xb_ld(&bar[XB_TOPGEN]) == tg, bar);
            __builtin_amdgcn_fence(__ATOMIC_ACQUIRE, "agent");
            xb_add(&bar[XB_XGEN(b.x)], 1u);
            asm volatile("s_waitcnt vmcnt(0)" ::: "memory");
        } else {
            XB_SPIN(xb_ld(&bar[XB_XGEN(b.x)]) == gen, bar);
            __builtin_amdgcn_fence(__ATOMIC_ACQUIRE, "agent");
            asm volatile("s_waitcnt vmcnt(0)" ::: "memory");
        }
    }
    __syncthreads();
}

__device__ __forceinline__ float wave_sum(float v) {
#pragma unroll
    for (int o = 1; o < 64; o <<= 1) v += __shfl_xor(v, o);
    return v;
}
__device__ __forceinline__ int rope_sigma(int p) { return (p < 16) ? ((p & 3) + 4 * ((p >> 3) & 1) + 8 * ((p >> 2) & 1)) : p; }
__device__ __forceinline__ void p0_transpose_item(const float* W, int ldw, int src_col0, int k0, bf16* dst, int ldd, int dst_row0, int dst_col0,
                                                  const float* kscale, bool perm, LAS float* scr, int lane) {
#pragma unroll 8
    for (int i = 0; i < 32; ++i) { const int kk = 2 * i + (lane >> 5); scr[kk * 33 + (lane & 31)] = W[(size_t)(k0 + kk) * ldw + src_col0 + (lane & 31)]; }
    LDS_WAIT(); asm volatile("" ::: "memory");
    const int c = lane & 7;
    float sc[8];
#pragma unroll
    for (int i = 0; i < 8; ++i) sc[i] = kscale ? kscale[k0 + 8 * c + i] : 1.f;
#pragma unroll
    for (int j = 0; j < 4; ++j) { const int nd = (lane >> 3) + 8 * j; const int scol = perm ? rope_sigma(nd) : nd; const LAS float* s = scr + (8 * c) * 33 + scol;
        v4u o; o.x = cvt_pk_bf16(s[0 * 33] * sc[0], s[1 * 33] * sc[1]); o.y = cvt_pk_bf16(s[2 * 33] * sc[2], s[3 * 33] * sc[3]);
        o.z = cvt_pk_bf16(s[4 * 33] * sc[4], s[5 * 33] * sc[5]); o.w = cvt_pk_bf16(s[6 * 33] * sc[6], s[7 * 33] * sc[7]);
        *(v4u*)(dst + (size_t)(dst_row0 + nd) * ldd + dst_col0 + k0 + 8 * c) = o; }
    LDS_WAIT(); asm volatile("" ::: "memory");
}
__device__ __forceinline__ void rms_row_to_bf16(const float* xrow, const float* g, bf16* orow, int lane) {
    const f32x4* xr = (const f32x4*)xrow + lane; const f32x4* gr = (const f32x4*)g + lane;
    f32x4 v[8]; float s = 0.f;
#pragma unroll
    for (int j = 0; j < 8; ++j) { v[j] = xr[64 * j]; s += (v[j].x * v[j].x + v[j].y * v[j].y) + (v[j].z * v[j].z + v[j].w * v[j].w); }
    const float rstd = 1.0f / sqrtf(wave_sum(s) * (1.0f / DM) + EPS);
    v2u* o8 = (v2u*)orow + lane;
#pragma unroll
    for (int j = 0; j < 8; ++j) { const f32x4 gg = gr[64 * j]; v2u w; w.x = cvt_pk_bf16(v[j].x * rstd * gg.x, v[j].y * rstd * gg.y); w.y = cvt_pk_bf16(v[j].z * rstd * gg.z, v[j].w * rstd * gg.w); o8[64 * j] = w; }
}

__device__ __forceinline__ s16x4 vtr(const LAS unsigned char* p) { typedef short v4i16_t __attribute__((ext_vector_type(4))); return __builtin_bit_cast(s16x4, __builtin_amdgcn_ds_read_tr16_b64_v4i16((LAS v4i16_t*)p)); }

__device__ __forceinline__ void swa_unit(LAS unsigned char* lds, int n, int g, const bf16* qb, const bf16* kb, const bf16* vb, const float* sinks, bf16* A2, int tid, int lane, int wave) {
    LAS unsigned char* Kl = lds; LAS unsigned char* Vl = lds + 32768;
#pragma unroll
    for (int i = 0; i < 4; ++i) { const int id = tid + 512 * i, row = id >> 3, ch = id & 7; const int tok = (n - 1) * 128 + row;
        v4u kv = (v4u){0u, 0u, 0u, 0u}, vv = (v4u){0u, 0u, 0u, 0u};
        if (tok >= 0) { kv = *(const v4u*)(kb + (size_t)tok * KVW + g * 64 + ch * 8); vv = *(const v4u*)(vb + (size_t)tok * KVW + g * 64 + ch * 8); }
        *(LAS v4u*)(Kl + row * 128 + ((ch ^ ((row >> 1) & 7)) << 4)) = kv;
        *(LAS v4u*)(Vl + row * 128 + ((ch ^ (((row >> 1) & 1) << 2)) << 4)) = vv; }
    __syncthreads();
    const int ql = lane & 31, h = lane >> 5, hq = g * 4 + (wave & 3);
    const float sinkl = sinks[hq] * LOG2E;
    const int li = lane & 15, qp = li >> 2, pp = li & 3, g1 = (lane >> 4) & 1;
    const float NEG = -__builtin_inff();
#pragma unroll 1
    for (int st = 0; st < 2; ++st) {
        const int r0 = (wave >> 2) * 64 + 32 * st; const size_t tok = (size_t)n * 128 + r0 + ql;
        bf16x8 qf[4];
#pragma unroll
        for (int ks = 0; ks < 4; ++ks) qf[ks] = *(const bf16x8*)(qb + tok * AW + hq * 64 + 16 * ks + 8 * h);
        f32x16 S[5];
#pragma unroll
        for (int t = 0; t < 5; ++t) { const int c = r0 + 32 * t + ql; S[t] = (f32x16){};
#pragma unroll
            for (int ks = 0; ks < 4; ++ks) { const bf16x8 kf = *(const LAS bf16x8*)(Kl + c * 128 + (((2 * ks + h) ^ ((c >> 1) & 7)) << 4));
                S[t] = __builtin_amdgcn_mfma_f32_32x32x16_bf16(kf, qf[ks], S[t], 0, 0, 0); } }
#pragma unroll
        for (int r = 0; r < 16; ++r) { const int cc = (r & 3) + 8 * (r >> 2) + 4 * h; if (!(cc > ql)) S[0][r] = NEG; if (!(cc <= ql)) S[4][r] = NEG; }
        if (n == 0) {
#pragma unroll
            for (int t = 0; t < 5; ++t)
#pragma unroll
                for (int r = 0; r < 16; ++r) { const int cc = (r & 3) + 8 * (r >> 2) + 4 * h; if (r0 + 32 * t + cc < 128) S[t][r] = NEG; } }
        float mx = sinkl;
#pragma unroll
        for (int t = 0; t < 5; ++t)
#pragma unroll
            for (int r = 0; r < 16; ++r) mx = fmaxf(mx, S[t][r]);
        mx = fmaxf(mx, __shfl_xor(mx, 32));
        float l = 0.f;
#pragma unroll
        for (int t = 0; t < 5; ++t)
#pragma unroll
            for (int r = 0; r < 16; ++r) { const float p = fast_exp2(S[t][r] - mx); S[t][r] = p; l += p; }
        l += __shfl_xor(l, 32); l += fast_exp2(sinkl - mx);
        f32x16 O[2]; O[0] = (f32x16){}; O[1] = (f32x16){};
#pragma unroll
        for (int t = 0; t < 5; ++t)
#pragma unroll
            for (int s = 0; s < 2; ++s) {
                v4u pw; pw.x = cvt_pk_bf16(S[t][8 * s + 0], S[t][8 * s + 1]); pw.y = cvt_pk_bf16(S[t][8 * s + 2], S[t][8 * s + 3]);
                pw.z = cvt_pk_bf16(S[t][8 * s + 4], S[t][8 * s + 5]); pw.w = cvt_pk_bf16(S[t][8 * s + 6], S[t][8 * s + 7]);
                const bf16x8 pf = __builtin_bit_cast(bf16x8, pw);
                const int krow = r0 + 32 * t + 16 * s + 4 * h + qp;
#pragma unroll
                for (int db = 0; db < 2; ++db) { const int chunk = (4 * db + 2 * g1 + (pp >> 1)) ^ (((qp >> 1) & 1) << 2);
                    const LAS unsigned char* va = Vl + krow * 128 + (chunk << 4) + (pp & 1) * 8;
                    const s16x4 lo = vtr(va), hi = vtr(va + 8 * 128);
                    const bf16x8 vf = (bf16x8){lo[0], lo[1], lo[2], lo[3], hi[0], hi[1], hi[2], hi[3]};
                    O[db] = __builtin_amdgcn_mfma_f32_32x32x16_bf16(vf, pf, O[db], 0, 0, 0); } }
        const float inv = 1.0f / l;
#pragma unroll
        for (int db = 0; db < 2; ++db)
#pragma unroll
            for (int rq = 0; rq < 4; ++rq) { v2u w; w.x = cvt_pk_bf16(O[db][4 * rq + 0] * inv, O[db][4 * rq + 1] * inv); w.y = cvt_pk_bf16(O[db][4 * rq + 2] * inv, O[db][4 * rq + 3] * inv);
                *(v2u*)(A2 + tok * DM + hq * 64 + 32 * db + 8 * rq + 4 * h) = w; }
    }
    __syncthreads();
}
__device__ __forceinline__ void wave_gemm_64x32_k128(const bf16* A, int lda, const bf16* Bt, int ldb, bf16* C, int ldc, int lane) {
    const int fr = lane & 15, fq = lane >> 4;
    f32x4 acc[4][2];
#pragma unroll
    for (int mi = 0; mi < 4; ++mi)
#pragma unroll
        for (int ni = 0; ni < 2; ++ni) acc[mi][ni] = (f32x4){0.f, 0.f, 0.f, 0.f};
#pragma unroll
    for (int ks = 0; ks < 4; ++ks) { bf16x8 a[4], b[2];
#pragma unroll
        for (int mi = 0; mi < 4; ++mi) a[mi] = *(const bf16x8*)(A + (size_t)(16 * mi + fr) * lda + 32 * ks + 8 * fq);
#pragma unroll
        for (int ni = 0; ni < 2; ++ni) b[ni] = *(const bf16x8*)(Bt + (size_t)(16 * ni + fr) * ldb + 32 * ks + 8 * fq);
#pragma unroll
        for (int mi = 0; mi < 4; ++mi)
#pragma unroll
            for (int ni = 0; ni < 2; ++ni) acc[mi][ni] = __builtin_amdgcn_mfma_f32_16x16x32_bf16(b[ni], a[mi], acc[mi][ni], 0, 0, 0); }
#pragma unroll
    for (int mi = 0; mi < 4; ++mi)
#pragma unroll
        for (int ni = 0; ni < 2; ++ni) { v2u w; w.x = cvt_pk_bf16(acc[mi][ni][0], acc[mi][ni][1]); w.y = cvt_pk_bf16(acc[mi][ni][2], acc[mi][ni][3]);
            *(v2u*)(C + (size_t)(16 * mi + fr) * ldc + 16 * ni + 4 * fq) = w; }
}

constexpr int NPHASE = 10;
struct Args { const float* in[18]; float* out; unsigned char* ws; int ph_lo, ph_hi, li, pad; };

__global__ void __launch_bounds__(512, 2) hyb_fwd(Args args) {
    extern __shared__ __attribute__((aligned(16))) unsigned char lds_raw[];
    LAS unsigned char* lds = (LAS unsigned char*)lds_raw;
    volatile LAS unsigned* MISC = (volatile LAS unsigned*)(lds + MISC_OFF);
    const int tid = threadIdx.x, lane = tid & 63, wave = __builtin_amdgcn_readfirstlane(tid >> 6);
    const int G = gridDim.x, bx = blockIdx.x;
    unsigned char* ws = args.ws;
    unsigned* ctl = (unsigned*)(ws + WS_CTL);
    const float* x = args.in[0]; const float* mem = args.in[1]; const float* g_mix = args.in[2]; const float* w_in = args.in[3]; const float* conv_w = args.in[4];
    const float* sinks = args.in[5]; const float* w_attn_o = args.in[6]; const float* w_conv_o = args.in[7]; const float* w_out = args.in[8]; const float* g_xattn = args.in[9];
    const float* g_mem = args.in[10]; const float* w_xq = args.in[11]; const float* w_xkv = args.in[12]; const float* w_xo = args.in[13]; const float* g_ffn = args.in[14];
    const float* w_gate_up = args.in[15]; const float* w_down = args.in[16]; const float* g_final = args.in[17];
    float* out = args.out;
    float* ss1 = (float*)(ws + WS_SS); float* ss2 = ss1 + SEQ; float* ss3 = ss2 + SEQ;
    float* cs = (float*)(ws + WS_CS);
    bf16* kvb = (bf16*)(ws + WS_KVB); bf16* memn = (bf16*)(ws + WS_MEMN); bf16* wxqp = (bf16*)(ws + WS_WXQ); bf16* wxot = (bf16*)(ws + WS_WXOT);
    bf16* WguT = (bf16*)(ws + WS_WGUT); bf16* WdT = (bf16*)(ws + WS_WDT); bf16* XN = (bf16*)(ws + WS_XN); float* H = (float*)(ws + WS_H);
    bf16* WinT = (bf16*)(ws + WS_WINT); bf16* WacT = (bf16*)(ws + WS_WACT); bf16* WoutT = (bf16*)(ws + WS_WOUTT); bf16* WxkvT = (bf16*)(ws + WS_WXKVT);
    bf16* WqKT = (bf16*)(ws + WS_WQKT); bf16* VWoT = (bf16*)(ws + WS_VWOT);
    bf16* qb = (bf16*)(ws + WS_Q); bf16* kb = (bf16*)(ws + WS_K); bf16* vb = (bf16*)(ws + WS_V); bf16* zc = (bf16*)(ws + WS_ZC);
    bf16* merged = (bf16*)(ws + WS_MERGED); bf16* Pb = (bf16*)(ws + WS_P); bf16* act = (bf16*)(ws + WS_ACT);
    bf16* sgr = (bf16*)out; bf16* sgc = sgr + (size_t)SEQ * DM;

    for (int u = tid; u < (LDS_BYTES - LDSCTL_OFF) / 4; u += 512) ((LAS unsigned*)(lds + LDSCTL_OFF))[u] = 0u;
    __syncthreads();
    XcdBarrier bar; bar.bar = ctl + CW_BAR; bar.x = 0; bar.st = nullptr;
    if (MK_N_LAUNCHES == 1) bar = xcd_barrier_post(ctl + CW_BAR, MISC + 8);
    const int lo = args.ph_lo, hi = args.ph_hi;
#define IN(k) (lo <= (k) && (k) < hi)
#define SEAM(k) do { if (IN(k) && IN((k) + 1)) xcd_barrier(bar); } while (0)

    if (IN(0)) {
        LAS float* scr = (LAS float*)(lds + wave * 16384);
        const int gw = bx * 8 + wave, NGW = G * 8;
        constexpr int I0 = 32 * 272, I1 = 16 * 64, I2 = 16 * 64, I3 = 32 * 64, I4 = 32 * 32, I5 = 32 * 352, I6 = 88 * 64, I7 = 8 * 64;
        constexpr int NITEMS = I0 + I1 + I2 + I3 + I4 + I5 + I6 + I7;
        for (int it = gw; it < NITEMS; it += NGW) {
            int r = it;
            if (r < I0) { const int kb_ = r / 272, Gp = r % 272; int src; bool perm = false;
                if (Gp < 40) { src = 32 * Gp; perm = (Gp & 1) == 0; }
                else if (Gp < 144) { src = 32 * Gp; }
                else { const int gg = Gp - 144, t = gg >> 3, i32 = gg & 7; src = (i32 < 4) ? (4608 + 128 * t + 32 * i32) : (6656 + 128 * t + 32 * (i32 - 4)); }
                p0_transpose_item(w_in, NIN, src, 64 * kb_, WinT, DM, 32 * Gp, 0, nullptr, perm, scr, lane); continue; } r -= I0;
            if (r < I1) { const int kb_ = r / 64, Gp = r % 64; p0_transpose_item(w_attn_o, DM, 32 * Gp, 64 * kb_, WacT, DM, 32 * Gp, 0, nullptr, false, scr, lane); continue; } r -= I1;
            if (r < I2) { const int kb_ = r / 64, Gp = r % 64; p0_transpose_item(w_conv_o, DM, 32 * Gp, 64 * kb_, WacT, DM, 32 * Gp, 1024, nullptr, false, scr, lane); continue; } r -= I2;
            if (r < I3) { const int kb_ = r / 64, Gp = r % 64; p0_transpose_item(w_out, DM, 32 * Gp, 64 * kb_, WoutT, DM, 32 * Gp, 0, nullptr, false, scr, lane); continue; } r -= I3;
            if (r < I4) { const int kb_ = r / 32, Gp = r % 32; p0_transpose_item(w_xkv, 2 * XW, 32 * Gp, 64 * kb_, WxkvT, DM, 32 * Gp, 0, nullptr, false, scr, lane); continue; } r -= I4;
            if (r < I5) { const int kb_ = r / 352, Gp = r % 352; const int t = Gp >> 3, i32 = Gp & 7; const int src = (i32 < 4) ? (128 * t + 32 * i32) : (DFF + 128 * t + 32 * (i32 - 4));
                p0_transpose_item(w_gate_up, 2 * DFF, src, 64 * kb_, WguT, DM, 32 * Gp, 0, g_ffn, false, scr, lane); continue; } r -= I5;
            if (r < I6) { const int kb_ = r / 64, Gp = r % 64; p0_transpose_item(w_down, DM, 32 * Gp, 64 * kb_, WdT, DFF, 32 * Gp, 0, nullptr, false, scr, lane); continue; } r -= I6;
            { const int kb_ = r / 64, Gp = r % 64; p0_transpose_item(w_xo, DM, 32 * Gp, 64 * kb_, wxot, XW, 32 * Gp, 0, nullptr, false, scr, lane); }
        }
        for (int m = gw; m < SEQ; m += NGW) rms_row_to_bf16(x + (size_t)m * DM, g_mix, XN + (size_t)m * DM, lane);
        for (int m = gw; m < NMEM; m += NGW) rms_row_to_bf16(mem + (size_t)m * DM, g_mem, memn + (size_t)m * DM, lane);
        for (int k = gw; k < DM; k += NGW) { const float gs = g_xattn[k] * C2X; const f32x4* src = (const f32x4*)(w_xq + (size_t)k * XW) + lane; v2u* dst = (v2u*)(wxqp + (size_t)k * XW) + lane;
#pragma unroll
            for (int j = 0; j < 2; ++j) { const f32x4 v = src[64 * j]; v2u w; w.x = cvt_pk_bf16(v.x * gs, v.y * gs); w.y = cvt_pk_bf16(v.z * gs, v.w * gs); dst[64 * j] = w; } }
        const int gt = bx * 512 + tid, NGT = G * 512;
        for (int e = gt; e < SEQ * 8; e += NGT) { const int pos = e >> 3, i = e & 7; const float inv_freq = (float)pow(500000.0, -(double)i / 8.0); const float ang = (float)pos * inv_freq;
            cs[(size_t)pos * 16 + i] = (float)cos((double)ang); cs[(size_t)pos * 16 + 8 + i] = (float)sin((double)ang); }
        for (int e = gt; e < 3 * SEQ; e += NGT) ss1[e] = 0.f;
    }
    SEAM(0);

    if (IN(1)) {
        { pg8::Prob g{XN, WinT, DM, DM, DM, 0}; pg8::StaticOrder S; S.init(SEQ, NIN, G, bx);
          EpiInProj E{qb, kb, vb, zc, sgr, sgc, cs};
          pg8::gemm_phase<EpiInProj, pg8::StaticOrder, PG8_ALIGN, PG8_SP2>(lds, g, S, E); }
        { pg8::Prob g{memn, WxkvT, DM, DM, DM, 0}; pg8::StaticOrder S; S.init(NMEM, 2 * XW, G, (bx >= 128 && bx < 132) ? bx - 128 : -1);
          EpiStoreBf16 E{kvb, 2 * XW};
          pg8::gemm_phase<EpiStoreBf16, pg8::StaticOrder, PG8_ALIGN, PG8_SP2>(lds, g, S, E); }
    }
    SEAM(1);

    if (IN(2)) {
        for (int u = bx; u < (SEQ / 128) * 4; u += G) swa_unit(lds, u >> 2, u & 3, qb, kb, vb, sinks, XN, tid, lane, wave);
        for (int ch = bx; ch < SEQ / 64; ch += G) { const int cg = tid & 127, tg = tid >> 7; const int ts = ch * 64 + tg * 16;
            f32x4 w0[2], w1[2], w2[2];
#pragma unroll
            for (int j = 0; j < 2; ++j) { w0[j] = *(const f32x4*)(conv_w + 8 * cg + 4 * j); w1[j] = *(const f32x4*)(conv_w + CW + 8 * cg + 4 * j); w2[j] = *(const f32x4*)(conv_w + 2 * CW + 8 * cg + 4 * j); }
            f32x4 p2[2], p1[2];
#pragma unroll
            for (int j = 0; j < 2; ++j) { p2[j] = (f32x4){0.f, 0.f, 0.f, 0.f}; p1[j] = p2[j]; }
            if (ts >= 2) { f32x4 a0, a1, b0, b1; unpack8(*(const v4u*)(zc + (size_t)(ts - 2) * (3 * CW) + CW + 8 * cg), a0, a1); unpack8(*(const v4u*)(zc + (size_t)(ts - 2) * (3 * CW) + 2 * CW + 8 * cg), b0, b1); p2[0] = a0 * b0; p2[1] = a1 * b1;
                           unpack8(*(const v4u*)(zc + (size_t)(ts - 1) * (3 * CW) + CW + 8 * cg), a0, a1); unpack8(*(const v4u*)(zc + (size_t)(ts - 1) * (3 * CW) + 2 * CW + 8 * cg), b0, b1); p1[0] = a0 * b0; p1[1] = a1 * b1; }
#pragma unroll 4
            for (int t = ts; t < ts + 16; ++t) { const bf16* zr = zc + (size_t)t * (3 * CW) + 8 * cg; f32x4 cb0, cb1, cc0, cc1, ch0, ch1;
                unpack8(*(const v4u*)(zr), cb0, cb1); unpack8(*(const v4u*)(zr + CW), cc0, cc1); unpack8(*(const v4u*)(zr + 2 * CW), ch0, ch1);
                const f32x4 p0a = cc0 * ch0, p0b = cc1 * ch1;
                const f32x4 y0 = cb0 * (w0[0] * p2[0] + w1[0] * p1[0] + w2[0] * p0a), y1 = cb1 * (w0[1] * p2[1] + w1[1] * p1[1] + w2[1] * p0b);
                *(v4u*)(XN + (size_t)t * DM + AW + 8 * cg) = pack8(y0, y1);
                p2[0] = p1[0]; p2[1] = p1[1]; p1[0] = p0a; p1[1] = p0b; } }
        for (int job = bx * 8 + wave; job < 2048; job += G * 8) { const int idx = job & 1023;
            if (job < 1024) { const int mt = idx >> 6, nt = idx & 63, m0 = 64 * mt, n0 = 32 * nt, hh = m0 >> 8, j0 = m0 & 255;
                wave_gemm_64x32_k128(kvb + (size_t)j0 * (2 * XW) + 128 * hh, 2 * XW, wxqp + (size_t)n0 * XW + 128 * hh, XW, WqKT + (size_t)m0 * DM + n0, DM, lane); }
            else { const int mt = idx >> 5, nt = idx & 31, m0 = 64 * mt, n0 = 32 * nt, hh = n0 >> 8, j0 = n0 & 255;
                wave_gemm_64x32_k128(wxot + (size_t)m0 * XW + 128 * hh, XW, kvb + (size_t)j0 * (2 * XW) + XW + 128 * hh, 2 * XW, VWoT + (size_t)m0 * (4 * NMEM) + n0, 4 * NMEM, lane); } }
    }
    SEAM(2);

    if (IN(3)) { pg8::Prob g{XN, WacT, DM, DM, AW, AW}; pg8::StaticOrder S; S.init(SEQ, DM, G, bx, 2);
        EpiMerge E{sgr, sgc, merged};
        pg8::gemm_phase<EpiMerge, pg8::StaticOrder, PG8_ALIGN, PG8_SP2>(lds, g, S, E); }
    SEAM(3);

    if (IN(4)) { pg8::Prob g{merged, WoutT, DM, DM, DM, 0}; pg8::StaticOrder S; S.init(SEQ, DM, G, bx);
        EpiResid E{x, H, XN, ss1};
        pg8::gemm_phase<EpiResid, pg8::StaticOrder, PG8_ALIGN, PG8_SP2>(lds, g, S, E); }
    SEAM(4);

    if (IN(5)) { pg8::Prob g{XN, WqKT, DM, DM, DM, 0}; pg8::StaticOrder S; S.init(SEQ, 4 * NMEM, G, bx);
        EpiSoftmax E{ss1, Pb};
        if ((SEQ / 256) * 4 <= G) pg8::gemm_phase<EpiSoftmax, pg8::StaticOrder, false, PG8_SP2>(lds, g, S, E); }
    SEAM(5);

    if (IN(6)) { pg8::Prob g{Pb, VWoT, 4 * NMEM, 4 * NMEM, 4 * NMEM, 0}; pg8::StaticOrder S; S.init(SEQ, DM, G, bx);
        EpiResid E{H, H, XN, ss2};
        pg8::gemm_phase<EpiResid, pg8::StaticOrder, PG8_ALIGN, PG8_SP2>(lds, g, S, E); }
    SEAM(6);

    if (IN(7)) { pg8::Prob g{XN, WguT, DM, DM, DM, 0}; pg8::StaticOrder S; S.init(SEQ, 2 * DFF, G, bx);
        EpiSwiGLU E{ss2, act};
        pg8::gemm_phase<EpiSwiGLU, pg8::StaticOrder, PG8_ALIGN, PG8_SP2>(lds, g, S, E); }
    SEAM(7);

    if (IN(8)) { pg8::Prob g{act, WdT, DFF, DFF, DFF, 0}; pg8::StaticOrder S; S.init(SEQ, DM, G, bx);
        EpiResid E{H, out, nullptr, ss3};
        pg8::gemm_phase<EpiResid, pg8::StaticOrder, PG8_ALIGN, PG8_SP2>(lds, g, S, E); }
    SEAM(8);

    if (IN(9)) { const int gw = bx * 8 + wave, NGW = G * 8;
        for (int m = gw; m < SEQ; m += NGW) { const float rs = 1.0f / sqrtf(ss3[m] * (1.0f / DM) + EPS); f32x4* o = (f32x4*)(out + (size_t)m * DM) + lane; const f32x4* gr = (const f32x4*)g_final + lane;
#pragma unroll
            for (int j = 0; j < 8; ++j) { const f32x4 v = o[64 * j], gg = gr[64 * j]; o[64 * j] = v * rs * gg; } } }
#ifdef DBG_STOP
    if (IN(10)) { const size_t gt = (size_t)bx * 512 + tid, NGT = (size_t)G * 512;
        for (size_t e = gt; e < (size_t)SEQ * DM; e += NGT) {
#if DBG_DUMP == 0
            out[e] = __builtin_bit_cast(float, (unsigned)XN[e] << 16);
#elif DBG_DUMP == 1
            out[e] = H[e];
#elif DBG_DUMP == 2
            out[e] = __builtin_bit_cast(float, (unsigned)merged[e] << 16);
#elif DBG_DUMP == 3
            { const size_t r = e / DM, c = e % DM; out[e] = __builtin_bit_cast(float, (unsigned)(c < 1024 ? qb[r * 1024 + c] : (c < 1280 ? kb[r * 256 + c - 1024] : (c < 1536 ? vb[r * 256 + c - 1280] : zc[r * 3072 + (c - 1536)]))) << 16); }
#elif DBG_DUMP == 5
            { const size_t n1 = (size_t)1024 * 2048, n2 = 2 * n1, n3 = n2 + 256 * 1024; out[e] = (e < n1) ? __builtin_bit_cast(float, (unsigned)WqKT[e] << 16) : (e < n2) ? __builtin_bit_cast(float, (unsigned)VWoT[e - n1] << 16) : (e < n3) ? __builtin_bit_cast(float, (unsigned)kvb[e - n2] << 16) : 0.f; }
#elif DBG_DUMP == 6
            out[e] = (e < (size_t)256 * 1024) ? __builtin_bit_cast(float, (unsigned)kvb[e] << 16) : (e < (size_t)256 * 1024 + 256 * 2048) ? __builtin_bit_cast(float, (unsigned)memn[e - 256 * 1024] << 16) : 0.f;
#elif DBG_DUMP == 7
            out[e] = (e < (size_t)2048 * 512) ? __builtin_bit_cast(float, (unsigned)wxqp[e] << 16) : (e < (size_t)2 * 2048 * 512) ? __builtin_bit_cast(float, (unsigned)wxot[e - 2048 * 512] << 16) : 0.f;
#elif DBG_DUMP == 4
            { const size_t r = e / DM, c = e % DM; out[e] = __builtin_bit_cast(float, (unsigned)(c < 1024 ? Pb[r * 1024 + c] : (bf16)0) << 16); }
#endif
        } }
#endif
#undef IN
#undef SEAM
}

extern "C" void kernel_launch(void* const* d_in, const int* in_sizes, int n_in, void* d_out, int out_size, void* d_ws, size_t ws_size, hipStream_t stream) {
    static int grid = 0;
    if (grid == 0) {
        if (n_in != 18 || in_sizes[0] != SEQ * DM || out_size != SEQ * DM || ws_size < WS_END) { fprintf(stderr, "kernel_launch: unexpected shapes / workspace (n_in %d, in0 %d, out %d, ws %zu); nothing launched\n", n_in, n_in > 0 ? in_sizes[0] : -1, out_size, ws_size); grid = -1; return; }
        int dev = 0, cus = 0;
        if (hipGetDevice(&dev) != hipSuccess || hipDeviceGetAttribute(&cus, hipDeviceAttributeMultiprocessorCount, dev) != hipSuccess) { fprintf(stderr, "kernel_launch: device query failed\n"); grid = -1; return; }
        if (hipFuncSetAttribute((const void*)hyb_fwd, hipFuncAttributeMaxDynamicSharedMemorySize, LDS_BYTES) != hipSuccess) { fprintf(stderr, "kernel_launch: hipFuncSetAttribute failed\n"); grid = -1; return; }
        int per_cu = 0;
        if (hipOccupancyMaxActiveBlocksPerMultiprocessor(&per_cu, (const void*)hyb_fwd, 512, LDS_BYTES) != hipSuccess || per_cu < 1) fprintf(stderr, "kernel_launch: note: occupancy query reports %d workgroups per CU\n", per_cu);
        (void)hipGetLastError();
        grid = cus;
    }
    if (grid < 0) return;
    if (hipMemsetAsync((char*)d_ws + WS_CTL, 0, CTL_ZERO_BYTES, stream) != hipSuccess) { fprintf(stderr, "kernel_launch: memset failed\n"); return; }
    Args a{};
    for (int i = 0; i < 18; ++i) a.in[i] = (const float*)d_in[i];
    a.out = (float*)d_out; a.ws = (unsigned char*)d_ws;
#ifdef DBG_STOP
    const int nl = DBG_STOP + 2;
#else
    const int nl = MK_N_LAUNCHES;
#endif
    for (int li = 0; li < nl; ++li) {
        a.ph_lo = (MK_N_LAUNCHES == 1) ? 0 : li; a.ph_hi = (MK_N_LAUNCHES == 1) ? NPHASE : li + 1; a.li = li; a.pad = 0;
#ifdef DBG_STOP
        if (li == nl - 1) { a.ph_lo = 10; a.ph_hi = 11; }
#endif
        hipLaunchKernelGGL(hyb_fwd, dim3(grid), dim3(512), LDS_BYTES, stream, a);
        const hipError_t le = hipPeekAtLastError();
        if (le != hipSuccess) { fprintf(stderr, "kernel_launch: launch %d failed: %s\n", li, hipGetErrorName(le)); break; }
    }
}
```

```cpp
#include <hip/hip_runtime.h>
#include <cstdio>
#include <cstdint>

#ifndef MK_N_LAUNCHES
#define MK_N_LAUNCHES 1
#endif

#define GAS __attribute__((address_space(1)))
#define LAS __attribute__((address_space(3)))
typedef unsigned short bf16;
typedef unsigned v4u __attribute__((ext_vector_type(4)));
typedef unsigned v2u __attribute__((ext_vector_type(2)));
typedef float f32x4 __attribute__((ext_vector_type(4)));
typedef float f32x16 __attribute__((ext_vector_type(16)));
typedef short bf16x8 __attribute__((ext_vector_type(8)));
typedef short s16x4 __attribute__((ext_vector_type(4)));

constexpr int SEQ = 16384, DM = 2048, NIN = 8704, AW = 1024, KVW = 256, CW = 1024, XW = 512, NMEM = 256, DFF = 5632;
constexpr float EPS = 1e-6f;
constexpr float LOG2E = 1.4426950408889634f;
constexpr float QSCALE = 0.125f * 1.4426950408889634f;
constexpr float C2X = 0.08838834764831845f * 1.4426950408889634f;

constexpr size_t MiB = 1u << 20;
constexpr size_t WS_CTL = 0, CTL_ZERO_BYTES = 256 * 1024;
constexpr size_t WS_SS = 1 * MiB;
constexpr size_t WS_CS = 2 * MiB;
constexpr size_t WS_KVB = 3 * MiB;
constexpr size_t WS_MEMN = 4 * MiB;
constexpr size_t WS_WXQ = 5 * MiB;
constexpr size_t WS_WXOT = 7 * MiB;
constexpr size_t WS_WGUT = 16 * MiB;
constexpr size_t WS_WDT = 60 * MiB;
constexpr size_t WS_XN = 82 * MiB;
constexpr size_t WS_WACT = 146 * MiB;
constexpr size_t WS_WOUTT = 154 * MiB;
constexpr size_t WS_WQKT = 162 * MiB;
constexpr size_t WS_VWOT = 166 * MiB;
constexpr size_t WS_Q = 170 * MiB, WS_K = 202 * MiB, WS_V = 210 * MiB, WS_ZC = 218 * MiB;
constexpr size_t WS_P = WS_Q;
constexpr size_t WS_ACT = 314 * MiB;
constexpr size_t WS_WINT = 314 * MiB;
constexpr size_t WS_WXKVT = 348 * MiB;
constexpr size_t WS_END = 490 * MiB;
static_assert(WS_ACT + (size_t)SEQ * DFF * 2 <= WS_END && WS_ZC + (size_t)SEQ * 3 * CW * 2 <= WS_ACT, "d_ws map");

constexpr int CW_BAR = 4096;
constexpr int CW_GRP = 16384;
constexpr int CW_XID = 49152;
constexpr int CW_GLOB = 32768;

constexpr int RING_BYTES = 131072;
constexpr int LDSCTL_OFF = RING_BYTES, MISC_OFF = LDSCTL_OFF + 320;
constexpr int LDS_BYTES = 147456;

#define RLX_AGENT __ATOMIC_RELAXED, __HIP_MEMORY_SCOPE_AGENT
#define LDS_WAIT() asm volatile("s_waitcnt lgkmcnt(0)" ::: "memory")
#define VM_WAIT() asm volatile("s_waitcnt vmcnt(0)" ::: "memory")

typedef float f32x2_t __attribute__((ext_vector_type(2))); typedef __bf16 bf16x2_t __attribute__((ext_vector_type(2)));
__device__ __forceinline__ unsigned cvt_pk_bf16(float lo, float hi) { f32x2_t v = {lo, hi}; bf16x2_t b = __builtin_convertvector(v, bf16x2_t); return __builtin_bit_cast(unsigned, b); }
__device__ __forceinline__ float bf_lo(unsigned u) { return __builtin_bit_cast(float, u << 16); }
__device__ __forceinline__ float bf_hi(unsigned u) { return __builtin_bit_cast(float, u & 0xffff0000u); }
__device__ __forceinline__ float fast_exp2(float x) { return __builtin_amdgcn_exp2f(x); }
__device__ __forceinline__ float fast_rcp(float x) { return __builtin_amdgcn_rcpf(x); }
__device__ __forceinline__ void st16_wt(void* p, v4u v) { asm volatile("global_store_dwordx4 %0, %1, off sc1\n\ts_nop 1" :: "v"(p), "v"(v) : "memory"); }
__device__ __forceinline__ void st8_wt(void* p, v2u v) { __hip_atomic_store((unsigned long long*)p, ((unsigned long long)v.y << 32) | v.x, __ATOMIC_RELAXED, __HIP_MEMORY_SCOPE_AGENT); }

namespace pg8 {
typedef unsigned short bf16_t;
constexpr int BM = 256, BK = 64, HALF = 128, HTB = HALF * BK * 2, STAGE_BYTES = 8 * HTB, NXCD = 8, WGM = 8;

__host__ __device__ __forceinline__ int lds_byte(int r, int c) { const int st = (r >> 4) * 2 + (c >> 5), rr = r & 15, cc = c & 31, ob = rr * 64 + cc * 2; return st * 1024 + (ob ^ (((ob >> 9) & 1) << 5)); }
__host__ __device__ __forceinline__ void stage_rc(int b, int& R, int& C) { const int st = b / 1024, sb = b % 1024, swz = sb ^ (((sb >> 9) & 1) << 5); R = (st >> 1) * 16 + swz / 64; C = (st & 1) * 32 + (swz % 64) / 2; }
__host__ __device__ __forceinline__ int perm32(int rho) { const int n = rho >> 4, i = rho & 15; return 8 * (i >> 2) + 4 * n + (i & 3); }

struct Unit { int pm, pn, z; };
struct Prob {
    const bf16_t* A; const bf16_t* Bt; int lda, ldb, K, zoff;
    __device__ __forceinline__ const char* a_ptr(const Unit& u) const { return (const char*)(A + (size_t)u.pm * BM * lda + (size_t)u.z * zoff); }
    __device__ __forceinline__ const char* b_ptr(const Unit& u) const { return (const char*)(Bt + (size_t)u.pn * BM * ldb + (size_t)u.z * zoff); }
};

__device__ __forceinline__ bool tile_of(long L, int nM, int nN, int& pm, int& pn) {
    const int nwg = nM * nN; if (L >= nwg) return false;
    int wgid = (int)L; { const int q = nwg / NXCD, r = nwg % NXCD, xcd = wgid % NXCD, off = wgid / NXCD; wgid = (xcd < r ? xcd * (q + 1) : r * (q + 1) + (xcd - r) * q) + off; }
    const int nig = WGM * nN, gid = wgid / nig, fm = gid * WGM, gsz = (nM - fm) < WGM ? (nM - fm) : WGM;
    pm = fm + ((wgid % nig) % gsz); pn = (wgid % nig) / gsz; return true;
}
struct StaticOrder {
    int nM, nN, G, c, ZS;
    __device__ __forceinline__ void init(int M, int N, int G_, int c_, int ZS_ = 1) { nM = M / BM; nN = N / BM; G = G_; c = c_; ZS = ZS_; }
    __device__ __forceinline__ bool next(int i, Unit& u) const {
        if (c < 0) return false;
        const int ti = (ZS == 2) ? (i >> 1) : i; u.z = (ZS == 2) ? (i & 1) : 0;
        return tile_of((long)ti * G + c, nM, nN, u.pm, u.pn);
    }
};

template <class Epi, class Sched, bool ALIGN_EPI = false, bool SP2 = false>
__device__ __forceinline__ void gemm_phase(LAS unsigned char* lds, const Prob g, const Sched& S, const Epi& E) {
    const int tid = threadIdx.x, wid = __builtin_amdgcn_readfirstlane(tid >> 6), lane = tid & 63, wr = wid >> 2, wc = wid & 3, fr = lane & 15, fq = lane >> 4;
    const int K = g.K, nt = K / BK;
    unsigned voffA[2], voffB[2];
#pragma unroll
    for (int i = 0; i < 2; ++i) { int R, C; stage_rc(tid * 16 + i * 8192, R, C); const int Rb = Epi::PERM ? ((R & ~31) + perm32(R & 31)) : R;
        voffA[i] = (unsigned)(R * g.lda + C) * 2u; voffB[i] = (unsigned)(Rb * g.ldb + C) * 2u; }
    const size_t kstep = (size_t)(BK * 2);
    const size_t hstepA = (size_t)HALF * g.lda * 2, hstepB = (size_t)HALF * g.ldb * 2;
    const unsigned ldsw = (unsigned)wid * 1024u;
    const int aoff = lds_byte(wr * 64 + fr, fq * 8), boff = lds_byte(wc * 32 + fr, fq * 8);
#define PG8_SA(b, h) (((b) * 2 + (h)) * HTB)
#define PG8_SB(b, h) ((4 + (b) * 2 + (h)) * HTB)
#define PG8_STAGE(bufoff, gbase, voff) do { _Pragma("unroll") for (int _i = 0; _i < 2; ++_i) \
        __builtin_amdgcn_global_load_lds((const unsigned*)((const char*)(gbase) + (voff)[_i]), (LAS unsigned*)(lds + (bufoff) + ldsw + _i * 8192), 16, 0, 0); } while (0)
#define PG8_LDA(dst, b, h) do { _Pragma("unroll") for (int m = 0; m < 4; ++m) _Pragma("unroll") for (int k = 0; k < 2; ++k) dst[m][k] = *(const LAS bf16x8*)(lds + PG8_SA(b, h) + aoff + m * 2048 + k * 1024); } while (0)
#define PG8_LDB(dst, b, h) do { _Pragma("unroll") for (int n = 0; n < 2; ++n) _Pragma("unroll") for (int k = 0; k < 2; ++k) dst[n][k] = *(const LAS bf16x8*)(lds + PG8_SB(b, h) + boff + n * 2048 + k * 1024); } while (0)
#define PG8_MMA(ai, bj, At, Bt) do { __builtin_amdgcn_s_setprio(1); _Pragma("unroll") for (int m = 0; m < 4; ++m) _Pragma("unroll") for (int n = 0; n < 2; ++n) _Pragma("unroll") for (int k = 0; k < 2; ++k) \
        acc[ai][bj][m][n] = __builtin_amdgcn_mfma_f32_16x16x32_bf16(Bt[n][k], At[m][k], acc[ai][bj][m][n], 0, 0, 0); __builtin_amdgcn_s_setprio(0); } while (0)
#define PG8_WAIT_V(n) asm volatile("s_waitcnt vmcnt(" #n ")" ::: "memory")
#define PG8_WAIT_L(n) asm volatile("s_waitcnt lgkmcnt(" #n ")" ::: "memory")
#define PG8_BAR __builtin_amdgcn_s_barrier()
#define PG8_SCHED __builtin_amdgcn_sched_barrier(0)
    Unit cur, nxt; int ui = 0;
    if (!S.next(0, cur)) return;
    f32x4 acc[2][2][4][2];
#pragma unroll
    for (int a = 0; a < 2; ++a)
#pragma unroll
        for (int b = 0; b < 2; ++b)
#pragma unroll
            for (int m = 0; m < 4; ++m)
#pragma unroll
                for (int n = 0; n < 2; ++n) acc[a][b][m][n] = (f32x4){0.f, 0.f, 0.f, 0.f};
    bf16x8 At[4][2], B0[2][2], B1[2][2];
    const char* cA = g.a_ptr(cur); const char* cB = g.b_ptr(cur);
    if constexpr (SP2) {
        PG8_STAGE(PG8_SB(0, 0), cB, voffB); PG8_STAGE(PG8_SB(0, 1), cB + hstepB, voffB); PG8_STAGE(PG8_SA(0, 0), cA, voffA); PG8_STAGE(PG8_SA(0, 1), cA + hstepA, voffA);
        if (wr == 1) PG8_BAR;
        PG8_WAIT_V(2); PG8_BAR;
        PG8_STAGE(PG8_SB(1, 0), cB + kstep, voffB); PG8_STAGE(PG8_SA(1, 0), cA + kstep, voffA); PG8_STAGE(PG8_SB(1, 1), cB + hstepB + kstep, voffB);
        PG8_WAIT_V(6); PG8_BAR;
    } else {
        PG8_STAGE(PG8_SB(0, 0), cB, voffB); PG8_STAGE(PG8_SA(0, 0), cA, voffA); PG8_STAGE(PG8_SB(0, 1), cB + hstepB, voffB); PG8_STAGE(PG8_SA(0, 1), cA + hstepA, voffA);
        if (wr == 1) PG8_BAR;
        PG8_WAIT_V(4); PG8_BAR;
        PG8_STAGE(PG8_SB(1, 0), cB + kstep, voffB); PG8_STAGE(PG8_SA(1, 0), cA + kstep, voffA); PG8_STAGE(PG8_SB(1, 1), cB + hstepB + kstep, voffB);
        PG8_WAIT_V(6); PG8_BAR;
    }
    for (;;) {
        const bool has_next = S.next(ui + 1, nxt);
        const char* nA = has_next ? g.a_ptr(nxt) : cA; const char* nB = has_next ? g.b_ptr(nxt) : cB;
        for (int t = 0; t < nt; t += 2) {
            const bool last = (t == nt - 2);
            const char* a1 = cA + (size_t)(t + 1) * kstep;
            const char* a2 = last ? nA : cA + (size_t)(t + 2) * kstep; const char* b2 = last ? nB : cB + (size_t)(t + 2) * kstep;
            const char* a3 = a2 + kstep; const char* b3 = b2 + kstep;
            if constexpr (SP2) {
            PG8_LDB(B0, 0, 0); PG8_LDB(B1, 0, 1); PG8_SCHED; PG8_LDA(At, 0, 0); PG8_STAGE(PG8_SA(1, 1), a1 + hstepA, voffA);
            PG8_WAIT_V(8); PG8_WAIT_L(0); PG8_BAR; PG8_MMA(0, 0, At, B0); PG8_MMA(0, 1, At, B1); PG8_BAR; PG8_SCHED;
            PG8_LDA(At, 0, 1); PG8_STAGE(PG8_SB(0, 0), b2, voffB); PG8_STAGE(PG8_SB(0, 1), b2 + hstepB, voffB); PG8_STAGE(PG8_SA(0, 0), a2, voffA);
            PG8_WAIT_V(8); PG8_WAIT_L(0); PG8_BAR; PG8_MMA(1, 0, At, B0); PG8_MMA(1, 1, At, B1); PG8_BAR; PG8_SCHED;
            PG8_LDB(B0, 1, 0); PG8_LDB(B1, 1, 1); PG8_SCHED; PG8_LDA(At, 1, 0); PG8_STAGE(PG8_SA(0, 1), a2 + hstepA, voffA);
            PG8_WAIT_V(8); PG8_WAIT_L(0); PG8_BAR; PG8_MMA(0, 0, At, B0); PG8_MMA(0, 1, At, B1); PG8_BAR; PG8_SCHED;
            PG8_LDA(At, 1, 1); PG8_STAGE(PG8_SB(1, 0), b3, voffB); PG8_STAGE(PG8_SB(1, 1), b3 + hstepB, voffB); PG8_STAGE(PG8_SA(1, 0), a3, voffA);
            PG8_WAIT_V(8); PG8_WAIT_L(0); PG8_BAR; PG8_MMA(1, 0, At, B0); PG8_MMA(1, 1, At, B1); PG8_BAR; PG8_SCHED;
            } else {
            PG8_LDB(B0, 0, 0); PG8_SCHED; PG8_LDA(At, 0, 0); PG8_STAGE(PG8_SA(1, 1), a1 + hstepA, voffA);
            PG8_WAIT_L(8); PG8_BAR; PG8_WAIT_L(0); PG8_MMA(0, 0, At, B0); PG8_BAR; PG8_SCHED;
            PG8_LDB(B1, 0, 1); PG8_STAGE(PG8_SB(0, 0), b2, voffB);
            PG8_BAR; PG8_WAIT_L(0); PG8_MMA(0, 1, At, B1); PG8_BAR;
            PG8_LDA(At, 0, 1); PG8_STAGE(PG8_SA(0, 0), a2, voffA);
            PG8_BAR; PG8_WAIT_L(0); PG8_MMA(1, 0, At, B0); PG8_BAR; PG8_SCHED;
            PG8_STAGE(PG8_SB(0, 1), b2 + hstepB, voffB);
            PG8_WAIT_V(6); PG8_BAR; PG8_MMA(1, 1, At, B1); PG8_BAR;
            PG8_LDB(B0, 1, 0); PG8_SCHED; PG8_LDA(At, 1, 0); PG8_STAGE(PG8_SA(0, 1), a2 + hstepA, voffA);
            PG8_WAIT_L(8); PG8_BAR; PG8_WAIT_L(0); PG8_MMA(0, 0, At, B0); PG8_BAR; PG8_SCHED;
            PG8_LDB(B1, 1, 1); PG8_STAGE(PG8_SB(1, 0), b3, voffB);
            PG8_BAR; PG8_WAIT_L(0); PG8_MMA(0, 1, At, B1); PG8_BAR;
            PG8_LDA(At, 1, 1); PG8_STAGE(PG8_SA(1, 0), a3, voffA);
            PG8_BAR; PG8_WAIT_L(0); PG8_MMA(1, 0, At, B0); PG8_BAR; PG8_SCHED;
            PG8_STAGE(PG8_SB(1, 1), b3 + hstepB, voffB);
            PG8_WAIT_V(6); PG8_BAR; PG8_MMA(1, 1, At, B1); PG8_BAR;
            }
        }
        if constexpr (ALIGN_EPI) { if (wr == 0) PG8_BAR; }
        if constexpr (!Epi::AFTER_DRAIN) { if (!(Epi::LAST_FUSED && !has_next)) E(acc, cur, wr, wc, fr, fq); }
        if (!has_next) break;
        if (!E.keep(cur)) {
#pragma unroll
        for (int a = 0; a < 2; ++a)
#pragma unroll
            for (int b = 0; b < 2; ++b)
#pragma unroll
                for (int m = 0; m < 4; ++m)
#pragma unroll
                    for (int n = 0; n < 2; ++n) acc[a][b][m][n] = (f32x4){0.f, 0.f, 0.f, 0.f};
        }
        cur = nxt; cA = nA; cB = nB; ++ui;
        if constexpr (ALIGN_EPI) { if (wr == 1) PG8_BAR; }
    }
    PG8_WAIT_V(0);
    if constexpr (!ALIGN_EPI) { if (wr == 0) PG8_BAR; }
    PG8_BAR;
    if constexpr (Epi::AFTER_DRAIN || Epi::LAST_FUSED) { E.fused(acc, cur, wr, wc, fr, fq, lds, wid, lane); }
#undef PG8_SA
#undef PG8_SB
#undef PG8_STAGE
#undef PG8_LDA
#undef PG8_LDB
#undef PG8_MMA
#undef PG8_WAIT_V
#undef PG8_WAIT_L
#undef PG8_BAR
#undef PG8_SCHED
}
}

#ifndef PG8_SP2
#define PG8_SP2 true
#endif
#ifndef PG8_ALIGN
#define PG8_ALIGN true
#endif

typedef f32x4 Acc[2][2][4][2];

__device__ __forceinline__ v4u pack8(f32x4 v0, f32x4 v1) { v4u w; w.x = cvt_pk_bf16(v0[0], v0[1]); w.y = cvt_pk_bf16(v0[2], v0[3]); w.z = cvt_pk_bf16(v1[0], v1[1]); w.w = cvt_pk_bf16(v1[2], v1[3]); return w; }
__device__ __forceinline__ void unpack8(v4u w, f32x4& v0, f32x4& v1) { v0 = (f32x4){bf_lo(w.x), bf_hi(w.x), bf_lo(w.y), bf_hi(w.y)}; v1 = (f32x4){bf_lo(w.z), bf_hi(w.z), bf_lo(w.w), bf_hi(w.w)}; }

struct EpiInProj {
    static constexpr bool PERM = true, AFTER_DRAIN = false, LAST_FUSED = false;
    bf16 *q, *k, *v, *zc, *sgr, *sgc; const float* cs;
    __device__ __forceinline__ bool keep(const pg8::Unit&) const { return false; }
    __device__ __forceinline__ void operator()(Acc& acc, const pg8::Unit& u, int wr, int wc, int fr, int fq) const {
        const int row0 = u.pm * 256 + wr * 64 + fr, ct = wc * 32 + 8 * fq;
        if (u.pn < 5) {
            const bool isq = u.pn < 4; bf16* base = isq ? q + u.pn * 256 : k; const int ld = isq ? AW : KVW; const float sc = isq ? QSCALE : 1.f;
            const bool rl = ((wc & 1) == 0) && (fq < 2);
#pragma unroll
            for (int ai = 0; ai < 2; ++ai)
#pragma unroll
                for (int m = 0; m < 4; ++m) { const int row = row0 + ai * 128 + m * 16;
                    f32x4 c4 = (f32x4){1.f, 1.f, 1.f, 1.f}, s4 = (f32x4){0.f, 0.f, 0.f, 0.f};
                    if (rl) { c4 = *(const f32x4*)(cs + (size_t)row * 16 + 4 * fq); s4 = *(const f32x4*)(cs + (size_t)row * 16 + 8 + 4 * fq); }
#pragma unroll
                    for (int bj = 0; bj < 2; ++bj) { const f32x4 t1 = acc[ai][bj][m][0], t2 = acc[ai][bj][m][1];
                        const f32x4 v0 = (t1 * c4 - t2 * s4) * sc, v1 = (t2 * c4 + t1 * s4) * sc;
                        *(v4u*)(base + (size_t)row * ld + bj * 128 + ct) = pack8(v0, v1); } }
        } else if (u.pn < 10) {
            bf16* base = (u.pn == 5) ? v : zc + (u.pn - 6) * 256; const int ld = (u.pn == 5) ? KVW : 2 * CW;
#pragma unroll
            for (int ai = 0; ai < 2; ++ai)
#pragma unroll
                for (int m = 0; m < 4; ++m) { const int row = row0 + ai * 128 + m * 16;
#pragma unroll
                    for (int bj = 0; bj < 2; ++bj) *(v4u*)(base + (size_t)row * ld + bj * 128 + ct) = pack8(acc[ai][bj][m][0], acc[ai][bj][m][1]); }
        } else if (u.pn < 18) {
            const int t = u.pn - 10;
#pragma unroll
            for (int ai = 0; ai < 2; ++ai)
#pragma unroll
                for (int m = 0; m < 4; ++m) { const int row = row0 + ai * 128 + m * 16;
                    *(v4u*)(zc + (size_t)row * (2 * CW) + CW + t * 128 + ct) = pack8(acc[ai][0][m][0] * acc[ai][1][m][0], acc[ai][0][m][1] * acc[ai][1][m][1]); }
        } else {
            const int t = u.pn - 18;
#pragma unroll
            for (int ai = 0; ai < 2; ++ai)
#pragma unroll
                for (int m = 0; m < 4; ++m) { const int row = row0 + ai * 128 + m * 16; f32x4 rr[2], ss[2];
#pragma unroll
                    for (int n = 0; n < 2; ++n)
#pragma unroll
                        for (int e = 0; e < 4; ++e) { const float ga = acc[ai][0][m][n][e], gc = acc[ai][1][m][n][e];
                            const float ea = fast_exp2(fminf(ga, 80.f)), ec = fast_exp2(fminf(gc, 80.f));
                            const float ia = fast_rcp(1.f + ea), ic = fast_rcp(1.f + ec);
                            rr[n][e] = (1.f + ec) * ia; ss[n][e] = ic; }
                    *(v4u*)(sgr + (size_t)row * DM + t * 128 + ct) = pack8(rr[0], rr[1]);
                    *(v4u*)(sgc + (size_t)row * DM + t * 128 + ct) = pack8(ss[0], ss[1]); }
        }
    }
};
struct EpiStoreBf16 {
    static constexpr bool PERM = true, AFTER_DRAIN = false, LAST_FUSED = false;
    bf16* O; int ldc;
    __device__ __forceinline__ bool keep(const pg8::Unit&) const { return false; }
    __device__ __forceinline__ void operator()(Acc& acc, const pg8::Unit& u, int wr, int wc, int fr, int fq) const {
        const int row0 = u.pm * 256 + wr * 64 + fr, col0 = u.pn * 256 + wc * 32 + 8 * fq;
#pragma unroll
        for (int ai = 0; ai < 2; ++ai)
#pragma unroll
            for (int m = 0; m < 4; ++m) { const int row = row0 + ai * 128 + m * 16;
#pragma unroll
                for (int bj = 0; bj < 2; ++bj) *(v4u*)(O + (size_t)row * ldc + col0 + bj * 128) = pack8(acc[ai][bj][m][0], acc[ai][bj][m][1]); }
    }
};
struct EpiMerge {
    static constexpr bool PERM = true, AFTER_DRAIN = false, LAST_FUSED = false;
    const bf16 *sgr, *sgc; bf16* merged;
    __device__ __forceinline__ bool keep(const pg8::Unit& u) const { return u.z == 0; }
    __device__ __forceinline__ void operator()(Acc& acc, const pg8::Unit& u, int wr, int wc, int fr, int fq) const {
        const int row0 = u.pm * 256 + wr * 64 + fr, col0 = u.pn * 256 + wc * 32 + 8 * fq;
        const bf16* gsrc = ((u.z == 0) ? sgr : sgc) + (size_t)row0 * DM + col0;
        v4u gw[2][4][2];
#pragma unroll
        for (int ai = 0; ai < 2; ++ai)
#pragma unroll
            for (int m = 0; m < 4; ++m)
#pragma unroll
                for (int bj = 0; bj < 2; ++bj) gw[ai][m][bj] = *(const v4u*)(gsrc + (size_t)(ai * 128 + m * 16) * DM + bj * 128);
#pragma unroll
        for (int ai = 0; ai < 2; ++ai)
#pragma unroll
            for (int m = 0; m < 4; ++m) { const int row = row0 + ai * 128 + m * 16;
#pragma unroll
                for (int bj = 0; bj < 2; ++bj) { f32x4 g0, g1; unpack8(gw[ai][m][bj], g0, g1);
                    const f32x4 v0 = acc[ai][bj][m][0] * g0, v1 = acc[ai][bj][m][1] * g1;
                    if (u.z == 0) { acc[ai][bj][m][0] = v0; acc[ai][bj][m][1] = v1; }
                    else *(v4u*)(merged + (size_t)row * DM + col0 + bj * 128) = pack8(v0, v1); } }
    }
};
template <bool BASE_F32> struct EpiResid {
    static constexpr bool PERM = true, AFTER_DRAIN = false, LAST_FUSED = false;
    const float* basef; bf16* hb; float* ss;
    __device__ __forceinline__ bool keep(const pg8::Unit&) const { return false; }
    __device__ __forceinline__ void operator()(Acc& acc, const pg8::Unit& u, int wr, int wc, int fr, int fq) const {
        const int row0 = u.pm * 256 + wr * 64 + fr, col0 = u.pn * 256 + wc * 32 + 8 * fq;
        const size_t off0 = (size_t)row0 * DM + col0;
        constexpr int NPRE = BASE_F32 ? 4 : 8;
        f32x4 pf[BASE_F32 ? 4 : 1][2][2]; v4u pb[BASE_F32 ? 1 : 8][2];
#pragma unroll
        for (int g = 0; g < NPRE; ++g)
#pragma unroll
            for (int bj = 0; bj < 2; ++bj) { const size_t off = off0 + (size_t)((g >> 2) * 128 + (g & 3) * 16) * DM + bj * 128;
                if (BASE_F32) { pf[g][bj][0] = __builtin_nontemporal_load((const f32x4*)(basef + off)); pf[g][bj][1] = __builtin_nontemporal_load((const f32x4*)(basef + off + 4)); } else pb[g][bj] = *(const v4u*)(hb + off); }
#pragma unroll
        for (int g = 0; g < 8; ++g) { const int ai = g >> 2, m = g & 3; const int row = row0 + ai * 128 + m * 16; float sq = 0.f;
#pragma unroll
            for (int bj = 0; bj < 2; ++bj) { const size_t off = (size_t)row * DM + col0 + bj * 128; f32x4 b0, b1;
                if (BASE_F32) { b0 = pf[g & 3][bj][0]; b1 = pf[g & 3][bj][1]; } else unpack8(pb[g][bj], b0, b1);
                const f32x4 v0 = acc[ai][bj][m][0] + b0, v1 = acc[ai][bj][m][1] + b1;
                *(v4u*)(hb + off) = pack8(v0, v1);
                sq += (v0[0] * v0[0] + v0[1] * v0[1]) + (v0[2] * v0[2] + v0[3] * v0[3]) + (v1[0] * v1[0] + v1[1] * v1[1]) + (v1[2] * v1[2] + v1[3] * v1[3]); }
            if (BASE_F32 && g + 4 < 8) {
#pragma unroll
                for (int bj = 0; bj < 2; ++bj) { const size_t off = off0 + (size_t)(128 + m * 16) * DM + bj * 128; pf[g & 3][bj][0] = __builtin_nontemporal_load((const f32x4*)(basef + off)); pf[g & 3][bj][1] = __builtin_nontemporal_load((const f32x4*)(basef + off + 4)); } }
            sq += __shfl_xor(sq, 16); sq += __shfl_xor(sq, 32);
            if (fq == 0) atomicAdd(ss + row, sq); }
    }
};
struct EpiSoftmax {
    static constexpr bool PERM = true, AFTER_DRAIN = true, LAST_FUSED = false;
    const float* ss; bf16* P;
    __device__ __forceinline__ bool keep(const pg8::Unit&) const { return false; }
    __device__ __forceinline__ void fused(Acc& acc, const pg8::Unit& u, int wr, int wc, int fr, int fq, LAS unsigned char* lds, int wid, int lane) const {
        LAS float* Pm = (LAS float*)lds; LAS float* Ps = (LAS float*)(lds + 4096);
        const int rl0 = wr * 64 + fr, col0 = u.pn * 256 + wc * 32 + 8 * fq;
#pragma unroll
        for (int ai = 0; ai < 2; ++ai)
#pragma unroll
            for (int m = 0; m < 4; ++m) { const int rl = rl0 + ai * 128 + m * 16; const float rs = 1.0f / sqrtf(ss[u.pm * 256 + rl] * (1.0f / DM) + EPS); float mx = -3.0e38f;
#pragma unroll
                for (int bj = 0; bj < 2; ++bj)
#pragma unroll
                    for (int n = 0; n < 2; ++n) { f32x4 s = acc[ai][bj][m][n] * rs; acc[ai][bj][m][n] = s; mx = fmaxf(mx, fmaxf(fmaxf(s[0], s[1]), fmaxf(s[2], s[3]))); }
                mx = fmaxf(mx, __shfl_xor(mx, 16)); mx = fmaxf(mx, __shfl_xor(mx, 32));
                if (fq == 0) Pm[rl * 4 + wc] = mx; }
        asm volatile("s_waitcnt lgkmcnt(0)" ::: "memory"); __builtin_amdgcn_s_barrier(); asm volatile("" ::: "memory");
#pragma unroll
        for (int ai = 0; ai < 2; ++ai)
#pragma unroll
            for (int m = 0; m < 4; ++m) { const int rl = rl0 + ai * 128 + m * 16; const f32x4 pm4 = *(const LAS f32x4*)(Pm + rl * 4);
                const float mx = fmaxf(fmaxf(pm4[0], pm4[1]), fmaxf(pm4[2], pm4[3])); float sm = 0.f;
#pragma unroll
                for (int bj = 0; bj < 2; ++bj)
#pragma unroll
                    for (int n = 0; n < 2; ++n) { f32x4 s = acc[ai][bj][m][n];
#pragma unroll
                        for (int e = 0; e < 4; ++e) { s[e] = fast_exp2(s[e] - mx); sm += s[e]; }
                        acc[ai][bj][m][n] = s; }
                sm += __shfl_xor(sm, 16); sm += __shfl_xor(sm, 32);
                if (fq == 0) Ps[rl * 4 + wc] = sm; }
        asm volatile("s_waitcnt lgkmcnt(0)" ::: "memory"); __builtin_amdgcn_s_barrier(); asm volatile("" ::: "memory");
#pragma unroll
        for (int ai = 0; ai < 2; ++ai)
#pragma unroll
            for (int m = 0; m < 4; ++m) { const int rl = rl0 + ai * 128 + m * 16; const f32x4 ps4 = *(const LAS f32x4*)(Ps + rl * 4);
                const float inv = 1.0f / ((ps4[0] + ps4[1]) + (ps4[2] + ps4[3])); const size_t rowoff = (size_t)(u.pm * 256 + rl) * (4 * NMEM) + col0;
#pragma unroll
                for (int bj = 0; bj < 2; ++bj) *(v4u*)(P + rowoff + bj * 128) = pack8(acc[ai][bj][m][0] * inv, acc[ai][bj][m][1] * inv); }
    }
};
struct EpiSwiGLU {
    static constexpr bool PERM = true, AFTER_DRAIN = false, LAST_FUSED = false;
    const float* ss; bf16* act;
    __device__ __forceinline__ bool keep(const pg8::Unit&) const { return false; }
    __device__ __forceinline__ void operator()(Acc& acc, const pg8::Unit& u, int wr, int wc, int fr, int fq) const {
        const int row0 = u.pm * 256 + wr * 64 + fr, col0 = u.pn * 128 + wc * 32 + 8 * fq;
#pragma unroll
        for (int ai = 0; ai < 2; ++ai)
#pragma unroll
            for (int m = 0; m < 4; ++m) { const int row = row0 + ai * 128 + m * 16; const float rs = 1.0f / sqrtf(ss[row] * (1.0f / DM) + EPS); f32x4 o[2];
                const float nrl = -rs * LOG2E, rs2 = rs * rs;
#pragma unroll
                for (int n = 0; n < 2; ++n)
#pragma unroll
                    for (int e = 0; e < 4; ++e) { const float a = acc[ai][0][m][n][e], b = acc[ai][1][m][n][e];
                        o[n][e] = (a * b) * (rs2 * fast_rcp(1.f + fast_exp2(a * nrl))); }
                *(v4u*)(act + (size_t)row * DFF + col0) = pack8(o[0], o[1]); }
    }
};

#define XB_TMO      128
#define XB_XCNT(j)  (256  + 64 * (j))
#define XB_XSUB(j)  (1280 + 64 * (j))
#define XB_XGEN(j)  (2304 + 64 * (j))
#define XB_TOP      3328
#define XB_TOPGEN   3392
#define XCD_BAR_WORDS 3456
#define XB_SPIN_CAP (1u << 18)

__device__ __forceinline__ unsigned xb_ld(unsigned* p)              { return __hip_atomic_load(p, __ATOMIC_RELAXED, __HIP_MEMORY_SCOPE_AGENT); }
__device__ __forceinline__ unsigned xb_add(unsigned* p, unsigned v) { return __hip_atomic_fetch_add(p, v, __ATOMIC_RELAXED, __HIP_MEMORY_SCOPE_AGENT); }
__device__ __forceinline__ unsigned xb_xcc_id() { return (unsigned)__builtin_amdgcn_s_getreg((3 << 11) | 20) & 0xFu; }
#define XB_SPIN(cond, bar) do { unsigned _sp = 0; while (cond) { __builtin_amdgcn_s_sleep(1); \
    if ((++_sp & 255u) == 0u) { if (xb_ld(&(bar)[XB_TMO])) break; if (_sp > XB_SPIN_CAP) { atomicAdd(&(bar)[XB_TMO], 1u); break; } } } } while (0)

struct XcdBarrier { unsigned* bar; unsigned x; volatile LAS unsigned* st; };

__device__ __forceinline__ XcdBarrier xcd_barrier_post(unsigned* bar, volatile LAS unsigned* st) {
    XcdBarrier b; b.bar = bar; b.x = xb_xcc_id(); b.st = st;
    if (threadIdx.x == 0) (void)xb_add(&bar[XB_XCNT(b.x)], 1u);
    return b;
}
__device__ __forceinline__ void xcd_barrier_complete(unsigned* bar, unsigned x, unsigned& nloc, unsigned& nx) {
    const unsigned G = gridDim.x * gridDim.y * gridDim.z;
    unsigned sum, cnt, mine, sp = 0u;
    for (;;) {
        sum = 0u; cnt = 0u; mine = 0u;
#pragma unroll
        for (unsigned j = 0; j < 16; ++j) { const unsigned c = xb_ld(&bar[XB_XCNT(j)]); sum += c; cnt += (c > 0u) ? 1u : 0u; mine = (j == x) ? c : mine; }
        if (sum == G) break;
        __builtin_amdgcn_s_sleep(1);
        if ((++sp & 255u) == 0u) { if (xb_ld(&bar[XB_TMO])) break; if (sp > XB_SPIN_CAP) { atomicAdd(&bar[XB_TMO], 1u); break; } }
    }
    nloc = mine > 0u ? mine : 1u; nx = cnt > 0u ? cnt : 1u;
}
__device__ __forceinline__ void xcd_barrier(const XcdBarrier& b) {
    asm volatile("s_waitcnt vmcnt(0)" ::: "memory");
    __syncthreads();
    if (threadIdx.x == 0) {
        unsigned* bar = b.bar;
        __builtin_amdgcn_s_waitcnt(0);
        unsigned nloc = b.st[0], nx = b.st[1];
        if (nloc == 0u) { xcd_barrier_complete(bar, b.x, nloc, nx); b.st[0] = nloc; b.st[1] = nx; }
        const unsigned old = xb_add(&bar[XB_XSUB(b.x)], 1u);
        const unsigned gen = old / nloc;
        if (old + 1u == (gen + 1u) * nloc) {
            __builtin_amdgcn_fence(__ATOMIC_RELEASE, "agent");
            asm volatile("s_waitcnt vmcnt(0)" ::: "memory");
            const unsigned og = xb_add(&bar[XB_TOP], 1u);
            const unsigned tg = og / nx;
            if (og + 1u == (tg + 1u) * nx) xb_add(&bar[XB_TOPGEN], 1u);
            else XB_SPIN(xb_ld(&bar[XB_TOPGEN]) == tg, bar);
            __builtin_amdgcn_fence(__ATOMIC_ACQUIRE, "agent");
            xb_add(&bar[XB_XGEN(b.x)], 1u);
            asm volatile("s_waitcnt vmcnt(0)" ::: "memory");
        } else {
            XB_SPIN(xb_ld(&bar[XB_XGEN(b.x)]) == gen, bar);
            __builtin_amdgcn_fence(__ATOMIC_ACQUIRE, "agent");
            asm volatile("s_waitcnt vmcnt(0)" ::: "memory");
        }
    }
    __syncthreads();
}


__device__ __forceinline__ void group_barrier(unsigned* cnt, unsigned target, unsigned* extra, unsigned* tmo, bool same_xcd) {
    asm volatile("s_waitcnt vmcnt(0)" ::: "memory");
    __syncthreads();
    if (threadIdx.x == 0) {
        __builtin_amdgcn_s_waitcnt(0);
        if (!same_xcd) { __builtin_amdgcn_fence(__ATOMIC_RELEASE, "agent"); asm volatile("s_waitcnt vmcnt(0)" ::: "memory"); }
        (void)xb_add(cnt, 1u);
        if (extra) (void)xb_add(extra, 1u);
        unsigned sp = 0;
        while (xb_ld(cnt) < target) { __builtin_amdgcn_s_sleep(1); if ((++sp & 255u) == 0u) { if (xb_ld(tmo)) break; if (sp > XB_SPIN_CAP) { atomicAdd(tmo, 1u); break; } } }
        __builtin_amdgcn_fence(__ATOMIC_ACQUIRE, "agent");
        asm volatile("s_waitcnt vmcnt(0)" ::: "memory");
    }
    __syncthreads();
}
__device__ __forceinline__ void wait_global(unsigned* cnt, unsigned target, unsigned* tmo) {
    if (threadIdx.x == 0) {
        unsigned sp = 0;
        while (xb_ld(cnt) < target) { __builtin_amdgcn_s_sleep(1); if ((++sp & 255u) == 0u) { if (xb_ld(tmo)) break; if (sp > XB_SPIN_CAP) { atomicAdd(tmo, 1u); break; } } }
        __builtin_amdgcn_fence(__ATOMIC_ACQUIRE, "agent");
        asm volatile("s_waitcnt vmcnt(0)" ::: "memory");
    }
    __syncthreads();
}

struct EpiFinal {
    static constexpr bool PERM = true, AFTER_DRAIN = false, LAST_FUSED = true;
    bf16* hb; float* ss; float* out; const float* gfin; unsigned* gcnt; unsigned target; unsigned* glob1; unsigned* tmo; bool same_xcd;
    __device__ __forceinline__ bool keep(const pg8::Unit&) const { return false; }
    __device__ __forceinline__ void operator()(Acc& acc, const pg8::Unit& u, int wr, int wc, int fr, int fq) const { const EpiResid<false> E{nullptr, hb, ss}; E(acc, u, wr, wc, fr, fq); }
    __device__ __forceinline__ void fused(Acc& acc, const pg8::Unit& u, int wr, int wc, int fr, int fq, LAS unsigned char* lds, int wid, int lane) const {
        const int row0 = u.pm * 256 + wr * 64 + fr, col0 = u.pn * 256 + wc * 32 + 8 * fq;
        const size_t off0 = (size_t)row0 * DM + col0;
        v4u pb[8][2];
#pragma unroll
        for (int g = 0; g < 8; ++g)
#pragma unroll
            for (int bj = 0; bj < 2; ++bj) pb[g][bj] = *(const v4u*)(hb + off0 + (size_t)((g >> 2) * 128 + (g & 3) * 16) * DM + bj * 128);
#pragma unroll
        for (int g = 0; g < 8; ++g) { const int ai = g >> 2, m = g & 3; const int row = row0 + ai * 128 + m * 16; float sq = 0.f;
#pragma unroll
            for (int bj = 0; bj < 2; ++bj) { f32x4 b0, b1; unpack8(pb[g][bj], b0, b1);
                const f32x4 v0 = acc[ai][bj][m][0] + b0, v1 = acc[ai][bj][m][1] + b1; acc[ai][bj][m][0] = v0; acc[ai][bj][m][1] = v1;
                sq += (v0[0] * v0[0] + v0[1] * v0[1]) + (v0[2] * v0[2] + v0[3] * v0[3]) + (v1[0] * v1[0] + v1[1] * v1[1]) + (v1[2] * v1[2] + v1[3] * v1[3]); }
            sq += __shfl_xor(sq, 16); sq += __shfl_xor(sq, 32);
            if (fq == 0) atomicAdd(ss + row, sq); }
        group_barrier(gcnt, target, nullptr, tmo, same_xcd);
        wait_global(glob1, 256u, tmo);
        const int col1 = col0 - 1024;
        { f32x4 gv[2][2];
#pragma unroll
          for (int bj = 0; bj < 2; ++bj) { gv[bj][0] = *(const f32x4*)(gfin + col0 + bj * 128); gv[bj][1] = *(const f32x4*)(gfin + col0 + bj * 128 + 4); }
#pragma unroll
          for (int g = 0; g < 8; ++g) { const int ai = g >> 2, m = g & 3; const int row = row0 + ai * 128 + m * 16; const float rs = 1.0f / sqrtf(ss[row] * (1.0f / DM) + EPS);
#pragma unroll
            for (int bj = 0; bj < 2; ++bj) { float* o = out + (size_t)row * DM + col0 + bj * 128; __builtin_nontemporal_store(acc[ai][bj][m][0] * rs * gv[bj][0], (f32x4*)o); __builtin_nontemporal_store(acc[ai][bj][m][1] * rs * gv[bj][1], (f32x4*)(o + 4)); } } }
        asm volatile("" ::: "memory");
        { f32x4 gw[2][2];
#pragma unroll
          for (int bj = 0; bj < 2; ++bj) { gw[bj][0] = *(const f32x4*)(gfin + col1 + bj * 128); gw[bj][1] = *(const f32x4*)(gfin + col1 + bj * 128 + 4); }
#pragma unroll
          for (int g = 0; g < 8; ++g)
#pragma unroll
            for (int bj = 0; bj < 2; ++bj) pb[g][bj] = *(const v4u*)(hb + off0 - 1024 + (size_t)((g >> 2) * 128 + (g & 3) * 16) * DM + bj * 128);
#pragma unroll
          for (int g = 0; g < 8; ++g) { const int ai = g >> 2, m = g & 3; const int row = row0 + ai * 128 + m * 16; const float rs = 1.0f / sqrtf(ss[row] * (1.0f / DM) + EPS);
#pragma unroll
            for (int bj = 0; bj < 2; ++bj) { f32x4 b0, b1; unpack8(pb[g][bj], b0, b1); float* o1 = out + (size_t)row * DM + col1 + bj * 128; __builtin_nontemporal_store(b0 * rs * gw[bj][0], (f32x4*)o1); __builtin_nontemporal_store(b1 * rs * gw[bj][1], (f32x4*)(o1 + 4)); } } }
    }
};

__device__ __forceinline__ float wave_sum(float v) {
#pragma unroll
    for (int o = 1; o < 64; o <<= 1) v += __shfl_xor(v, o);
    return v;
}
__device__ __forceinline__ int rope_sigma(int p) { return (p < 16) ? ((p & 3) + 4 * ((p >> 3) & 1) + 8 * ((p >> 2) & 1)) : p; }
struct TpItem { const float* src; bf16* dst; const float* ks; int ldw, ldd, perm; float cscale; };
struct TpPtrs { const float *w_in, *w_attn_o, *w_conv_o, *w_out, *w_xkv, *w_xo, *w_gate_up, *w_down, *g_ffn; bf16 *WinT, *WacT, *WoutT, *WxkvT, *wxot, *WguT, *WdT; };
constexpr int TP_I0 = 32 * 272, TP_I1 = 16 * 64, TP_I2 = 16 * 64, TP_I3 = 32 * 64, TP_I4 = 32 * 32, TP_I7 = 8 * 64, TP_I5 = 32 * 352, TP_I6 = 88 * 64;
#ifndef P1_HEAD_PCT
#define P1_HEAD_PCT 50
#endif
constexpr int TP_NEARLY = TP_I0 + TP_I1 + TP_I2 + TP_I3 + TP_I4 + TP_I7, TP_NITEMS = TP_NEARLY + TP_I5 + TP_I6;
__device__ __forceinline__ TpItem tp_mk(const float* W, int ldw, int src_col0, int k0, bf16* dst, int ldd, int dst_row0, int dst_col0, const float* kscale, int perm, float cscale = 1.f) {
    TpItem d; d.cscale = cscale; d.src = W + (size_t)k0 * ldw + src_col0; d.dst = dst + (size_t)dst_row0 * ldd + dst_col0 + k0; d.ks = kscale ? kscale + k0 : nullptr; d.ldw = ldw; d.ldd = ldd; d.perm = perm; return d; }
__device__ __forceinline__ TpItem tp_desc(int it, const TpPtrs& P) {
    int r = it;
    if (r < TP_I0) { const int kb_ = r / 272, Gp = r % 272; int src, perm = 0;
        if (Gp < 40) { src = 32 * Gp; perm = ((Gp & 1) == 0) ? 1 : 0; }
        else if (Gp < 80) { src = 32 * Gp; }
        else if (Gp < 144) { const int gg = Gp - 80, t = gg >> 3, i32 = gg & 7; src = (i32 < 4) ? (2560 + 128 * t + 32 * i32) : (3584 + 128 * t + 32 * (i32 - 4)); }
        else { const int gg = Gp - 144, t = gg >> 3, i32 = gg & 7; src = (i32 < 4) ? (4608 + 128 * t + 32 * i32) : (6656 + 128 * t + 32 * (i32 - 4)); }
        return tp_mk(P.w_in, NIN, src, 64 * kb_, P.WinT, DM, 32 * Gp, 0, nullptr, perm, Gp >= 144 ? -LOG2E : 1.f); } r -= TP_I0;
    if (r < TP_I1) { const int kb_ = r / 64, Gp = r % 64; return tp_mk(P.w_attn_o, DM, 32 * Gp, 64 * kb_, P.WacT, DM, 32 * Gp, 0, nullptr, 0); } r -= TP_I1;
    if (r < TP_I2) { const int kb_ = r / 64, Gp = r % 64; return tp_mk(P.w_conv_o, DM, 32 * Gp, 64 * kb_, P.WacT, DM, 32 * Gp, 1024, nullptr, 0); } r -= TP_I2;
    if (r < TP_I3) { const int kb_ = r / 64, Gp = r % 64; return tp_mk(P.w_out, DM, 32 * Gp, 64 * kb_, P.WoutT, DM, 32 * Gp, 0, nullptr, 0); } r -= TP_I3;
    if (r < TP_I4) { const int kb_ = r / 32, Gp = r % 32; return tp_mk(P.w_xkv, 2 * XW, 32 * Gp, 64 * kb_, P.WxkvT, DM, 32 * Gp, 0, nullptr, 0); } r -= TP_I4;
    if (r < TP_I7) { const int kb_ = r / 64, Gp = r % 64; return tp_mk(P.w_xo, DM, 32 * Gp, 64 * kb_, P.wxot, XW, 32 * Gp, 0, nullptr, 0); } r -= TP_I7;
    if (r < TP_I5) { const int kb_ = r / 352, Gp = r % 352; const int t = Gp >> 3, i32 = Gp & 7; const int src = (i32 < 4) ? (128 * t + 32 * i32) : (DFF + 128 * t + 32 * (i32 - 4));
        return tp_mk(P.w_gate_up, 2 * DFF, src, 64 * kb_, P.WguT, DM, 32 * Gp, 0, P.g_ffn, 0); } r -= TP_I5;
    { const int kb_ = r / 64, Gp = r % 64; return tp_mk(P.w_down, DM, 32 * Gp, 64 * kb_, P.WdT, DFF, 32 * Gp, 0, nullptr, 0); }
}
__device__ __forceinline__ void tp_load(const TpItem& d, float (&tv)[32], int lane) {
    const float* sp = d.src + (size_t)(lane >> 5) * d.ldw + (lane & 31);
#pragma unroll
    for (int i = 0; i < 32; ++i) tv[i] = __builtin_nontemporal_load(sp + (size_t)(2 * i) * d.ldw);
}
__device__ __forceinline__ void tp_finish(const TpItem& d, const float (&tv)[32], LAS float* scr, int lane) {
#pragma unroll
    for (int i = 0; i < 32; ++i) scr[(2 * i + (lane >> 5)) * 33 + (lane & 31)] = tv[i];
    LDS_WAIT(); asm volatile("" ::: "memory");
    const int c = lane & 7;
    float sc[8];
#pragma unroll
    for (int i = 0; i < 8; ++i) sc[i] = d.ks ? d.ks[8 * c + i] * d.cscale : d.cscale;
#pragma unroll
    for (int j = 0; j < 4; ++j) { const int nd = (lane >> 3) + 8 * j; const int scol = d.perm ? rope_sigma(nd) : nd; const LAS float* s = scr + (8 * c) * 33 + scol;
        v4u o; o.x = cvt_pk_bf16(s[0 * 33] * sc[0], s[1 * 33] * sc[1]); o.y = cvt_pk_bf16(s[2 * 33] * sc[2], s[3 * 33] * sc[3]);
        o.z = cvt_pk_bf16(s[4 * 33] * sc[4], s[5 * 33] * sc[5]); o.w = cvt_pk_bf16(s[6 * 33] * sc[6], s[7 * 33] * sc[7]);
        *(v4u*)(d.dst + (size_t)nd * d.ldd + 8 * c) = o; }
    LDS_WAIT(); asm volatile("" ::: "memory");
}
__device__ __forceinline__ void tp_run(int it0, int it_end, int stride, const TpPtrs& P, LAS float* scr, int lane) {
    if (it0 >= it_end) return;
    TpItem d = tp_desc(it0, P); float tv[32]; tp_load(d, tv, lane);
    for (int it = it0; it < it_end; it += stride) {
        const int nx = it + stride; const bool more = nx < it_end; TpItem dn = d; float tn[32];
        if (more) { dn = tp_desc(nx, P); tp_load(dn, tn, lane); }
        tp_finish(d, tv, scr, lane);
        if (more) { d = dn;
#pragma unroll
            for (int i = 0; i < 32; ++i) tv[i] = tn[i]; }
    }
}
__device__ __forceinline__ void tp_run3(int it0, int it_end, int stride, const TpPtrs& P, LAS float* scr, int lane) {
    if (it0 >= it_end) return;
    TpItem d0 = tp_desc(it0, P), d1 = d0; float t0[32], t1[32]; tp_load(d0, t0, lane);
    if (it0 + stride < it_end) { d1 = tp_desc(it0 + stride, P); tp_load(d1, t1, lane); }
    for (int it = it0; it < it_end; it += stride) {
        const int n2 = it + 2 * stride; const bool more2 = n2 < it_end; TpItem d2 = d0; float t2[32];
        if (more2) { d2 = tp_desc(n2, P); tp_load(d2, t2, lane); }
        tp_finish(d0, t0, scr, lane);
        d0 = d1; d1 = d2;
#pragma unroll
        for (int i = 0; i < 32; ++i) { t0[i] = t1[i]; t1[i] = t2[i]; }
    }
}
__device__ __forceinline__ void rms_rows_to_bf16(const float* xb, const float* g, bf16* ob, int m0, int m_end, int stride, int lane) {
    if (m0 >= m_end) return;
    f32x4 v[8];
    { const f32x4* xr = (const f32x4*)(xb + (size_t)m0 * DM) + lane;
#pragma unroll
      for (int j = 0; j < 8; ++j) v[j] = __builtin_nontemporal_load(xr + 64 * j); }
    f32x4 gg[8];
#pragma unroll
    for (int j = 0; j < 8; ++j) gg[j] = ((const f32x4*)g + lane)[64 * j];
    for (int m = m0; m < m_end; m += stride) {
        const int nx = m + stride; const bool more = nx < m_end; f32x4 vn[8];
        if (more) { const f32x4* xr = (const f32x4*)(xb + (size_t)nx * DM) + lane;
#pragma unroll
            for (int j = 0; j < 8; ++j) vn[j] = __builtin_nontemporal_load(xr + 64 * j); }
        float s = 0.f;
#pragma unroll
        for (int j = 0; j < 8; ++j) s += (v[j].x * v[j].x + v[j].y * v[j].y) + (v[j].z * v[j].z + v[j].w * v[j].w);
        const float rstd = 1.0f / sqrtf(wave_sum(s) * (1.0f / DM) + EPS);
        v2u* o8 = (v2u*)(ob + (size_t)m * DM) + lane;
#pragma unroll
        for (int j = 0; j < 8; ++j) { v2u w; w.x = cvt_pk_bf16(v[j].x * rstd * gg[j].x, v[j].y * rstd * gg[j].y); w.y = cvt_pk_bf16(v[j].z * rstd * gg[j].z, v[j].w * rstd * gg[j].w); o8[64 * j] = w; }
        if (more) {
#pragma unroll
            for (int j = 0; j < 8; ++j) v[j] = vn[j]; }
    }
}

__device__ __forceinline__ s16x4 vtr(const LAS unsigned char* p) { typedef short v4i16_t __attribute__((ext_vector_type(4))); return __builtin_bit_cast(s16x4, __builtin_amdgcn_ds_read_tr16_b64_v4i16((LAS v4i16_t*)p)); }

struct ConvCtx { const bf16* zc; bf16* xn; int ts, cg; f32x4 w0[2], w1[2], w2[2], p1[2], p2[2]; };
__device__ __forceinline__ void conv_issue(const ConvCtx& c, int batch, v4u (&zb)[4], v4u (&zp)[4]) {
#pragma unroll
    for (int i = 0; i < 4; ++i) { const bf16* zr = c.zc + (size_t)(c.ts + 4 * batch + i) * (2 * CW) + 8 * c.cg; zb[i] = *(const v4u*)(zr); zp[i] = *(const v4u*)(zr + CW); }
}
__device__ __forceinline__ void conv_finish(ConvCtx& c, int batch, const v4u (&zb)[4], const v4u (&zp)[4]) {
#pragma unroll
    for (int i = 0; i < 4; ++i) { f32x4 cb0, cb1, p0a, p0b; unpack8(zb[i], cb0, cb1); unpack8(zp[i], p0a, p0b);
        const f32x4 y0 = cb0 * (c.w0[0] * c.p2[0] + c.w1[0] * c.p1[0] + c.w2[0] * p0a), y1 = cb1 * (c.w0[1] * c.p2[1] + c.w1[1] * c.p1[1] + c.w2[1] * p0b);
        *(v4u*)(c.xn + (size_t)(c.ts + 4 * batch + i) * DM + AW + 8 * c.cg) = pack8(y0, y1);
        c.p2[0] = c.p1[0]; c.p2[1] = c.p1[1]; c.p1[0] = p0a; c.p1[1] = p0b; }
}
__device__ __forceinline__ void conv_init(ConvCtx& c, const bf16* zc, bf16* xn, const float* conv_w, int chunk, int tid) {
    c.zc = zc; c.xn = xn; c.cg = tid & 127; c.ts = chunk * 64 + (tid >> 7) * 16;
#pragma unroll
    for (int j = 0; j < 2; ++j) { c.w0[j] = *(const f32x4*)(conv_w + 8 * c.cg + 4 * j); c.w1[j] = *(const f32x4*)(conv_w + CW + 8 * c.cg + 4 * j); c.w2[j] = *(const f32x4*)(conv_w + 2 * CW + 8 * c.cg + 4 * j);
        c.p2[j] = (f32x4){0.f, 0.f, 0.f, 0.f}; c.p1[j] = c.p2[j]; }
    if (c.ts >= 2) { unpack8(*(const v4u*)(zc + (size_t)(c.ts - 2) * (2 * CW) + CW + 8 * c.cg), c.p2[0], c.p2[1]); unpack8(*(const v4u*)(zc + (size_t)(c.ts - 1) * (2 * CW) + CW + 8 * c.cg), c.p1[0], c.p1[1]); }
}
template <bool CONV>
__device__ __forceinline__ void swa_unit(LAS unsigned char* lds, int n, int g, const bf16* qb, const bf16* kb, const bf16* vb, const float* sinks, bf16* A2, int tid, int lane, int wave, ConvCtx& cc, int batch0) {
    LAS unsigned char* Kl = lds; LAS unsigned char* Vl = lds + 32768;
#pragma unroll
    for (int i = 0; i < 4; ++i) { const int id = tid + 512 * i, row = id >> 3, ch = id & 7; const int tok = (n - 1) * 128 + row;
        v4u kv = (v4u){0u, 0u, 0u, 0u}, vv = (v4u){0u, 0u, 0u, 0u};
        if (tok >= 0) { kv = *(const v4u*)(kb + (size_t)tok * KVW + g * 64 + ch * 8); vv = *(const v4u*)(vb + (size_t)tok * KVW + g * 64 + ch * 8); }
        *(LAS v4u*)(Kl + row * 128 + ((ch ^ ((row >> 1) & 7)) << 4)) = kv;
        *(LAS v4u*)(Vl + row * 128 + ((ch ^ (((row >> 1) & 1) << 2)) << 4)) = vv; }
    __syncthreads();
    const int ql = lane & 31, h = lane >> 5, hq = g * 4 + (wave & 3);
    const float sinkl = sinks[hq] * LOG2E;
    const int li = lane & 15, qp = li >> 2, pp = li & 3, g1 = (lane >> 4) & 1;
    const float NEG = -__builtin_inff();
#pragma unroll 1
    for (int st = 0; st < 2; ++st) {
        const int r0 = (wave >> 2) * 64 + 32 * st; const size_t tok = (size_t)n * 128 + r0 + ql;
        bf16x8 qf[4];
#pragma unroll
        for (int ks = 0; ks < 4; ++ks) qf[ks] = *(const bf16x8*)(qb + tok * AW + hq * 64 + 16 * ks + 8 * h);
        v4u zb[4], zp[4];
        if (CONV) conv_issue(cc, batch0 + st, zb, zp);
        f32x16 S[5];
#pragma unroll
        for (int t = 0; t < 5; ++t) { const int c = r0 + 32 * t + ql; S[t] = (f32x16){};
#pragma unroll
            for (int ks = 0; ks < 4; ++ks) { const bf16x8 kf = *(const LAS bf16x8*)(Kl + c * 128 + (((2 * ks + h) ^ ((c >> 1) & 7)) << 4));
                S[t] = __builtin_amdgcn_mfma_f32_32x32x16_bf16(kf, qf[ks], S[t], 0, 0, 0); } }
#pragma unroll
        for (int r = 0; r < 16; ++r) { const int cc = (r & 3) + 8 * (r >> 2) + 4 * h; if (!(cc > ql)) S[0][r] = NEG; if (!(cc <= ql)) S[4][r] = NEG; }
        if (n == 0) {
#pragma unroll
            for (int t = 0; t < 5; ++t)
#pragma unroll
                for (int r = 0; r < 16; ++r) { const int cc = (r & 3) + 8 * (r >> 2) + 4 * h; if (r0 + 32 * t + cc < 128) S[t][r] = NEG; } }
        float mx = sinkl;
#pragma unroll
        for (int t = 0; t < 5; ++t)
#pragma unroll
            for (int r = 0; r < 16; ++r) mx = fmaxf(mx, S[t][r]);
        mx = fmaxf(mx, __shfl_xor(mx, 32));
        float l = 0.f;
#pragma unroll
        for (int t = 0; t < 5; ++t)
#pragma unroll
            for (int r = 0; r < 16; ++r) { const float p = fast_exp2(S[t][r] - mx); S[t][r] = p; l += p; }
        l += __shfl_xor(l, 32); l += fast_exp2(sinkl - mx);
        f32x16 O[2]; O[0] = (f32x16){}; O[1] = (f32x16){};
#pragma unroll
        for (int t = 0; t < 5; ++t)
#pragma unroll
            for (int s = 0; s < 2; ++s) {
                v4u pw; pw.x = cvt_pk_bf16(S[t][8 * s + 0], S[t][8 * s + 1]); pw.y = cvt_pk_bf16(S[t][8 * s + 2], S[t][8 * s + 3]);
                pw.z = cvt_pk_bf16(S[t][8 * s + 4], S[t][8 * s + 5]); pw.w = cvt_pk_bf16(S[t][8 * s + 6], S[t][8 * s + 7]);
                const bf16x8 pf = __builtin_bit_cast(bf16x8, pw);
                const int krow = r0 + 32 * t + 16 * s + 4 * h + qp;
#pragma unroll
                for (int db = 0; db < 2; ++db) { const int chunk = (4 * db + 2 * g1 + (pp >> 1)) ^ (((qp >> 1) & 1) << 2);
                    const LAS unsigned char* va = Vl + krow * 128 + (chunk << 4) + (pp & 1) * 8;
                    const s16x4 lo = vtr(va), hi = vtr(va + 8 * 128);
                    const bf16x8 vf = (bf16x8){lo[0], lo[1], lo[2], lo[3], hi[0], hi[1], hi[2], hi[3]};
                    O[db] = __builtin_amdgcn_mfma_f32_32x32x16_bf16(vf, pf, O[db], 0, 0, 0); } }
        const float inv = 1.0f / l;
#pragma unroll
        for (int db = 0; db < 2; ++db)
#pragma unroll
            for (int pr = 0; pr < 2; ++pr) { const int ra = 8 * pr, rb = 8 * pr + 4;
                unsigned ax = cvt_pk_bf16(O[db][ra + 0] * inv, O[db][ra + 1] * inv), ay = cvt_pk_bf16(O[db][ra + 2] * inv, O[db][ra + 3] * inv);
                unsigned bx_ = cvt_pk_bf16(O[db][rb + 0] * inv, O[db][rb + 1] * inv), by = cvt_pk_bf16(O[db][rb + 2] * inv, O[db][rb + 3] * inv);
                { auto r = __builtin_amdgcn_permlane32_swap(ax, bx_, false, false); ax = r[0]; bx_ = r[1]; }
                { auto r = __builtin_amdgcn_permlane32_swap(ay, by, false, false); ay = r[0]; by = r[1]; }
                *(v4u*)(A2 + tok * DM + hq * 64 + 32 * db + 16 * pr + 8 * h) = (v4u){ax, ay, bx_, by}; }
        if (CONV) conv_finish(cc, batch0 + st, zb, zp);
    }
    __syncthreads();
}
__device__ __forceinline__ void wave_gemm_64x32_k128(const bf16* A, int lda, const bf16* Bt, int ldb, bf16* C, int ldc, int lane) {
    const int fr = lane & 15, fq = lane >> 4;
    f32x4 acc[4][2];
#pragma unroll
    for (int mi = 0; mi < 4; ++mi)
#pragma unroll
        for (int ni = 0; ni < 2; ++ni) acc[mi][ni] = (f32x4){0.f, 0.f, 0.f, 0.f};
#pragma unroll
    for (int ks = 0; ks < 4; ++ks) { bf16x8 a[4], b[2];
#pragma unroll
        for (int mi = 0; mi < 4; ++mi) a[mi] = *(const bf16x8*)(A + (size_t)(16 * mi + fr) * lda + 32 * ks + 8 * fq);
#pragma unroll
        for (int ni = 0; ni < 2; ++ni) b[ni] = *(const bf16x8*)(Bt + (size_t)(16 * ni + fr) * ldb + 32 * ks + 8 * fq);
#pragma unroll
        for (int mi = 0; mi < 4; ++mi)
#pragma unroll
            for (int ni = 0; ni < 2; ++ni) acc[mi][ni] = __builtin_amdgcn_mfma_f32_16x16x32_bf16(b[ni], a[mi], acc[mi][ni], 0, 0, 0); }
#pragma unroll
    for (int mi = 0; mi < 4; ++mi)
#pragma unroll
        for (int ni = 0; ni < 2; ++ni) { v2u w; w.x = cvt_pk_bf16(acc[mi][ni][0], acc[mi][ni][1]); w.y = cvt_pk_bf16(acc[mi][ni][2], acc[mi][ni][3]);
            st8_wt(C + (size_t)(16 * mi + fr) * ldc + 16 * ni + 4 * fq, w); }
}

constexpr int NPHASE = 10;
struct Args { const float* in[18]; float* out; unsigned char* ws; int ph_lo, ph_hi, li, pad; };

__global__ void __launch_bounds__(512, 2) hyb_fwd(Args args) {
    extern __shared__ __attribute__((aligned(16))) unsigned char lds_raw[];
    LAS unsigned char* lds = (LAS unsigned char*)lds_raw;
    volatile LAS unsigned* MISC = (volatile LAS unsigned*)(lds + MISC_OFF);
    const int tid = threadIdx.x, lane = tid & 63, wave = __builtin_amdgcn_readfirstlane(tid >> 6);
    const int G = gridDim.x, bx = blockIdx.x;
    unsigned char* ws = args.ws;
    unsigned* ctl = (unsigned*)(ws + WS_CTL);
    const float* x = args.in[0]; const float* mem = args.in[1]; const float* g_mix = args.in[2]; const float* w_in = args.in[3]; const float* conv_w = args.in[4];
    const float* sinks = args.in[5]; const float* w_attn_o = args.in[6]; const float* w_conv_o = args.in[7]; const float* w_out = args.in[8]; const float* g_xattn = args.in[9];
    const float* g_mem = args.in[10]; const float* w_xq = args.in[11]; const float* w_xkv = args.in[12]; const float* w_xo = args.in[13]; const float* g_ffn = args.in[14];
    const float* w_gate_up = args.in[15]; const float* w_down = args.in[16]; const float* g_final = args.in[17];
    float* out = args.out;
    float* ss1 = (float*)(ws + WS_SS); float* ss2 = ss1 + SEQ; float* ss3 = ss2 + SEQ;
    float* cs = (float*)(ws + WS_CS);
    bf16* kvb = (bf16*)(ws + WS_KVB); bf16* memn = (bf16*)(ws + WS_MEMN); bf16* wxqp = (bf16*)(ws + WS_WXQ); bf16* wxot = (bf16*)(ws + WS_WXOT);
    bf16* WguT = (bf16*)(ws + WS_WGUT); bf16* WdT = (bf16*)(ws + WS_WDT); bf16* XN = (bf16*)(ws + WS_XN);
    bf16* WinT = (bf16*)(ws + WS_WINT); bf16* WacT = (bf16*)(ws + WS_WACT); bf16* WoutT = (bf16*)(ws + WS_WOUTT); bf16* WxkvT = (bf16*)(ws + WS_WXKVT);
    bf16* WqKT = (bf16*)(ws + WS_WQKT); bf16* VWoT = (bf16*)(ws + WS_VWOT);
    bf16* qb = (bf16*)(ws + WS_Q); bf16* kb = (bf16*)(ws + WS_K); bf16* vb = (bf16*)(ws + WS_V); bf16* zc = (bf16*)(ws + WS_ZC);
    bf16* Pb = (bf16*)(ws + WS_P); bf16* act = (bf16*)(ws + WS_ACT);
    bf16* sgr = (bf16*)out; bf16* sgc = sgr + (size_t)SEQ * DM;
    bf16* merged = sgr;

    for (int u = tid; u < (LDS_BYTES - LDSCTL_OFF) / 4; u += 512) ((LAS unsigned*)(lds + LDSCTL_OFF))[u] = 0u;
    __syncthreads();
    XcdBarrier bar; bar.bar = ctl + CW_BAR; bar.x = 0; bar.st = nullptr;
    if (MK_N_LAUNCHES == 1) bar = xcd_barrier_post(ctl + CW_BAR, MISC + 8);
    if (tid == 0) __hip_atomic_store(ctl + CW_XID + 64 * (bx & 63) + (bx >> 6), xb_xcc_id() + 1u, __ATOMIC_RELAXED, __HIP_MEMORY_SCOPE_AGENT);
    const int lo = args.ph_lo, hi = args.ph_hi;
    const bool tailfill = (G == 256);
#define IN(k) (lo <= (k) && (k) < hi)
#ifdef PROBE_PHASE
    int n_stamp = 0;
#define STAMP() do { if (bx == 0 && tid == 0) { ((volatile LAS unsigned long long*)(lds + MISC_OFF + 128))[n_stamp] = __builtin_amdgcn_s_memrealtime(); ((volatile LAS unsigned long long*)(lds + MISC_OFF + 256))[n_stamp] = __builtin_amdgcn_s_memtime(); } ++n_stamp; } while (0)
#define SUBSTAMP(i) do { __builtin_amdgcn_s_waitcnt(0); if (bx == 0 && tid == 0) ((volatile LAS unsigned long long*)(lds + MISC_OFF + 128))[40 + (i)] = __builtin_amdgcn_s_memrealtime(); } while (0)
#else
#define STAMP() do { } while (0)
#define SUBSTAMP(i) do { } while (0)
#endif
#define SEAM(k) do { if (IN(k) && IN((k) + 1)) xcd_barrier(bar); STAMP(); } while (0)
    const bool grp = (G == 256) && (MK_N_LAUNCHES == 1);
    const int pm_own = 8 * (bx & 7) + ((bx >> 3) & 7), jmem = bx >> 6;
    unsigned* gcnt = ctl + CW_GRP + 64 * (bx & 63); unsigned* glob = ctl + CW_GLOB; unsigned* gtmo = ctl + CW_BAR + XB_TMO;
    unsigned gepoch = 0; bool same_xcd = false;
#define GSEAM(k, extra) do { if (IN(k) && IN((k) + 1)) { if (grp) { gepoch += 4u; group_barrier(gcnt, gepoch, (extra), gtmo, same_xcd); } else xcd_barrier(bar); } STAMP(); } while (0)
    STAMP();

    const TpPtrs TP{w_in, w_attn_o, w_conv_o, w_out, w_xkv, w_xo, w_gate_up, w_down, g_ffn, WinT, WacT, WoutT, WxkvT, wxot, WguT, WdT};
    if (IN(0)) {
        LAS float* scr = (LAS float*)(lds + wave * 16384);
        const int gw = bx * 8 + wave, NGW = G * 8;
        SUBSTAMP(0);
        tp_run(gw, tailfill ? TP_NEARLY : TP_NITEMS, NGW, TP, scr, lane);
        SUBSTAMP(1);
        rms_rows_to_bf16(x, g_mix, XN, gw, SEQ, NGW, lane);
        SUBSTAMP(2);
        rms_rows_to_bf16(mem, g_mem, memn, gw, NMEM, NGW, lane);
        for (int k = gw; k < DM; k += NGW) { const float gs = g_xattn[k] * C2X; const f32x4* src = (const f32x4*)(w_xq + (size_t)k * XW) + lane; v2u* dst = (v2u*)(wxqp + (size_t)k * XW) + lane;
#pragma unroll
            for (int j = 0; j < 2; ++j) { const f32x4 v = src[64 * j]; v2u w; w.x = cvt_pk_bf16(v.x * gs, v.y * gs); w.y = cvt_pk_bf16(v.z * gs, v.w * gs); dst[64 * j] = w; } }
        const int gt = bx * 512 + tid, NGT = G * 512;
        for (int e = gt; e < SEQ * 8; e += NGT) { const int pos = e >> 3, i = e & 7;
            const float inv_freq = (i == 0) ? 1.0f : (i == 1) ? 0.19392274f : (i == 2) ? 0.037606031f : (i == 3) ? 0.0072926646f : (i == 4) ? 0.0014142136f : (i == 5) ? 0.00027424819f : (i == 6) ? 5.3182957e-05f : 1.0313385e-05f;
            const float ang = (float)pos * inv_freq; float sn, cn; sincosf(ang, &sn, &cn);
            cs[(size_t)pos * 16 + i] = cn; cs[(size_t)pos * 16 + 8 + i] = sn; }
        for (int e = gt; e < 3 * SEQ; e += NGT) ss1[e] = 0.f;
        SUBSTAMP(3);
    }
    SEAM(0);

    if (IN(1)) {
        { pg8::Prob g{memn, WxkvT, DM, DM, DM, 0}; pg8::StaticOrder S; S.init(NMEM, 2 * XW, G, (bx >= 128 && bx < 132) ? bx - 128 : -1);
          EpiStoreBf16 E{kvb, 2 * XW};
          pg8::gemm_phase<EpiStoreBf16, pg8::StaticOrder, PG8_ALIGN, PG8_SP2>(lds, g, S, E); }
        constexpr int TP_MID = TP_NEARLY + (TP_NITEMS - TP_NEARLY) * P1_HEAD_PCT / 100;
        if (tailfill && bx >= 132) { tp_run3(TP_NEARLY + (bx - 132) * 8 + wave, TP_MID, (256 - 132) * 8, TP, (LAS float*)(lds + wave * 16384), lane); __syncthreads(); }
        { pg8::Prob g{XN, WinT, DM, DM, DM, 0}; pg8::StaticOrder S; S.init(SEQ, NIN, G, bx);
          EpiInProj E{qb, kb, vb, zc, sgr, sgc, cs};
          pg8::gemm_phase<EpiInProj, pg8::StaticOrder, PG8_ALIGN, PG8_SP2>(lds, g, S, E); }
        if (tailfill && bx >= 132) tp_run3(TP_MID + (bx - 132) * 8 + wave, TP_NITEMS, (256 - 132) * 8, TP, (LAS float*)(lds + wave * 16384), lane);
    }
    SEAM(1);

    if (grp && IN(2)) {
        if (tid == 0) { unsigned* xt = ctl + CW_XID + 64 * (bx & 63); const unsigned a0 = xb_ld(xt), a1 = xb_ld(xt + 1), a2 = xb_ld(xt + 2), a3 = xb_ld(xt + 3);
            MISC[12] = (a0 != 0u && a0 == a1 && a0 == a2 && a0 == a3) ? 1u : 0u; }
        __syncthreads();
        same_xcd = __builtin_amdgcn_readfirstlane(MISC[12]) != 0u;
    }
    if (IN(2)) {
        SUBSTAMP(4);
        ConvCtx cc;
        if (grp) {
            conv_init(cc, zc, XN, conv_w, 4 * pm_own + jmem, tid);
            swa_unit<true>(lds, 2 * pm_own + ((2 * jmem) >> 2), (2 * jmem) & 3, qb, kb, vb, sinks, XN, tid, lane, wave, cc, 0);
            swa_unit<true>(lds, 2 * pm_own + ((2 * jmem + 1) >> 2), (2 * jmem + 1) & 3, qb, kb, vb, sinks, XN, tid, lane, wave, cc, 2);
        } else {
            for (int u = bx; u < (SEQ / 128) * 4; u += G) swa_unit<false>(lds, u >> 2, u & 3, qb, kb, vb, sinks, XN, tid, lane, wave, cc, 0);
            for (int ch = bx; ch < SEQ / 64; ch += G) { conv_init(cc, zc, XN, conv_w, ch, tid);
#pragma unroll 1
                for (int b = 0; b < 4; ++b) { v4u zb[4], zp[4]; conv_issue(cc, b, zb, zp); conv_finish(cc, b, zb, zp); } }
        }
        SUBSTAMP(5);
        const bool pp_all = !grp; const int pp_w = ((bx >> 4) << 3) + (bx & 7);
        for (int job = pp_all ? bx * 8 + wave : (((bx >> 3) & 1) ? pp_w * 8 + wave : 2048); job < 2048; job += (pp_all ? G * 8 : 1024)) { const int idx = job & 1023;
            if (job < 1024) { const int mt = idx >> 6, nt = idx & 63, m0 = 64 * mt, n0 = 32 * nt, hh = m0 >> 8, j0 = m0 & 255;
                wave_gemm_64x32_k128(kvb + (size_t)j0 * (2 * XW) + 128 * hh, 2 * XW, wxqp + (size_t)n0 * XW + 128 * hh, XW, WqKT + (size_t)m0 * DM + n0, DM, lane); }
            else { const int mt = idx >> 5, nt = idx & 31, m0 = 64 * mt, n0 = 32 * nt, hh = n0 >> 8, j0 = n0 & 255;
                wave_gemm_64x32_k128(wxot + (size_t)m0 * XW + 128 * hh, XW, kvb + (size_t)j0 * (2 * XW) + XW + 128 * hh, 2 * XW, VWoT + (size_t)m0 * (4 * NMEM) + n0, 4 * NMEM, lane); } }
    }
    SUBSTAMP(7);
    GSEAM(2, glob);

    if (IN(3)) { pg8::Prob g{XN, WacT, DM, DM, AW, AW}; pg8::StaticOrder S; S.init(SEQ, DM, G, bx, 2);
        EpiMerge E{sgr, sgc, merged};
        pg8::gemm_phase<EpiMerge, pg8::StaticOrder, PG8_ALIGN, PG8_SP2>(lds, g, S, E); }
    GSEAM(3, nullptr);

    if (IN(4)) { pg8::Prob g{merged, WoutT, DM, DM, DM, 0}; pg8::StaticOrder S; S.init(SEQ, DM, G, bx);
        EpiResid<true> E{x, XN, ss1};
        pg8::gemm_phase<EpiResid<true>, pg8::StaticOrder, PG8_ALIGN, PG8_SP2>(lds, g, S, E); }
    GSEAM(4, glob + 64);

    if (IN(5)) { if (grp) wait_global(glob, 256u, gtmo);
        pg8::Prob g{XN, WqKT, DM, DM, DM, 0}; pg8::StaticOrder S; S.init(SEQ, 4 * NMEM, G, bx);
        EpiSoftmax E{ss1, Pb};
        if ((SEQ / 256) * 4 <= G) pg8::gemm_phase<EpiSoftmax, pg8::StaticOrder, false, PG8_SP2>(lds, g, S, E); }
    GSEAM(5, nullptr);

    if (IN(6)) { pg8::Prob g{Pb, VWoT, 4 * NMEM, 4 * NMEM, 4 * NMEM, 0}; pg8::StaticOrder S; S.init(SEQ, DM, G, bx);
        EpiResid<false> E{nullptr, XN, ss2};
        pg8::gemm_phase<EpiResid<false>, pg8::StaticOrder, PG8_ALIGN, PG8_SP2>(lds, g, S, E); }
    GSEAM(6, nullptr);

    if (IN(7)) { pg8::Prob g{XN, WguT, DM, DM, DM, 0}; pg8::StaticOrder S; S.init(SEQ, 2 * DFF, G, bx);
        EpiSwiGLU E{ss2, act};
        pg8::gemm_phase<EpiSwiGLU, pg8::StaticOrder, PG8_ALIGN, PG8_SP2>(lds, g, S, E); }
    GSEAM(7, nullptr);

    if (IN(8)) { pg8::Prob g{act, WdT, DFF, DFF, DFF, 0}; pg8::StaticOrder S; S.init(SEQ, DM, G, bx);
        if (grp) { EpiFinal E{XN, ss3, out, g_final, gcnt, gepoch + 4u, glob + 64, gtmo, same_xcd}; gepoch += 4u;
            pg8::gemm_phase<EpiFinal, pg8::StaticOrder, PG8_ALIGN, PG8_SP2>(lds, g, S, E); }
        else { EpiResid<false> E{nullptr, XN, ss3};
            pg8::gemm_phase<EpiResid<false>, pg8::StaticOrder, PG8_ALIGN, PG8_SP2>(lds, g, S, E); } }
    if (!grp) { GSEAM(8, nullptr); } else { STAMP(); }

    if (IN(9) && !grp) {
        if (grp) wait_global(glob + 64, 256u, gtmo);
        const int m0 = grp ? 256 * pm_own + 64 * jmem + wave : bx * 8 + wave, m_end = grp ? 256 * pm_own + 64 * jmem + 64 : SEQ, NGW = grp ? 8 : G * 8;
        f32x4 gg[4][2];
#pragma unroll
        for (int j = 0; j < 4; ++j) { gg[j][0] = ((const f32x4*)g_final + 2 * lane)[128 * j]; gg[j][1] = ((const f32x4*)g_final + 2 * lane)[128 * j + 1]; }
        v4u hv[4];
        if (m0 < m_end) {
#pragma unroll
            for (int j = 0; j < 4; ++j) hv[j] = ((const v4u*)(XN + (size_t)m0 * DM) + lane)[64 * j]; }
        for (int m = m0; m < m_end; m += NGW) { const int nx = m + NGW; const bool more = nx < m_end; v4u hn[4];
            if (more) {
#pragma unroll
                for (int j = 0; j < 4; ++j) hn[j] = ((const v4u*)(XN + (size_t)nx * DM) + lane)[64 * j]; }
            const float rs = 1.0f / sqrtf(ss3[m] * (1.0f / DM) + EPS); f32x4* o = (f32x4*)(out + (size_t)m * DM) + 2 * lane;
#pragma unroll
            for (int j = 0; j < 4; ++j) { f32x4 v0, v1; unpack8(hv[j], v0, v1); o[128 * j] = v0 * rs * gg[j][0]; o[128 * j + 1] = v1 * rs * gg[j][1]; }
            if (more) {
#pragma unroll
                for (int j = 0; j < 4; ++j) hv[j] = hn[j]; } } }
#ifdef PROBE_PHASE
    STAMP();
    if (bx == 0 && tid == 0) { volatile LAS unsigned long long* st = (volatile LAS unsigned long long*)(lds + MISC_OFF + 128);
        volatile LAS unsigned long long* sc = (volatile LAS unsigned long long*)(lds + MISC_OFF + 256);
        unsigned long long span = st[PROBE_PHASE + 1] - st[PROBE_PHASE]; const unsigned long long t0 = __builtin_amdgcn_s_memrealtime();
#ifdef PROBE_SUB
        span = st[40 + PROBE_SUB + 1] - st[40 + PROBE_SUB];
#endif
#ifdef PROBE_CLOCK
        span = (sc[PROBE_PHASE + 1] - sc[PROBE_PHASE]) * 1250ull / span;
#endif
        while (__builtin_amdgcn_s_memrealtime() - t0 < 8ull * span) __builtin_amdgcn_s_sleep(8); }
#endif
#ifdef DBG_STOP
    if (IN(10)) { const size_t gt = (size_t)bx * 512 + tid, NGT = (size_t)G * 512;
        for (size_t e = gt; e < (size_t)SEQ * DM; e += NGT) {
#if DBG_DUMP == 0
            out[e] = __builtin_bit_cast(float, (unsigned)XN[e] << 16);
#elif DBG_DUMP == 1
            out[e] = __builtin_bit_cast(float, (unsigned)XN[e] << 16);
#elif DBG_DUMP == 2
            out[e] = __builtin_bit_cast(float, (unsigned)merged[e] << 16);
#elif DBG_DUMP == 3
            { const size_t r = e / DM, c = e % DM; out[e] = __builtin_bit_cast(float, (unsigned)(c < 1024 ? qb[r * 1024 + c] : (c < 1280 ? kb[r * 256 + c - 1024] : (c < 1536 ? vb[r * 256 + c - 1280] : zc[r * 2048 + ((c - 1536) & 2047)]))) << 16); }
#elif DBG_DUMP == 5
            { const size_t n1 = (size_t)1024 * 2048, n2 = 2 * n1, n3 = n2 + 256 * 1024; out[e] = (e < n1) ? __builtin_bit_cast(float, (unsigned)WqKT[e] << 16) : (e < n2) ? __builtin_bit_cast(float, (unsigned)VWoT[e - n1] << 16) : (e < n3) ? __builtin_bit_cast(float, (unsigned)kvb[e - n2] << 16) : 0.f; }
#elif DBG_DUMP == 6
            out[e] = (e < (size_t)256 * 1024) ? __builtin_bit_cast(float, (unsigned)kvb[e] << 16) : (e < (size_t)256 * 1024 + 256 * 2048) ? __builtin_bit_cast(float, (unsigned)memn[e - 256 * 1024] << 16) : 0.f;
#elif DBG_DUMP == 7
            out[e] = (e < (size_t)2048 * 512) ? __builtin_bit_cast(float, (unsigned)wxqp[e] << 16) : (e < (size_t)2 * 2048 * 512) ? __builtin_bit_cast(float, (unsigned)wxot[e - 2048 * 512] << 16) : 0.f;
#elif DBG_DUMP == 4
            { const size_t r = e / DM, c = e % DM; out[e] = __builtin_bit_cast(float, (unsigned)(c < 1024 ? Pb[r * 1024 + c] : (bf16)0) << 16); }
#endif
        } }
#endif
#undef IN
#undef SEAM
#undef GSEAM
}

extern "C" void kernel_launch(void* const* d_in, const int* in_sizes, int n_in, void* d_out, int out_size, void* d_ws, size_t ws_size, hipStream_t stream) {
    static int grid = 0;
    if (grid == 0) {
        if (n_in != 18 || in_sizes[0] != SEQ * DM || out_size != SEQ * DM || ws_size < WS_END) { fprintf(stderr, "kernel_launch: unexpected shapes / workspace (n_in %d, in0 %d, out %d, ws %zu); nothing launched\n", n_in, n_in > 0 ? in_sizes[0] : -1, out_size, ws_size); grid = -1; return; }
        int dev = 0, cus = 0;
        if (hipGetDevice(&dev) != hipSuccess || hipDeviceGetAttribute(&cus, hipDeviceAttributeMultiprocessorCount, dev) != hipSuccess) { fprintf(stderr, "kernel_launch: device query failed\n"); grid = -1; return; }
        if (hipFuncSetAttribute((const void*)hyb_fwd, hipFuncAttributeMaxDynamicSharedMemorySize, LDS_BYTES) != hipSuccess) { fprintf(stderr, "kernel_launch: hipFuncSetAttribute failed\n"); grid = -1; return; }
        int per_cu = 0;
        if (hipOccupancyMaxActiveBlocksPerMultiprocessor(&per_cu, (const void*)hyb_fwd, 512, LDS_BYTES) != hipSuccess || per_cu < 1) fprintf(stderr, "kernel_launch: note: occupancy query reports %d workgroups per CU\n", per_cu);
        (void)hipGetLastError();
        grid = cus;
    }
    if (grid < 0) return;
    if (hipMemsetAsync((char*)d_ws + WS_CTL, 0, CTL_ZERO_BYTES, stream) != hipSuccess) { fprintf(stderr, "kernel_launch: memset failed\n"); return; }
    Args a{};
    for (int i = 0; i < 18; ++i) a.in[i] = (const float*)d_in[i];
    a.out = (float*)d_out; a.ws = (unsigned char*)d_ws;
#ifdef DBG_STOP
    const int nl = DBG_STOP + 2;
#else
    const int nl = MK_N_LAUNCHES;
#endif
    for (int li = 0; li < nl; ++li) {
        a.ph_lo = (MK_N_LAUNCHES == 1) ? 0 : li; a.ph_hi = (MK_N_LAUNCHES == 1) ? NPHASE : li + 1; a.li = li; a.pad = 0;
#ifdef DBG_STOP
        if (li == nl - 1) { a.ph_lo = 10; a.ph_hi = 11; }
#endif
        hipLaunchKernelGGL(hyb_fwd, dim3(grid), dim3(512), LDS_BYTES, stream, a);
        const hipError_t le = hipPeekAtLastError();
        if (le != hipSuccess) { fprintf(stderr, "kernel_launch: launch %d failed: %s\n", li, hipGetErrorName(le)); break; }
    }
}
```

```cpp
#include <hip/hip_runtime.h>
#include <cstdio>
#include <cstdint>

#ifndef MK_N_LAUNCHES
#define MK_N_LAUNCHES 1
#endif

#define GAS __attribute__((address_space(1)))
#define LAS __attribute__((address_space(3)))
typedef unsigned short bf16;
typedef unsigned v4u __attribute__((ext_vector_type(4)));
typedef unsigned v2u __attribute__((ext_vector_type(2)));
typedef float f32x4 __attribute__((ext_vector_type(4)));
typedef float f32x16 __attribute__((ext_vector_type(16)));
typedef short bf16x8 __attribute__((ext_vector_type(8)));
typedef short s16x4 __attribute__((ext_vector_type(4)));

constexpr int SEQ = 16384, DM = 2048, NIN = 8704, AW = 1024, KVW = 256, CW = 1024, XW = 512, NMEM = 256, DFF = 5632;
constexpr float EPS = 1e-6f;
constexpr float LOG2E = 1.4426950408889634f;
constexpr float QSCALE = 0.125f * 1.4426950408889634f;
constexpr float C2X = 0.08838834764831845f * 1.4426950408889634f;

constexpr size_t MiB = 1u << 20;
constexpr size_t WS_CTL = 0, CTL_ZERO_BYTES = 256 * 1024;
constexpr size_t WS_SS = 1 * MiB;
constexpr size_t WS_CS = 2 * MiB;
constexpr size_t WS_KVB = 3 * MiB;
constexpr size_t WS_MEMN = 4 * MiB;
constexpr size_t WS_WXQ = 5 * MiB;
constexpr size_t WS_WXOT = 7 * MiB;
constexpr size_t WS_WGUT = 16 * MiB;
constexpr size_t WS_WDT = 60 * MiB;
constexpr size_t WS_XN = 82 * MiB;
constexpr size_t WS_WACT = 146 * MiB;
constexpr size_t WS_WOUTT = 154 * MiB;
constexpr size_t WS_WQKT = 162 * MiB;
constexpr size_t WS_VWOT = 166 * MiB;
constexpr size_t WS_Q = 170 * MiB, WS_K = 202 * MiB, WS_V = 210 * MiB, WS_ZC = 218 * MiB;
constexpr size_t WS_P = WS_Q;
constexpr size_t WS_ACT = 314 * MiB;
constexpr size_t WS_WINT = 314 * MiB;
constexpr size_t WS_WXKVT = 348 * MiB;
constexpr size_t WS_END = 490 * MiB;
static_assert(WS_ACT + (size_t)SEQ * DFF * 2 <= WS_END && WS_ZC + (size_t)SEQ * 3 * CW * 2 <= WS_ACT, "d_ws map");

constexpr int CW_BAR = 4096;
constexpr int CW_GRP = 16384;
constexpr int CW_XID = 49152;
constexpr int CW_GLOB = 32768;

constexpr int RING_BYTES = 131072;
constexpr int LDSCTL_OFF = RING_BYTES, MISC_OFF = LDSCTL_OFF + 320;
constexpr int LDS_BYTES = 147456;

#define RLX_AGENT __ATOMIC_RELAXED, __HIP_MEMORY_SCOPE_AGENT
#define LDS_WAIT() asm volatile("s_waitcnt lgkmcnt(0)" ::: "memory")
#define VM_WAIT() asm volatile("s_waitcnt vmcnt(0)" ::: "memory")

typedef float f32x2_t __attribute__((ext_vector_type(2))); typedef __bf16 bf16x2_t __attribute__((ext_vector_type(2)));
__device__ __forceinline__ unsigned cvt_pk_bf16(float lo, float hi) { f32x2_t v = {lo, hi}; bf16x2_t b = __builtin_convertvector(v, bf16x2_t); return __builtin_bit_cast(unsigned, b); }
__device__ __forceinline__ float bf_lo(unsigned u) { return __builtin_bit_cast(float, u << 16); }
__device__ __forceinline__ float bf_hi(unsigned u) { return __builtin_bit_cast(float, u & 0xffff0000u); }
__device__ __forceinline__ float fast_exp2(float x) { return __builtin_amdgcn_exp2f(x); }
__device__ __forceinline__ float fast_rcp(float x) { return __builtin_amdgcn_rcpf(x); }
__device__ __forceinline__ void st16_wt(void* p, v4u v) { asm volatile("global_store_dwordx4 %0, %1, off sc1\n\ts_nop 1" :: "v"(p), "v"(v) : "memory"); }
__device__ __forceinline__ void st8_wt(void* p, v2u v) { __hip_atomic_store((unsigned long long*)p, ((unsigned long long)v.y << 32) | v.x, __ATOMIC_RELAXED, __HIP_MEMORY_SCOPE_AGENT); }

namespace pg8 {
typedef unsigned short bf16_t;
constexpr int BM = 256, BK = 64, HALF = 128, HTB = HALF * BK * 2, STAGE_BYTES = 8 * HTB, NXCD = 8, WGM = 8;

__host__ __device__ __forceinline__ int lds_byte(int r, int c) { const int st = (r >> 4) * 2 + (c >> 5), rr = r & 15, cc = c & 31, ob = rr * 64 + cc * 2; return st * 1024 + (ob ^ (((ob >> 9) & 1) << 5)); }
__host__ __device__ __forceinline__ void stage_rc(int b, int& R, int& C) { const int st = b / 1024, sb = b % 1024, swz = sb ^ (((sb >> 9) & 1) << 5); R = (st >> 1) * 16 + swz / 64; C = (st & 1) * 32 + (swz % 64) / 2; }
__host__ __device__ __forceinline__ int perm32(int rho) { const int n = rho >> 4, i = rho & 15; return 8 * (i >> 2) + 4 * n + (i & 3); }

struct Unit { int pm, pn, z; };
struct Prob {
    const bf16_t* A; const bf16_t* Bt; int lda, ldb, K, zoff;
    __device__ __forceinline__ const char* a_ptr(const Unit& u) const { return (const char*)(A + (size_t)u.pm * BM * lda + (size_t)u.z * zoff); }
    __device__ __forceinline__ const char* b_ptr(const Unit& u) const { return (const char*)(Bt + (size_t)u.pn * BM * ldb + (size_t)u.z * zoff); }
};

__device__ __forceinline__ bool tile_of(long L, int nM, int nN, int& pm, int& pn) {
    const int nwg = nM * nN; if (L >= nwg) return false;
    int wgid = (int)L; { const int q = nwg / NXCD, r = nwg % NXCD, xcd = wgid % NXCD, off = wgid / NXCD; wgid = (xcd < r ? xcd * (q + 1) : r * (q + 1) + (xcd - r) * q) + off; }
    const int nig = WGM * nN, gid = wgid / nig, fm = gid * WGM, gsz = (nM - fm) < WGM ? (nM - fm) : WGM;
    pm = fm + ((wgid % nig) % gsz); pn = (wgid % nig) / gsz; return true;
}
struct StaticOrder {
    int nM, nN, G, c, ZS;
    __device__ __forceinline__ void init(int M, int N, int G_, int c_, int ZS_ = 1) { nM = M / BM; nN = N / BM; G = G_; c = c_; ZS = ZS_; }
    __device__ __forceinline__ bool next(int i, Unit& u) const {
        if (c < 0) return false;
        const int ti = (ZS == 2) ? (i >> 1) : i; u.z = (ZS == 2) ? (i & 1) : 0;
        return tile_of((long)ti * G + c, nM, nN, u.pm, u.pn);
    }
};

template <class Epi, class Sched, bool ALIGN_EPI = false, bool SP2 = false>
__device__ __forceinline__ void gemm_phase(LAS unsigned char* lds, const Prob g, const Sched& S, const Epi& E) {
    const int tid = threadIdx.x, wid = __builtin_amdgcn_readfirstlane(tid >> 6), lane = tid & 63, wr = wid >> 2, wc = wid & 3, fr = lane & 15, fq = lane >> 4;
    const int K = g.K, nt = K / BK;
    unsigned voffA[2], voffB[2];
#pragma unroll
    for (int i = 0; i < 2; ++i) { int R, C; stage_rc(tid * 16 + i * 8192, R, C); const int Rb = Epi::PERM ? ((R & ~31) + perm32(R & 31)) : R;
        voffA[i] = (unsigned)(R * g.lda + C) * 2u; voffB[i] = (unsigned)(Rb * g.ldb + C) * 2u; }
    const size_t kstep = (size_t)(BK * 2);
    const size_t hstepA = (size_t)HALF * g.lda * 2, hstepB = (size_t)HALF * g.ldb * 2;
    const unsigned ldsw = (unsigned)wid * 1024u;
    const int aoff = lds_byte(wr * 64 + fr, fq * 8), boff = lds_byte(wc * 32 + fr, fq * 8);
#define PG8_SA(b, h) (((b) * 2 + (h)) * HTB)
#define PG8_SB(b, h) ((4 + (b) * 2 + (h)) * HTB)
#define PG8_STAGE(bufoff, gbase, voff) do { _Pragma("unroll") for (int _i = 0; _i < 2; ++_i) \
        __builtin_amdgcn_global_load_lds((const unsigned*)((const char*)(gbase) + (voff)[_i]), (LAS unsigned*)(lds + (bufoff) + ldsw + _i * 8192), 16, 0, 0); } while (0)
#define PG8_LDA(dst, b, h) do { _Pragma("unroll") for (int m = 0; m < 4; ++m) _Pragma("unroll") for (int k = 0; k < 2; ++k) dst[m][k] = *(const LAS bf16x8*)(lds + PG8_SA(b, h) + aoff + m * 2048 + k * 1024); } while (0)
#define PG8_LDB(dst, b, h) do { _Pragma("unroll") for (int n = 0; n < 2; ++n) _Pragma("unroll") for (int k = 0; k < 2; ++k) dst[n][k] = *(const LAS bf16x8*)(lds + PG8_SB(b, h) + boff + n * 2048 + k * 1024); } while (0)
#define PG8_MMA(ai, bj, At, Bt) do { __builtin_amdgcn_s_setprio(1); _Pragma("unroll") for (int m = 0; m < 4; ++m) _Pragma("unroll") for (int n = 0; n < 2; ++n) _Pragma("unroll") for (int k = 0; k < 2; ++k) \
        acc[ai][bj][m][n] = __builtin_amdgcn_mfma_f32_16x16x32_bf16(Bt[n][k], At[m][k], acc[ai][bj][m][n], 0, 0, 0); __builtin_amdgcn_s_setprio(0); } while (0)
#define PG8_WAIT_V(n) asm volatile("s_waitcnt vmcnt(" #n ")" ::: "memory")
#define PG8_WAIT_L(n) __builtin_amdgcn_s_waitcnt(0xC07F | ((n) << 8))
#define PG8_BAR __builtin_amdgcn_s_barrier()
#define PG8_SCHED __builtin_amdgcn_sched_barrier(0)
    Unit cur, nxt; int ui = 0;
    if (!S.next(0, cur)) return;
    f32x4 acc[2][2][4][2];
#pragma unroll
    for (int a = 0; a < 2; ++a)
#pragma unroll
        for (int b = 0; b < 2; ++b)
#pragma unroll
            for (int m = 0; m < 4; ++m)
#pragma unroll
                for (int n = 0; n < 2; ++n) acc[a][b][m][n] = (f32x4){0.f, 0.f, 0.f, 0.f};
    bf16x8 At[4][2], B0[2][2], B1[2][2];
    const char* cA = g.a_ptr(cur); const char* cB = g.b_ptr(cur);
    if constexpr (SP2) {
        PG8_STAGE(PG8_SB(0, 0), cB, voffB); PG8_STAGE(PG8_SB(0, 1), cB + hstepB, voffB); PG8_STAGE(PG8_SA(0, 0), cA, voffA); PG8_STAGE(PG8_SA(0, 1), cA + hstepA, voffA);
        if (wr == 1) PG8_BAR;
        PG8_WAIT_V(2); PG8_BAR;
        PG8_STAGE(PG8_SB(1, 0), cB + kstep, voffB); PG8_STAGE(PG8_SA(1, 0), cA + kstep, voffA); PG8_STAGE(PG8_SB(1, 1), cB + hstepB + kstep, voffB);
        PG8_WAIT_V(6); PG8_BAR;
    } else {
        PG8_STAGE(PG8_SB(0, 0), cB, voffB); PG8_STAGE(PG8_SA(0, 0), cA, voffA); PG8_STAGE(PG8_SB(0, 1), cB + hstepB, voffB); PG8_STAGE(PG8_SA(0, 1), cA + hstepA, voffA);
        if (wr == 1) PG8_BAR;
        PG8_WAIT_V(4); PG8_BAR;
        PG8_STAGE(PG8_SB(1, 0), cB + kstep, voffB); PG8_STAGE(PG8_SA(1, 0), cA + kstep, voffA); PG8_STAGE(PG8_SB(1, 1), cB + hstepB + kstep, voffB);
        PG8_WAIT_V(6); PG8_BAR;
    }
    for (;;) {
        const bool has_next = S.next(ui + 1, nxt);
        const char* nA = has_next ? g.a_ptr(nxt) : cA; const char* nB = has_next ? g.b_ptr(nxt) : cB;
        for (int t = 0; t < nt; t += 2) {
            const bool last = (t == nt - 2);
            const char* a1 = cA + (size_t)(t + 1) * kstep;
            const char* a2 = last ? nA : cA + (size_t)(t + 2) * kstep; const char* b2 = last ? nB : cB + (size_t)(t + 2) * kstep;
            const char* a3 = a2 + kstep; const char* b3 = b2 + kstep;
            if constexpr (SP2) {
            PG8_LDB(B0, 0, 0); PG8_SCHED; PG8_LDA(At, 0, 0); PG8_SCHED; PG8_LDB(B1, 0, 1); PG8_STAGE(PG8_SA(1, 1), a1 + hstepA, voffA);
            PG8_WAIT_V(8); PG8_WAIT_L(4); PG8_BAR; PG8_MMA(0, 0, At, B0); PG8_MMA(0, 1, At, B1); PG8_BAR; PG8_SCHED;
            PG8_LDA(At, 0, 1); PG8_STAGE(PG8_SB(0, 0), b2, voffB); PG8_STAGE(PG8_SB(0, 1), b2 + hstepB, voffB); PG8_STAGE(PG8_SA(0, 0), a2, voffA);
            PG8_WAIT_V(8); PG8_WAIT_L(0); PG8_BAR; PG8_MMA(1, 0, At, B0); PG8_MMA(1, 1, At, B1); PG8_BAR; PG8_SCHED;
            PG8_LDB(B0, 1, 0); PG8_SCHED; PG8_LDA(At, 1, 0); PG8_SCHED; PG8_LDB(B1, 1, 1); PG8_STAGE(PG8_SA(0, 1), a2 + hstepA, voffA);
            PG8_WAIT_V(8); PG8_WAIT_L(4); PG8_BAR; PG8_MMA(0, 0, At, B0); PG8_MMA(0, 1, At, B1); PG8_BAR; PG8_SCHED;
            PG8_LDA(At, 1, 1); PG8_STAGE(PG8_SB(1, 0), b3, voffB); PG8_STAGE(PG8_SB(1, 1), b3 + hstepB, voffB); PG8_STAGE(PG8_SA(1, 0), a3, voffA);
            PG8_WAIT_V(8); PG8_WAIT_L(0); PG8_BAR; PG8_MMA(1, 0, At, B0); PG8_MMA(1, 1, At, B1); PG8_BAR; PG8_SCHED;
            } else {
            PG8_LDB(B0, 0, 0); PG8_SCHED; PG8_LDA(At, 0, 0); PG8_STAGE(PG8_SA(1, 1), a1 + hstepA, voffA);
            PG8_WAIT_L(8); PG8_BAR; PG8_WAIT_L(0); PG8_MMA(0, 0, At, B0); PG8_BAR; PG8_SCHED;
            PG8_LDB(B1, 0, 1); PG8_STAGE(PG8_SB(0, 0), b2, voffB);
            PG8_BAR; PG8_WAIT_L(0); PG8_MMA(0, 1, At, B1); PG8_BAR;
            PG8_LDA(At, 0, 1); PG8_STAGE(PG8_SA(0, 0), a2, voffA);
            PG8_BAR; PG8_WAIT_L(0); PG8_MMA(1, 0, At, B0); PG8_BAR; PG8_SCHED;
            PG8_STAGE(PG8_SB(0, 1), b2 + hstepB, voffB);
            PG8_WAIT_V(6); PG8_BAR; PG8_MMA(1, 1, At, B1); PG8_BAR;
            PG8_LDB(B0, 1, 0); PG8_SCHED; PG8_LDA(At, 1, 0); PG8_STAGE(PG8_SA(0, 1), a2 + hstepA, voffA);
            PG8_WAIT_L(8); PG8_BAR; PG8_WAIT_L(0); PG8_MMA(0, 0, At, B0); PG8_BAR; PG8_SCHED;
            PG8_LDB(B1, 1, 1); PG8_STAGE(PG8_SB(1, 0), b3, voffB);
            PG8_BAR; PG8_WAIT_L(0); PG8_MMA(0, 1, At, B1); PG8_BAR;
            PG8_LDA(At, 1, 1); PG8_STAGE(PG8_SA(1, 0), a3, voffA);
            PG8_BAR; PG8_WAIT_L(0); PG8_MMA(1, 0, At, B0); PG8_BAR; PG8_SCHED;
            PG8_STAGE(PG8_SB(1, 1), b3 + hstepB, voffB);
            PG8_WAIT_V(6); PG8_BAR; PG8_MMA(1, 1, At, B1); PG8_BAR;
            }
        }
        if constexpr (ALIGN_EPI) { if (wr == 0) PG8_BAR; }
        if constexpr (!Epi::AFTER_DRAIN) { if (!(Epi::LAST_FUSED && !has_next)) E(acc, cur, wr, wc, fr, fq); }
        if (!has_next) break;
        if (!E.keep(cur)) {
#pragma unroll
        for (int a = 0; a < 2; ++a)
#pragma unroll
            for (int b = 0; b < 2; ++b)
#pragma unroll
                for (int m = 0; m < 4; ++m)
#pragma unroll
                    for (int n = 0; n < 2; ++n) acc[a][b][m][n] = (f32x4){0.f, 0.f, 0.f, 0.f};
        }
        cur = nxt; cA = nA; cB = nB; ++ui;
        if constexpr (ALIGN_EPI) { if (wr == 1) PG8_BAR; }
    }
    PG8_WAIT_V(0);
    if constexpr (!ALIGN_EPI) { if (wr == 0) PG8_BAR; }
    PG8_BAR;
    if constexpr (Epi::AFTER_DRAIN || Epi::LAST_FUSED) { E.fused(acc, cur, wr, wc, fr, fq, lds, wid, lane); }
#undef PG8_SA
#undef PG8_SB
#undef PG8_STAGE
#undef PG8_LDA
#undef PG8_LDB
#undef PG8_MMA
#undef PG8_WAIT_V
#undef PG8_WAIT_L
#undef PG8_BAR
#undef PG8_SCHED
}
}

#ifndef PG8_SP2
#define PG8_SP2 true
#endif
#ifndef PG8_ALIGN
#define PG8_ALIGN true
#endif

typedef f32x4 Acc[2][2][4][2];

__device__ __forceinline__ v4u pack8(f32x4 v0, f32x4 v1) { v4u w; w.x = cvt_pk_bf16(v0[0], v0[1]); w.y = cvt_pk_bf16(v0[2], v0[3]); w.z = cvt_pk_bf16(v1[0], v1[1]); w.w = cvt_pk_bf16(v1[2], v1[3]); return w; }
__device__ __forceinline__ void unpack8(v4u w, f32x4& v0, f32x4& v1) { v0 = (f32x4){bf_lo(w.x), bf_hi(w.x), bf_lo(w.y), bf_hi(w.y)}; v1 = (f32x4){bf_lo(w.z), bf_hi(w.z), bf_lo(w.w), bf_hi(w.w)}; }

struct EpiInProj {
    static constexpr bool PERM = true, AFTER_DRAIN = false, LAST_FUSED = false;
    bf16 *q, *k, *v, *zc, *sgr, *sgc; const float* cs;
    __device__ __forceinline__ bool keep(const pg8::Unit&) const { return false; }
    __device__ __forceinline__ void operator()(Acc& acc, const pg8::Unit& u, int wr, int wc, int fr, int fq) const {
        const int row0 = u.pm * 256 + wr * 64 + fr, ct = wc * 32 + 8 * fq;
        if (u.pn < 5) {
            const bool isq = u.pn < 4; bf16* base = isq ? q + u.pn * 256 : k; const int ld = isq ? AW : KVW; const float sc = isq ? QSCALE : 1.f;
            const bool rl = ((wc & 1) == 0) && (fq < 2);
#pragma unroll
            for (int ai = 0; ai < 2; ++ai)
#pragma unroll
                for (int m = 0; m < 4; ++m) { const int row = row0 + ai * 128 + m * 16;
                    f32x4 c4 = (f32x4){1.f, 1.f, 1.f, 1.f}, s4 = (f32x4){0.f, 0.f, 0.f, 0.f};
                    if (rl) { c4 = *(const f32x4*)(cs + (size_t)row * 16 + 4 * fq); s4 = *(const f32x4*)(cs + (size_t)row * 16 + 8 + 4 * fq); }
#pragma unroll
                    for (int bj = 0; bj < 2; ++bj) { const f32x4 t1 = acc[ai][bj][m][0], t2 = acc[ai][bj][m][1];
                        const f32x4 v0 = (t1 * c4 - t2 * s4) * sc, v1 = (t2 * c4 + t1 * s4) * sc;
                        *(v4u*)(base + (size_t)row * ld + bj * 128 + ct) = pack8(v0, v1); } }
        } else if (u.pn < 10) {
            bf16* base = (u.pn == 5) ? v : zc + (u.pn - 6) * 256; const int ld = (u.pn == 5) ? KVW : 2 * CW;
#pragma unroll
            for (int ai = 0; ai < 2; ++ai)
#pragma unroll
                for (int m = 0; m < 4; ++m) { const int row = row0 + ai * 128 + m * 16;
#pragma unroll
                    for (int bj = 0; bj < 2; ++bj) *(v4u*)(base + (size_t)row * ld + bj * 128 + ct) = pack8(acc[ai][bj][m][0], acc[ai][bj][m][1]); }
        } else if (u.pn < 18) {
            const int t = u.pn - 10;
#pragma unroll
            for (int ai = 0; ai < 2; ++ai)
#pragma unroll
                for (int m = 0; m < 4; ++m) { const int row = row0 + ai * 128 + m * 16;
                    *(v4u*)(zc + (size_t)row * (2 * CW) + CW + t * 128 + ct) = pack8(acc[ai][0][m][0] * acc[ai][1][m][0], acc[ai][0][m][1] * acc[ai][1][m][1]); }
        } else {
            const int t = u.pn - 18;
#pragma unroll
            for (int ai = 0; ai < 2; ++ai)
#pragma unroll
                for (int m = 0; m < 4; ++m) { const int row = row0 + ai * 128 + m * 16; f32x4 rr[2], ss[2];
#pragma unroll
                    for (int n = 0; n < 2; ++n)
#pragma unroll
                        for (int e = 0; e < 4; ++e) { const float ga = acc[ai][0][m][n][e], gc = acc[ai][1][m][n][e];
                            const float ea = fast_exp2(fminf(ga, 80.f)), ec = fast_exp2(fminf(gc, 80.f));
                            const float ia = fast_rcp(1.f + ea), ic = fast_rcp(1.f + ec);
                            rr[n][e] = (1.f + ec) * ia; ss[n][e] = ic; }
                    *(v4u*)(sgr + (size_t)row * DM + t * 128 + ct) = pack8(rr[0], rr[1]);
                    *(v4u*)(sgc + (size_t)row * DM + t * 128 + ct) = pack8(ss[0], ss[1]); }
        }
    }
};
struct EpiStoreBf16 {
    static constexpr bool PERM = true, AFTER_DRAIN = false, LAST_FUSED = false;
    bf16* O; int ldc;
    __device__ __forceinline__ bool keep(const pg8::Unit&) const { return false; }
    __device__ __forceinline__ void operator()(Acc& acc, const pg8::Unit& u, int wr, int wc, int fr, int fq) const {
        const int row0 = u.pm * 256 + wr * 64 + fr, col0 = u.pn * 256 + wc * 32 + 8 * fq;
#pragma unroll
        for (int ai = 0; ai < 2; ++ai)
#pragma unroll
            for (int m = 0; m < 4; ++m) { const int row = row0 + ai * 128 + m * 16;
#pragma unroll
                for (int bj = 0; bj < 2; ++bj) *(v4u*)(O + (size_t)row * ldc + col0 + bj * 128) = pack8(acc[ai][bj][m][0], acc[ai][bj][m][1]); }
    }
};
struct EpiMerge {
    static constexpr bool PERM = true, AFTER_DRAIN = false, LAST_FUSED = false;
    const bf16 *sgr, *sgc; bf16* merged;
    __device__ __forceinline__ bool keep(const pg8::Unit& u) const { return u.z == 0; }
    __device__ __forceinline__ void operator()(Acc& acc, const pg8::Unit& u, int wr, int wc, int fr, int fq) const {
        const int row0 = u.pm * 256 + wr * 64 + fr, col0 = u.pn * 256 + wc * 32 + 8 * fq;
        const bf16* gsrc = ((u.z == 0) ? sgr : sgc) + (size_t)row0 * DM + col0;
        v4u gw[2][4][2];
#pragma unroll
        for (int ai = 0; ai < 2; ++ai)
#pragma unroll
            for (int m = 0; m < 4; ++m)
#pragma unroll
                for (int bj = 0; bj < 2; ++bj) gw[ai][m][bj] = *(const v4u*)(gsrc + (size_t)(ai * 128 + m * 16) * DM + bj * 128);
#pragma unroll
        for (int ai = 0; ai < 2; ++ai)
#pragma unroll
            for (int m = 0; m < 4; ++m) { const int row = row0 + ai * 128 + m * 16;
#pragma unroll
                for (int bj = 0; bj < 2; ++bj) { f32x4 g0, g1; unpack8(gw[ai][m][bj], g0, g1);
                    const f32x4 v0 = acc[ai][bj][m][0] * g0, v1 = acc[ai][bj][m][1] * g1;
                    if (u.z == 0) { acc[ai][bj][m][0] = v0; acc[ai][bj][m][1] = v1; }
                    else *(v4u*)(merged + (size_t)row * DM + col0 + bj * 128) = pack8(v0, v1); } }
    }
};
template <bool BASE_F32> struct EpiResid {
    static constexpr bool PERM = true, AFTER_DRAIN = false, LAST_FUSED = false;
    const float* basef; bf16* hb; float* ss;
    __device__ __forceinline__ bool keep(const pg8::Unit&) const { return false; }
    __device__ __forceinline__ void operator()(Acc& acc, const pg8::Unit& u, int wr, int wc, int fr, int fq) const {
        const int row0 = u.pm * 256 + wr * 64 + fr, col0 = u.pn * 256 + wc * 32 + 8 * fq;
        const size_t off0 = (size_t)row0 * DM + col0;
        constexpr int NPRE = BASE_F32 ? 4 : 8;
        f32x4 pf[BASE_F32 ? 4 : 1][2][2]; v4u pb[BASE_F32 ? 1 : 8][2];
#pragma unroll
        for (int g = 0; g < NPRE; ++g)
#pragma unroll
            for (int bj = 0; bj < 2; ++bj) { const size_t off = off0 + (size_t)((g >> 2) * 128 + (g & 3) * 16) * DM + bj * 128;
                if (BASE_F32) { pf[g][bj][0] = __builtin_nontemporal_load((const f32x4*)(basef + off)); pf[g][bj][1] = __builtin_nontemporal_load((const f32x4*)(basef + off + 4)); } else pb[g][bj] = *(const v4u*)(hb + off); }
#pragma unroll
        for (int g = 0; g < 8; ++g) { const int ai = g >> 2, m = g & 3; const int row = row0 + ai * 128 + m * 16; float sq = 0.f;
#pragma unroll
            for (int bj = 0; bj < 2; ++bj) { const size_t off = (size_t)row * DM + col0 + bj * 128; f32x4 b0, b1;
                if (BASE_F32) { b0 = pf[g & 3][bj][0]; b1 = pf[g & 3][bj][1]; } else unpack8(pb[g][bj], b0, b1);
                const f32x4 v0 = acc[ai][bj][m][0] + b0, v1 = acc[ai][bj][m][1] + b1;
                *(v4u*)(hb + off) = pack8(v0, v1);
                sq += (v0[0] * v0[0] + v0[1] * v0[1]) + (v0[2] * v0[2] + v0[3] * v0[3]) + (v1[0] * v1[0] + v1[1] * v1[1]) + (v1[2] * v1[2] + v1[3] * v1[3]); }
            if (BASE_F32 && g + 4 < 8) {
#pragma unroll
                for (int bj = 0; bj < 2; ++bj) { const size_t off = off0 + (size_t)(128 + m * 16) * DM + bj * 128; pf[g & 3][bj][0] = __builtin_nontemporal_load((const f32x4*)(basef + off)); pf[g & 3][bj][1] = __builtin_nontemporal_load((const f32x4*)(basef + off + 4)); } }
            sq += __shfl_xor(sq, 16); sq += __shfl_xor(sq, 32);
            if (fq == 0) atomicAdd(ss + row, sq); }
    }
};
struct EpiSoftmax {
    static constexpr bool PERM = true, AFTER_DRAIN = true, LAST_FUSED = false;
    const float* ss; bf16* P;
    __device__ __forceinline__ bool keep(const pg8::Unit&) const { return false; }
    __device__ __forceinline__ void fused(Acc& acc, const pg8::Unit& u, int wr, int wc, int fr, int fq, LAS unsigned char* lds, int wid, int lane) const {
        LAS float* Pm = (LAS float*)lds; LAS float* Ps = (LAS float*)(lds + 4096);
        const int rl0 = wr * 64 + fr, col0 = u.pn * 256 + wc * 32 + 8 * fq;
#pragma unroll
        for (int ai = 0; ai < 2; ++ai)
#pragma unroll
            for (int m = 0; m < 4; ++m) { const int rl = rl0 + ai * 128 + m * 16; const float rs = 1.0f / sqrtf(ss[u.pm * 256 + rl] * (1.0f / DM) + EPS); float mx = -3.0e38f;
#pragma unroll
                for (int bj = 0; bj < 2; ++bj)
#pragma unroll
                    for (int n = 0; n < 2; ++n) { f32x4 s = acc[ai][bj][m][n] * rs; acc[ai][bj][m][n] = s; mx = fmaxf(mx, fmaxf(fmaxf(s[0], s[1]), fmaxf(s[2], s[3]))); }
                mx = fmaxf(mx, __shfl_xor(mx, 16)); mx = fmaxf(mx, __shfl_xor(mx, 32));
                if (fq == 0) Pm[rl * 4 + wc] = mx; }
        asm volatile("s_waitcnt lgkmcnt(0)" ::: "memory"); __builtin_amdgcn_s_barrier(); asm volatile("" ::: "memory");
#pragma unroll
        for (int ai = 0; ai < 2; ++ai)
#pragma unroll
            for (int m = 0; m < 4; ++m) { const int rl = rl0 + ai * 128 + m * 16; const f32x4 pm4 = *(const LAS f32x4*)(Pm + rl * 4);
                const float mx = fmaxf(fmaxf(pm4[0], pm4[1]), fmaxf(pm4[2], pm4[3])); float sm = 0.f;
#pragma unroll
                for (int bj = 0; bj < 2; ++bj)
#pragma unroll
                    for (int n = 0; n < 2; ++n) { f32x4 s = acc[ai][bj][m][n];
#pragma unroll
                        for (int e = 0; e < 4; ++e) { s[e] = fast_exp2(s[e] - mx); sm += s[e]; }
                        acc[ai][bj][m][n] = s; }
                sm += __shfl_xor(sm, 16); sm += __shfl_xor(sm, 32);
                if (fq == 0) Ps[rl * 4 + wc] = sm; }
        asm volatile("s_waitcnt lgkmcnt(0)" ::: "memory"); __builtin_amdgcn_s_barrier(); asm volatile("" ::: "memory");
#pragma unroll
        for (int ai = 0; ai < 2; ++ai)
#pragma unroll
            for (int m = 0; m < 4; ++m) { const int rl = rl0 + ai * 128 + m * 16; const f32x4 ps4 = *(const LAS f32x4*)(Ps + rl * 4);
                const float inv = 1.0f / ((ps4[0] + ps4[1]) + (ps4[2] + ps4[3])); const size_t rowoff = (size_t)(u.pm * 256 + rl) * (4 * NMEM) + col0;
#pragma unroll
                for (int bj = 0; bj < 2; ++bj) *(v4u*)(P + rowoff + bj * 128) = pack8(acc[ai][bj][m][0] * inv, acc[ai][bj][m][1] * inv); }
    }
};
struct EpiSwiGLU {
    static constexpr bool PERM = true, AFTER_DRAIN = false, LAST_FUSED = false;
    const float* ss; bf16* act;
    __device__ __forceinline__ bool keep(const pg8::Unit&) const { return false; }
    __device__ __forceinline__ void operator()(Acc& acc, const pg8::Unit& u, int wr, int wc, int fr, int fq) const {
        const int row0 = u.pm * 256 + wr * 64 + fr, col0 = u.pn * 128 + wc * 32 + 8 * fq;
#pragma unroll
        for (int ai = 0; ai < 2; ++ai)
#pragma unroll
            for (int m = 0; m < 4; ++m) { const int row = row0 + ai * 128 + m * 16; const float rs = 1.0f / sqrtf(ss[row] * (1.0f / DM) + EPS); f32x4 o[2];
                const float nrl = -rs * LOG2E, rs2 = rs * rs;
#pragma unroll
                for (int n = 0; n < 2; ++n)
#pragma unroll
                    for (int e = 0; e < 4; ++e) { const float a = acc[ai][0][m][n][e], b = acc[ai][1][m][n][e];
                        o[n][e] = (a * b) * (rs2 * fast_rcp(1.f + fast_exp2(a * nrl))); }
                *(v4u*)(act + (size_t)row * DFF + col0) = pack8(o[0], o[1]); }
    }
};

#define XB_TMO      128
#define XB_XCNT(j)  (256  + 64 * (j))
#define XB_XSUB(j)  (1280 + 64 * (j))
#define XB_XGEN(j)  (2304 + 64 * (j))
#define XB_TOP      3328
#define XB_TOPGEN   3392
#define XCD_BAR_WORDS 3456
#define XB_SPIN_CAP (1u << 18)

__device__ __forceinline__ unsigned xb_ld(unsigned* p)              { return __hip_atomic_load(p, __ATOMIC_RELAXED, __HIP_MEMORY_SCOPE_AGENT); }
__device__ __forceinline__ unsigned xb_add(unsigned* p, unsigned v) { return __hip_atomic_fetch_add(p, v, __ATOMIC_RELAXED, __HIP_MEMORY_SCOPE_AGENT); }
__device__ __forceinline__ unsigned xb_xcc_id() { return (unsigned)__builtin_amdgcn_s_getreg((3 << 11) | 20) & 0xFu; }
#define XB_SPIN(cond, bar) do { unsigned _sp = 0; while (cond) { __builtin_amdgcn_s_sleep(1); \
    if ((++_sp & 255u) == 0u) { if (xb_ld(&(bar)[XB_TMO])) break; if (_sp > XB_SPIN_CAP) { atomicAdd(&(bar)[XB_TMO], 1u); break; } } } } while (0)

struct XcdBarrier { unsigned* bar; unsigned x; volatile LAS unsigned* st; };

__device__ __forceinline__ XcdBarrier xcd_barrier_post(unsigned* bar, volatile LAS unsigned* st) {
    XcdBarrier b; b.bar = bar; b.x = xb_xcc_id(); b.st = st;
    if (threadIdx.x == 0) (void)xb_add(&bar[XB_XCNT(b.x)], 1u);
    return b;
}
__device__ __forceinline__ void xcd_barrier_complete(unsigned* bar, unsigned x, unsigned& nloc, unsigned& nx) {
    const unsigned G = gridDim.x * gridDim.y * gridDim.z;
    unsigned sum, cnt, mine, sp = 0u;
    for (;;) {
        sum = 0u; cnt = 0u; mine = 0u;
#pragma unroll
        for (unsigned j = 0; j < 16; ++j) { const unsigned c = xb_ld(&bar[XB_XCNT(j)]); sum += c; cnt += (c > 0u) ? 1u : 0u; mine = (j == x) ? c : mine; }
        if (sum == G) break;
        __builtin_amdgcn_s_sleep(1);
        if ((++sp & 255u) == 0u) { if (xb_ld(&bar[XB_TMO])) break; if (sp > XB_SPIN_CAP) { atomicAdd(&bar[XB_TMO], 1u); break; } }
    }
    nloc = mine > 0u ? mine : 1u; nx = cnt > 0u ? cnt : 1u;
}
__device__ __forceinline__ void xcd_barrier(const XcdBarrier& b) {
    asm volatile("s_waitcnt vmcnt(0)" ::: "memory");
    __syncthreads();
    if (threadIdx.x == 0) {
        unsigned* bar = b.bar;
        __builtin_amdgcn_s_waitcnt(0);
        unsigned nloc = b.st[0], nx = b.st[1];
        if (nloc == 0u) { xcd_barrier_complete(bar, b.x, nloc, nx); b.st[0] = nloc; b.st[1] = nx; }
        const unsigned old = xb_add(&bar[XB_XSUB(b.x)], 1u);
        const unsigned gen = old / nloc;
        if (old + 1u == (gen + 1u) * nloc) {
            __builtin_amdgcn_fence(__ATOMIC_RELEASE, "agent");
            asm volatile("s_waitcnt vmcnt(0)" ::: "memory");
            const unsigned og = xb_add(&bar[XB_TOP], 1u);
            const unsigned tg = og / nx;
            if (og + 1u == (tg + 1u) * nx) xb_add(&bar[XB_TOPGEN], 1u);
            else XB_SPIN(xb_ld(&bar[XB_TOPGEN]) == tg, bar);
            __builtin_amdgcn_fence(__ATOMIC_ACQUIRE, "agent");
            xb_add(&bar[XB_XGEN(b.x)], 1u);
            asm volatile("s_waitcnt vmcnt(0)" ::: "memory");
        } else {
            XB_SPIN(xb_ld(&bar[XB_XGEN(b.x)]) == gen, bar);
            __builtin_amdgcn_fence(__ATOMIC_ACQUIRE, "agent");
            asm volatile("s_waitcnt vmcnt(0)" ::: "memory");
        }
    }
    __syncthreads();
}


__device__ __forceinline__ void group_barrier(unsigned* cnt, unsigned target, unsigned* extra, unsigned* tmo, bool same_xcd) {
    asm volatile("s_waitcnt vmcnt(0)" ::: "memory");
    __syncthreads();
    if (threadIdx.x == 0) {
        __builtin_amdgcn_s_waitcnt(0);
        if (!same_xcd) { __builtin_amdgcn_fence(__ATOMIC_RELEASE, "agent"); asm volatile("s_waitcnt vmcnt(0)" ::: "memory"); }
        (void)xb_add(cnt, 1u);
        if (extra) (void)xb_add(extra, 1u);
        unsigned sp = 0;
        while (xb_ld(cnt) < target) { __builtin_amdgcn_s_sleep(1); if ((++sp & 255u) == 0u) { if (xb_ld(tmo)) break; if (sp > XB_SPIN_CAP) { atomicAdd(tmo, 1u); break; } } }
        __builtin_amdgcn_fence(__ATOMIC_ACQUIRE, "agent");
        asm volatile("s_waitcnt vmcnt(0)" ::: "memory");
    }
    __syncthreads();
}
__device__ __forceinline__ void wait_global(unsigned* cnt, unsigned target, unsigned* tmo) {
    if (threadIdx.x == 0) {
        unsigned sp = 0;
        while (xb_ld(cnt) < target) { __builtin_amdgcn_s_sleep(1); if ((++sp & 255u) == 0u) { if (xb_ld(tmo)) break; if (sp > XB_SPIN_CAP) { atomicAdd(tmo, 1u); break; } } }
        __builtin_amdgcn_fence(__ATOMIC_ACQUIRE, "agent");
        asm volatile("s_waitcnt vmcnt(0)" ::: "memory");
    }
    __syncthreads();
}

struct EpiFinal {
    static constexpr bool PERM = true, AFTER_DRAIN = false, LAST_FUSED = true;
    bf16* hb; float* ss; float* out; const float* gfin; unsigned* gcnt; unsigned target; unsigned* glob1; unsigned* tmo; bool same_xcd;
    __device__ __forceinline__ bool keep(const pg8::Unit&) const { return false; }
    __device__ __forceinline__ void operator()(Acc& acc, const pg8::Unit& u, int wr, int wc, int fr, int fq) const { const EpiResid<false> E{nullptr, hb, ss}; E(acc, u, wr, wc, fr, fq); }
    __device__ __forceinline__ void fused(Acc& acc, const pg8::Unit& u, int wr, int wc, int fr, int fq, LAS unsigned char* lds, int wid, int lane) const {
        const int row0 = u.pm * 256 + wr * 64 + fr, col0 = u.pn * 256 + wc * 32 + 8 * fq;
        const size_t off0 = (size_t)row0 * DM + col0;
        v4u pb[8][2];
#pragma unroll
        for (int g = 0; g < 8; ++g)
#pragma unroll
            for (int bj = 0; bj < 2; ++bj) pb[g][bj] = *(const v4u*)(hb + off0 + (size_t)((g >> 2) * 128 + (g & 3) * 16) * DM + bj * 128);
#pragma unroll
        for (int g = 0; g < 8; ++g) { const int ai = g >> 2, m = g & 3; const int row = row0 + ai * 128 + m * 16; float sq = 0.f;
#pragma unroll
            for (int bj = 0; bj < 2; ++bj) { f32x4 b0, b1; unpack8(pb[g][bj], b0, b1);
                const f32x4 v0 = acc[ai][bj][m][0] + b0, v1 = acc[ai][bj][m][1] + b1; acc[ai][bj][m][0] = v0; acc[ai][bj][m][1] = v1;
                sq += (v0[0] * v0[0] + v0[1] * v0[1]) + (v0[2] * v0[2] + v0[3] * v0[3]) + (v1[0] * v1[0] + v1[1] * v1[1]) + (v1[2] * v1[2] + v1[3] * v1[3]); }
            sq += __shfl_xor(sq, 16); sq += __shfl_xor(sq, 32);
            if (fq == 0) atomicAdd(ss + row, sq); }
        group_barrier(gcnt, target, nullptr, tmo, same_xcd);
        wait_global(glob1, 256u, tmo);
        const int col1 = col0 - 1024;
        { f32x4 gv[2][2];
#pragma unroll
          for (int bj = 0; bj < 2; ++bj) { gv[bj][0] = *(const f32x4*)(gfin + col0 + bj * 128); gv[bj][1] = *(const f32x4*)(gfin + col0 + bj * 128 + 4); }
#pragma unroll
          for (int g = 0; g < 8; ++g) { const int ai = g >> 2, m = g & 3; const int row = row0 + ai * 128 + m * 16; const float rs = 1.0f / sqrtf(ss[row] * (1.0f / DM) + EPS);
#pragma unroll
            for (int bj = 0; bj < 2; ++bj) { float* o = out + (size_t)row * DM + col0 + bj * 128; __builtin_nontemporal_store(acc[ai][bj][m][0] * rs * gv[bj][0], (f32x4*)o); __builtin_nontemporal_store(acc[ai][bj][m][1] * rs * gv[bj][1], (f32x4*)(o + 4)); } } }
        asm volatile("" ::: "memory");
        { f32x4 gw[2][2];
#pragma unroll
          for (int bj = 0; bj < 2; ++bj) { gw[bj][0] = *(const f32x4*)(gfin + col1 + bj * 128); gw[bj][1] = *(const f32x4*)(gfin + col1 + bj * 128 + 4); }
#pragma unroll
          for (int g = 0; g < 8; ++g)
#pragma unroll
            for (int bj = 0; bj < 2; ++bj) pb[g][bj] = *(const v4u*)(hb + off0 - 1024 + (size_t)((g >> 2) * 128 + (g & 3) * 16) * DM + bj * 128);
#pragma unroll
          for (int g = 0; g < 8; ++g) { const int ai = g >> 2, m = g & 3; const int row = row0 + ai * 128 + m * 16; const float rs = 1.0f / sqrtf(ss[row] * (1.0f / DM) + EPS);
#pragma unroll
            for (int bj = 0; bj < 2; ++bj) { f32x4 b0, b1; unpack8(pb[g][bj], b0, b1); float* o1 = out + (size_t)row * DM + col1 + bj * 128; __builtin_nontemporal_store(b0 * rs * gw[bj][0], (f32x4*)o1); __builtin_nontemporal_store(b1 * rs * gw[bj][1], (f32x4*)(o1 + 4)); } } }
    }
};

__device__ __forceinline__ float wave_sum(float v) {
#pragma unroll
    for (int o = 1; o < 64; o <<= 1) v += __shfl_xor(v, o);
    return v;
}
__device__ __forceinline__ int rope_sigma(int p) { return (p < 16) ? ((p & 3) + 4 * ((p >> 3) & 1) + 8 * ((p >> 2) & 1)) : p; }
struct TpItem { const float* src; bf16* dst; const float* ks; int ldw, ldd, perm; float cscale; };
struct TpPtrs { const float *w_in, *w_attn_o, *w_conv_o, *w_out, *w_xkv, *w_xo, *w_gate_up, *w_down, *g_ffn; bf16 *WinT, *WacT, *WoutT, *WxkvT, *wxot, *WguT, *WdT; };
constexpr int TP_I0 = 32 * 272, TP_I1 = 16 * 64, TP_I2 = 16 * 64, TP_I3 = 32 * 64, TP_I4 = 32 * 32, TP_I7 = 8 * 64, TP_I5 = 32 * 352, TP_I6 = 88 * 64;
constexpr int TP_NEARLY = TP_I0 + TP_I1 + TP_I2 + TP_I3 + TP_I4 + TP_I7, TP_NITEMS = TP_NEARLY + TP_I5 + TP_I6;
__device__ __forceinline__ TpItem tp_mk(const float* W, int ldw, int src_col0, int k0, bf16* dst, int ldd, int dst_row0, int dst_col0, const float* kscale, int perm, float cscale = 1.f) {
    TpItem d; d.cscale = cscale; d.src = W + (size_t)k0 * ldw + src_col0; d.dst = dst + (size_t)dst_row0 * ldd + dst_col0 + k0; d.ks = kscale ? kscale + k0 : nullptr; d.ldw = ldw; d.ldd = ldd; d.perm = perm; return d; }
__device__ __forceinline__ TpItem tp_desc(int it, const TpPtrs& P) {
    int r = it;
    if (r < TP_I0) { const int kb_ = r / 272, Gp = r % 272; int src, perm = 0;
        if (Gp < 40) { src = 32 * Gp; perm = ((Gp & 1) == 0) ? 1 : 0; }
        else if (Gp < 80) { src = 32 * Gp; }
        else if (Gp < 144) { const int gg = Gp - 80, t = gg >> 3, i32 = gg & 7; src = (i32 < 4) ? (2560 + 128 * t + 32 * i32) : (3584 + 128 * t + 32 * (i32 - 4)); }
        else { const int gg = Gp - 144, t = gg >> 3, i32 = gg & 7; src = (i32 < 4) ? (4608 + 128 * t + 32 * i32) : (6656 + 128 * t + 32 * (i32 - 4)); }
        return tp_mk(P.w_in, NIN, src, 64 * kb_, P.WinT, DM, 32 * Gp, 0, nullptr, perm, Gp >= 144 ? -LOG2E : 1.f); } r -= TP_I0;
    if (r < TP_I1) { const int kb_ = r / 64, Gp = r % 64; return tp_mk(P.w_attn_o, DM, 32 * Gp, 64 * kb_, P.WacT, DM, 32 * Gp, 0, nullptr, 0); } r -= TP_I1;
    if (r < TP_I2) { const int kb_ = r / 64, Gp = r % 64; return tp_mk(P.w_conv_o, DM, 32 * Gp, 64 * kb_, P.WacT, DM, 32 * Gp, 1024, nullptr, 0); } r -= TP_I2;
    if (r < TP_I3) { const int kb_ = r / 64, Gp = r % 64; return tp_mk(P.w_out, DM, 32 * Gp, 64 * kb_, P.WoutT, DM, 32 * Gp, 0, nullptr, 0); } r -= TP_I3;
    if (r < TP_I4) { const int kb_ = r / 32, Gp = r % 32; return tp_mk(P.w_xkv, 2 * XW, 32 * Gp, 64 * kb_, P.WxkvT, DM, 32 * Gp, 0, nullptr, 0); } r -= TP_I4;
    if (r < TP_I7) { const int kb_ = r / 64, Gp = r % 64; return tp_mk(P.w_xo, DM, 32 * Gp, 64 * kb_, P.wxot, XW, 32 * Gp, 0, nullptr, 0); } r -= TP_I7;
    if (r < TP_I5) { const int kb_ = r / 352, Gp = r % 352; const int t = Gp >> 3, i32 = Gp & 7; const int src = (i32 < 4) ? (128 * t + 32 * i32) : (DFF + 128 * t + 32 * (i32 - 4));
        return tp_mk(P.w_gate_up, 2 * DFF, src, 64 * kb_, P.WguT, DM, 32 * Gp, 0, P.g_ffn, 0); } r -= TP_I5;
    { const int kb_ = r / 64, Gp = r % 64; return tp_mk(P.w_down, DM, 32 * Gp, 64 * kb_, P.WdT, DFF, 32 * Gp, 0, nullptr, 0); }
}
__device__ __forceinline__ void tp_load(const TpItem& d, float (&tv)[32], int lane) {
    const float* sp = d.src + (size_t)(lane >> 5) * d.ldw + (lane & 31);
#pragma unroll
    for (int i = 0; i < 32; ++i) tv[i] = __builtin_nontemporal_load(sp + (size_t)(2 * i) * d.ldw);
}
__device__ __forceinline__ void tp_finish(const TpItem& d, const float (&tv)[32], LAS float* scr, int lane) {
#pragma unroll
    for (int i = 0; i < 32; ++i) scr[(2 * i + (lane >> 5)) * 33 + (lane & 31)] = tv[i];
    LDS_WAIT(); asm volatile("" ::: "memory");
    const int c = lane & 7;
    float sc[8];
#pragma unroll
    for (int i = 0; i < 8; ++i) sc[i] = d.ks ? d.ks[8 * c + i] * d.cscale : d.cscale;
#pragma unroll
    for (int j = 0; j < 4; ++j) { const int nd = (lane >> 3) + 8 * j; const int scol = d.perm ? rope_sigma(nd) : nd; const LAS float* s = scr + (8 * c) * 33 + scol;
        v4u o; o.x = cvt_pk_bf16(s[0 * 33] * sc[0], s[1 * 33] * sc[1]); o.y = cvt_pk_bf16(s[2 * 33] * sc[2], s[3 * 33] * sc[3]);
        o.z = cvt_pk_bf16(s[4 * 33] * sc[4], s[5 * 33] * sc[5]); o.w = cvt_pk_bf16(s[6 * 33] * sc[6], s[7 * 33] * sc[7]);
        *(v4u*)(d.dst + (size_t)nd * d.ldd + 8 * c) = o; }
    LDS_WAIT(); asm volatile("" ::: "memory");
}
__device__ __forceinline__ void tp_run(int it0, int it_end, int stride, const TpPtrs& P, LAS float* scr, int lane) {
    if (it0 >= it_end) return;
    TpItem d = tp_desc(it0, P); float tv[32]; tp_load(d, tv, lane);
    for (int it = it0; it < it_end; it += stride) {
        const int nx = it + stride; const bool more = nx < it_end; TpItem dn = d; float tn[32];
        if (more) { dn = tp_desc(nx, P); tp_load(dn, tn, lane); }
        tp_finish(d, tv, scr, lane);
        if (more) { d = dn;
#pragma unroll
            for (int i = 0; i < 32; ++i) tv[i] = tn[i]; }
    }
}
__device__ __forceinline__ void tp_run3(int it0, int it_end, int stride, const TpPtrs& P, LAS float* scr, int lane) {
    if (it0 >= it_end) return;
    TpItem d0 = tp_desc(it0, P), d1 = d0; float t0[32], t1[32]; tp_load(d0, t0, lane);
    if (it0 + stride < it_end) { d1 = tp_desc(it0 + stride, P); tp_load(d1, t1, lane); }
    for (int it = it0; it < it_end; it += stride) {
        const int n2 = it + 2 * stride; const bool more2 = n2 < it_end; TpItem d2 = d0; float t2[32];
        if (more2) { d2 = tp_desc(n2, P); tp_load(d2, t2, lane); }
        tp_finish(d0, t0, scr, lane);
        d0 = d1; d1 = d2;
#pragma unroll
        for (int i = 0; i < 32; ++i) { t0[i] = t1[i]; t1[i] = t2[i]; }
    }
}
__device__ __forceinline__ void rms_rows_to_bf16(const float* xb, const float* g, bf16* ob, int m0, int m_end, int stride, int lane) {
    if (m0 >= m_end) return;
    f32x4 v[8];
    { const f32x4* xr = (const f32x4*)(xb + (size_t)m0 * DM) + lane;
#pragma unroll
      for (int j = 0; j < 8; ++j) v[j] = __builtin_nontemporal_load(xr + 64 * j); }
    f32x4 gg[8];
#pragma unroll
    for (int j = 0; j < 8; ++j) gg[j] = ((const f32x4*)g + lane)[64 * j];
    for (int m = m0; m < m_end; m += stride) {
        const int nx = m + stride; const bool more = nx < m_end; f32x4 vn[8];
        if (more) { const f32x4* xr = (const f32x4*)(xb + (size_t)nx * DM) + lane;
#pragma unroll
            for (int j = 0; j < 8; ++j) vn[j] = __builtin_nontemporal_load(xr + 64 * j); }
        float s = 0.f;
#pragma unroll
        for (int j = 0; j < 8; ++j) s += (v[j].x * v[j].x + v[j].y * v[j].y) + (v[j].z * v[j].z + v[j].w * v[j].w);
        const float rstd = 1.0f / sqrtf(wave_sum(s) * (1.0f / DM) + EPS);
        v2u* o8 = (v2u*)(ob + (size_t)m * DM) + lane;
#pragma unroll
        for (int j = 0; j < 8; ++j) { v2u w; w.x = cvt_pk_bf16(v[j].x * rstd * gg[j].x, v[j].y * rstd * gg[j].y); w.y = cvt_pk_bf16(v[j].z * rstd * gg[j].z, v[j].w * rstd * gg[j].w); o8[64 * j] = w; }
        if (more) {
#pragma unroll
            for (int j = 0; j < 8; ++j) v[j] = vn[j]; }
    }
}

__device__ __forceinline__ s16x4 vtr(const LAS unsigned char* p) { typedef short v4i16_t __attribute__((ext_vector_type(4))); return __builtin_bit_cast(s16x4, __builtin_amdgcn_ds_read_tr16_b64_v4i16((LAS v4i16_t*)p)); }

struct ConvCtx { const bf16* zc; bf16* xn; int ts, cg; f32x4 w0[2], w1[2], w2[2], p1[2], p2[2]; };
__device__ __forceinline__ void conv_issue(const ConvCtx& c, int batch, v4u (&zb)[4], v4u (&zp)[4]) {
#pragma unroll
    for (int i = 0; i < 4; ++i) { const bf16* zr = c.zc + (size_t)(c.ts + 4 * batch + i) * (2 * CW) + 8 * c.cg; zb[i] = *(const v4u*)(zr); zp[i] = *(const v4u*)(zr + CW); }
}
__device__ __forceinline__ void conv_finish(ConvCtx& c, int batch, const v4u (&zb)[4], const v4u (&zp)[4]) {
#pragma unroll
    for (int i = 0; i < 4; ++i) { f32x4 cb0, cb1, p0a, p0b; unpack8(zb[i], cb0, cb1); unpack8(zp[i], p0a, p0b);
        const f32x4 y0 = cb0 * (c.w0[0] * c.p2[0] + c.w1[0] * c.p1[0] + c.w2[0] * p0a), y1 = cb1 * (c.w0[1] * c.p2[1] + c.w1[1] * c.p1[1] + c.w2[1] * p0b);
        *(v4u*)(c.xn + (size_t)(c.ts + 4 * batch + i) * DM + AW + 8 * c.cg) = pack8(y0, y1);
        c.p2[0] = c.p1[0]; c.p2[1] = c.p1[1]; c.p1[0] = p0a; c.p1[1] = p0b; }
}
__device__ __forceinline__ void conv_init(ConvCtx& c, const bf16* zc, bf16* xn, const float* conv_w, int chunk, int tid) {
    c.zc = zc; c.xn = xn; c.cg = tid & 127; c.ts = chunk * 64 + (tid >> 7) * 16;
#pragma unroll
    for (int j = 0; j < 2; ++j) { c.w0[j] = *(const f32x4*)(conv_w + 8 * c.cg + 4 * j); c.w1[j] = *(const f32x4*)(conv_w + CW + 8 * c.cg + 4 * j); c.w2[j] = *(const f32x4*)(conv_w + 2 * CW + 8 * c.cg + 4 * j);
        c.p2[j] = (f32x4){0.f, 0.f, 0.f, 0.f}; c.p1[j] = c.p2[j]; }
    if (c.ts >= 2) { unpack8(*(const v4u*)(zc + (size_t)(c.ts - 2) * (2 * CW) + CW + 8 * c.cg), c.p2[0], c.p2[1]); unpack8(*(const v4u*)(zc + (size_t)(c.ts - 1) * (2 * CW) + CW + 8 * c.cg), c.p1[0], c.p1[1]); }
}
template <bool CONV>
__device__ __forceinline__ void swa_unit(LAS unsigned char* lds, int n, int g, const bf16* qb, const bf16* kb, const bf16* vb, const float* sinks, bf16* A2, int tid, int lane, int wave, ConvCtx& cc, int batch0) {
    LAS unsigned char* Kl = lds; LAS unsigned char* Vl = lds + 32768;
#pragma unroll
    for (int i = 0; i < 4; ++i) { const int id = tid + 512 * i, row = id >> 3, ch = id & 7; const int tok = (n - 1) * 128 + row;
        v4u kv = (v4u){0u, 0u, 0u, 0u}, vv = (v4u){0u, 0u, 0u, 0u};
        if (tok >= 0) { kv = *(const v4u*)(kb + (size_t)tok * KVW + g * 64 + ch * 8); vv = *(const v4u*)(vb + (size_t)tok * KVW + g * 64 + ch * 8); }
        *(LAS v4u*)(Kl + row * 128 + ((ch ^ ((row >> 1) & 7)) << 4)) = kv;
        *(LAS v4u*)(Vl + row * 128 + ((ch ^ (((row >> 1) & 1) << 2)) << 4)) = vv; }
    __syncthreads();
    const int ql = lane & 31, h = lane >> 5, hq = g * 4 + (wave & 3);
    const float sinkl = sinks[hq] * LOG2E;
    const int li = lane & 15, qp = li >> 2, pp = li & 3, g1 = (lane >> 4) & 1;
    const float NEG = -__builtin_inff();
#pragma unroll 1
    for (int st = 0; st < 2; ++st) {
        const int r0 = (wave >> 2) * 64 + 32 * st; const size_t tok = (size_t)n * 128 + r0 + ql;
        bf16x8 qf[4];
#pragma unroll
        for (int ks = 0; ks < 4; ++ks) qf[ks] = *(const bf16x8*)(qb + tok * AW + hq * 64 + 16 * ks + 8 * h);
        v4u zb[4], zp[4];
        if (CONV) conv_issue(cc, batch0 + st, zb, zp);
        f32x16 S[5];
#pragma unroll
        for (int t = 0; t < 5; ++t) { const int c = r0 + 32 * t + ql; S[t] = (f32x16){};
#pragma unroll
            for (int ks = 0; ks < 4; ++ks) { const bf16x8 kf = *(const LAS bf16x8*)(Kl + c * 128 + (((2 * ks + h) ^ ((c >> 1) & 7)) << 4));
                S[t] = __builtin_amdgcn_mfma_f32_32x32x16_bf16(kf, qf[ks], S[t], 0, 0, 0); } }
#pragma unroll
        for (int r = 0; r < 16; ++r) { const int cc = (r & 3) + 8 * (r >> 2) + 4 * h; if (!(cc > ql)) S[0][r] = NEG; if (!(cc <= ql)) S[4][r] = NEG; }
        if (n == 0) {
#pragma unroll
            for (int t = 0; t < 5; ++t)
#pragma unroll
                for (int r = 0; r < 16; ++r) { const int cc = (r & 3) + 8 * (r >> 2) + 4 * h; if (r0 + 32 * t + cc < 128) S[t][r] = NEG; } }
        float mx = sinkl;
#pragma unroll
        for (int t = 0; t < 5; ++t)
#pragma unroll
            for (int r = 0; r < 16; ++r) mx = fmaxf(mx, S[t][r]);
        mx = fmaxf(mx, __shfl_xor(mx, 32));
        float l = 0.f;
#pragma unroll
        for (int t = 0; t < 5; ++t)
#pragma unroll
            for (int r = 0; r < 16; ++r) { const float p = fast_exp2(S[t][r] - mx); S[t][r] = p; l += p; }
        l += __shfl_xor(l, 32); l += fast_exp2(sinkl - mx);
        f32x16 O[2]; O[0] = (f32x16){}; O[1] = (f32x16){};
#pragma unroll
        for (int t = 0; t < 5; ++t)
#pragma unroll
            for (int s = 0; s < 2; ++s) {
                v4u pw; pw.x = cvt_pk_bf16(S[t][8 * s + 0], S[t][8 * s + 1]); pw.y = cvt_pk_bf16(S[t][8 * s + 2], S[t][8 * s + 3]);
                pw.z = cvt_pk_bf16(S[t][8 * s + 4], S[t][8 * s + 5]); pw.w = cvt_pk_bf16(S[t][8 * s + 6], S[t][8 * s + 7]);
                const bf16x8 pf = __builtin_bit_cast(bf16x8, pw);
                const int krow = r0 + 32 * t + 16 * s + 4 * h + qp;
#pragma unroll
                for (int db = 0; db < 2; ++db) { const int chunk = (4 * db + 2 * g1 + (pp >> 1)) ^ (((qp >> 1) & 1) << 2);
                    const LAS unsigned char* va = Vl + krow * 128 + (chunk << 4) + (pp & 1) * 8;
                    const s16x4 lo = vtr(va), hi = vtr(va + 8 * 128);
                    const bf16x8 vf = (bf16x8){lo[0], lo[1], lo[2], lo[3], hi[0], hi[1], hi[2], hi[3]};
                    O[db] = __builtin_amdgcn_mfma_f32_32x32x16_bf16(vf, pf, O[db], 0, 0, 0); } }
        const float inv = 1.0f / l;
#pragma unroll
        for (int db = 0; db < 2; ++db)
#pragma unroll
            for (int pr = 0; pr < 2; ++pr) { const int ra = 8 * pr, rb = 8 * pr + 4;
                unsigned ax = cvt_pk_bf16(O[db][ra + 0] * inv, O[db][ra + 1] * inv), ay = cvt_pk_bf16(O[db][ra + 2] * inv, O[db][ra + 3] * inv);
                unsigned bx_ = cvt_pk_bf16(O[db][rb + 0] * inv, O[db][rb + 1] * inv), by = cvt_pk_bf16(O[db][rb + 2] * inv, O[db][rb + 3] * inv);
                { auto r = __builtin_amdgcn_permlane32_swap(ax, bx_, false, false); ax = r[0]; bx_ = r[1]; }
                { auto r = __builtin_amdgcn_permlane32_swap(ay, by, false, false); ay = r[0]; by = r[1]; }
                *(v4u*)(A2 + tok * DM + hq * 64 + 32 * db + 16 * pr + 8 * h) = (v4u){ax, ay, bx_, by}; }
        if (CONV) conv_finish(cc, batch0 + st, zb, zp);
    }
    __syncthreads();
}
__device__ __forceinline__ void wave_gemm_64x32_k128(const bf16* A, int lda, const bf16* Bt, int ldb, bf16* C, int ldc, int lane) {
    const int fr = lane & 15, fq = lane >> 4;
    f32x4 acc[4][2];
#pragma unroll
    for (int mi = 0; mi < 4; ++mi)
#pragma unroll
        for (int ni = 0; ni < 2; ++ni) acc[mi][ni] = (f32x4){0.f, 0.f, 0.f, 0.f};
#pragma unroll
    for (int ks = 0; ks < 4; ++ks) { bf16x8 a[4], b[2];
#pragma unroll
        for (int mi = 0; mi < 4; ++mi) a[mi] = *(const bf16x8*)(A + (size_t)(16 * mi + fr) * lda + 32 * ks + 8 * fq);
#pragma unroll
        for (int ni = 0; ni < 2; ++ni) b[ni] = *(const bf16x8*)(Bt + (size_t)(16 * ni + fr) * ldb + 32 * ks + 8 * fq);
#pragma unroll
        for (int mi = 0; mi < 4; ++mi)
#pragma unroll
            for (int ni = 0; ni < 2; ++ni) acc[mi][ni] = __builtin_amdgcn_mfma_f32_16x16x32_bf16(b[ni], a[mi], acc[mi][ni], 0, 0, 0); }
#pragma unroll
    for (int mi = 0; mi < 4; ++mi)
#pragma unroll
        for (int ni = 0; ni < 2; ++ni) { v2u w; w.x = cvt_pk_bf16(acc[mi][ni][0], acc[mi][ni][1]); w.y = cvt_pk_bf16(acc[mi][ni][2], acc[mi][ni][3]);
            st8_wt(C + (size_t)(16 * mi + fr) * ldc + 16 * ni + 4 * fq, w); }
}

constexpr int NPHASE = 10;
struct Args { const float* in[18]; float* out; unsigned char* ws; int ph_lo, ph_hi, li, pad; };

__global__ void __launch_bounds__(512, 2) hyb_fwd(Args args) {
    extern __shared__ __attribute__((aligned(16))) unsigned char lds_raw[];
    LAS unsigned char* lds = (LAS unsigned char*)lds_raw;
    volatile LAS unsigned* MISC = (volatile LAS unsigned*)(lds + MISC_OFF);
    const int tid = threadIdx.x, lane = tid & 63, wave = __builtin_amdgcn_readfirstlane(tid >> 6);
    const int G = gridDim.x, bx = blockIdx.x;
    unsigned char* ws = args.ws;
    unsigned* ctl = (unsigned*)(ws + WS_CTL);
    const float* x = args.in[0]; const float* mem = args.in[1]; const float* g_mix = args.in[2]; const float* w_in = args.in[3]; const float* conv_w = args.in[4];
    const float* sinks = args.in[5]; const float* w_attn_o = args.in[6]; const float* w_conv_o = args.in[7]; const float* w_out = args.in[8]; const float* g_xattn = args.in[9];
    const float* g_mem = args.in[10]; const float* w_xq = args.in[11]; const float* w_xkv = args.in[12]; const float* w_xo = args.in[13]; const float* g_ffn = args.in[14];
    const float* w_gate_up = args.in[15]; const float* w_down = args.in[16]; const float* g_final = args.in[17];
    float* out = args.out;
    float* ss1 = (float*)(ws + WS_SS); float* ss2 = ss1 + SEQ; float* ss3 = ss2 + SEQ;
    float* cs = (float*)(ws + WS_CS);
    bf16* kvb = (bf16*)(ws + WS_KVB); bf16* memn = (bf16*)(ws + WS_MEMN); bf16* wxqp = (bf16*)(ws + WS_WXQ); bf16* wxot = (bf16*)(ws + WS_WXOT);
    bf16* WguT = (bf16*)(ws + WS_WGUT); bf16* WdT = (bf16*)(ws + WS_WDT); bf16* XN = (bf16*)(ws + WS_XN);
    bf16* WinT = (bf16*)(ws + WS_WINT); bf16* WacT = (bf16*)(ws + WS_WACT); bf16* WoutT = (bf16*)(ws + WS_WOUTT); bf16* WxkvT = (bf16*)(ws + WS_WXKVT);
    bf16* WqKT = (bf16*)(ws + WS_WQKT); bf16* VWoT = (bf16*)(ws + WS_VWOT);
    bf16* qb = (bf16*)(ws + WS_Q); bf16* kb = (bf16*)(ws + WS_K); bf16* vb = (bf16*)(ws + WS_V); bf16* zc = (bf16*)(ws + WS_ZC);
    bf16* Pb = (bf16*)(ws + WS_P); bf16* act = (bf16*)(ws + WS_ACT);
    bf16* sgr = (bf16*)out; bf16* sgc = sgr + (size_t)SEQ * DM;
    bf16* merged = sgr;

    for (int u = tid; u < (LDS_BYTES - LDSCTL_OFF) / 4; u += 512) ((LAS unsigned*)(lds + LDSCTL_OFF))[u] = 0u;
    __syncthreads();
    XcdBarrier bar; bar.bar = ctl + CW_BAR; bar.x = 0; bar.st = nullptr;
    if (MK_N_LAUNCHES == 1) bar = xcd_barrier_post(ctl + CW_BAR, MISC + 8);
    if (tid == 0) __hip_atomic_store(ctl + CW_XID + 64 * (bx & 63) + (bx >> 6), xb_xcc_id() + 1u, __ATOMIC_RELAXED, __HIP_MEMORY_SCOPE_AGENT);
    const int lo = args.ph_lo, hi = args.ph_hi;
    const bool tailfill = (G == 256);
#define IN(k) (lo <= (k) && (k) < hi)
#ifdef PROBE_PHASE
    int n_stamp = 0;
#define STAMP() do { if (bx == 0 && tid == 0) { ((volatile LAS unsigned long long*)(lds + MISC_OFF + 128))[n_stamp] = __builtin_amdgcn_s_memrealtime(); ((volatile LAS unsigned long long*)(lds + MISC_OFF + 256))[n_stamp] = __builtin_amdgcn_s_memtime(); } ++n_stamp; } while (0)
#define SUBSTAMP(i) do { __builtin_amdgcn_s_waitcnt(0); if (bx == 0 && tid == 0) ((volatile LAS unsigned long long*)(lds + MISC_OFF + 128))[40 + (i)] = __builtin_amdgcn_s_memrealtime(); } while (0)
#else
#define STAMP() do { } while (0)
#define SUBSTAMP(i) do { } while (0)
#endif
#define SEAM(k) do { if (IN(k) && IN((k) + 1)) xcd_barrier(bar); STAMP(); } while (0)
    const bool grp = (G == 256) && (MK_N_LAUNCHES == 1);
    const int pm_own = 8 * (bx & 7) + ((bx >> 3) & 7), jmem = bx >> 6;
    unsigned* gcnt = ctl + CW_GRP + 64 * (bx & 63); unsigned* glob = ctl + CW_GLOB; unsigned* gtmo = ctl + CW_BAR + XB_TMO;
    unsigned gepoch = 0; bool same_xcd = false;
#define GSEAM(k, extra) do { if (IN(k) && IN((k) + 1)) { if (grp) { gepoch += 4u; group_barrier(gcnt, gepoch, (extra), gtmo, same_xcd); } else xcd_barrier(bar); } STAMP(); } while (0)
    STAMP();

    const TpPtrs TP{w_in, w_attn_o, w_conv_o, w_out, w_xkv, w_xo, w_gate_up, w_down, g_ffn, WinT, WacT, WoutT, WxkvT, wxot, WguT, WdT};
    if (IN(0)) {
        LAS float* scr = (LAS float*)(lds + wave * 16384);
        const int gw = bx * 8 + wave, NGW = G * 8;
        SUBSTAMP(0);
        tp_run(gw, tailfill ? TP_NEARLY : TP_NITEMS, NGW, TP, scr, lane);
        SUBSTAMP(1);
        rms_rows_to_bf16(x, g_mix, XN, gw, SEQ, NGW, lane);
        SUBSTAMP(2);
        rms_rows_to_bf16(mem, g_mem, memn, gw, NMEM, NGW, lane);
        for (int k = gw; k < DM; k += NGW) { const float gs = g_xattn[k] * C2X; const f32x4* src = (const f32x4*)(w_xq + (size_t)k * XW) + lane; v2u* dst = (v2u*)(wxqp + (size_t)k * XW) + lane;
#pragma unroll
            for (int j = 0; j < 2; ++j) { const f32x4 v = src[64 * j]; v2u w; w.x = cvt_pk_bf16(v.x * gs, v.y * gs); w.y = cvt_pk_bf16(v.z * gs, v.w * gs); dst[64 * j] = w; } }
        const int gt = bx * 512 + tid, NGT = G * 512;
        for (int e = gt; e < SEQ * 8; e += NGT) { const int pos = e >> 3, i = e & 7;
            const float inv_freq = (i == 0) ? 1.0f : (i == 1) ? 0.19392274f : (i == 2) ? 0.037606031f : (i == 3) ? 0.0072926646f : (i == 4) ? 0.0014142136f : (i == 5) ? 0.00027424819f : (i == 6) ? 5.3182957e-05f : 1.0313385e-05f;
            const float ang = (float)pos * inv_freq; float sn, cn; sincosf(ang, &sn, &cn);
            cs[(size_t)pos * 16 + i] = cn; cs[(size_t)pos * 16 + 8 + i] = sn; }
        for (int e = gt; e < 3 * SEQ; e += NGT) ss1[e] = 0.f;
        SUBSTAMP(3);
    }
    SEAM(0);

    if (IN(1)) {
        { pg8::Prob g{memn, WxkvT, DM, DM, DM, 0}; pg8::StaticOrder S; S.init(NMEM, 2 * XW, G, (bx >= 128 && bx < 132) ? bx - 128 : -1);
          EpiStoreBf16 E{kvb, 2 * XW};
          pg8::gemm_phase<EpiStoreBf16, pg8::StaticOrder, PG8_ALIGN, PG8_SP2>(lds, g, S, E); }
        if (tailfill && bx >= 132) { tp_run3(TP_NEARLY + (bx - 132) * 8 + wave, TP_NITEMS, (256 - 132) * 8, TP, (LAS float*)(lds + wave * 16384), lane); __syncthreads(); }
        { pg8::Prob g{XN, WinT, DM, DM, DM, 0}; pg8::StaticOrder S; S.init(SEQ, NIN, G, bx);
          EpiInProj E{qb, kb, vb, zc, sgr, sgc, cs};
          pg8::gemm_phase<EpiInProj, pg8::StaticOrder, PG8_ALIGN, PG8_SP2>(lds, g, S, E); }
    }
    SEAM(1);

    if (grp && IN(2)) {
        if (tid == 0) { unsigned* xt = ctl + CW_XID + 64 * (bx & 63); const unsigned a0 = xb_ld(xt), a1 = xb_ld(xt + 1), a2 = xb_ld(xt + 2), a3 = xb_ld(xt + 3);
            MISC[12] = (a0 != 0u && a0 == a1 && a0 == a2 && a0 == a3) ? 1u : 0u; }
        __syncthreads();
        same_xcd = __builtin_amdgcn_readfirstlane(MISC[12]) != 0u;
    }
    if (IN(2)) {
        SUBSTAMP(4);
        ConvCtx cc;
        if (grp) {
            conv_init(cc, zc, XN, conv_w, 4 * pm_own + jmem, tid);
            swa_unit<true>(lds, 2 * pm_own + ((2 * jmem) >> 2), (2 * jmem) & 3, qb, kb, vb, sinks, XN, tid, lane, wave, cc, 0);
            swa_unit<true>(lds, 2 * pm_own + ((2 * jmem + 1) >> 2), (2 * jmem + 1) & 3, qb, kb, vb, sinks, XN, tid, lane, wave, cc, 2);
        } else {
            for (int u = bx; u < (SEQ / 128) * 4; u += G) swa_unit<false>(lds, u >> 2, u & 3, qb, kb, vb, sinks, XN, tid, lane, wave, cc, 0);
            for (int ch = bx; ch < SEQ / 64; ch += G) { conv_init(cc, zc, XN, conv_w, ch, tid);
#pragma unroll 1
                for (int b = 0; b < 4; ++b) { v4u zb[4], zp[4]; conv_issue(cc, b, zb, zp); conv_finish(cc, b, zb, zp); } }
        }
        SUBSTAMP(5);
        const bool pp_all = !grp; const int pp_w = ((bx >> 4) << 3) + (bx & 7);
        for (int job = pp_all ? bx * 8 + wave : (((bx >> 3) & 1) ? pp_w * 8 + wave : 2048); job < 2048; job += (pp_all ? G * 8 : 1024)) { const int idx = job & 1023;
            if (job < 1024) { const int mt = idx >> 6, nt = idx & 63, m0 = 64 * mt, n0 = 32 * nt, hh = m0 >> 8, j0 = m0 & 255;
                wave_gemm_64x32_k128(kvb + (size_t)j0 * (2 * XW) + 128 * hh, 2 * XW, wxqp + (size_t)n0 * XW + 128 * hh, XW, WqKT + (size_t)m0 * DM + n0, DM, lane); }
            else { const int mt = idx >> 5, nt = idx & 31, m0 = 64 * mt, n0 = 32 * nt, hh = n0 >> 8, j0 = n0 & 255;
                wave_gemm_64x32_k128(wxot + (size_t)m0 * XW + 128 * hh, XW, kvb + (size_t)j0 * (2 * XW) + XW + 128 * hh, 2 * XW, VWoT + (size_t)m0 * (4 * NMEM) + n0, 4 * NMEM, lane); } }
    }
    SUBSTAMP(7);
    GSEAM(2, glob);

    if (IN(3)) { pg8::Prob g{XN, WacT, DM, DM, AW, AW}; pg8::StaticOrder S; S.init(SEQ, DM, G, bx, 2);
        EpiMerge E{sgr, sgc, merged};
        pg8::gemm_phase<EpiMerge, pg8::StaticOrder, PG8_ALIGN, PG8_SP2>(lds, g, S, E); }
    GSEAM(3, nullptr);

    if (IN(4)) { pg8::Prob g{merged, WoutT, DM, DM, DM, 0}; pg8::StaticOrder S; S.init(SEQ, DM, G, bx);
        EpiResid<true> E{x, XN, ss1};
        pg8::gemm_phase<EpiResid<true>, pg8::StaticOrder, PG8_ALIGN, PG8_SP2>(lds, g, S, E); }
    GSEAM(4, glob + 64);

    if (IN(5)) { if (grp) wait_global(glob, 256u, gtmo);
        pg8::Prob g{XN, WqKT, DM, DM, DM, 0}; pg8::StaticOrder S; S.init(SEQ, 4 * NMEM, G, bx);
        EpiSoftmax E{ss1, Pb};
        if ((SEQ / 256) * 4 <= G) pg8::gemm_phase<EpiSoftmax, pg8::StaticOrder, false, PG8_SP2>(lds, g, S, E); }
    GSEAM(5, nullptr);

    if (IN(6)) { pg8::Prob g{Pb, VWoT, 4 * NMEM, 4 * NMEM, 4 * NMEM, 0}; pg8::StaticOrder S; S.init(SEQ, DM, G, bx);
        EpiResid<false> E{nullptr, XN, ss2};
        pg8::gemm_phase<EpiResid<false>, pg8::StaticOrder, PG8_ALIGN, PG8_SP2>(lds, g, S, E); }
    GSEAM(6, nullptr);

    if (IN(7)) { pg8::Prob g{XN, WguT, DM, DM, DM, 0}; pg8::StaticOrder S; S.init(SEQ, 2 * DFF, G, bx);
        EpiSwiGLU E{ss2, act};
        pg8::gemm_phase<EpiSwiGLU, pg8::StaticOrder, PG8_ALIGN, PG8_SP2>(lds, g, S, E); }
    GSEAM(7, nullptr);

    if (IN(8)) { pg8::Prob g{act, WdT, DFF, DFF, DFF, 0}; pg8::StaticOrder S; S.init(SEQ, DM, G, bx);
        if (grp) { EpiFinal E{XN, ss3, out, g_final, gcnt, gepoch + 4u, glob + 64, gtmo, same_xcd}; gepoch += 4u;
            pg8::gemm_phase<EpiFinal, pg8::StaticOrder, PG8_ALIGN, PG8_SP2>(lds, g, S, E); }
        else { EpiResid<false> E{nullptr, XN, ss3};
            pg8::gemm_phase<EpiResid<false>, pg8::StaticOrder, PG8_ALIGN, PG8_SP2>(lds, g, S, E); } }
    if (!grp) { GSEAM(8, nullptr); } else { STAMP(); }

    if (IN(9) && !grp) {
        if (grp) wait_global(glob + 64, 256u, gtmo);
        const int m0 = grp ? 256 * pm_own + 64 * jmem + wave : bx * 8 + wave, m_end = grp ? 256 * pm_own + 64 * jmem + 64 : SEQ, NGW = grp ? 8 : G * 8;
        f32x4 gg[4][2];
#pragma unroll
        for (int j = 0; j < 4; ++j) { gg[j][0] = ((const f32x4*)g_final + 2 * lane)[128 * j]; gg[j][1] = ((const f32x4*)g_final + 2 * lane)[128 * j + 1]; }
        v4u hv[4];
        if (m0 < m_end) {
#pragma unroll
            for (int j = 0; j < 4; ++j) hv[j] = ((const v4u*)(XN + (size_t)m0 * DM) + lane)[64 * j]; }
        for (int m = m0; m < m_end; m += NGW) { const int nx = m + NGW; const bool more = nx < m_end; v4u hn[4];
            if (more) {
#pragma unroll
                for (int j = 0; j < 4; ++j) hn[j] = ((const v4u*)(XN + (size_t)nx * DM) + lane)[64 * j]; }
            const float rs = 1.0f / sqrtf(ss3[m] * (1.0f / DM) + EPS); f32x4* o = (f32x4*)(out + (size_t)m * DM) + 2 * lane;
#pragma unroll
            for (int j = 0; j < 4; ++j) { f32x4 v0, v1; unpack8(hv[j], v0, v1); o[128 * j] = v0 * rs * gg[j][0]; o[128 * j + 1] = v1 * rs * gg[j][1]; }
            if (more) {
#pragma unroll
                for (int j = 0; j < 4; ++j) hv[j] = hn[j]; } } }
#ifdef PROBE_PHASE
    STAMP();
    if (bx == 0 && tid == 0) { volatile LAS unsigned long long* st = (volatile LAS unsigned long long*)(lds + MISC_OFF + 128);
        volatile LAS unsigned long long* sc = (volatile LAS unsigned long long*)(lds + MISC_OFF + 256);
        unsigned long long span = st[PROBE_PHASE + 1] - st[PROBE_PHASE]; const unsigned long long t0 = __builtin_amdgcn_s_memrealtime();
#ifdef PROBE_SUB
        span = st[40 + PROBE_SUB + 1] - st[40 + PROBE_SUB];
#endif
#ifdef PROBE_CLOCK
        span = (sc[PROBE_PHASE + 1] - sc[PROBE_PHASE]) * 1250ull / span;
#endif
        while (__builtin_amdgcn_s_memrealtime() - t0 < 8ull * span) __builtin_amdgcn_s_sleep(8); }
#endif
#ifdef DBG_STOP
    if (IN(10)) { const size_t gt = (size_t)bx * 512 + tid, NGT = (size_t)G * 512;
        for (size_t e = gt; e < (size_t)SEQ * DM; e += NGT) {
#if DBG_DUMP == 0
            out[e] = __builtin_bit_cast(float, (unsigned)XN[e] << 16);
#elif DBG_DUMP == 1
            out[e] = __builtin_bit_cast(float, (unsigned)XN[e] << 16);
#elif DBG_DUMP == 2
            out[e] = __builtin_bit_cast(float, (unsigned)merged[e] << 16);
#elif DBG_DUMP == 3
            { const size_t r = e / DM, c = e % DM; out[e] = __builtin_bit_cast(float, (unsigned)(c < 1024 ? qb[r * 1024 + c] : (c < 1280 ? kb[r * 256 + c - 1024] : (c < 1536 ? vb[r * 256 + c - 1280] : zc[r * 2048 + ((c - 1536) & 2047)]))) << 16); }
#elif DBG_DUMP == 5
            { const size_t n1 = (size_t)1024 * 2048, n2 = 2 * n1, n3 = n2 + 256 * 1024; out[e] = (e < n1) ? __builtin_bit_cast(float, (unsigned)WqKT[e] << 16) : (e < n2) ? __builtin_bit_cast(float, (unsigned)VWoT[e - n1] << 16) : (e < n3) ? __builtin_bit_cast(float, (unsigned)kvb[e - n2] << 16) : 0.f; }
#elif DBG_DUMP == 6
            out[e] = (e < (size_t)256 * 1024) ? __builtin_bit_cast(float, (unsigned)kvb[e] << 16) : (e < (size_t)256 * 1024 + 256 * 2048) ? __builtin_bit_cast(float, (unsigned)memn[e - 256 * 1024] << 16) : 0.f;
#elif DBG_DUMP == 7
            out[e] = (e < (size_t)2048 * 512) ? __builtin_bit_cast(float, (unsigned)wxqp[e] << 16) : (e < (size_t)2 * 2048 * 512) ? __builtin_bit_cast(float, (unsigned)wxot[e - 2048 * 512] << 16) : 0.f;
#elif DBG_DUMP == 4
            { const size_t r = e / DM, c = e % DM; out[e] = __builtin_bit_cast(float, (unsigned)(c < 1024 ? Pb[r * 1024 + c] : (bf16)0) << 16); }
#endif
        } }
#endif
#undef IN
#undef SEAM
#undef GSEAM
}

extern "C" void kernel_launch(void* const* d_in, const int* in_sizes, int n_in, void* d_out, int out_size, void* d_ws, size_t ws_size, hipStream_t stream) {
    static int grid = 0;
    if (grid == 0) {
        if (n_in != 18 || in_sizes[0] != SEQ * DM || out_size != SEQ * DM || ws_size < WS_END) { fprintf(stderr, "kernel_launch: unexpected shapes / workspace (n_in %d, in0 %d, out %d, ws %zu); nothing launched\n", n_in, n_in > 0 ? in_sizes[0] : -1, out_size, ws_size); grid = -1; return; }
        int dev = 0, cus = 0;
        if (hipGetDevice(&dev) != hipSuccess || hipDeviceGetAttribute(&cus, hipDeviceAttributeMultiprocessorCount, dev) != hipSuccess) { fprintf(stderr, "kernel_launch: device query failed\n"); grid = -1; return; }
        if (hipFuncSetAttribute((const void*)hyb_fwd, hipFuncAttributeMaxDynamicSharedMemorySize, LDS_BYTES) != hipSuccess) { fprintf(stderr, "kernel_launch: hipFuncSetAttribute failed\n"); grid = -1; return; }
        int per_cu = 0;
        if (hipOccupancyMaxActiveBlocksPerMultiprocessor(&per_cu, (const void*)hyb_fwd, 512, LDS_BYTES) != hipSuccess || per_cu < 1) fprintf(stderr, "kernel_launch: note: occupancy query reports %d workgroups per CU\n", per_cu);
        (void)hipGetLastError();
        grid = cus;
    }
    if (grid < 0) return;
    if (hipMemsetAsync((char*)d_ws + WS_CTL, 0, CTL_ZERO_BYTES, stream) != hipSuccess) { fprintf(stderr, "kernel_launch: memset failed\n"); return; }
    Args a{};
    for (int i = 0; i < 18; ++i) a.in[i] = (const float*)d_in[i];
    a.out = (float*)d_out; a.ws = (unsigned char*)d_ws;
#ifdef DBG_STOP
    const int nl = DBG_STOP + 2;
#else
    const int nl = MK_N_LAUNCHES;
#endif
    for (int li = 0; li < nl; ++li) {
        a.ph_lo = (MK_N_LAUNCHES == 1) ? 0 : li; a.ph_hi = (MK_N_LAUNCHES == 1) ? NPHASE : li + 1; a.li = li; a.pad = 0;
#ifdef DBG_STOP
        if (li == nl - 1) { a.ph_lo = 10; a.ph_hi = 11; }
#endif
        hipLaunchKernelGGL(hyb_fwd, dim3(grid), dim3(512), LDS_BYTES, stream, a);
        const hipError_t le = hipPeekAtLastError();
        if (le != hipSuccess) { fprintf(stderr, "kernel_launch: launch %d failed: %s\n", li, hipGetErrorName(le)); break; }
    }
}
```

```cpp
#include <hip/hip_runtime.h>
#include <cstdio>
#include <cstdint>

#ifndef MK_N_LAUNCHES
#define MK_N_LAUNCHES 1
#endif

#define GAS __attribute__((address_space(1)))
#define LAS __attribute__((address_space(3)))
typedef unsigned short bf16;
typedef unsigned v4u __attribute__((ext_vector_type(4)));
typedef unsigned v2u __attribute__((ext_vector_type(2)));
typedef float f32x4 __attribute__((ext_vector_type(4)));
typedef float f32x16 __attribute__((ext_vector_type(16)));
typedef short bf16x8 __attribute__((ext_vector_type(8)));
typedef short s16x4 __attribute__((ext_vector_type(4)));

constexpr int SEQ = 16384, DM = 2048, NIN = 8704, AW = 1024, KVW = 256, CW = 1024, XW = 512, NMEM = 256, DFF = 5632;
constexpr float EPS = 1e-6f;
constexpr float LOG2E = 1.4426950408889634f;
constexpr float QSCALE = 0.125f * 1.4426950408889634f;
constexpr float C2X = 0.08838834764831845f * 1.4426950408889634f;

constexpr size_t MiB = 1u << 20;
constexpr size_t WS_CTL = 0, CTL_ZERO_BYTES = 256 * 1024;
constexpr size_t WS_SS = 1 * MiB;
constexpr size_t WS_CS = 2 * MiB;
constexpr size_t WS_KVB = 3 * MiB;
constexpr size_t WS_MEMN = 4 * MiB;
constexpr size_t WS_WXQ = 5 * MiB;
constexpr size_t WS_WXOT = 7 * MiB;
constexpr size_t WS_WGUT = 16 * MiB;
constexpr size_t WS_WDT = 60 * MiB;
constexpr size_t WS_XN = 82 * MiB;
constexpr size_t WS_WACT = 146 * MiB;
constexpr size_t WS_WOUTT = 154 * MiB;
constexpr size_t WS_WQKT = 162 * MiB;
constexpr size_t WS_VWOT = 166 * MiB;
constexpr size_t WS_Q = 170 * MiB, WS_K = 202 * MiB, WS_V = 210 * MiB, WS_ZC = 218 * MiB;
constexpr size_t WS_P = WS_Q;
constexpr size_t WS_ACT = 314 * MiB;
constexpr size_t WS_WINT = 314 * MiB;
constexpr size_t WS_WXKVT = 348 * MiB;
constexpr size_t WS_END = 490 * MiB;
static_assert(WS_ACT + (size_t)SEQ * DFF * 2 <= WS_END && WS_ZC + (size_t)SEQ * 3 * CW * 2 <= WS_ACT, "d_ws map");

constexpr int CW_BAR = 4096;
constexpr int CW_GRP = 16384;
constexpr int CW_XID = 49152;
constexpr int CW_GLOB = 32768;

constexpr int RING_BYTES = 131072;
constexpr int LDSCTL_OFF = RING_BYTES, MISC_OFF = LDSCTL_OFF + 320;
constexpr int LDS_BYTES = 147456;

#define RLX_AGENT __ATOMIC_RELAXED, __HIP_MEMORY_SCOPE_AGENT
#define LDS_WAIT() asm volatile("s_waitcnt lgkmcnt(0)" ::: "memory")
#define VM_WAIT() asm volatile("s_waitcnt vmcnt(0)" ::: "memory")

typedef float f32x2_t __attribute__((ext_vector_type(2))); typedef __bf16 bf16x2_t __attribute__((ext_vector_type(2)));
__device__ __forceinline__ unsigned cvt_pk_bf16(float lo, float hi) { f32x2_t v = {lo, hi}; bf16x2_t b = __builtin_convertvector(v, bf16x2_t); return __builtin_bit_cast(unsigned, b); }
__device__ __forceinline__ float bf_lo(unsigned u) { return __builtin_bit_cast(float, u << 16); }
__device__ __forceinline__ float bf_hi(unsigned u) { return __builtin_bit_cast(float, u & 0xffff0000u); }
__device__ __forceinline__ float fast_exp2(float x) { return __builtin_amdgcn_exp2f(x); }
__device__ __forceinline__ float fast_rcp(float x) { return __builtin_amdgcn_rcpf(x); }
__device__ __forceinline__ void st16_wt(void* p, v4u v) { asm volatile("global_store_dwordx4 %0, %1, off sc1\n\ts_nop 1" :: "v"(p), "v"(v) : "memory"); }
__device__ __forceinline__ void st8_wt(void* p, v2u v) { __hip_atomic_store((unsigned long long*)p, ((unsigned long long)v.y << 32) | v.x, __ATOMIC_RELAXED, __HIP_MEMORY_SCOPE_AGENT); }

namespace pg8 {
typedef unsigned short bf16_t;
constexpr int BM = 256, BK = 64, HALF = 128, HTB = HALF * BK * 2, STAGE_BYTES = 8 * HTB, NXCD = 8, WGM = 8;

__host__ __device__ __forceinline__ int lds_byte(int r, int c) { const int st = (r >> 4) * 2 + (c >> 5), rr = r & 15, cc = c & 31, ob = rr * 64 + cc * 2; return st * 1024 + (ob ^ (((ob >> 9) & 1) << 5)); }
__host__ __device__ __forceinline__ void stage_rc(int b, int& R, int& C) { const int st = b / 1024, sb = b % 1024, swz = sb ^ (((sb >> 9) & 1) << 5); R = (st >> 1) * 16 + swz / 64; C = (st & 1) * 32 + (swz % 64) / 2; }
__host__ __device__ __forceinline__ int perm32(int rho) { const int n = rho >> 4, i = rho & 15; return 8 * (i >> 2) + 4 * n + (i & 3); }

struct Unit { int pm, pn, z; };
struct Prob {
    const bf16_t* A; const bf16_t* Bt; int lda, ldb, K, zoff;
    int akstep = 0; size_t apanel = 0;
    __device__ __forceinline__ const char* a_ptr(const Unit& u) const { return (const char*)(A + (apanel ? (size_t)u.pm * apanel : (size_t)u.pm * BM * lda) + (size_t)u.z * zoff); }
    __device__ __forceinline__ const char* b_ptr(const Unit& u) const { return (const char*)(Bt + (size_t)u.pn * BM * ldb + (size_t)u.z * zoff); }
};

__device__ __forceinline__ bool tile_of(long L, int nM, int nN, int& pm, int& pn) {
    const int nwg = nM * nN; if (L >= nwg) return false;
    int wgid = (int)L; { const int q = nwg / NXCD, r = nwg % NXCD, xcd = wgid % NXCD, off = wgid / NXCD; wgid = (xcd < r ? xcd * (q + 1) : r * (q + 1) + (xcd - r) * q) + off; }
    const int nig = WGM * nN, gid = wgid / nig, fm = gid * WGM, gsz = (nM - fm) < WGM ? (nM - fm) : WGM;
    pm = fm + ((wgid % nig) % gsz); pn = (wgid % nig) / gsz; return true;
}
struct StaticOrder {
    int nM, nN, G, c, ZS;
    __device__ __forceinline__ void init(int M, int N, int G_, int c_, int ZS_ = 1) { nM = M / BM; nN = N / BM; G = G_; c = c_; ZS = ZS_; }
    __device__ __forceinline__ bool next(int i, Unit& u) const {
        if (c < 0) return false;
        const int ti = (ZS == 2) ? (i >> 1) : i; u.z = (ZS == 2) ? (i & 1) : 0;
        return tile_of((long)ti * G + c, nM, nN, u.pm, u.pn);
    }
};

template <class Epi, class Sched, bool ALIGN_EPI = false, bool SP2 = false>
__device__ __forceinline__ void gemm_phase(LAS unsigned char* lds, const Prob g, const Sched& S, const Epi& E) {
    const int tid = threadIdx.x, wid = __builtin_amdgcn_readfirstlane(tid >> 6), lane = tid & 63, wr = wid >> 2, wc = wid & 3, fr = lane & 15, fq = lane >> 4;
    const int K = g.K, nt = K / BK;
    unsigned voffA[2], voffB[2];
#pragma unroll
    for (int i = 0; i < 2; ++i) { int R, C; stage_rc(tid * 16 + i * 8192, R, C); const int Rb = Epi::PERM ? ((R & ~31) + perm32(R & 31)) : R;
        voffA[i] = (unsigned)(R * g.lda + C) * 2u; voffB[i] = (unsigned)(Rb * g.ldb + C) * 2u; }
    const size_t kstep = (size_t)(BK * 2), kstepA = g.akstep ? (size_t)g.akstep : kstep;
    const size_t hstepA = (size_t)HALF * g.lda * 2, hstepB = (size_t)HALF * g.ldb * 2;
    const unsigned ldsw = (unsigned)wid * 1024u;
    const int aoff = lds_byte(wr * 64 + fr, fq * 8), boff = lds_byte(wc * 32 + fr, fq * 8);
#define PG8_SA(b, h) (((b) * 2 + (h)) * HTB)
#define PG8_SB(b, h) ((4 + (b) * 2 + (h)) * HTB)
#define PG8_STAGE(bufoff, gbase, voff) do { _Pragma("unroll") for (int _i = 0; _i < 2; ++_i) \
        __builtin_amdgcn_global_load_lds((const unsigned*)((const char*)(gbase) + (voff)[_i]), (LAS unsigned*)(lds + (bufoff) + ldsw + _i * 8192), 16, 0, 0); } while (0)
#define PG8_LDA(dst, b, h) do { _Pragma("unroll") for (int m = 0; m < 4; ++m) _Pragma("unroll") for (int k = 0; k < 2; ++k) dst[m][k] = *(const LAS bf16x8*)(lds + PG8_SA(b, h) + aoff + m * 2048 + k * 1024); } while (0)
#define PG8_LDB(dst, b, h) do { _Pragma("unroll") for (int n = 0; n < 2; ++n) _Pragma("unroll") for (int k = 0; k < 2; ++k) dst[n][k] = *(const LAS bf16x8*)(lds + PG8_SB(b, h) + boff + n * 2048 + k * 1024); } while (0)
#define PG8_MMA(ai, bj, At, Bt) do { __builtin_amdgcn_s_setprio(1); _Pragma("unroll") for (int m = 0; m < 4; ++m) _Pragma("unroll") for (int n = 0; n < 2; ++n) _Pragma("unroll") for (int k = 0; k < 2; ++k) \
        acc[ai][bj][m][n] = __builtin_amdgcn_mfma_f32_16x16x32_bf16(Bt[n][k], At[m][k], acc[ai][bj][m][n], 0, 0, 0); __builtin_amdgcn_s_setprio(0); } while (0)
#define PG8_WAIT_V(n) asm volatile("s_waitcnt vmcnt(" #n ")" ::: "memory")
#define PG8_WAIT_L(n) asm volatile("s_waitcnt lgkmcnt(" #n ")" ::: "memory")
#define PG8_BAR __builtin_amdgcn_s_barrier()
#define PG8_SCHED __builtin_amdgcn_sched_barrier(0)
    Unit cur, nxt; int ui = 0;
    if (!S.next(0, cur)) return;
    f32x4 acc[2][2][4][2];
#pragma unroll
    for (int a = 0; a < 2; ++a)
#pragma unroll
        for (int b = 0; b < 2; ++b)
#pragma unroll
            for (int m = 0; m < 4; ++m)
#pragma unroll
                for (int n = 0; n < 2; ++n) acc[a][b][m][n] = (f32x4){0.f, 0.f, 0.f, 0.f};
    bf16x8 At[4][2], B0[2][2], B1[2][2];
    const char* cA = g.a_ptr(cur); const char* cB = g.b_ptr(cur);
    if constexpr (SP2) {
        PG8_STAGE(PG8_SB(0, 0), cB, voffB); PG8_STAGE(PG8_SB(0, 1), cB + hstepB, voffB); PG8_STAGE(PG8_SA(0, 0), cA, voffA); PG8_STAGE(PG8_SA(0, 1), cA + hstepA, voffA);
        if (wr == 1) PG8_BAR;
        PG8_WAIT_V(2); PG8_BAR;
        PG8_STAGE(PG8_SB(1, 0), cB + kstep, voffB); PG8_STAGE(PG8_SA(1, 0), cA + kstepA, voffA); PG8_STAGE(PG8_SB(1, 1), cB + hstepB + kstep, voffB);
        PG8_WAIT_V(6); PG8_BAR;
    } else {
        PG8_STAGE(PG8_SB(0, 0), cB, voffB); PG8_STAGE(PG8_SA(0, 0), cA, voffA); PG8_STAGE(PG8_SB(0, 1), cB + hstepB, voffB); PG8_STAGE(PG8_SA(0, 1), cA + hstepA, voffA);
        if (wr == 1) PG8_BAR;
        PG8_WAIT_V(4); PG8_BAR;
        PG8_STAGE(PG8_SB(1, 0), cB + kstep, voffB); PG8_STAGE(PG8_SA(1, 0), cA + kstepA, voffA); PG8_STAGE(PG8_SB(1, 1), cB + hstepB + kstep, voffB);
        PG8_WAIT_V(6); PG8_BAR;
    }
    for (;;) {
        const bool has_next = S.next(ui + 1, nxt);
        const char* nA = has_next ? g.a_ptr(nxt) : cA; const char* nB = has_next ? g.b_ptr(nxt) : cB;
        for (int t = 0; t < nt; t += 2) {
            const bool last = (t == nt - 2);
            const char* a1 = cA + (size_t)(t + 1) * kstepA;
            const char* a2 = last ? nA : cA + (size_t)(t + 2) * kstepA; const char* b2 = last ? nB : cB + (size_t)(t + 2) * kstep;
            const char* a3 = a2 + kstepA; const char* b3 = b2 + kstep;
            if constexpr (SP2) {
            PG8_LDB(B0, 0, 0); PG8_LDB(B1, 0, 1); PG8_SCHED; PG8_LDA(At, 0, 0); PG8_STAGE(PG8_SA(1, 1), a1 + hstepA, voffA);
            PG8_WAIT_V(8); PG8_WAIT_L(0); PG8_BAR; PG8_MMA(0, 0, At, B0); PG8_MMA(0, 1, At, B1); PG8_BAR; PG8_SCHED;
            PG8_LDA(At, 0, 1); PG8_STAGE(PG8_SB(0, 0), b2, voffB); PG8_STAGE(PG8_SB(0, 1), b2 + hstepB, voffB); PG8_STAGE(PG8_SA(0, 0), a2, voffA);
            PG8_WAIT_V(8); PG8_WAIT_L(0); PG8_BAR; PG8_MMA(1, 0, At, B0); PG8_MMA(1, 1, At, B1); PG8_BAR; PG8_SCHED;
            PG8_LDB(B0, 1, 0); PG8_LDB(B1, 1, 1); PG8_SCHED; PG8_LDA(At, 1, 0); PG8_STAGE(PG8_SA(0, 1), a2 + hstepA, voffA);
            PG8_WAIT_V(8); PG8_WAIT_L(0); PG8_BAR; PG8_MMA(0, 0, At, B0); PG8_MMA(0, 1, At, B1); PG8_BAR; PG8_SCHED;
            PG8_LDA(At, 1, 1); PG8_STAGE(PG8_SB(1, 0), b3, voffB); PG8_STAGE(PG8_SB(1, 1), b3 + hstepB, voffB); PG8_STAGE(PG8_SA(1, 0), a3, voffA);
            PG8_WAIT_V(8); PG8_WAIT_L(0); PG8_BAR; PG8_MMA(1, 0, At, B0); PG8_MMA(1, 1, At, B1); PG8_BAR; PG8_SCHED;
            } else {
            PG8_LDB(B0, 0, 0); PG8_SCHED; PG8_LDA(At, 0, 0); PG8_STAGE(PG8_SA(1, 1), a1 + hstepA, voffA);
            PG8_WAIT_L(8); PG8_BAR; PG8_WAIT_L(0); PG8_MMA(0, 0, At, B0); PG8_BAR; PG8_SCHED;
            PG8_LDB(B1, 0, 1); PG8_STAGE(PG8_SB(0, 0), b2, voffB);
            PG8_BAR; PG8_WAIT_L(0); PG8_MMA(0, 1, At, B1); PG8_BAR;
            PG8_LDA(At, 0, 1); PG8_STAGE(PG8_SA(0, 0), a2, voffA);
            PG8_BAR; PG8_WAIT_L(0); PG8_MMA(1, 0, At, B0); PG8_BAR; PG8_SCHED;
            PG8_STAGE(PG8_SB(0, 1), b2 + hstepB, voffB);
            PG8_WAIT_V(6); PG8_BAR; PG8_MMA(1, 1, At, B1); PG8_BAR;
            PG8_LDB(B0, 1, 0); PG8_SCHED; PG8_LDA(At, 1, 0); PG8_STAGE(PG8_SA(0, 1), a2 + hstepA, voffA);
            PG8_WAIT_L(8); PG8_BAR; PG8_WAIT_L(0); PG8_MMA(0, 0, At, B0); PG8_BAR; PG8_SCHED;
            PG8_LDB(B1, 1, 1); PG8_STAGE(PG8_SB(1, 0), b3, voffB);
            PG8_BAR; PG8_WAIT_L(0); PG8_MMA(0, 1, At, B1); PG8_BAR;
            PG8_LDA(At, 1, 1); PG8_STAGE(PG8_SA(1, 0), a3, voffA);
            PG8_BAR; PG8_WAIT_L(0); PG8_MMA(1, 0, At, B0); PG8_BAR; PG8_SCHED;
            PG8_STAGE(PG8_SB(1, 1), b3 + hstepB, voffB);
            PG8_WAIT_V(6); PG8_BAR; PG8_MMA(1, 1, At, B1); PG8_BAR;
            }
        }
        if constexpr (ALIGN_EPI) { if (wr == 0) PG8_BAR; }
        if constexpr (!Epi::AFTER_DRAIN) { if (!(Epi::LAST_FUSED && !has_next)) E(acc, cur, wr, wc, fr, fq); }
        if (!has_next) break;
        if (!E.keep(cur)) {
#pragma unroll
        for (int a = 0; a < 2; ++a)
#pragma unroll
            for (int b = 0; b < 2; ++b)
#pragma unroll
                for (int m = 0; m < 4; ++m)
#pragma unroll
                    for (int n = 0; n < 2; ++n) acc[a][b][m][n] = (f32x4){0.f, 0.f, 0.f, 0.f};
        }
        cur = nxt; cA = nA; cB = nB; ++ui;
        if constexpr (ALIGN_EPI) { if (wr == 1) PG8_BAR; }
    }
    PG8_WAIT_V(0);
    if constexpr (!ALIGN_EPI) { if (wr == 0) PG8_BAR; }
    PG8_BAR;
    if constexpr (Epi::AFTER_DRAIN || Epi::LAST_FUSED) { E.fused(acc, cur, wr, wc, fr, fq, lds, wid, lane); }
#undef PG8_SA
#undef PG8_SB
#undef PG8_STAGE
#undef PG8_LDA
#undef PG8_LDB
#undef PG8_MMA
#undef PG8_WAIT_V
#undef PG8_WAIT_L
#undef PG8_BAR
#undef PG8_SCHED
}
}

#ifndef PG8_SP2
#define PG8_SP2 true
#endif
#ifndef PG8_ALIGN
#define PG8_ALIGN true
#endif

typedef f32x4 Acc[2][2][4][2];

__device__ __forceinline__ v4u pack8(f32x4 v0, f32x4 v1) { v4u w; w.x = cvt_pk_bf16(v0[0], v0[1]); w.y = cvt_pk_bf16(v0[2], v0[3]); w.z = cvt_pk_bf16(v1[0], v1[1]); w.w = cvt_pk_bf16(v1[2], v1[3]); return w; }
__device__ __forceinline__ void unpack8(v4u w, f32x4& v0, f32x4& v1) { v0 = (f32x4){bf_lo(w.x), bf_hi(w.x), bf_lo(w.y), bf_hi(w.y)}; v1 = (f32x4){bf_lo(w.z), bf_hi(w.z), bf_lo(w.w), bf_hi(w.w)}; }

struct EpiInProj {
    static constexpr bool PERM = true, AFTER_DRAIN = false, LAST_FUSED = false;
    bf16 *q, *k, *v, *zc, *sgr, *sgc; const float* cs;
    __device__ __forceinline__ bool keep(const pg8::Unit&) const { return false; }
    __device__ __forceinline__ void operator()(Acc& acc, const pg8::Unit& u, int wr, int wc, int fr, int fq) const {
        const int row0 = u.pm * 256 + wr * 64 + fr, ct = wc * 32 + 8 * fq;
        if (u.pn < 5) {
            const bool isq = u.pn < 4; bf16* base = isq ? q + u.pn * 256 : k; const int ld = isq ? AW : KVW; const float sc = isq ? QSCALE : 1.f;
            const bool rl = ((wc & 1) == 0) && (fq < 2);
#pragma unroll
            for (int ai = 0; ai < 2; ++ai)
#pragma unroll
                for (int m = 0; m < 4; ++m) { const int row = row0 + ai * 128 + m * 16;
                    f32x4 c4 = (f32x4){1.f, 1.f, 1.f, 1.f}, s4 = (f32x4){0.f, 0.f, 0.f, 0.f};
                    if (rl) { c4 = *(const f32x4*)(cs + (size_t)row * 16 + 4 * fq); s4 = *(const f32x4*)(cs + (size_t)row * 16 + 8 + 4 * fq); }
#pragma unroll
                    for (int bj = 0; bj < 2; ++bj) { const f32x4 t1 = acc[ai][bj][m][0], t2 = acc[ai][bj][m][1];
                        const f32x4 v0 = (t1 * c4 - t2 * s4) * sc, v1 = (t2 * c4 + t1 * s4) * sc;
                        *(v4u*)(base + (size_t)row * ld + bj * 128 + ct) = pack8(v0, v1); } }
        } else if (u.pn < 10) {
            bf16* base = (u.pn == 5) ? v : zc + (u.pn - 6) * 256; const int ld = (u.pn == 5) ? KVW : 2 * CW;
#pragma unroll
            for (int ai = 0; ai < 2; ++ai)
#pragma unroll
                for (int m = 0; m < 4; ++m) { const int row = row0 + ai * 128 + m * 16;
#pragma unroll
                    for (int bj = 0; bj < 2; ++bj) *(v4u*)(base + (size_t)row * ld + bj * 128 + ct) = pack8(acc[ai][bj][m][0], acc[ai][bj][m][1]); }
        } else if (u.pn < 18) {
            const int t = u.pn - 10;
#pragma unroll
            for (int ai = 0; ai < 2; ++ai)
#pragma unroll
                for (int m = 0; m < 4; ++m) { const int row = row0 + ai * 128 + m * 16;
                    *(v4u*)(zc + (size_t)row * (2 * CW) + CW + t * 128 + ct) = pack8(acc[ai][0][m][0] * acc[ai][1][m][0], acc[ai][0][m][1] * acc[ai][1][m][1]); }
        } else {
            const int t = u.pn - 18;
#pragma unroll
            for (int ai = 0; ai < 2; ++ai)
#pragma unroll
                for (int m = 0; m < 4; ++m) { const int row = row0 + ai * 128 + m * 16; f32x4 rr[2], ss[2];
#pragma unroll
                    for (int n = 0; n < 2; ++n)
#pragma unroll
                        for (int e = 0; e < 4; ++e) { const float ga = acc[ai][0][m][n][e], gc = acc[ai][1][m][n][e];
                            const float ea = fast_exp2(fminf(ga, 80.f)), ec = fast_exp2(fminf(gc, 80.f));
                            const float ia = fast_rcp(1.f + ea), ic = fast_rcp(1.f + ec);
                            rr[n][e] = (1.f + ec) * ia; ss[n][e] = ic; }
                    *(v4u*)(sgr + (size_t)row * DM + t * 128 + ct) = pack8(rr[0], rr[1]);
                    *(v4u*)(sgc + (size_t)row * DM + t * 128 + ct) = pack8(ss[0], ss[1]); }
        }
    }
};
struct EpiStoreBf16 {
    static constexpr bool PERM = true, AFTER_DRAIN = false, LAST_FUSED = false;
    bf16* O; int ldc;
    __device__ __forceinline__ bool keep(const pg8::Unit&) const { return false; }
    __device__ __forceinline__ void operator()(Acc& acc, const pg8::Unit& u, int wr, int wc, int fr, int fq) const {
        const int row0 = u.pm * 256 + wr * 64 + fr, col0 = u.pn * 256 + wc * 32 + 8 * fq;
#pragma unroll
        for (int ai = 0; ai < 2; ++ai)
#pragma unroll
            for (int m = 0; m < 4; ++m) { const int row = row0 + ai * 128 + m * 16;
#pragma unroll
                for (int bj = 0; bj < 2; ++bj) *(v4u*)(O + (size_t)row * ldc + col0 + bj * 128) = pack8(acc[ai][bj][m][0], acc[ai][bj][m][1]); }
    }
};
struct EpiMerge {
    static constexpr bool PERM = true, AFTER_DRAIN = false, LAST_FUSED = false;
    const bf16 *sgr, *sgc; bf16* merged;
    __device__ __forceinline__ bool keep(const pg8::Unit& u) const { return u.z == 0; }
    __device__ __forceinline__ void operator()(Acc& acc, const pg8::Unit& u, int wr, int wc, int fr, int fq) const {
        const int row0 = u.pm * 256 + wr * 64 + fr, col0 = u.pn * 256 + wc * 32 + 8 * fq;
        const bf16* gsrc = ((u.z == 0) ? sgr : sgc) + (size_t)row0 * DM + col0;
        v4u gw[2][4][2];
#pragma unroll
        for (int ai = 0; ai < 2; ++ai)
#pragma unroll
            for (int m = 0; m < 4; ++m)
#pragma unroll
                for (int bj = 0; bj < 2; ++bj) gw[ai][m][bj] = *(const v4u*)(gsrc + (size_t)(ai * 128 + m * 16) * DM + bj * 128);
#pragma unroll
        for (int ai = 0; ai < 2; ++ai)
#pragma unroll
            for (int m = 0; m < 4; ++m) { const int row = row0 + ai * 128 + m * 16;
#pragma unroll
                for (int bj = 0; bj < 2; ++bj) { f32x4 g0, g1; unpack8(gw[ai][m][bj], g0, g1);
                    const f32x4 v0 = acc[ai][bj][m][0] * g0, v1 = acc[ai][bj][m][1] * g1;
                    if (u.z == 0) { acc[ai][bj][m][0] = v0; acc[ai][bj][m][1] = v1; }
                    else *(v4u*)(merged + (size_t)row * DM + col0 + bj * 128) = pack8(v0, v1); } }
    }
};
template <bool BASE_F32> struct EpiResid {
    static constexpr bool PERM = true, AFTER_DRAIN = false, LAST_FUSED = false;
    const float* basef; bf16* hb; float* ss;
    __device__ __forceinline__ bool keep(const pg8::Unit&) const { return false; }
    __device__ __forceinline__ void operator()(Acc& acc, const pg8::Unit& u, int wr, int wc, int fr, int fq) const {
        const int row0 = u.pm * 256 + wr * 64 + fr, col0 = u.pn * 256 + wc * 32 + 8 * fq;
        const size_t off0 = (size_t)row0 * DM + col0;
        constexpr int NPRE = BASE_F32 ? 4 : 8;
        f32x4 pf[BASE_F32 ? 4 : 1][2][2]; v4u pb[BASE_F32 ? 1 : 8][2];
#pragma unroll
        for (int g = 0; g < NPRE; ++g)
#pragma unroll
            for (int bj = 0; bj < 2; ++bj) { const size_t off = off0 + (size_t)((g >> 2) * 128 + (g & 3) * 16) * DM + bj * 128;
                if (BASE_F32) { pf[g][bj][0] = __builtin_nontemporal_load((const f32x4*)(basef + off)); pf[g][bj][1] = __builtin_nontemporal_load((const f32x4*)(basef + off + 4)); } else pb[g][bj] = *(const v4u*)(hb + off); }
#pragma unroll
        for (int g = 0; g < 8; ++g) { const int ai = g >> 2, m = g & 3; const int row = row0 + ai * 128 + m * 16; float sq = 0.f;
#pragma unroll
            for (int bj = 0; bj < 2; ++bj) { const size_t off = (size_t)row * DM + col0 + bj * 128; f32x4 b0, b1;
                if (BASE_F32) { b0 = pf[g & 3][bj][0]; b1 = pf[g & 3][bj][1]; } else unpack8(pb[g][bj], b0, b1);
                const f32x4 v0 = acc[ai][bj][m][0] + b0, v1 = acc[ai][bj][m][1] + b1;
                *(v4u*)(hb + off) = pack8(v0, v1);
                sq += (v0[0] * v0[0] + v0[1] * v0[1]) + (v0[2] * v0[2] + v0[3] * v0[3]) + (v1[0] * v1[0] + v1[1] * v1[1]) + (v1[2] * v1[2] + v1[3] * v1[3]); }
            if (BASE_F32 && g + 4 < 8) {
#pragma unroll
                for (int bj = 0; bj < 2; ++bj) { const size_t off = off0 + (size_t)(128 + m * 16) * DM + bj * 128; pf[g & 3][bj][0] = __builtin_nontemporal_load((const f32x4*)(basef + off)); pf[g & 3][bj][1] = __builtin_nontemporal_load((const f32x4*)(basef + off + 4)); } }
            sq += __shfl_xor(sq, 16); sq += __shfl_xor(sq, 32);
            if (fq == 0) atomicAdd(ss + row, sq); }
    }
};
struct EpiSoftmax {
    static constexpr bool PERM = true, AFTER_DRAIN = true, LAST_FUSED = false;
    const float* ss; bf16* P;
    __device__ __forceinline__ bool keep(const pg8::Unit&) const { return false; }
    __device__ __forceinline__ void fused(Acc& acc, const pg8::Unit& u, int wr, int wc, int fr, int fq, LAS unsigned char* lds, int wid, int lane) const {
        LAS float* Pm = (LAS float*)lds; LAS float* Ps = (LAS float*)(lds + 4096);
        const int rl0 = wr * 64 + fr, col0 = u.pn * 256 + wc * 32 + 8 * fq;
#pragma unroll
        for (int ai = 0; ai < 2; ++ai)
#pragma unroll
            for (int m = 0; m < 4; ++m) { const int rl = rl0 + ai * 128 + m * 16; const float rs = 1.0f / sqrtf(ss[u.pm * 256 + rl] * (1.0f / DM) + EPS); float mx = -3.0e38f;
#pragma unroll
                for (int bj = 0; bj < 2; ++bj)
#pragma unroll
                    for (int n = 0; n < 2; ++n) { f32x4 s = acc[ai][bj][m][n] * rs; acc[ai][bj][m][n] = s; mx = fmaxf(mx, fmaxf(fmaxf(s[0], s[1]), fmaxf(s[2], s[3]))); }
                mx = fmaxf(mx, __shfl_xor(mx, 16)); mx = fmaxf(mx, __shfl_xor(mx, 32));
                if (fq == 0) Pm[rl * 4 + wc] = mx; }
        asm volatile("s_waitcnt lgkmcnt(0)" ::: "memory"); __builtin_amdgcn_s_barrier(); asm volatile("" ::: "memory");
#pragma unroll
        for (int ai = 0; ai < 2; ++ai)
#pragma unroll
            for (int m = 0; m < 4; ++m) { const int rl = rl0 + ai * 128 + m * 16; const f32x4 pm4 = *(const LAS f32x4*)(Pm + rl * 4);
                const float mx = fmaxf(fmaxf(pm4[0], pm4[1]), fmaxf(pm4[2], pm4[3])); float sm = 0.f;
#pragma unroll
                for (int bj = 0; bj < 2; ++bj)
#pragma unroll
                    for (int n = 0; n < 2; ++n) { f32x4 s = acc[ai][bj][m][n];
#pragma unroll
                        for (int e = 0; e < 4; ++e) { s[e] = fast_exp2(s[e] - mx); sm += s[e]; }
                        acc[ai][bj][m][n] = s; }
                sm += __shfl_xor(sm, 16); sm += __shfl_xor(sm, 32);
                if (fq == 0) Ps[rl * 4 + wc] = sm; }
        asm volatile("s_waitcnt lgkmcnt(0)" ::: "memory"); __builtin_amdgcn_s_barrier(); asm volatile("" ::: "memory");
#pragma unroll
        for (int ai = 0; ai < 2; ++ai)
#pragma unroll
            for (int m = 0; m < 4; ++m) { const int rl = rl0 + ai * 128 + m * 16; const f32x4 ps4 = *(const LAS f32x4*)(Ps + rl * 4);
                const float inv = 1.0f / ((ps4[0] + ps4[1]) + (ps4[2] + ps4[3])); const size_t rowoff = (size_t)(u.pm * 256 + rl) * (4 * NMEM) + col0;
#pragma unroll
                for (int bj = 0; bj < 2; ++bj) *(v4u*)(P + rowoff + bj * 128) = pack8(acc[ai][bj][m][0] * inv, acc[ai][bj][m][1] * inv); }
    }
};
struct EpiSwiGLU {
    static constexpr bool PERM = true, AFTER_DRAIN = false, LAST_FUSED = false;
    const float* ss; bf16* act;
    __device__ __forceinline__ bool keep(const pg8::Unit&) const { return false; }
    __device__ __forceinline__ void operator()(Acc& acc, const pg8::Unit& u, int wr, int wc, int fr, int fq) const {
        const int row0 = u.pm * 256 + wr * 64 + fr, col0 = u.pn * 128 + wc * 32 + 8 * fq;
#pragma unroll
        for (int ai = 0; ai < 2; ++ai)
#pragma unroll
            for (int m = 0; m < 4; ++m) { const int row = row0 + ai * 128 + m * 16; const float rs = 1.0f / sqrtf(ss[row] * (1.0f / DM) + EPS); f32x4 o[2];
                const float nrl = -rs * LOG2E, rs2 = rs * rs;
#pragma unroll
                for (int n = 0; n < 2; ++n)
#pragma unroll
                    for (int e = 0; e < 4; ++e) { const float a = acc[ai][0][m][n][e], b = acc[ai][1][m][n][e];
                        o[n][e] = (a * b) * (rs2 * fast_rcp(1.f + fast_exp2(a * nrl))); }
                *(v4u*)(act + ((((size_t)u.pm * (DFF / 64) + (col0 >> 6)) * 256 + (row - u.pm * 256)) << 6) + (col0 & 63)) = pack8(o[0], o[1]); }
    }
};

#define XB_TMO      128
#define XB_XCNT(j)  (256  + 64 * (j))
#define XB_XSUB(j)  (1280 + 64 * (j))
#define XB_XGEN(j)  (2304 + 64 * (j))
#define XB_TOP      3328
#define XB_TOPGEN   3392
#define XCD_BAR_WORDS 3456
#define XB_SPIN_CAP (1u << 18)

__device__ __forceinline__ unsigned xb_ld(unsigned* p)              { return __hip_atomic_load(p, __ATOMIC_RELAXED, __HIP_MEMORY_SCOPE_AGENT); }
__device__ __forceinline__ unsigned xb_add(unsigned* p, unsigned v) { return __hip_atomic_fetch_add(p, v, __ATOMIC_RELAXED, __HIP_MEMORY_SCOPE_AGENT); }
__device__ __forceinline__ unsigned xb_xcc_id() { return (unsigned)__builtin_amdgcn_s_getreg((3 << 11) | 20) & 0xFu; }
#define XB_SPIN(cond, bar) do { unsigned _sp = 0; while (cond) { __builtin_amdgcn_s_sleep(1); \
    if ((++_sp & 255u) == 0u) { if (xb_ld(&(bar)[XB_TMO])) break; if (_sp > XB_SPIN_CAP) { atomicAdd(&(bar)[XB_TMO], 1u); break; } } } } while (0)

struct XcdBarrier { unsigned* bar; unsigned x; volatile LAS unsigned* st; };

__device__ __forceinline__ XcdBarrier xcd_barrier_post(unsigned* bar, volatile LAS unsigned* st) {
    XcdBarrier b; b.bar = bar; b.x = xb_xcc_id(); b.st = st;
    if (threadIdx.x == 0) (void)xb_add(&bar[XB_XCNT(b.x)], 1u);
    return b;
}
__device__ __forceinline__ void xcd_barrier_complete(unsigned* bar, unsigned x, unsigned& nloc, unsigned& nx) {
    const unsigned G = gridDim.x * gridDim.y * gridDim.z;
    unsigned sum, cnt, mine, sp = 0u;
    for (;;) {
        sum = 0u; cnt = 0u; mine = 0u;
#pragma unroll
        for (unsigned j = 0; j < 16; ++j) { const unsigned c = xb_ld(&bar[XB_XCNT(j)]); sum += c; cnt += (c > 0u) ? 1u : 0u; mine = (j == x) ? c : mine; }
        if (sum == G) break;
        __builtin_amdgcn_s_sleep(1);
        if ((++sp & 255u) == 0u) { if (xb_ld(&bar[XB_TMO])) break; if (sp > XB_SPIN_CAP) { atomicAdd(&bar[XB_TMO], 1u); break; } }
    }
    nloc = mine > 0u ? mine : 1u; nx = cnt > 0u ? cnt : 1u;
}
__device__ __forceinline__ void xcd_barrier(const XcdBarrier& b) {
    asm volatile("s_waitcnt vmcnt(0)" ::: "memory");
    __syncthreads();
    if (threadIdx.x == 0) {
        unsigned* bar = b.bar;
        __builtin_amdgcn_s_waitcnt(0);
        unsigned nloc = b.st[0], nx = b.st[1];
        if (nloc == 0u) { xcd_barrier_complete(bar, b.x, nloc, nx); b.st[0] = nloc; b.st[1] = nx; }
        const unsigned old = xb_add(&bar[XB_XSUB(b.x)], 1u);
        const unsigned gen = old / nloc;
        if (old + 1u == (gen + 1u) * nloc) {
            __builtin_amdgcn_fence(__ATOMIC_RELEASE, "agent");
            asm volatile("s_waitcnt vmcnt(0)" ::: "memory");
            const unsigned og = xb_add(&bar[XB_TOP], 1u);
            const unsigned tg = og / nx;
            if (og + 1u == (tg + 1u) * nx) xb_add(&bar[XB_TOPGEN], 1u);
            else XB_SPIN(xb_ld(&bar[XB_TOPGEN]) == tg, bar);
            __builtin_amdgcn_fence(__ATOMIC_ACQUIRE, "agent");
            xb_add(&bar[XB_XGEN(b.x)], 1u);
            asm volatile("s_waitcnt vmcnt(0)" ::: "memory");
        } else {
            XB_SPIN(xb_ld(&bar[XB_XGEN(b.x)]) == gen, bar);
            __builtin_amdgcn_fence(__ATOMIC_ACQUIRE, "agent");
            asm volatile("s_waitcnt vmcnt(0)" ::: "memory");
        }
    }
    __syncthreads();
}


__device__ __forceinline__ void group_barrier(unsigned* cnt, unsigned target, unsigned* extra, unsigned* tmo, bool same_xcd) {
    asm volatile("s_waitcnt vmcnt(0)" ::: "memory");
    __syncthreads();
    if (threadIdx.x == 0) {
        __builtin_amdgcn_s_waitcnt(0);
        if (!same_xcd) { __builtin_amdgcn_fence(__ATOMIC_RELEASE, "agent"); asm volatile("s_waitcnt vmcnt(0)" ::: "memory"); }
        (void)xb_add(cnt, 1u);
        if (extra) (void)xb_add(extra, 1u);
        unsigned sp = 0;
        while (xb_ld(cnt) < target) { __builtin_amdgcn_s_sleep(1); if ((++sp & 255u) == 0u) { if (xb_ld(tmo)) break; if (sp > XB_SPIN_CAP) { atomicAdd(tmo, 1u); break; } } }
        __builtin_amdgcn_fence(__ATOMIC_ACQUIRE, "agent");
        asm volatile("s_waitcnt vmcnt(0)" ::: "memory");
    }
    __syncthreads();
}
__device__ __forceinline__ void wait_global(unsigned* cnt, unsigned target, unsigned* tmo) {
    if (threadIdx.x == 0) {
        unsigned sp = 0;
        while (xb_ld(cnt) < target) { __builtin_amdgcn_s_sleep(1); if ((++sp & 255u) == 0u) { if (xb_ld(tmo)) break; if (sp > XB_SPIN_CAP) { atomicAdd(tmo, 1u); break; } } }
        __builtin_amdgcn_fence(__ATOMIC_ACQUIRE, "agent");
        asm volatile("s_waitcnt vmcnt(0)" ::: "memory");
    }
    __syncthreads();
}

struct EpiFinal {
    static constexpr bool PERM = true, AFTER_DRAIN = false, LAST_FUSED = true;
    bf16* hb; float* ss; float* out; const float* gfin; unsigned* gcnt; unsigned target; unsigned* glob1; unsigned* tmo; bool same_xcd;
    __device__ __forceinline__ bool keep(const pg8::Unit&) const { return false; }
    __device__ __forceinline__ void operator()(Acc& acc, const pg8::Unit& u, int wr, int wc, int fr, int fq) const { const EpiResid<false> E{nullptr, hb, ss}; E(acc, u, wr, wc, fr, fq); }
    __device__ __forceinline__ void fused(Acc& acc, const pg8::Unit& u, int wr, int wc, int fr, int fq, LAS unsigned char* lds, int wid, int lane) const {
        const int row0 = u.pm * 256 + wr * 64 + fr, col0 = u.pn * 256 + wc * 32 + 8 * fq;
        const size_t off0 = (size_t)row0 * DM + col0;
        v4u pb[8][2];
#pragma unroll
        for (int g = 0; g < 8; ++g)
#pragma unroll
            for (int bj = 0; bj < 2; ++bj) pb[g][bj] = *(const v4u*)(hb + off0 + (size_t)((g >> 2) * 128 + (g & 3) * 16) * DM + bj * 128);
#pragma unroll
        for (int g = 0; g < 8; ++g) { const int ai = g >> 2, m = g & 3; const int row = row0 + ai * 128 + m * 16; float sq = 0.f;
#pragma unroll
            for (int bj = 0; bj < 2; ++bj) { f32x4 b0, b1; unpack8(pb[g][bj], b0, b1);
                const f32x4 v0 = acc[ai][bj][m][0] + b0, v1 = acc[ai][bj][m][1] + b1; acc[ai][bj][m][0] = v0; acc[ai][bj][m][1] = v1;
                sq += (v0[0] * v0[0] + v0[1] * v0[1]) + (v0[2] * v0[2] + v0[3] * v0[3]) + (v1[0] * v1[0] + v1[1] * v1[1]) + (v1[2] * v1[2] + v1[3] * v1[3]); }
            sq += __shfl_xor(sq, 16); sq += __shfl_xor(sq, 32);
            if (fq == 0) atomicAdd(ss + row, sq); }
        group_barrier(gcnt, target, nullptr, tmo, same_xcd);
        wait_global(glob1, 256u, tmo);
        const int col1 = col0 - 1024;
        { f32x4 gv[2][2];
#pragma unroll
          for (int bj = 0; bj < 2; ++bj) { gv[bj][0] = *(const f32x4*)(gfin + col0 + bj * 128); gv[bj][1] = *(const f32x4*)(gfin + col0 + bj * 128 + 4); }
#pragma unroll
          for (int g = 0; g < 8; ++g) { const int ai = g >> 2, m = g & 3; const int row = row0 + ai * 128 + m * 16; const float rs = 1.0f / sqrtf(ss[row] * (1.0f / DM) + EPS);
#pragma unroll
            for (int bj = 0; bj < 2; ++bj) { float* o = out + (size_t)row * DM + col0 + bj * 128; __builtin_nontemporal_store(acc[ai][bj][m][0] * rs * gv[bj][0], (f32x4*)o); __builtin_nontemporal_store(acc[ai][bj][m][1] * rs * gv[bj][1], (f32x4*)(o + 4)); } } }
        asm volatile("" ::: "memory");
        { f32x4 gw[2][2];
#pragma unroll
          for (int bj = 0; bj < 2; ++bj) { gw[bj][0] = *(const f32x4*)(gfin + col1 + bj * 128); gw[bj][1] = *(const f32x4*)(gfin + col1 + bj * 128 + 4); }
#pragma unroll
          for (int g = 0; g < 8; ++g)
#pragma unroll
            for (int bj = 0; bj < 2; ++bj) pb[g][bj] = *(const v4u*)(hb + off0 - 1024 + (size_t)((g >> 2) * 128 + (g & 3) * 16) * DM + bj * 128);
#pragma unroll
          for (int g = 0; g < 8; ++g) { const int ai = g >> 2, m = g & 3; const int row = row0 + ai * 128 + m * 16; const float rs = 1.0f / sqrtf(ss[row] * (1.0f / DM) + EPS);
#pragma unroll
            for (int bj = 0; bj < 2; ++bj) { f32x4 b0, b1; unpack8(pb[g][bj], b0, b1); float* o1 = out + (size_t)row * DM + col1 + bj * 128; __builtin_nontemporal_store(b0 * rs * gw[bj][0], (f32x4*)o1); __builtin_nontemporal_store(b1 * rs * gw[bj][1], (f32x4*)(o1 + 4)); } } }
    }
};

__device__ __forceinline__ float wave_sum(float v) {
#pragma unroll
    for (int o = 1; o < 64; o <<= 1) v += __shfl_xor(v, o);
    return v;
}
__device__ __forceinline__ int rope_sigma(int p) { return (p < 16) ? ((p & 3) + 4 * ((p >> 3) & 1) + 8 * ((p >> 2) & 1)) : p; }
struct TpItem { const float* src; bf16* dst; const float* ks; int ldw, ldd, perm; float cscale; };
struct TpPtrs { const float *w_in, *w_attn_o, *w_conv_o, *w_out, *w_xkv, *w_xo, *w_gate_up, *w_down, *g_ffn; bf16 *WinT, *WacT, *WoutT, *WxkvT, *wxot, *WguT, *WdT; };
constexpr int TP_I0 = 32 * 272, TP_I1 = 16 * 64, TP_I2 = 16 * 64, TP_I3 = 32 * 64, TP_I4 = 32 * 32, TP_I7 = 8 * 64, TP_I5 = 32 * 352, TP_I6 = 88 * 64;
constexpr int TP_NEARLY = TP_I0 + TP_I1 + TP_I2 + TP_I3 + TP_I4 + TP_I7, TP_NITEMS = TP_NEARLY + TP_I5 + TP_I6;
__device__ __forceinline__ TpItem tp_mk(const float* W, int ldw, int src_col0, int k0, bf16* dst, int ldd, int dst_row0, int dst_col0, const float* kscale, int perm, float cscale = 1.f) {
    TpItem d; d.cscale = cscale; d.src = W + (size_t)k0 * ldw + src_col0; d.dst = dst + (size_t)dst_row0 * ldd + dst_col0 + k0; d.ks = kscale ? kscale + k0 : nullptr; d.ldw = ldw; d.ldd = ldd; d.perm = perm; return d; }
__device__ __forceinline__ TpItem tp_desc(int it, const TpPtrs& P) {
    int r = it;
    if (r < TP_I0) { const int kb_ = r / 272, Gp = r % 272; int src, perm = 0;
        if (Gp < 40) { src = 32 * Gp; perm = ((Gp & 1) == 0) ? 1 : 0; }
        else if (Gp < 80) { src = 32 * Gp; }
        else if (Gp < 144) { const int gg = Gp - 80, t = gg >> 3, i32 = gg & 7; src = (i32 < 4) ? (2560 + 128 * t + 32 * i32) : (3584 + 128 * t + 32 * (i32 - 4)); }
        else { const int gg = Gp - 144, t = gg >> 3, i32 = gg & 7; src = (i32 < 4) ? (4608 + 128 * t + 32 * i32) : (6656 + 128 * t + 32 * (i32 - 4)); }
        return tp_mk(P.w_in, NIN, src, 64 * kb_, P.WinT, DM, 32 * Gp, 0, nullptr, perm, Gp >= 144 ? -LOG2E : 1.f); } r -= TP_I0;
    if (r < TP_I1) { const int kb_ = r / 64, Gp = r % 64; return tp_mk(P.w_attn_o, DM, 32 * Gp, 64 * kb_, P.WacT, DM, 32 * Gp, 0, nullptr, 0); } r -= TP_I1;
    if (r < TP_I2) { const int kb_ = r / 64, Gp = r % 64; return tp_mk(P.w_conv_o, DM, 32 * Gp, 64 * kb_, P.WacT, DM, 32 * Gp, 1024, nullptr, 0); } r -= TP_I2;
    if (r < TP_I3) { const int kb_ = r / 64, Gp = r % 64; return tp_mk(P.w_out, DM, 32 * Gp, 64 * kb_, P.WoutT, DM, 32 * Gp, 0, nullptr, 0); } r -= TP_I3;
    if (r < TP_I4) { const int kb_ = r / 32, Gp = r % 32; return tp_mk(P.w_xkv, 2 * XW, 32 * Gp, 64 * kb_, P.WxkvT, DM, 32 * Gp, 0, nullptr, 0); } r -= TP_I4;
    if (r < TP_I7) { const int kb_ = r / 64, Gp = r % 64; return tp_mk(P.w_xo, DM, 32 * Gp, 64 * kb_, P.wxot, XW, 32 * Gp, 0, nullptr, 0); } r -= TP_I7;
    if (r < TP_I5) { const int kb_ = r / 352, Gp = r % 352; const int t = Gp >> 3, i32 = Gp & 7; const int src = (i32 < 4) ? (128 * t + 32 * i32) : (DFF + 128 * t + 32 * (i32 - 4));
        return tp_mk(P.w_gate_up, 2 * DFF, src, 64 * kb_, P.WguT, DM, 32 * Gp, 0, P.g_ffn, 0); } r -= TP_I5;
    { const int kb_ = r / 64, Gp = r % 64; return tp_mk(P.w_down, DM, 32 * Gp, 64 * kb_, P.WdT, DFF, 32 * Gp, 0, nullptr, 0); }
}
__device__ __forceinline__ void tp_load(const TpItem& d, float (&tv)[32], int lane) {
    const float* sp = d.src + (size_t)(lane >> 5) * d.ldw + (lane & 31);
#pragma unroll
    for (int i = 0; i < 32; ++i) tv[i] = __builtin_nontemporal_load(sp + (size_t)(2 * i) * d.ldw);
}
__device__ __forceinline__ void tp_finish(const TpItem& d, const float (&tv)[32], LAS float* scr, int lane) {
#pragma unroll
    for (int i = 0; i < 32; ++i) scr[(2 * i + (lane >> 5)) * 33 + (lane & 31)] = tv[i];
    LDS_WAIT(); asm volatile("" ::: "memory");
    const int c = lane & 7;
    float sc[8];
#pragma unroll
    for (int i = 0; i < 8; ++i) sc[i] = d.ks ? d.ks[8 * c + i] * d.cscale : d.cscale;
#pragma unroll
    for (int j = 0; j < 4; ++j) { const int nd = (lane >> 3) + 8 * j; const int scol = d.perm ? rope_sigma(nd) : nd; const LAS float* s = scr + (8 * c) * 33 + scol;
        v4u o; o.x = cvt_pk_bf16(s[0 * 33] * sc[0], s[1 * 33] * sc[1]); o.y = cvt_pk_bf16(s[2 * 33] * sc[2], s[3 * 33] * sc[3]);
        o.z = cvt_pk_bf16(s[4 * 33] * sc[4], s[5 * 33] * sc[5]); o.w = cvt_pk_bf16(s[6 * 33] * sc[6], s[7 * 33] * sc[7]);
        *(v4u*)(d.dst + (size_t)nd * d.ldd + 8 * c) = o; }
    LDS_WAIT(); asm volatile("" ::: "memory");
}
__device__ __forceinline__ void tp_run(int it0, int it_end, int stride, const TpPtrs& P, LAS float* scr, int lane) {
    if (it0 >= it_end) return;
    TpItem d = tp_desc(it0, P); float tv[32]; tp_load(d, tv, lane);
    for (int it = it0; it < it_end; it += stride) {
        const int nx = it + stride; const bool more = nx < it_end; TpItem dn = d; float tn[32];
        if (more) { dn = tp_desc(nx, P); tp_load(dn, tn, lane); }
        tp_finish(d, tv, scr, lane);
        if (more) { d = dn;
#pragma unroll
            for (int i = 0; i < 32; ++i) tv[i] = tn[i]; }
    }
}
__device__ __forceinline__ void tp_run3(int it0, int it_end, int stride, const TpPtrs& P, LAS float* scr, int lane) {
    if (it0 >= it_end) return;
    TpItem d0 = tp_desc(it0, P), d1 = d0; float t0[32], t1[32]; tp_load(d0, t0, lane);
    if (it0 + stride < it_end) { d1 = tp_desc(it0 + stride, P); tp_load(d1, t1, lane); }
    for (int it = it0; it < it_end; it += stride) {
        const int n2 = it + 2 * stride; const bool more2 = n2 < it_end; TpItem d2 = d0; float t2[32];
        if (more2) { d2 = tp_desc(n2, P); tp_load(d2, t2, lane); }
        tp_finish(d0, t0, scr, lane);
        d0 = d1; d1 = d2;
#pragma unroll
        for (int i = 0; i < 32; ++i) { t0[i] = t1[i]; t1[i] = t2[i]; }
    }
}
__device__ __forceinline__ void rms_rows_to_bf16(const float* xb, const float* g, bf16* ob, int m0, int m_end, int stride, int lane) {
    if (m0 >= m_end) return;
    f32x4 v[8];
    { const f32x4* xr = (const f32x4*)(xb + (size_t)m0 * DM) + lane;
#pragma unroll
      for (int j = 0; j < 8; ++j) v[j] = __builtin_nontemporal_load(xr + 64 * j); }
    f32x4 gg[8];
#pragma unroll
    for (int j = 0; j < 8; ++j) gg[j] = ((const f32x4*)g + lane)[64 * j];
    for (int m = m0; m < m_end; m += stride) {
        const int nx = m + stride; const bool more = nx < m_end; f32x4 vn[8];
        if (more) { const f32x4* xr = (const f32x4*)(xb + (size_t)nx * DM) + lane;
#pragma unroll
            for (int j = 0; j < 8; ++j) vn[j] = __builtin_nontemporal_load(xr + 64 * j); }
        float s = 0.f;
#pragma unroll
        for (int j = 0; j < 8; ++j) s += (v[j].x * v[j].x + v[j].y * v[j].y) + (v[j].z * v[j].z + v[j].w * v[j].w);
        const float rstd = 1.0f / sqrtf(wave_sum(s) * (1.0f / DM) + EPS);
        v2u* o8 = (v2u*)(ob + (size_t)m * DM) + lane;
#pragma unroll
        for (int j = 0; j < 8; ++j) { v2u w; w.x = cvt_pk_bf16(v[j].x * rstd * gg[j].x, v[j].y * rstd * gg[j].y); w.y = cvt_pk_bf16(v[j].z * rstd * gg[j].z, v[j].w * rstd * gg[j].w); o8[64 * j] = w; }
        if (more) {
#pragma unroll
            for (int j = 0; j < 8; ++j) v[j] = vn[j]; }
    }
}

__device__ __forceinline__ s16x4 vtr(const LAS unsigned char* p) { typedef short v4i16_t __attribute__((ext_vector_type(4))); return __builtin_bit_cast(s16x4, __builtin_amdgcn_ds_read_tr16_b64_v4i16((LAS v4i16_t*)p)); }

struct ConvCtx { const bf16* zc; bf16* xn; int ts, cg; f32x4 w0[2], w1[2], w2[2], p1[2], p2[2]; };
__device__ __forceinline__ void conv_issue(const ConvCtx& c, int batch, v4u (&zb)[4], v4u (&zp)[4]) {
#pragma unroll
    for (int i = 0; i < 4; ++i) { const bf16* zr = c.zc + (size_t)(c.ts + 4 * batch + i) * (2 * CW) + 8 * c.cg; zb[i] = *(const v4u*)(zr); zp[i] = *(const v4u*)(zr + CW); }
}
__device__ __forceinline__ void conv_finish(ConvCtx& c, int batch, const v4u (&zb)[4], const v4u (&zp)[4]) {
#pragma unroll
    for (int i = 0; i < 4; ++i) { f32x4 cb0, cb1, p0a, p0b; unpack8(zb[i], cb0, cb1); unpack8(zp[i], p0a, p0b);
        const f32x4 y0 = cb0 * (c.w0[0] * c.p2[0] + c.w1[0] * c.p1[0] + c.w2[0] * p0a), y1 = cb1 * (c.w0[1] * c.p2[1] + c.w1[1] * c.p1[1] + c.w2[1] * p0b);
        *(v4u*)(c.xn + (size_t)(c.ts + 4 * batch + i) * DM + AW + 8 * c.cg) = pack8(y0, y1);
        c.p2[0] = c.p1[0]; c.p2[1] = c.p1[1]; c.p1[0] = p0a; c.p1[1] = p0b; }
}
__device__ __forceinline__ void conv_init(ConvCtx& c, const bf16* zc, bf16* xn, const float* conv_w, int chunk, int tid) {
    c.zc = zc; c.xn = xn; c.cg = tid & 127; c.ts = chunk * 64 + (tid >> 7) * 16;
#pragma unroll
    for (int j = 0; j < 2; ++j) { c.w0[j] = *(const f32x4*)(conv_w + 8 * c.cg + 4 * j); c.w1[j] = *(const f32x4*)(conv_w + CW + 8 * c.cg + 4 * j); c.w2[j] = *(const f32x4*)(conv_w + 2 * CW + 8 * c.cg + 4 * j);
        c.p2[j] = (f32x4){0.f, 0.f, 0.f, 0.f}; c.p1[j] = c.p2[j]; }
    if (c.ts >= 2) { unpack8(*(const v4u*)(zc + (size_t)(c.ts - 2) * (2 * CW) + CW + 8 * c.cg), c.p2[0], c.p2[1]); unpack8(*(const v4u*)(zc + (size_t)(c.ts - 1) * (2 * CW) + CW + 8 * c.cg), c.p1[0], c.p1[1]); }
}
template <bool CONV>
__device__ __forceinline__ void swa_unit(LAS unsigned char* lds, int n, int g, const bf16* qb, const bf16* kb, const bf16* vb, const float* sinks, bf16* A2, int tid, int lane, int wave, ConvCtx& cc, int batch0) {
    LAS unsigned char* Kl = lds; LAS unsigned char* Vl = lds + 32768;
#pragma unroll
    for (int i = 0; i < 4; ++i) { const int id = tid + 512 * i, row = id >> 3, ch = id & 7; const int tok = (n - 1) * 128 + row;
        v4u kv = (v4u){0u, 0u, 0u, 0u}, vv = (v4u){0u, 0u, 0u, 0u};
        if (tok >= 0) { kv = *(const v4u*)(kb + (size_t)tok * KVW + g * 64 + ch * 8); vv = *(const v4u*)(vb + (size_t)tok * KVW + g * 64 + ch * 8); }
        *(LAS v4u*)(Kl + row * 128 + ((ch ^ ((row >> 1) & 7)) << 4)) = kv;
        *(LAS v4u*)(Vl + row * 128 + ((ch ^ (((row >> 1) & 1) << 2)) << 4)) = vv; }
    __syncthreads();
    const int ql = lane & 31, h = lane >> 5, hq = g * 4 + (wave & 3);
    const float sinkl = sinks[hq] * LOG2E;
    const int li = lane & 15, qp = li >> 2, pp = li & 3, g1 = (lane >> 4) & 1;
    const float NEG = -__builtin_inff();
#pragma unroll 1
    for (int st = 0; st < 2; ++st) {
        const int r0 = (wave >> 2) * 64 + 32 * st; const size_t tok = (size_t)n * 128 + r0 + ql;
        bf16x8 qf[4];
#pragma unroll
        for (int ks = 0; ks < 4; ++ks) qf[ks] = *(const bf16x8*)(qb + tok * AW + hq * 64 + 16 * ks + 8 * h);
        v4u zb[4], zp[4];
        if (CONV) conv_issue(cc, batch0 + st, zb, zp);
        f32x16 S[5];
#pragma unroll
        for (int t = 0; t < 5; ++t) { const int c = r0 + 32 * t + ql; S[t] = (f32x16){};
#pragma unroll
            for (int ks = 0; ks < 4; ++ks) { const bf16x8 kf = *(const LAS bf16x8*)(Kl + c * 128 + (((2 * ks + h) ^ ((c >> 1) & 7)) << 4));
                S[t] = __builtin_amdgcn_mfma_f32_32x32x16_bf16(kf, qf[ks], S[t], 0, 0, 0); } }
#pragma unroll
        for (int r = 0; r < 16; ++r) { const int cc = (r & 3) + 8 * (r >> 2) + 4 * h; if (!(cc > ql)) S[0][r] = NEG; if (!(cc <= ql)) S[4][r] = NEG; }
        if (n == 0) {
#pragma unroll
            for (int t = 0; t < 5; ++t)
#pragma unroll
                for (int r = 0; r < 16; ++r) { const int cc = (r & 3) + 8 * (r >> 2) + 4 * h; if (r0 + 32 * t + cc < 128) S[t][r] = NEG; } }
        float mx = sinkl;
#pragma unroll
        for (int t = 0; t < 5; ++t)
#pragma unroll
            for (int r = 0; r < 16; ++r) mx = fmaxf(mx, S[t][r]);
        mx = fmaxf(mx, __shfl_xor(mx, 32));
        float l = 0.f;
#pragma unroll
        for (int t = 0; t < 5; ++t)
#pragma unroll
            for (int r = 0; r < 16; ++r) { const float p = fast_exp2(S[t][r] - mx); S[t][r] = p; l += p; }
        l += __shfl_xor(l, 32); l += fast_exp2(sinkl - mx);
        f32x16 O[2]; O[0] = (f32x16){}; O[1] = (f32x16){};
#pragma unroll
        for (int t = 0; t < 5; ++t)
#pragma unroll
            for (int s = 0; s < 2; ++s) {
                v4u pw; pw.x = cvt_pk_bf16(S[t][8 * s + 0], S[t][8 * s + 1]); pw.y = cvt_pk_bf16(S[t][8 * s + 2], S[t][8 * s + 3]);
                pw.z = cvt_pk_bf16(S[t][8 * s + 4], S[t][8 * s + 5]); pw.w = cvt_pk_bf16(S[t][8 * s + 6], S[t][8 * s + 7]);
                const bf16x8 pf = __builtin_bit_cast(bf16x8, pw);
                const int krow = r0 + 32 * t + 16 * s + 4 * h + qp;
#pragma unroll
                for (int db = 0; db < 2; ++db) { const int chunk = (4 * db + 2 * g1 + (pp >> 1)) ^ (((qp >> 1) & 1) << 2);
                    const LAS unsigned char* va = Vl + krow * 128 + (chunk << 4) + (pp & 1) * 8;
                    const s16x4 lo = vtr(va), hi = vtr(va + 8 * 128);
                    const bf16x8 vf = (bf16x8){lo[0], lo[1], lo[2], lo[3], hi[0], hi[1], hi[2], hi[3]};
                    O[db] = __builtin_amdgcn_mfma_f32_32x32x16_bf16(vf, pf, O[db], 0, 0, 0); } }
        const float inv = 1.0f / l;
#pragma unroll
        for (int db = 0; db < 2; ++db)
#pragma unroll
            for (int pr = 0; pr < 2; ++pr) { const int ra = 8 * pr, rb = 8 * pr + 4;
                unsigned ax = cvt_pk_bf16(O[db][ra + 0] * inv, O[db][ra + 1] * inv), ay = cvt_pk_bf16(O[db][ra + 2] * inv, O[db][ra + 3] * inv);
                unsigned bx_ = cvt_pk_bf16(O[db][rb + 0] * inv, O[db][rb + 1] * inv), by = cvt_pk_bf16(O[db][rb + 2] * inv, O[db][rb + 3] * inv);
                { auto r = __builtin_amdgcn_permlane32_swap(ax, bx_, false, false); ax = r[0]; bx_ = r[1]; }
                { auto r = __builtin_amdgcn_permlane32_swap(ay, by, false, false); ay = r[0]; by = r[1]; }
                *(v4u*)(A2 + tok * DM + hq * 64 + 32 * db + 16 * pr + 8 * h) = (v4u){ax, ay, bx_, by}; }
        if (CONV) conv_finish(cc, batch0 + st, zb, zp);
    }
    __syncthreads();
}
__device__ __forceinline__ void wave_gemm_64x32_k128(const bf16* A, int lda, const bf16* Bt, int ldb, bf16* C, int ldc, int lane) {
    const int fr = lane & 15, fq = lane >> 4;
    f32x4 acc[4][2];
#pragma unroll
    for (int mi = 0; mi < 4; ++mi)
#pragma unroll
        for (int ni = 0; ni < 2; ++ni) acc[mi][ni] = (f32x4){0.f, 0.f, 0.f, 0.f};
#pragma unroll
    for (int ks = 0; ks < 4; ++ks) { bf16x8 a[4], b[2];
#pragma unroll
        for (int mi = 0; mi < 4; ++mi) a[mi] = *(const bf16x8*)(A + (size_t)(16 * mi + fr) * lda + 32 * ks + 8 * fq);
#pragma unroll
        for (int ni = 0; ni < 2; ++ni) b[ni] = *(const bf16x8*)(Bt + (size_t)(16 * ni + fr) * ldb + 32 * ks + 8 * fq);
#pragma unroll
        for (int mi = 0; mi < 4; ++mi)
#pragma unroll
            for (int ni = 0; ni < 2; ++ni) acc[mi][ni] = __builtin_amdgcn_mfma_f32_16x16x32_bf16(b[ni], a[mi], acc[mi][ni], 0, 0, 0); }
#pragma unroll
    for (int mi = 0; mi < 4; ++mi)
#pragma unroll
        for (int ni = 0; ni < 2; ++ni) { v2u w; w.x = cvt_pk_bf16(acc[mi][ni][0], acc[mi][ni][1]); w.y = cvt_pk_bf16(acc[mi][ni][2], acc[mi][ni][3]);
            st8_wt(C + (size_t)(16 * mi + fr) * ldc + 16 * ni + 4 * fq, w); }
}

constexpr int NPHASE = 10;
struct Args { const float* in[18]; float* out; unsigned char* ws; int ph_lo, ph_hi, li, pad; };

__global__ void __launch_bounds__(512, 2) hyb_fwd(Args args) {
    extern __shared__ __attribute__((aligned(16))) unsigned char lds_raw[];
    LAS unsigned char* lds = (LAS unsigned char*)lds_raw;
    volatile LAS unsigned* MISC = (volatile LAS unsigned*)(lds + MISC_OFF);
    const int tid = threadIdx.x, lane = tid & 63, wave = __builtin_amdgcn_readfirstlane(tid >> 6);
    const int G = gridDim.x, bx = blockIdx.x;
    unsigned char* ws = args.ws;
    unsigned* ctl = (unsigned*)(ws + WS_CTL);
    const float* x = args.in[0]; const float* mem = args.in[1]; const float* g_mix = args.in[2]; const float* w_in = args.in[3]; const float* conv_w = args.in[4];
    const float* sinks = args.in[5]; const float* w_attn_o = args.in[6]; const float* w_conv_o = args.in[7]; const float* w_out = args.in[8]; const float* g_xattn = args.in[9];
    const float* g_mem = args.in[10]; const float* w_xq = args.in[11]; const float* w_xkv = args.in[12]; const float* w_xo = args.in[13]; const float* g_ffn = args.in[14];
    const float* w_gate_up = args.in[15]; const float* w_down = args.in[16]; const float* g_final = args.in[17];
    float* out = args.out;
    float* ss1 = (float*)(ws + WS_SS); float* ss2 = ss1 + SEQ; float* ss3 = ss2 + SEQ;
    float* cs = (float*)(ws + WS_CS);
    bf16* kvb = (bf16*)(ws + WS_KVB); bf16* memn = (bf16*)(ws + WS_MEMN); bf16* wxqp = (bf16*)(ws + WS_WXQ); bf16* wxot = (bf16*)(ws + WS_WXOT);
    bf16* WguT = (bf16*)(ws + WS_WGUT); bf16* WdT = (bf16*)(ws + WS_WDT); bf16* XN = (bf16*)(ws + WS_XN);
    bf16* WinT = (bf16*)(ws + WS_WINT); bf16* WacT = (bf16*)(ws + WS_WACT); bf16* WoutT = (bf16*)(ws + WS_WOUTT); bf16* WxkvT = (bf16*)(ws + WS_WXKVT);
    bf16* WqKT = (bf16*)(ws + WS_WQKT); bf16* VWoT = (bf16*)(ws + WS_VWOT);
    bf16* qb = (bf16*)(ws + WS_Q); bf16* kb = (bf16*)(ws + WS_K); bf16* vb = (bf16*)(ws + WS_V); bf16* zc = (bf16*)(ws + WS_ZC);
    bf16* Pb = (bf16*)(ws + WS_P); bf16* act = (bf16*)(ws + WS_ACT);
    bf16* sgr = (bf16*)out; bf16* sgc = sgr + (size_t)SEQ * DM;
    bf16* merged = sgr;

    for (int u = tid; u < (LDS_BYTES - LDSCTL_OFF) / 4; u += 512) ((LAS unsigned*)(lds + LDSCTL_OFF))[u] = 0u;
    __syncthreads();
    XcdBarrier bar; bar.bar = ctl + CW_BAR; bar.x = 0; bar.st = nullptr;
    if (MK_N_LAUNCHES == 1) bar = xcd_barrier_post(ctl + CW_BAR, MISC + 8);
    if (tid == 0) __hip_atomic_store(ctl + CW_XID + 64 * (bx & 63) + (bx >> 6), xb_xcc_id() + 1u, __ATOMIC_RELAXED, __HIP_MEMORY_SCOPE_AGENT);
    const int lo = args.ph_lo, hi = args.ph_hi;
    const bool tailfill = (G == 256);
#define IN(k) (lo <= (k) && (k) < hi)
#ifdef PROBE_PHASE
    int n_stamp = 0;
#define STAMP() do { if (bx == 0 && tid == 0) { ((volatile LAS unsigned long long*)(lds + MISC_OFF + 128))[n_stamp] = __builtin_amdgcn_s_memrealtime(); ((volatile LAS unsigned long long*)(lds + MISC_OFF + 256))[n_stamp] = __builtin_amdgcn_s_memtime(); } ++n_stamp; } while (0)
#define SUBSTAMP(i) do { __builtin_amdgcn_s_waitcnt(0); if (bx == 0 && tid == 0) ((volatile LAS unsigned long long*)(lds + MISC_OFF + 128))[40 + (i)] = __builtin_amdgcn_s_memrealtime(); } while (0)
#else
#define STAMP() do { } while (0)
#define SUBSTAMP(i) do { } while (0)
#endif
#define SEAM(k) do { if (IN(k) && IN((k) + 1)) xcd_barrier(bar); STAMP(); } while (0)
    const bool grp = (G == 256) && (MK_N_LAUNCHES == 1);
    const int pm_own = 8 * (bx & 7) + ((bx >> 3) & 7), jmem = bx >> 6;
    unsigned* gcnt = ctl + CW_GRP + 64 * (bx & 63); unsigned* glob = ctl + CW_GLOB; unsigned* gtmo = ctl + CW_BAR + XB_TMO;
    unsigned gepoch = 0; bool same_xcd = false;
#define GSEAM(k, extra) do { if (IN(k) && IN((k) + 1)) { if (grp) { gepoch += 4u; group_barrier(gcnt, gepoch, (extra), gtmo, same_xcd); } else xcd_barrier(bar); } STAMP(); } while (0)
    STAMP();

    const TpPtrs TP{w_in, w_attn_o, w_conv_o, w_out, w_xkv, w_xo, w_gate_up, w_down, g_ffn, WinT, WacT, WoutT, WxkvT, wxot, WguT, WdT};
    if (IN(0)) {
        LAS float* scr = (LAS float*)(lds + wave * 16384);
        const int gw = bx * 8 + wave, NGW = G * 8;
        SUBSTAMP(0);
        tp_run(gw, tailfill ? TP_NEARLY : TP_NITEMS, NGW, TP, scr, lane);
        SUBSTAMP(1);
        rms_rows_to_bf16(x, g_mix, XN, gw, SEQ, NGW, lane);
        SUBSTAMP(2);
        rms_rows_to_bf16(mem, g_mem, memn, gw, NMEM, NGW, lane);
        for (int k = gw; k < DM; k += NGW) { const float gs = g_xattn[k] * C2X; const f32x4* src = (const f32x4*)(w_xq + (size_t)k * XW) + lane; v2u* dst = (v2u*)(wxqp + (size_t)k * XW) + lane;
#pragma unroll
            for (int j = 0; j < 2; ++j) { const f32x4 v = src[64 * j]; v2u w; w.x = cvt_pk_bf16(v.x * gs, v.y * gs); w.y = cvt_pk_bf16(v.z * gs, v.w * gs); dst[64 * j] = w; } }
        const int gt = bx * 512 + tid, NGT = G * 512;
        for (int e = gt; e < SEQ * 8; e += NGT) { const int pos = e >> 3, i = e & 7;
            const float inv_freq = (i == 0) ? 1.0f : (i == 1) ? 0.19392274f : (i == 2) ? 0.037606031f : (i == 3) ? 0.0072926646f : (i == 4) ? 0.0014142136f : (i == 5) ? 0.00027424819f : (i == 6) ? 5.3182957e-05f : 1.0313385e-05f;
            const float ang = (float)pos * inv_freq; float sn, cn; sincosf(ang, &sn, &cn);
            cs[(size_t)pos * 16 + i] = cn; cs[(size_t)pos * 16 + 8 + i] = sn; }
        for (int e = gt; e < 3 * SEQ; e += NGT) ss1[e] = 0.f;
        SUBSTAMP(3);
    }
    SEAM(0);

    if (IN(1)) {
        { pg8::Prob g{memn, WxkvT, DM, DM, DM, 0}; pg8::StaticOrder S; S.init(NMEM, 2 * XW, G, (bx >= 128 && bx < 132) ? bx - 128 : -1);
          EpiStoreBf16 E{kvb, 2 * XW};
          pg8::gemm_phase<EpiStoreBf16, pg8::StaticOrder, PG8_ALIGN, PG8_SP2>(lds, g, S, E); }
        if (tailfill && bx >= 132) { tp_run3(TP_NEARLY + (bx - 132) * 8 + wave, TP_NITEMS, (256 - 132) * 8, TP, (LAS float*)(lds + wave * 16384), lane); __syncthreads(); }
        { pg8::Prob g{XN, WinT, DM, DM, DM, 0}; pg8::StaticOrder S; S.init(SEQ, NIN, G, bx);
          EpiInProj E{qb, kb, vb, zc, sgr, sgc, cs};
          pg8::gemm_phase<EpiInProj, pg8::StaticOrder, PG8_ALIGN, PG8_SP2>(lds, g, S, E); }
    }
    SEAM(1);

    if (grp && IN(2)) {
        if (tid == 0) { unsigned* xt = ctl + CW_XID + 64 * (bx & 63); const unsigned a0 = xb_ld(xt), a1 = xb_ld(xt + 1), a2 = xb_ld(xt + 2), a3 = xb_ld(xt + 3);
            MISC[12] = (a0 != 0u && a0 == a1 && a0 == a2 && a0 == a3) ? 1u : 0u; }
        __syncthreads();
        same_xcd = __builtin_amdgcn_readfirstlane(MISC[12]) != 0u;
    }
    if (IN(2)) {
        SUBSTAMP(4);
        ConvCtx cc;
        if (grp) {
            conv_init(cc, zc, XN, conv_w, 4 * pm_own + jmem, tid);
            swa_unit<true>(lds, 2 * pm_own + ((2 * jmem) >> 2), (2 * jmem) & 3, qb, kb, vb, sinks, XN, tid, lane, wave, cc, 0);
            swa_unit<true>(lds, 2 * pm_own + ((2 * jmem + 1) >> 2), (2 * jmem + 1) & 3, qb, kb, vb, sinks, XN, tid, lane, wave, cc, 2);
        } else {
            for (int u = bx; u < (SEQ / 128) * 4; u += G) swa_unit<false>(lds, u >> 2, u & 3, qb, kb, vb, sinks, XN, tid, lane, wave, cc, 0);
            for (int ch = bx; ch < SEQ / 64; ch += G) { conv_init(cc, zc, XN, conv_w, ch, tid);
#pragma unroll 1
                for (int b = 0; b < 4; ++b) { v4u zb[4], zp[4]; conv_issue(cc, b, zb, zp); conv_finish(cc, b, zb, zp); } }
        }
        SUBSTAMP(5);
        const bool pp_all = !grp; const int pp_w = ((bx >> 4) << 3) + (bx & 7);
        for (int job = pp_all ? bx * 8 + wave : (((bx >> 3) & 1) ? pp_w * 8 + wave : 2048); job < 2048; job += (pp_all ? G * 8 : 1024)) { const int idx = job & 1023;
            if (job < 1024) { const int mt = idx >> 6, nt = idx & 63, m0 = 64 * mt, n0 = 32 * nt, hh = m0 >> 8, j0 = m0 & 255;
                wave_gemm_64x32_k128(kvb + (size_t)j0 * (2 * XW) + 128 * hh, 2 * XW, wxqp + (size_t)n0 * XW + 128 * hh, XW, WqKT + (size_t)m0 * DM + n0, DM, lane); }
            else { const int mt = idx >> 5, nt = idx & 31, m0 = 64 * mt, n0 = 32 * nt, hh = n0 >> 8, j0 = n0 & 255;
                wave_gemm_64x32_k128(wxot + (size_t)m0 * XW + 128 * hh, XW, kvb + (size_t)j0 * (2 * XW) + XW + 128 * hh, 2 * XW, VWoT + (size_t)m0 * (4 * NMEM) + n0, 4 * NMEM, lane); } }
    }
    SUBSTAMP(7);
    GSEAM(2, glob);

    if (IN(3)) { pg8::Prob g{XN, WacT, DM, DM, AW, AW}; pg8::StaticOrder S; S.init(SEQ, DM, G, bx, 2);
        EpiMerge E{sgr, sgc, merged};
        pg8::gemm_phase<EpiMerge, pg8::StaticOrder, PG8_ALIGN, PG8_SP2>(lds, g, S, E); }
    GSEAM(3, nullptr);

    if (IN(4)) { pg8::Prob g{merged, WoutT, DM, DM, DM, 0}; pg8::StaticOrder S; S.init(SEQ, DM, G, bx);
        EpiResid<true> E{x, XN, ss1};
        pg8::gemm_phase<EpiResid<true>, pg8::StaticOrder, PG8_ALIGN, PG8_SP2>(lds, g, S, E); }
    GSEAM(4, glob + 64);

    if (IN(5)) { if (grp) wait_global(glob, 256u, gtmo);
        pg8::Prob g{XN, WqKT, DM, DM, DM, 0}; pg8::StaticOrder S; S.init(SEQ, 4 * NMEM, G, bx);
        EpiSoftmax E{ss1, Pb};
        if ((SEQ / 256) * 4 <= G) pg8::gemm_phase<EpiSoftmax, pg8::StaticOrder, false, PG8_SP2>(lds, g, S, E); }
    GSEAM(5, nullptr);

    if (IN(6)) { pg8::Prob g{Pb, VWoT, 4 * NMEM, 4 * NMEM, 4 * NMEM, 0}; pg8::StaticOrder S; S.init(SEQ, DM, G, bx);
        EpiResid<false> E{nullptr, XN, ss2};
        pg8::gemm_phase<EpiResid<false>, pg8::StaticOrder, PG8_ALIGN, PG8_SP2>(lds, g, S, E); }
    GSEAM(6, nullptr);

    if (IN(7)) { pg8::Prob g{XN, WguT, DM, DM, DM, 0}; pg8::StaticOrder S; S.init(SEQ, 2 * DFF, G, bx);
        EpiSwiGLU E{ss2, act};
        pg8::gemm_phase<EpiSwiGLU, pg8::StaticOrder, PG8_ALIGN, PG8_SP2>(lds, g, S, E); }
    GSEAM(7, nullptr);

    if (IN(8)) { pg8::Prob g{act, WdT, 64, DFF, DFF, 0, 256 * 64 * 2, (size_t)256 * DFF}; pg8::StaticOrder S; S.init(SEQ, DM, G, bx);
        if (grp) { EpiFinal E{XN, ss3, out, g_final, gcnt, gepoch + 4u, glob + 64, gtmo, same_xcd}; gepoch += 4u;
            pg8::gemm_phase<EpiFinal, pg8::StaticOrder, PG8_ALIGN, PG8_SP2>(lds, g, S, E); }
        else { EpiResid<false> E{nullptr, XN, ss3};
            pg8::gemm_phase<EpiResid<false>, pg8::StaticOrder, PG8_ALIGN, PG8_SP2>(lds, g, S, E); } }
    if (!grp) { GSEAM(8, nullptr); } else { STAMP(); }

    if (IN(9) && !grp) {
        if (grp) wait_global(glob + 64, 256u, gtmo);
        const int m0 = grp ? 256 * pm_own + 64 * jmem + wave : bx * 8 + wave, m_end = grp ? 256 * pm_own + 64 * jmem + 64 : SEQ, NGW = grp ? 8 : G * 8;
        f32x4 gg[4][2];
#pragma unroll
        for (int j = 0; j < 4; ++j) { gg[j][0] = ((const f32x4*)g_final + 2 * lane)[128 * j]; gg[j][1] = ((const f32x4*)g_final + 2 * lane)[128 * j + 1]; }
        v4u hv[4];
        if (m0 < m_end) {
#pragma unroll
            for (int j = 0; j < 4; ++j) hv[j] = ((const v4u*)(XN + (size_t)m0 * DM) + lane)[64 * j]; }
        for (int m = m0; m < m_end; m += NGW) { const int nx = m + NGW; const bool more = nx < m_end; v4u hn[4];
            if (more) {
#pragma unroll
                for (int j = 0; j < 4; ++j) hn[j] = ((const v4u*)(XN + (size_t)nx * DM) + lane)[64 * j]; }
            const float rs = 1.0f / sqrtf(ss3[m] * (1.0f / DM) + EPS); f32x4* o = (f32x4*)(out + (size_t)m * DM) + 2 * lane;
#pragma unroll
            for (int j = 0; j < 4; ++j) { f32x4 v0, v1; unpack8(hv[j], v0, v1); o[128 * j] = v0 * rs * gg[j][0]; o[128 * j + 1] = v1 * rs * gg[j][1]; }
            if (more) {
#pragma unroll
                for (int j = 0; j < 4; ++j) hv[j] = hn[j]; } } }
#ifdef PROBE_PHASE
    STAMP();
    if (bx == 0 && tid == 0) { volatile LAS unsigned long long* st = (volatile LAS unsigned long long*)(lds + MISC_OFF + 128);
        volatile LAS unsigned long long* sc = (volatile LAS unsigned long long*)(lds + MISC_OFF + 256);
        unsigned long long span = st[PROBE_PHASE + 1] - st[PROBE_PHASE]; const unsigned long long t0 = __builtin_amdgcn_s_memrealtime();
#ifdef PROBE_SUB
        span = st[40 + PROBE_SUB + 1] - st[40 + PROBE_SUB];
#endif
#ifdef PROBE_CLOCK
        span = (sc[PROBE_PHASE + 1] - sc[PROBE_PHASE]) * 1250ull / span;
#endif
        while (__builtin_amdgcn_s_memrealtime() - t0 < 8ull * span) __builtin_amdgcn_s_sleep(8); }
#endif
#ifdef DBG_STOP
    if (IN(10)) { const size_t gt = (size_t)bx * 512 + tid, NGT = (size_t)G * 512;
        for (size_t e = gt; e < (size_t)SEQ * DM; e += NGT) {
#if DBG_DUMP == 0
            out[e] = __builtin_bit_cast(float, (unsigned)XN[e] << 16);
#elif DBG_DUMP == 1
            out[e] = __builtin_bit_cast(float, (unsigned)XN[e] << 16);
#elif DBG_DUMP == 2
            out[e] = __builtin_bit_cast(float, (unsigned)merged[e] << 16);
#elif DBG_DUMP == 3
            { const size_t r = e / DM, c = e % DM; out[e] = __builtin_bit_cast(float, (unsigned)(c < 1024 ? qb[r * 1024 + c] : (c < 1280 ? kb[r * 256 + c - 1024] : (c < 1536 ? vb[r * 256 + c - 1280] : zc[r * 2048 + ((c - 1536) & 2047)]))) << 16); }
#elif DBG_DUMP == 5
            { const size_t n1 = (size_t)1024 * 2048, n2 = 2 * n1, n3 = n2 + 256 * 1024; out[e] = (e < n1) ? __builtin_bit_cast(float, (unsigned)WqKT[e] << 16) : (e < n2) ? __builtin_bit_cast(float, (unsigned)VWoT[e - n1] << 16) : (e < n3) ? __builtin_bit_cast(float, (unsigned)kvb[e - n2] << 16) : 0.f; }
#elif DBG_DUMP == 6
            out[e] = (e < (size_t)256 * 1024) ? __builtin_bit_cast(float, (unsigned)kvb[e] << 16) : (e < (size_t)256 * 1024 + 256 * 2048) ? __builtin_bit_cast(float, (unsigned)memn[e - 256 * 1024] << 16) : 0.f;
#elif DBG_DUMP == 7
            out[e] = (e < (size_t)2048 * 512) ? __builtin_bit_cast(float, (unsigned)wxqp[e] << 16) : (e < (size_t)2 * 2048 * 512) ? __builtin_bit_cast(float, (unsigned)wxot[e - 2048 * 512] << 16) : 0.f;
#elif DBG_DUMP == 4
            { const size_t r = e / DM, c = e % DM; out[e] = __builtin_bit_cast(float, (unsigned)(c < 1024 ? Pb[r * 1024 + c] : (bf16)0) << 16); }
#endif
        } }
#endif
#undef IN
#undef SEAM
#undef GSEAM
}

extern "C" void kernel_launch(void* const* d_in, const int* in_sizes, int n_in, void* d_out, int out_size, void* d_ws, size_t ws_size, hipStream_t stream) {
    static int grid = 0;
    if (grid == 0) {
        if (n_in != 18 || in_sizes[0] != SEQ * DM || out_size != SEQ * DM || ws_size < WS_END) { fprintf(stderr, "kernel_launch: unexpected shapes / workspace (n_in %d, in0 %d, out %d, ws %zu); nothing launched\n", n_in, n_in > 0 ? in_sizes[0] : -1, out_size, ws_size); grid = -1; return; }
        int dev = 0, cus = 0;
        if (hipGetDevice(&dev) != hipSuccess || hipDeviceGetAttribute(&cus, hipDeviceAttributeMultiprocessorCount, dev) != hipSuccess) { fprintf(stderr, "kernel_launch: device query failed\n"); grid = -1; return; }
        if (hipFuncSetAttribute((const void*)hyb_fwd, hipFuncAttributeMaxDynamicSharedMemorySize, LDS_BYTES) != hipSuccess) { fprintf(stderr, "kernel_launch: hipFuncSetAttribute failed\n"); grid = -1; return; }
        int per_cu = 0;
        if (hipOccupancyMaxActiveBlocksPerMultiprocessor(&per_cu, (const void*)hyb_fwd, 512, LDS_BYTES) != hipSuccess || per_cu < 1) fprintf(stderr, "kernel_launch: note: occupancy query reports %d workgroups per CU\n", per_cu);
        (void)hipGetLastError();
        grid = cus;
    }
    if (grid < 0) return;
    if (hipMemsetAsync((char*)d_ws + WS_CTL, 0, CTL_ZERO_BYTES, stream) != hipSuccess) { fprintf(stderr, "kernel_launch: memset failed\n"); return; }
    Args a{};
    for (int i = 0; i < 18; ++i) a.in[i] = (const float*)d_in[i];
    a.out = (float*)d_out; a.ws = (unsigned char*)d_ws;
#ifdef DBG_STOP
    const int nl = DBG_STOP + 2;
#else
    const int nl = MK_N_LAUNCHES;
#endif
    for (int li = 0; li < nl; ++li) {
        a.ph_lo = (MK_N_LAUNCHES == 1) ? 0 : li; a.ph_hi = (MK_N_LAUNCHES == 1) ? NPHASE : li + 1; a.li = li; a.pad = 0;
#ifdef DBG_STOP
        if (li == nl - 1) { a.ph_lo = 10; a.ph_hi = 11; }
#endif
        hipLaunchKernelGGL(hyb_fwd, dim3(grid), dim3(512), LDS_BYTES, stream, a);
        const hipError_t le = hipPeekAtLastError();
        if (le != hipSuccess) { fprintf(stderr, "kernel_launch: launch %d failed: %s\n", li, hipGetErrorName(le)); break; }
    }
}
```

```cpp
#include <hip/hip_runtime.h>
#include <cstdio>
#include <cstdint>

#ifndef MK_N_LAUNCHES
#define MK_N_LAUNCHES 1
#endif

#define GAS __attribute__((address_space(1)))
#define LAS __attribute__((address_space(3)))
typedef unsigned short bf16;
typedef unsigned v4u __attribute__((ext_vector_type(4)));
typedef unsigned v2u __attribute__((ext_vector_type(2)));
typedef float f32x4 __attribute__((ext_vector_type(4)));
typedef float f32x16 __attribute__((ext_vector_type(16)));
typedef short bf16x8 __attribute__((ext_vector_type(8)));
typedef short s16x4 __attribute__((ext_vector_type(4)));

constexpr int SEQ = 16384, DM = 2048, NIN = 8704, AW = 1024, KVW = 256, CW = 1024, XW = 512, NMEM = 256, DFF = 5632;
constexpr float EPS = 1e-6f;
constexpr float LOG2E = 1.4426950408889634f;
constexpr float QSCALE = 0.125f * 1.4426950408889634f;
constexpr float C2X = 0.08838834764831845f * 1.4426950408889634f;

constexpr size_t MiB = 1u << 20;
constexpr size_t WS_CTL = 0, CTL_ZERO_BYTES = 256 * 1024;
constexpr size_t WS_SS = 1 * MiB;
constexpr size_t WS_CS = 2 * MiB;
constexpr size_t WS_KVB = 3 * MiB;
constexpr size_t WS_MEMN = 4 * MiB;
constexpr size_t WS_WXQ = 5 * MiB;
constexpr size_t WS_WXOT = 7 * MiB;
constexpr size_t WS_WGUT = 16 * MiB;
constexpr size_t WS_WDT = 60 * MiB;
constexpr size_t WS_XN = 82 * MiB;
constexpr size_t WS_WACT = 146 * MiB;
constexpr size_t WS_WOUTT = 154 * MiB;
constexpr size_t WS_WQKT = 162 * MiB;
constexpr size_t WS_VWOT = 166 * MiB;
constexpr size_t WS_Q = 170 * MiB, WS_K = 202 * MiB, WS_V = 210 * MiB, WS_ZC = 218 * MiB;
constexpr size_t WS_P = WS_Q;
constexpr size_t WS_ACT = 314 * MiB;
constexpr size_t WS_WINT = 314 * MiB;
constexpr size_t WS_WXKVT = 348 * MiB;
constexpr size_t WS_END = 490 * MiB;
static_assert(WS_ACT + (size_t)SEQ * DFF * 2 <= WS_END && WS_ZC + (size_t)SEQ * 3 * CW * 2 <= WS_ACT, "d_ws map");

constexpr int CW_BAR = 4096;
constexpr int CW_GRP = 16384;
constexpr int CW_XID = 49152;
constexpr int CW_GLOB = 32768;

constexpr int RING_BYTES = 131072;
constexpr int LDSCTL_OFF = RING_BYTES, MISC_OFF = LDSCTL_OFF + 320;
constexpr int LDS_BYTES = 147456;

#define RLX_AGENT __ATOMIC_RELAXED, __HIP_MEMORY_SCOPE_AGENT
#define LDS_WAIT() asm volatile("s_waitcnt lgkmcnt(0)" ::: "memory")
#define VM_WAIT() asm volatile("s_waitcnt vmcnt(0)" ::: "memory")

typedef float f32x2_t __attribute__((ext_vector_type(2))); typedef __bf16 bf16x2_t __attribute__((ext_vector_type(2)));
__device__ __forceinline__ unsigned cvt_pk_bf16(float lo, float hi) { f32x2_t v = {lo, hi}; bf16x2_t b = __builtin_convertvector(v, bf16x2_t); return __builtin_bit_cast(unsigned, b); }
__device__ __forceinline__ float bf_lo(unsigned u) { return __builtin_bit_cast(float, u << 16); }
__device__ __forceinline__ float bf_hi(unsigned u) { return __builtin_bit_cast(float, u & 0xffff0000u); }
__device__ __forceinline__ float fast_exp2(float x) { return __builtin_amdgcn_exp2f(x); }
__device__ __forceinline__ float fast_rcp(float x) { return __builtin_amdgcn_rcpf(x); }
__device__ __forceinline__ void st16_wt(void* p, v4u v) { asm volatile("global_store_dwordx4 %0, %1, off sc1\n\ts_nop 1" :: "v"(p), "v"(v) : "memory"); }
__device__ __forceinline__ void st8_wt(void* p, v2u v) { __hip_atomic_store((unsigned long long*)p, ((unsigned long long)v.y << 32) | v.x, __ATOMIC_RELAXED, __HIP_MEMORY_SCOPE_AGENT); }

namespace pg8 {
typedef unsigned short bf16_t;
constexpr int BM = 256, BK = 64, HALF = 128, HTB = HALF * BK * 2, STAGE_BYTES = 8 * HTB, NXCD = 8, WGM = 8;

__host__ __device__ __forceinline__ int lds_byte(int r, int c) { const int st = (r >> 4) * 2 + (c >> 5), rr = r & 15, cc = c & 31, ob = rr * 64 + cc * 2; return st * 1024 + (ob ^ (((ob >> 9) & 1) << 5)); }
__host__ __device__ __forceinline__ void stage_rc(int b, int& R, int& C) { const int st = b / 1024, sb = b % 1024, swz = sb ^ (((sb >> 9) & 1) << 5); R = (st >> 1) * 16 + swz / 64; C = (st & 1) * 32 + (swz % 64) / 2; }
__host__ __device__ __forceinline__ int perm32(int rho) { const int n = rho >> 4, i = rho & 15; return 8 * (i >> 2) + 4 * n + (i & 3); }

struct Unit { int pm, pn, z; };
struct Prob {
    const bf16_t* A; const bf16_t* Bt; int lda, ldb, K, zoff;
    int akstep = 0; size_t apanel = 0;
    __device__ __forceinline__ const char* a_ptr(const Unit& u) const { return (const char*)(A + (apanel ? (size_t)u.pm * apanel : (size_t)u.pm * BM * lda) + (size_t)u.z * zoff); }
    __device__ __forceinline__ const char* b_ptr(const Unit& u) const { return (const char*)(Bt + (size_t)u.pn * BM * ldb + (size_t)u.z * zoff); }
};

__device__ __forceinline__ bool tile_of(long L, int nM, int nN, int& pm, int& pn) {
    const int nwg = nM * nN; if (L >= nwg) return false;
    int wgid = (int)L; { const int q = nwg / NXCD, r = nwg % NXCD, xcd = wgid % NXCD, off = wgid / NXCD; wgid = (xcd < r ? xcd * (q + 1) : r * (q + 1) + (xcd - r) * q) + off; }
    const int nig = WGM * nN, gid = wgid / nig, fm = gid * WGM, gsz = (nM - fm) < WGM ? (nM - fm) : WGM;
    pm = fm + ((wgid % nig) % gsz); pn = (wgid % nig) / gsz; return true;
}
struct StaticOrder {
    int nM, nN, G, c, ZS;
    __device__ __forceinline__ void init(int M, int N, int G_, int c_, int ZS_ = 1) { nM = M / BM; nN = N / BM; G = G_; c = c_; ZS = ZS_; }
    __device__ __forceinline__ bool next(int i, Unit& u) const {
        if (c < 0) return false;
        const int ti = (ZS == 2) ? (i >> 1) : i; u.z = (ZS == 2) ? (i & 1) : 0;
        return tile_of((long)ti * G + c, nM, nN, u.pm, u.pn);
    }
};

template <class Epi, class Sched, bool ALIGN_EPI = false, bool SP2 = false>
__device__ __forceinline__ void gemm_phase(LAS unsigned char* lds, const Prob g, const Sched& S, const Epi& E) {
    const int tid = threadIdx.x, wid = __builtin_amdgcn_readfirstlane(tid >> 6), lane = tid & 63, wr = wid >> 2, wc = wid & 3, fr = lane & 15, fq = lane >> 4;
    const int K = g.K, nt = K / BK;
    unsigned voffA[2], voffB[2];
#pragma unroll
    for (int i = 0; i < 2; ++i) { int R, C; stage_rc(tid * 16 + i * 8192, R, C); const int Rb = Epi::PERM ? ((R & ~31) + perm32(R & 31)) : R;
        voffA[i] = (unsigned)(R * g.lda + C) * 2u; voffB[i] = (unsigned)(Rb * g.ldb + C) * 2u; }
    const size_t kstep = (size_t)(BK * 2), kstepA = g.akstep ? (size_t)g.akstep : kstep;
    const size_t hstepA = (size_t)HALF * g.lda * 2, hstepB = (size_t)HALF * g.ldb * 2;
    const unsigned ldsw = (unsigned)wid * 1024u;
    const int aoff = lds_byte(wr * 64 + fr, fq * 8), boff = lds_byte(wc * 32 + fr, fq * 8);
#define PG8_SA(b, h) (((b) * 2 + (h)) * HTB)
#define PG8_SB(b, h) ((4 + (b) * 2 + (h)) * HTB)
#define PG8_STAGE(bufoff, gbase, voff) do { _Pragma("unroll") for (int _i = 0; _i < 2; ++_i) \
        __builtin_amdgcn_global_load_lds((const unsigned*)((const char*)(gbase) + (voff)[_i]), (LAS unsigned*)(lds + (bufoff) + ldsw + _i * 8192), 16, 0, 0); } while (0)
#define PG8_LDA(dst, b, h) do { _Pragma("unroll") for (int m = 0; m < 4; ++m) _Pragma("unroll") for (int k = 0; k < 2; ++k) dst[m][k] = *(const LAS bf16x8*)(lds + PG8_SA(b, h) + aoff + m * 2048 + k * 1024); } while (0)
#define PG8_LDB(dst, b, h) do { _Pragma("unroll") for (int n = 0; n < 2; ++n) _Pragma("unroll") for (int k = 0; k < 2; ++k) dst[n][k] = *(const LAS bf16x8*)(lds + PG8_SB(b, h) + boff + n * 2048 + k * 1024); } while (0)
#define PG8_MMA(ai, bj, At, Bt) do { __builtin_amdgcn_s_setprio(1); _Pragma("unroll") for (int m = 0; m < 4; ++m) _Pragma("unroll") for (int n = 0; n < 2; ++n) _Pragma("unroll") for (int k = 0; k < 2; ++k) \
        acc[ai][bj][m][n] = __builtin_amdgcn_mfma_f32_16x16x32_bf16(Bt[n][k], At[m][k], acc[ai][bj][m][n], 0, 0, 0); __builtin_amdgcn_s_setprio(0); } while (0)
#define PG8_WAIT_V(n) asm volatile("s_waitcnt vmcnt(" #n ")" ::: "memory")
#define PG8_WAIT_L(n) asm volatile("s_waitcnt lgkmcnt(" #n ")" ::: "memory")
#define PG8_BAR __builtin_amdgcn_s_barrier()
#define PG8_SCHED __builtin_amdgcn_sched_barrier(0)
    Unit cur, nxt; int ui = 0;
    if (!S.next(0, cur)) return;
    f32x4 acc[2][2][4][2];
#pragma unroll
    for (int a = 0; a < 2; ++a)
#pragma unroll
        for (int b = 0; b < 2; ++b)
#pragma unroll
            for (int m = 0; m < 4; ++m)
#pragma unroll
                for (int n = 0; n < 2; ++n) acc[a][b][m][n] = (f32x4){0.f, 0.f, 0.f, 0.f};
    bf16x8 At[4][2], B0[2][2], B1[2][2];
    const char* cA = g.a_ptr(cur); const char* cB = g.b_ptr(cur);
    if constexpr (SP2) {
        PG8_STAGE(PG8_SB(0, 0), cB, voffB); PG8_STAGE(PG8_SB(0, 1), cB + hstepB, voffB); PG8_STAGE(PG8_SA(0, 0), cA, voffA); PG8_STAGE(PG8_SA(0, 1), cA + hstepA, voffA);
        if (wr == 1) PG8_BAR;
        PG8_WAIT_V(2); PG8_BAR;
        PG8_STAGE(PG8_SB(1, 0), cB + kstep, voffB); PG8_STAGE(PG8_SA(1, 0), cA + kstepA, voffA); PG8_STAGE(PG8_SB(1, 1), cB + hstepB + kstep, voffB);
        PG8_WAIT_V(6); PG8_BAR;
    } else {
        PG8_STAGE(PG8_SB(0, 0), cB, voffB); PG8_STAGE(PG8_SA(0, 0), cA, voffA); PG8_STAGE(PG8_SB(0, 1), cB + hstepB, voffB); PG8_STAGE(PG8_SA(0, 1), cA + hstepA, voffA);
        if (wr == 1) PG8_BAR;
        PG8_WAIT_V(4); PG8_BAR;
        PG8_STAGE(PG8_SB(1, 0), cB + kstep, voffB); PG8_STAGE(PG8_SA(1, 0), cA + kstepA, voffA); PG8_STAGE(PG8_SB(1, 1), cB + hstepB + kstep, voffB);
        PG8_WAIT_V(6); PG8_BAR;
    }
    for (;;) {
        const bool has_next = S.next(ui + 1, nxt);
        const char* nA = has_next ? g.a_ptr(nxt) : cA; const char* nB = has_next ? g.b_ptr(nxt) : cB;
        for (int t = 0; t < nt; t += 2) {
            const bool last = (t == nt - 2);
            const char* a1 = cA + (size_t)(t + 1) * kstepA;
            const char* a2 = last ? nA : cA + (size_t)(t + 2) * kstepA; const char* b2 = last ? nB : cB + (size_t)(t + 2) * kstep;
            const char* a3 = a2 + kstepA; const char* b3 = b2 + kstep;
            if constexpr (SP2) {
            PG8_LDB(B0, 0, 0); PG8_LDB(B1, 0, 1); PG8_SCHED; PG8_LDA(At, 0, 0); PG8_STAGE(PG8_SA(1, 1), a1 + hstepA, voffA);
            PG8_WAIT_V(8); PG8_WAIT_L(0); PG8_BAR; PG8_MMA(0, 0, At, B0); PG8_MMA(0, 1, At, B1); PG8_BAR; PG8_SCHED;
            PG8_LDA(At, 0, 1); PG8_STAGE(PG8_SB(0, 0), b2, voffB); PG8_STAGE(PG8_SB(0, 1), b2 + hstepB, voffB); PG8_STAGE(PG8_SA(0, 0), a2, voffA);
            PG8_WAIT_V(8); PG8_WAIT_L(0); PG8_BAR; PG8_MMA(1, 0, At, B0); PG8_MMA(1, 1, At, B1); PG8_BAR; PG8_SCHED;
            PG8_LDB(B0, 1, 0); PG8_LDB(B1, 1, 1); PG8_SCHED; PG8_LDA(At, 1, 0); PG8_STAGE(PG8_SA(0, 1), a2 + hstepA, voffA);
            PG8_WAIT_V(8); PG8_WAIT_L(0); PG8_BAR; PG8_MMA(0, 0, At, B0); PG8_MMA(0, 1, At, B1); PG8_BAR; PG8_SCHED;
            PG8_LDA(At, 1, 1); PG8_STAGE(PG8_SB(1, 0), b3, voffB); PG8_STAGE(PG8_SB(1, 1), b3 + hstepB, voffB); PG8_STAGE(PG8_SA(1, 0), a3, voffA);
            PG8_WAIT_V(8); PG8_WAIT_L(0); PG8_BAR; PG8_MMA(1, 0, At, B0); PG8_MMA(1, 1, At, B1); PG8_BAR; PG8_SCHED;
            } else {
            PG8_LDB(B0, 0, 0); PG8_SCHED; PG8_LDA(At, 0, 0); PG8_STAGE(PG8_SA(1, 1), a1 + hstepA, voffA);
            PG8_WAIT_L(8); PG8_BAR; PG8_WAIT_L(0); PG8_MMA(0, 0, At, B0); PG8_BAR; PG8_SCHED;
            PG8_LDB(B1, 0, 1); PG8_STAGE(PG8_SB(0, 0), b2, voffB);
            PG8_BAR; PG8_WAIT_L(0); PG8_MMA(0, 1, At, B1); PG8_BAR;
            PG8_LDA(At, 0, 1); PG8_STAGE(PG8_SA(0, 0), a2, voffA);
            PG8_BAR; PG8_WAIT_L(0); PG8_MMA(1, 0, At, B0); PG8_BAR; PG8_SCHED;
            PG8_STAGE(PG8_SB(0, 1), b2 + hstepB, voffB);
            PG8_WAIT_V(6); PG8_BAR; PG8_MMA(1, 1, At, B1); PG8_BAR;
            PG8_LDB(B0, 1, 0); PG8_SCHED; PG8_LDA(At, 1, 0); PG8_STAGE(PG8_SA(0, 1), a2 + hstepA, voffA);
            PG8_WAIT_L(8); PG8_BAR; PG8_WAIT_L(0); PG8_MMA(0, 0, At, B0); PG8_BAR; PG8_SCHED;
            PG8_LDB(B1, 1, 1); PG8_STAGE(PG8_SB(1, 0), b3, voffB);
            PG8_BAR; PG8_WAIT_L(0); PG8_MMA(0, 1, At, B1); PG8_BAR;
            PG8_LDA(At, 1, 1); PG8_STAGE(PG8_SA(1, 0), a3, voffA);
            PG8_BAR; PG8_WAIT_L(0); PG8_MMA(1, 0, At, B0); PG8_BAR; PG8_SCHED;
            PG8_STAGE(PG8_SB(1, 1), b3 + hstepB, voffB);
            PG8_WAIT_V(6); PG8_BAR; PG8_MMA(1, 1, At, B1); PG8_BAR;
            }
        }
        if constexpr (ALIGN_EPI) { if (wr == 0) PG8_BAR; }
        if constexpr (!Epi::AFTER_DRAIN) { if (!(Epi::LAST_FUSED && !has_next)) E(acc, cur, wr, wc, fr, fq); }
        if (!has_next) break;
        if (!E.keep(cur)) {
#pragma unroll
        for (int a = 0; a < 2; ++a)
#pragma unroll
            for (int b = 0; b < 2; ++b)
#pragma unroll
                for (int m = 0; m < 4; ++m)
#pragma unroll
                    for (int n = 0; n < 2; ++n) acc[a][b][m][n] = (f32x4){0.f, 0.f, 0.f, 0.f};
        }
        cur = nxt; cA = nA; cB = nB; ++ui;
        if constexpr (ALIGN_EPI) { if (wr == 1) PG8_BAR; }
    }
    PG8_WAIT_V(0);
    if constexpr (!ALIGN_EPI) { if (wr == 0) PG8_BAR; }
    PG8_BAR;
    if constexpr (Epi::AFTER_DRAIN || Epi::LAST_FUSED) { E.fused(acc, cur, wr, wc, fr, fq, lds, wid, lane); }
#undef PG8_SA
#undef PG8_SB
#undef PG8_STAGE
#undef PG8_LDA
#undef PG8_LDB
#undef PG8_MMA
#undef PG8_WAIT_V
#undef PG8_WAIT_L
#undef PG8_BAR
#undef PG8_SCHED
}
}

#ifndef PG8_SP2
#define PG8_SP2 true
#endif
#ifndef PG8_ALIGN
#define PG8_ALIGN true
#endif

typedef f32x4 Acc[2][2][4][2];

__device__ __forceinline__ v4u pack8(f32x4 v0, f32x4 v1) { v4u w; w.x = cvt_pk_bf16(v0[0], v0[1]); w.y = cvt_pk_bf16(v0[2], v0[3]); w.z = cvt_pk_bf16(v1[0], v1[1]); w.w = cvt_pk_bf16(v1[2], v1[3]); return w; }
__device__ __forceinline__ void unpack8(v4u w, f32x4& v0, f32x4& v1) { v0 = (f32x4){bf_lo(w.x), bf_hi(w.x), bf_lo(w.y), bf_hi(w.y)}; v1 = (f32x4){bf_lo(w.z), bf_hi(w.z), bf_lo(w.w), bf_hi(w.w)}; }

struct EpiInProj {
    static constexpr bool PERM = true, AFTER_DRAIN = false, LAST_FUSED = false;
    bf16 *q, *k, *v, *zc, *sgr, *sgc; const float* cs;
    __device__ __forceinline__ bool keep(const pg8::Unit&) const { return false; }
    __device__ __forceinline__ void operator()(Acc& acc, const pg8::Unit& u, int wr, int wc, int fr, int fq) const {
        const int row0 = u.pm * 256 + wr * 64 + fr, ct = wc * 32 + 8 * fq;
        if (u.pn < 5) {
            const bool isq = u.pn < 4; bf16* base = isq ? q + u.pn * 256 : k; const int ld = isq ? AW : KVW; const float sc = isq ? QSCALE : 1.f;
            const bool rl = ((wc & 1) == 0) && (fq < 2);
#pragma unroll
            for (int ai = 0; ai < 2; ++ai)
#pragma unroll
                for (int m = 0; m < 4; ++m) { const int row = row0 + ai * 128 + m * 16;
                    f32x4 c4 = (f32x4){1.f, 1.f, 1.f, 1.f}, s4 = (f32x4){0.f, 0.f, 0.f, 0.f};
                    if (rl) { c4 = *(const f32x4*)(cs + (size_t)row * 16 + 4 * fq); s4 = *(const f32x4*)(cs + (size_t)row * 16 + 8 + 4 * fq); }
#pragma unroll
                    for (int bj = 0; bj < 2; ++bj) { const f32x4 t1 = acc[ai][bj][m][0], t2 = acc[ai][bj][m][1];
                        const f32x4 v0 = (t1 * c4 - t2 * s4) * sc, v1 = (t2 * c4 + t1 * s4) * sc;
                        *(v4u*)(base + (size_t)row * ld + bj * 128 + ct) = pack8(v0, v1); } }
        } else if (u.pn < 10) {
            bf16* base = (u.pn == 5) ? v : zc + (u.pn - 6) * 256; const int ld = (u.pn == 5) ? KVW : 2 * CW;
#pragma unroll
            for (int ai = 0; ai < 2; ++ai)
#pragma unroll
                for (int m = 0; m < 4; ++m) { const int row = row0 + ai * 128 + m * 16;
#pragma unroll
                    for (int bj = 0; bj < 2; ++bj) *(v4u*)(base + (size_t)row * ld + bj * 128 + ct) = pack8(acc[ai][bj][m][0], acc[ai][bj][m][1]); }
        } else if (u.pn < 18) {
            const int t = u.pn - 10;
#pragma unroll
            for (int ai = 0; ai < 2; ++ai)
#pragma unroll
                for (int m = 0; m < 4; ++m) { const int row = row0 + ai * 128 + m * 16;
                    *(v4u*)(zc + (size_t)row * (2 * CW) + CW + t * 128 + ct) = pack8(acc[ai][0][m][0] * acc[ai][1][m][0], acc[ai][0][m][1] * acc[ai][1][m][1]); }
        } else {
            const int t = u.pn - 18;
#pragma unroll
            for (int ai = 0; ai < 2; ++ai)
#pragma unroll
                for (int m = 0; m < 4; ++m) { const int row = row0 + ai * 128 + m * 16; f32x4 rr[2], ss[2];
#pragma unroll
                    for (int n = 0; n < 2; ++n)
#pragma unroll
                        for (int e = 0; e < 4; ++e) { const float ga = acc[ai][0][m][n][e], gc = acc[ai][1][m][n][e];
                            const float ea = fast_exp2(fminf(ga, 80.f)), ec = fast_exp2(fminf(gc, 80.f));
                            const float ia = fast_rcp(1.f + ea), ic = fast_rcp(1.f + ec);
                            rr[n][e] = (1.f + ec) * ia; ss[n][e] = ic; }
                    *(v4u*)(sgr + (size_t)row * DM + t * 128 + ct) = pack8(rr[0], rr[1]);
                    *(v4u*)(sgc + (size_t)row * DM + t * 128 + ct) = pack8(ss[0], ss[1]); }
        }
    }
};
struct EpiStoreBf16 {
    static constexpr bool PERM = true, AFTER_DRAIN = false, LAST_FUSED = false;
    bf16* O; int ldc;
    __device__ __forceinline__ bool keep(const pg8::Unit&) const { return false; }
    __device__ __forceinline__ void operator()(Acc& acc, const pg8::Unit& u, int wr, int wc, int fr, int fq) const {
        const int row0 = u.pm * 256 + wr * 64 + fr, col0 = u.pn * 256 + wc * 32 + 8 * fq;
#pragma unroll
        for (int ai = 0; ai < 2; ++ai)
#pragma unroll
            for (int m = 0; m < 4; ++m) { const int row = row0 + ai * 128 + m * 16;
#pragma unroll
                for (int bj = 0; bj < 2; ++bj) *(v4u*)(O + (size_t)row * ldc + col0 + bj * 128) = pack8(acc[ai][bj][m][0], acc[ai][bj][m][1]); }
    }
};
struct EpiMerge {
    static constexpr bool PERM = true, AFTER_DRAIN = false, LAST_FUSED = false;
    const bf16 *sgr, *sgc; bf16* merged;
    __device__ __forceinline__ bool keep(const pg8::Unit& u) const { return u.z == 0; }
    __device__ __forceinline__ void operator()(Acc& acc, const pg8::Unit& u, int wr, int wc, int fr, int fq) const {
        const int row0 = u.pm * 256 + wr * 64 + fr, col0 = u.pn * 256 + wc * 32 + 8 * fq;
        const bf16* gsrc = ((u.z == 0) ? sgr : sgc) + (size_t)row0 * DM + col0;
        v4u gw[2][4][2];
#pragma unroll
        for (int ai = 0; ai < 2; ++ai)
#pragma unroll
            for (int m = 0; m < 4; ++m)
#pragma unroll
                for (int bj = 0; bj < 2; ++bj) gw[ai][m][bj] = *(const v4u*)(gsrc + (size_t)(ai * 128 + m * 16) * DM + bj * 128);
#pragma unroll
        for (int ai = 0; ai < 2; ++ai)
#pragma unroll
            for (int m = 0; m < 4; ++m) { const int row = row0 + ai * 128 + m * 16;
#pragma unroll
                for (int bj = 0; bj < 2; ++bj) { f32x4 g0, g1; unpack8(gw[ai][m][bj], g0, g1);
                    const f32x4 v0 = acc[ai][bj][m][0] * g0, v1 = acc[ai][bj][m][1] * g1;
                    if (u.z == 0) { acc[ai][bj][m][0] = v0; acc[ai][bj][m][1] = v1; }
                    else *(v4u*)(merged + (size_t)row * DM + col0 + bj * 128) = pack8(v0, v1); } }
    }
};
template <bool BASE_F32> struct EpiResid {
    static constexpr bool PERM = true, AFTER_DRAIN = false, LAST_FUSED = false;
    const float* basef; bf16* hb; float* ss;
    __device__ __forceinline__ bool keep(const pg8::Unit&) const { return false; }
    __device__ __forceinline__ void operator()(Acc& acc, const pg8::Unit& u, int wr, int wc, int fr, int fq) const {
        const int row0 = u.pm * 256 + wr * 64 + fr, col0 = u.pn * 256 + wc * 32 + 8 * fq;
        const size_t off0 = (size_t)row0 * DM + col0;
        constexpr int NPRE = BASE_F32 ? 4 : 8;
        f32x4 pf[BASE_F32 ? 4 : 1][2][2]; v4u pb[BASE_F32 ? 1 : 8][2];
#pragma unroll
        for (int g = 0; g < NPRE; ++g)
#pragma unroll
            for (int bj = 0; bj < 2; ++bj) { const size_t off = off0 + (size_t)((g >> 2) * 128 + (g & 3) * 16) * DM + bj * 128;
                if (BASE_F32) { pf[g][bj][0] = __builtin_nontemporal_load((const f32x4*)(basef + off)); pf[g][bj][1] = __builtin_nontemporal_load((const f32x4*)(basef + off + 4)); } else pb[g][bj] = *(const v4u*)(hb + off); }
#pragma unroll
        for (int g = 0; g < 8; ++g) { const int ai = g >> 2, m = g & 3; const int row = row0 + ai * 128 + m * 16; float sq = 0.f;
#pragma unroll
            for (int bj = 0; bj < 2; ++bj) { const size_t off = (size_t)row * DM + col0 + bj * 128; f32x4 b0, b1;
                if (BASE_F32) { b0 = pf[g & 3][bj][0]; b1 = pf[g & 3][bj][1]; } else unpack8(pb[g][bj], b0, b1);
                const f32x4 v0 = acc[ai][bj][m][0] + b0, v1 = acc[ai][bj][m][1] + b1;
                *(v4u*)(hb + off) = pack8(v0, v1);
                sq += (v0[0] * v0[0] + v0[1] * v0[1]) + (v0[2] * v0[2] + v0[3] * v0[3]) + (v1[0] * v1[0] + v1[1] * v1[1]) + (v1[2] * v1[2] + v1[3] * v1[3]); }
            if (BASE_F32 && g + 4 < 8) {
#pragma unroll
                for (int bj = 0; bj < 2; ++bj) { const size_t off = off0 + (size_t)(128 + m * 16) * DM + bj * 128; pf[g & 3][bj][0] = __builtin_nontemporal_load((const f32x4*)(basef + off)); pf[g & 3][bj][1] = __builtin_nontemporal_load((const f32x4*)(basef + off + 4)); } }
            sq += __shfl_xor(sq, 16); sq += __shfl_xor(sq, 32);
            if (fq == 0) atomicAdd(ss + row, sq); }
    }
};
struct EpiSoftmax {
    static constexpr bool PERM = true, AFTER_DRAIN = true, LAST_FUSED = false;
    const float* ss; bf16* P;
    __device__ __forceinline__ bool keep(const pg8::Unit&) const { return false; }
    __device__ __forceinline__ void fused(Acc& acc, const pg8::Unit& u, int wr, int wc, int fr, int fq, LAS unsigned char* lds, int wid, int lane) const {
        LAS float* Pm = (LAS float*)lds; LAS float* Ps = (LAS float*)(lds + 4096);
        const int rl0 = wr * 64 + fr, col0 = u.pn * 256 + wc * 32 + 8 * fq;
#pragma unroll
        for (int ai = 0; ai < 2; ++ai)
#pragma unroll
            for (int m = 0; m < 4; ++m) { const int rl = rl0 + ai * 128 + m * 16; const float rs = 1.0f / sqrtf(ss[u.pm * 256 + rl] * (1.0f / DM) + EPS); float mx = -3.0e38f;
#pragma unroll
                for (int bj = 0; bj < 2; ++bj)
#pragma unroll
                    for (int n = 0; n < 2; ++n) { f32x4 s = acc[ai][bj][m][n] * rs; acc[ai][bj][m][n] = s; mx = fmaxf(mx, fmaxf(fmaxf(s[0], s[1]), fmaxf(s[2], s[3]))); }
                mx = fmaxf(mx, __shfl_xor(mx, 16)); mx = fmaxf(mx, __shfl_xor(mx, 32));
                if (fq == 0) Pm[rl * 4 + wc] = mx; }
        asm volatile("s_waitcnt lgkmcnt(0)" ::: "memory"); __builtin_amdgcn_s_barrier(); asm volatile("" ::: "memory");
#pragma unroll
        for (int ai = 0; ai < 2; ++ai)
#pragma unroll
            for (int m = 0; m < 4; ++m) { const int rl = rl0 + ai * 128 + m * 16; const f32x4 pm4 = *(const LAS f32x4*)(Pm + rl * 4);
                const float mx = fmaxf(fmaxf(pm4[0], pm4[1]), fmaxf(pm4[2], pm4[3])); float sm = 0.f;
#pragma unroll
                for (int bj = 0; bj < 2; ++bj)
#pragma unroll
                    for (int n = 0; n < 2; ++n) { f32x4 s = acc[ai][bj][m][n];
#pragma unroll
                        for (int e = 0; e < 4; ++e) { s[e] = fast_exp2(s[e] - mx); sm += s[e]; }
                        acc[ai][bj][m][n] = s; }
                sm += __shfl_xor(sm, 16); sm += __shfl_xor(sm, 32);
                if (fq == 0) Ps[rl * 4 + wc] = sm; }
        asm volatile("s_waitcnt lgkmcnt(0)" ::: "memory"); __builtin_amdgcn_s_barrier(); asm volatile("" ::: "memory");
#pragma unroll
        for (int ai = 0; ai < 2; ++ai)
#pragma unroll
            for (int m = 0; m < 4; ++m) { const int rl = rl0 + ai * 128 + m * 16; const f32x4 ps4 = *(const LAS f32x4*)(Ps + rl * 4);
                const float inv = 1.0f / ((ps4[0] + ps4[1]) + (ps4[2] + ps4[3])); const size_t rowoff = (size_t)(u.pm * 256 + rl) * (4 * NMEM) + col0;
#pragma unroll
                for (int bj = 0; bj < 2; ++bj) *(v4u*)(P + rowoff + bj * 128) = pack8(acc[ai][bj][m][0] * inv, acc[ai][bj][m][1] * inv); }
    }
};
struct EpiSwiGLU {
    static constexpr bool PERM = true, AFTER_DRAIN = false, LAST_FUSED = false;
    const float* ss; bf16* act;
    __device__ __forceinline__ bool keep(const pg8::Unit&) const { return false; }
    __device__ __forceinline__ void operator()(Acc& acc, const pg8::Unit& u, int wr, int wc, int fr, int fq) const {
        const int row0 = u.pm * 256 + wr * 64 + fr, col0 = u.pn * 128 + wc * 32 + 8 * fq;
#pragma unroll
        for (int ai = 0; ai < 2; ++ai)
#pragma unroll
            for (int m = 0; m < 4; ++m) { const int row = row0 + ai * 128 + m * 16; const float rs = 1.0f / sqrtf(ss[row] * (1.0f / DM) + EPS); f32x4 o[2];
                const float nrl = -rs * LOG2E, rs2 = rs * rs;
#pragma unroll
                for (int n = 0; n < 2; ++n)
#pragma unroll
                    for (int e = 0; e < 4; ++e) { const float a = acc[ai][0][m][n][e], b = acc[ai][1][m][n][e];
                        o[n][e] = (a * b) * (rs2 * fast_rcp(1.f + fast_exp2(a * nrl))); }
                *(v4u*)(act + ((((size_t)u.pm * (DFF / 64) + (col0 >> 6)) * 256 + (row - u.pm * 256)) << 6) + (col0 & 63)) = pack8(o[0], o[1]); }
    }
};

#define XB_TMO      128
#define XB_XCNT(j)  (256  + 64 * (j))
#define XB_XSUB(j)  (1280 + 64 * (j))
#define XB_XGEN(j)  (2304 + 64 * (j))
#define XB_TOP      3328
#define XB_TOPGEN   3392
#define XCD_BAR_WORDS 3456
#define XB_SPIN_CAP (1u << 18)

__device__ __forceinline__ unsigned xb_ld(unsigned* p)              { return __hip_atomic_load(p, __ATOMIC_RELAXED, __HIP_MEMORY_SCOPE_AGENT); }
__device__ __forceinline__ unsigned xb_add(unsigned* p, unsigned v) { return __hip_atomic_fetch_add(p, v, __ATOMIC_RELAXED, __HIP_MEMORY_SCOPE_AGENT); }
__device__ __forceinline__ unsigned xb_xcc_id() { return (unsigned)__builtin_amdgcn_s_getreg((3 << 11) | 20) & 0xFu; }
#define XB_SPIN(cond, bar) do { unsigned _sp = 0; while (cond) { __builtin_amdgcn_s_sleep(1); \
    if ((++_sp & 255u) == 0u) { if (xb_ld(&(bar)[XB_TMO])) break; if (_sp > XB_SPIN_CAP) { atomicAdd(&(bar)[XB_TMO], 1u); break; } } } } while (0)

struct XcdBarrier { unsigned* bar; unsigned x; volatile LAS unsigned* st; };

__device__ __forceinline__ XcdBarrier xcd_barrier_post(unsigned* bar, volatile LAS unsigned* st) {
    XcdBarrier b; b.bar = bar; b.x = xb_xcc_id(); b.st = st;
    if (threadIdx.x == 0) (void)xb_add(&bar[XB_XCNT(b.x)], 1u);
    return b;
}
__device__ __forceinline__ void xcd_barrier_complete(unsigned* bar, unsigned x, unsigned& nloc, unsigned& nx) {
    const unsigned G = gridDim.x * gridDim.y * gridDim.z;
    unsigned sum, cnt, mine, sp = 0u;
    for (;;) {
        sum = 0u; cnt = 0u; mine = 0u;
#pragma unroll
        for (unsigned j = 0; j < 16; ++j) { const unsigned c = xb_ld(&bar[XB_XCNT(j)]); sum += c; cnt += (c > 0u) ? 1u : 0u; mine = (j == x) ? c : mine; }
        if (sum == G) break;
        __builtin_amdgcn_s_sleep(1);
        if ((++sp & 255u) == 0u) { if (xb_ld(&bar[XB_TMO])) break; if (sp > XB_SPIN_CAP) { atomicAdd(&bar[XB_TMO], 1u); break; } }
    }
    nloc = mine > 0u ? mine : 1u; nx = cnt > 0u ? cnt : 1u;
}
__device__ __forceinline__ void xcd_barrier(const XcdBarrier& b) {
    asm volatile("s_waitcnt vmcnt(0)" ::: "memory");
    __syncthreads();
    if (threadIdx.x == 0) {
        unsigned* bar = b.bar;
        __builtin_amdgcn_s_waitcnt(0);
        unsigned nloc = b.st[0], nx = b.st[1];
        if (nloc == 0u) { xcd_barrier_complete(bar, b.x, nloc, nx); b.st[0] = nloc; b.st[1] = nx; }
        const unsigned old = xb_add(&bar[XB_XSUB(b.x)], 1u);
        const unsigned gen = old / nloc;
        if (old + 1u == (gen + 1u) * nloc) {
            __builtin_amdgcn_fence(__ATOMIC_RELEASE, "agent");
            asm volatile("s_waitcnt vmcnt(0)" ::: "memory");
            const unsigned og = xb_add(&bar[XB_TOP], 1u);
            const unsigned tg = og / nx;
            if (og + 1u == (tg + 1u) * nx) xb_add(&bar[XB_TOPGEN], 1u);
            else XB_SPIN(xb_ld(&bar[XB_TOPGEN]) == tg, bar);
            __builtin_amdgcn_fence(__ATOMIC_ACQUIRE, "agent");
            xb_add(&bar[XB_XGEN(b.x)], 1u);
            asm volatile("s_waitcnt vmcnt(0)" ::: "memory");
        } else {
            XB_SPIN(xb_ld(&bar[XB_XGEN(b.x)]) == gen, bar);
            __builtin_amdgcn_fence(__ATOMIC_ACQUIRE, "agent");
            asm volatile("s_waitcnt vmcnt(0)" ::: "memory");
        }
    }
    __syncthreads();
}


__device__ __forceinline__ void group_barrier(unsigned* cnt, unsigned target, unsigned* extra, unsigned* tmo, bool same_xcd) {
    asm volatile("s_waitcnt vmcnt(0)" ::: "memory");
    __syncthreads();
    if (threadIdx.x == 0) {
        __builtin_amdgcn_s_waitcnt(0);
        if (!same_xcd) { __builtin_amdgcn_fence(__ATOMIC_RELEASE, "agent"); asm volatile("s_waitcnt vmcnt(0)" ::: "memory"); }
        (void)xb_add(cnt, 1u);
        if (extra) (void)xb_add(extra, 1u);
        unsigned sp = 0;
        while (xb_ld(cnt) < target) { __builtin_amdgcn_s_sleep(1); if ((++sp & 255u) == 0u) { if (xb_ld(tmo)) break; if (sp > XB_SPIN_CAP) { atomicAdd(tmo, 1u); break; } } }
        __builtin_amdgcn_fence(__ATOMIC_ACQUIRE, "agent");
        asm volatile("s_waitcnt vmcnt(0)" ::: "memory");
    }
    __syncthreads();
}
__device__ __forceinline__ void wait_global(unsigned* cnt, unsigned target, unsigned* tmo) {
    if (threadIdx.x == 0) {
        unsigned sp = 0;
        while (xb_ld(cnt) < target) { __builtin_amdgcn_s_sleep(1); if ((++sp & 255u) == 0u) { if (xb_ld(tmo)) break; if (sp > XB_SPIN_CAP) { atomicAdd(tmo, 1u); break; } } }
        __builtin_amdgcn_fence(__ATOMIC_ACQUIRE, "agent");
        asm volatile("s_waitcnt vmcnt(0)" ::: "memory");
    }
    __syncthreads();
}

struct EpiFinal {
    static constexpr bool PERM = true, AFTER_DRAIN = false, LAST_FUSED = true;
    bf16* hb; float* ss; float* out; const float* gfin; unsigned* gcnt; unsigned target; unsigned* glob1; unsigned* tmo; bool same_xcd;
    __device__ __forceinline__ bool keep(const pg8::Unit&) const { return false; }
    __device__ __forceinline__ void operator()(Acc& acc, const pg8::Unit& u, int wr, int wc, int fr, int fq) const { const EpiResid<false> E{nullptr, hb, ss}; E(acc, u, wr, wc, fr, fq); }
    __device__ __forceinline__ void fused(Acc& acc, const pg8::Unit& u, int wr, int wc, int fr, int fq, LAS unsigned char* lds, int wid, int lane) const {
        const int row0 = u.pm * 256 + wr * 64 + fr, col0 = u.pn * 256 + wc * 32 + 8 * fq;
        const size_t off0 = (size_t)row0 * DM + col0;
        v4u pb[8][2];
#pragma unroll
        for (int g = 0; g < 8; ++g)
#pragma unroll
            for (int bj = 0; bj < 2; ++bj) pb[g][bj] = *(const v4u*)(hb + off0 + (size_t)((g >> 2) * 128 + (g & 3) * 16) * DM + bj * 128);
#pragma unroll
        for (int g = 0; g < 8; ++g) { const int ai = g >> 2, m = g & 3; const int row = row0 + ai * 128 + m * 16; float sq = 0.f;
#pragma unroll
            for (int bj = 0; bj < 2; ++bj) { f32x4 b0, b1; unpack8(pb[g][bj], b0, b1);
                const f32x4 v0 = acc[ai][bj][m][0] + b0, v1 = acc[ai][bj][m][1] + b1; acc[ai][bj][m][0] = v0; acc[ai][bj][m][1] = v1;
                sq += (v0[0] * v0[0] + v0[1] * v0[1]) + (v0[2] * v0[2] + v0[3] * v0[3]) + (v1[0] * v1[0] + v1[1] * v1[1]) + (v1[2] * v1[2] + v1[3] * v1[3]); }
            sq += __shfl_xor(sq, 16); sq += __shfl_xor(sq, 32);
            if (fq == 0) atomicAdd(ss + row, sq); }
        group_barrier(gcnt, target, nullptr, tmo, same_xcd);
        wait_global(glob1, 256u, tmo);
        const int col1 = col0 - 1024;
        { f32x4 gv[2][2];
#pragma unroll
          for (int bj = 0; bj < 2; ++bj) { gv[bj][0] = *(const f32x4*)(gfin + col0 + bj * 128); gv[bj][1] = *(const f32x4*)(gfin + col0 + bj * 128 + 4); }
#pragma unroll
          for (int g = 0; g < 8; ++g) { const int ai = g >> 2, m = g & 3; const int row = row0 + ai * 128 + m * 16; const float rs = 1.0f / sqrtf(ss[row] * (1.0f / DM) + EPS);
#pragma unroll
            for (int bj = 0; bj < 2; ++bj) { float* o = out + (size_t)row * DM + col0 + bj * 128; __builtin_nontemporal_store(acc[ai][bj][m][0] * rs * gv[bj][0], (f32x4*)o); __builtin_nontemporal_store(acc[ai][bj][m][1] * rs * gv[bj][1], (f32x4*)(o + 4)); } } }
        asm volatile("" ::: "memory");
        { f32x4 gw[2][2];
#pragma unroll
          for (int bj = 0; bj < 2; ++bj) { gw[bj][0] = *(const f32x4*)(gfin + col1 + bj * 128); gw[bj][1] = *(const f32x4*)(gfin + col1 + bj * 128 + 4); }
#pragma unroll
          for (int g = 0; g < 8; ++g)
#pragma unroll
            for (int bj = 0; bj < 2; ++bj) pb[g][bj] = *(const v4u*)(hb + off0 - 1024 + (size_t)((g >> 2) * 128 + (g & 3) * 16) * DM + bj * 128);
#pragma unroll
          for (int g = 0; g < 8; ++g) { const int ai = g >> 2, m = g & 3; const int row = row0 + ai * 128 + m * 16; const float rs = 1.0f / sqrtf(ss[row] * (1.0f / DM) + EPS);
#pragma unroll
            for (int bj = 0; bj < 2; ++bj) { f32x4 b0, b1; unpack8(pb[g][bj], b0, b1); float* o1 = out + (size_t)row * DM + col1 + bj * 128; __builtin_nontemporal_store(b0 * rs * gw[bj][0], (f32x4*)o1); __builtin_nontemporal_store(b1 * rs * gw[bj][1], (f32x4*)(o1 + 4)); } } }
    }
};

__device__ __forceinline__ float wave_sum(float v) {
#pragma unroll
    for (int o = 1; o < 64; o <<= 1) v += __shfl_xor(v, o);
    return v;
}
__device__ __forceinline__ int rope_sigma(int p) { return (p < 16) ? ((p & 3) + 4 * ((p >> 3) & 1) + 8 * ((p >> 2) & 1)) : p; }
struct TpItem { const float* src; bf16* dst; const float* ks; int ldw, ldd, perm; float cscale; };
struct TpPtrs { const float *w_in, *w_attn_o, *w_conv_o, *w_out, *w_xkv, *w_xo, *w_gate_up, *w_down, *g_ffn; bf16 *WinT, *WacT, *WoutT, *WxkvT, *wxot, *WguT, *WdT; };
constexpr int TP_I0 = 32 * 272, TP_I1 = 16 * 64, TP_I2 = 16 * 64, TP_I3 = 32 * 64, TP_I4 = 32 * 32, TP_I7 = 8 * 64, TP_I5 = 32 * 352, TP_I6 = 88 * 64;
constexpr int TP_NEARLY = TP_I0 + TP_I1 + TP_I2 + TP_I3 + TP_I4 + TP_I7, TP_NITEMS = TP_NEARLY + TP_I5 + TP_I6;
__device__ __forceinline__ TpItem tp_mk(const float* W, int ldw, int src_col0, int k0, bf16* dst, int ldd, int dst_row0, int dst_col0, const float* kscale, int perm, float cscale = 1.f) {
    TpItem d; d.cscale = cscale; d.src = W + (size_t)k0 * ldw + src_col0; d.dst = dst + (size_t)dst_row0 * ldd + dst_col0 + k0; d.ks = kscale ? kscale + k0 : nullptr; d.ldw = ldw; d.ldd = ldd; d.perm = perm; return d; }
__device__ __forceinline__ TpItem tp_desc(int it, const TpPtrs& P) {
    int r = it;
    if (r < TP_I0) { const int kb_ = r / 272, Gp = r % 272; int src, perm = 0;
        if (Gp < 40) { src = 32 * Gp; perm = ((Gp & 1) == 0) ? 1 : 0; }
        else if (Gp < 80) { src = 32 * Gp; }
        else if (Gp < 144) { const int gg = Gp - 80, t = gg >> 3, i32 = gg & 7; src = (i32 < 4) ? (2560 + 128 * t + 32 * i32) : (3584 + 128 * t + 32 * (i32 - 4)); }
        else { const int gg = Gp - 144, t = gg >> 3, i32 = gg & 7; src = (i32 < 4) ? (4608 + 128 * t + 32 * i32) : (6656 + 128 * t + 32 * (i32 - 4)); }
        return tp_mk(P.w_in, NIN, src, 64 * kb_, P.WinT, DM, 32 * Gp, 0, nullptr, perm, Gp >= 144 ? -LOG2E : 1.f); } r -= TP_I0;
    if (r < TP_I1) { const int kb_ = r / 64, Gp = r % 64; return tp_mk(P.w_attn_o, DM, 32 * Gp, 64 * kb_, P.WacT, DM, 32 * Gp, 0, nullptr, 0); } r -= TP_I1;
    if (r < TP_I2) { const int kb_ = r / 64, Gp = r % 64; return tp_mk(P.w_conv_o, DM, 32 * Gp, 64 * kb_, P.WacT, DM, 32 * Gp, 1024, nullptr, 0); } r -= TP_I2;
    if (r < TP_I3) { const int kb_ = r / 64, Gp = r % 64; return tp_mk(P.w_out, DM, 32 * Gp, 64 * kb_, P.WoutT, DM, 32 * Gp, 0, nullptr, 0); } r -= TP_I3;
    if (r < TP_I4) { const int kb_ = r / 32, Gp = r % 32; return tp_mk(P.w_xkv, 2 * XW, 32 * Gp, 64 * kb_, P.WxkvT, DM, 32 * Gp, 0, nullptr, 0); } r -= TP_I4;
    if (r < TP_I7) { const int kb_ = r / 64, Gp = r % 64; return tp_mk(P.w_xo, DM, 32 * Gp, 64 * kb_, P.wxot, XW, 32 * Gp, 0, nullptr, 0); } r -= TP_I7;
    if (r < TP_I5) { const int kb_ = r / 352, Gp = r % 352; const int t = Gp >> 3, i32 = Gp & 7; const int src = (i32 < 4) ? (128 * t + 32 * i32) : (DFF + 128 * t + 32 * (i32 - 4));
        return tp_mk(P.w_gate_up, 2 * DFF, src, 64 * kb_, P.WguT, DM, 32 * Gp, 0, P.g_ffn, 0); } r -= TP_I5;
    { const int kb_ = r / 64, Gp = r % 64; return tp_mk(P.w_down, DM, 32 * Gp, 64 * kb_, P.WdT, DFF, 32 * Gp, 0, nullptr, 0); }
}
__device__ __forceinline__ void tp_load(const TpItem& d, float (&tv)[32], int lane) {
    const float* sp = d.src + (size_t)(lane >> 5) * d.ldw + (lane & 31);
#pragma unroll
    for (int i = 0; i < 32; ++i) tv[i] = __builtin_nontemporal_load(sp + (size_t)(2 * i) * d.ldw);
}
__device__ __forceinline__ void tp_finish(const TpItem& d, const float (&tv)[32], LAS float* scr, int lane) {
#pragma unroll
    for (int i = 0; i < 32; ++i) scr[(2 * i + (lane >> 5)) * 33 + (lane & 31)] = tv[i];
    LDS_WAIT(); asm volatile("" ::: "memory");
    const int c = lane & 7;
    float sc[8];
#pragma unroll
    for (int i = 0; i < 8; ++i) sc[i] = d.ks ? d.ks[8 * c + i] * d.cscale : d.cscale;
#pragma unroll
    for (int j = 0; j < 4; ++j) { const int nd = (lane >> 3) + 8 * j; const int scol = d.perm ? rope_sigma(nd) : nd; const LAS float* s = scr + (8 * c) * 33 + scol;
        v4u o; o.x = cvt_pk_bf16(s[0 * 33] * sc[0], s[1 * 33] * sc[1]); o.y = cvt_pk_bf16(s[2 * 33] * sc[2], s[3 * 33] * sc[3]);
        o.z = cvt_pk_bf16(s[4 * 33] * sc[4], s[5 * 33] * sc[5]); o.w = cvt_pk_bf16(s[6 * 33] * sc[6], s[7 * 33] * sc[7]);
        *(v4u*)(d.dst + (size_t)nd * d.ldd + 8 * c) = o; }
    LDS_WAIT(); asm volatile("" ::: "memory");
}
__device__ __forceinline__ void tp_run(int it0, int it_end, int stride, const TpPtrs& P, LAS float* scr, int lane) {
    if (it0 >= it_end) return;
    TpItem d = tp_desc(it0, P); float tv[32]; tp_load(d, tv, lane);
    for (int it = it0; it < it_end; it += stride) {
        const int nx = it + stride; const bool more = nx < it_end; TpItem dn = d; float tn[32];
        if (more) { dn = tp_desc(nx, P); tp_load(dn, tn, lane); }
        tp_finish(d, tv, scr, lane);
        if (more) { d = dn;
#pragma unroll
            for (int i = 0; i < 32; ++i) tv[i] = tn[i]; }
    }
}
__device__ __forceinline__ void tp_run3(int it0, int it_end, int stride, const TpPtrs& P, LAS float* scr, int lane) {
    if (it0 >= it_end) return;
    TpItem d0 = tp_desc(it0, P), d1 = d0; float t0[32], t1[32]; tp_load(d0, t0, lane);
    if (it0 + stride < it_end) { d1 = tp_desc(it0 + stride, P); tp_load(d1, t1, lane); }
    for (int it = it0; it < it_end; it += stride) {
        const int n2 = it + 2 * stride; const bool more2 = n2 < it_end; TpItem d2 = d0; float t2[32];
        if (more2) { d2 = tp_desc(n2, P); tp_load(d2, t2, lane); }
        tp_finish(d0, t0, scr, lane);
        d0 = d1; d1 = d2;
#pragma unroll
        for (int i = 0; i < 32; ++i) { t0[i] = t1[i]; t1[i] = t2[i]; }
    }
}
__device__ __forceinline__ void rms_rows_to_bf16(const float* xb, const float* g, bf16* ob, int m0, int m_end, int stride, int lane) {
    if (m0 >= m_end) return;
    f32x4 v[8];
    { const f32x4* xr = (const f32x4*)(xb + (size_t)m0 * DM) + lane;
#pragma unroll
      for (int j = 0; j < 8; ++j) v[j] = __builtin_nontemporal_load(xr + 64 * j); }
    f32x4 gg[8];
#pragma unroll
    for (int j = 0; j < 8; ++j) gg[j] = ((const f32x4*)g + lane)[64 * j];
    for (int m = m0; m < m_end; m += stride) {
        const int nx = m + stride; const bool more = nx < m_end; f32x4 vn[8];
        if (more) { const f32x4* xr = (const f32x4*)(xb + (size_t)nx * DM) + lane;
#pragma unroll
            for (int j = 0; j < 8; ++j) vn[j] = __builtin_nontemporal_load(xr + 64 * j); }
        float s = 0.f;
#pragma unroll
        for (int j = 0; j < 8; ++j) s += (v[j].x * v[j].x + v[j].y * v[j].y) + (v[j].z * v[j].z + v[j].w * v[j].w);
        const float rstd = 1.0f / sqrtf(wave_sum(s) * (1.0f / DM) + EPS);
        v2u* o8 = (v2u*)(ob + (size_t)m * DM) + lane;
#pragma unroll
        for (int j = 0; j < 8; ++j) { v2u w; w.x = cvt_pk_bf16(v[j].x * rstd * gg[j].x, v[j].y * rstd * gg[j].y); w.y = cvt_pk_bf16(v[j].z * rstd * gg[j].z, v[j].w * rstd * gg[j].w); o8[64 * j] = w; }
        if (more) {
#pragma unroll
            for (int j = 0; j < 8; ++j) v[j] = vn[j]; }
    }
}

__device__ __forceinline__ s16x4 vtr(const LAS unsigned char* p) { typedef short v4i16_t __attribute__((ext_vector_type(4))); return __builtin_bit_cast(s16x4, __builtin_amdgcn_ds_read_tr16_b64_v4i16((LAS v4i16_t*)p)); }

struct ConvCtx { const bf16* zc; bf16* xn; int ts, cg; f32x4 w0[2], w1[2], w2[2], p1[2], p2[2]; };
__device__ __forceinline__ void conv_issue(const ConvCtx& c, int batch, v4u (&zb)[4], v4u (&zp)[4]) {
#pragma unroll
    for (int i = 0; i < 4; ++i) { const bf16* zr = c.zc + (size_t)(c.ts + 4 * batch + i) * (2 * CW) + 8 * c.cg; zb[i] = *(const v4u*)(zr); zp[i] = *(const v4u*)(zr + CW); }
}
__device__ __forceinline__ void conv_finish(ConvCtx& c, int batch, const v4u (&zb)[4], const v4u (&zp)[4]) {
#pragma unroll
    for (int i = 0; i < 4; ++i) { f32x4 cb0, cb1, p0a, p0b; unpack8(zb[i], cb0, cb1); unpack8(zp[i], p0a, p0b);
        const f32x4 y0 = cb0 * (c.w0[0] * c.p2[0] + c.w1[0] * c.p1[0] + c.w2[0] * p0a), y1 = cb1 * (c.w0[1] * c.p2[1] + c.w1[1] * c.p1[1] + c.w2[1] * p0b);
        *(v4u*)(c.xn + (size_t)(c.ts + 4 * batch + i) * DM + AW + 8 * c.cg) = pack8(y0, y1);
        c.p2[0] = c.p1[0]; c.p2[1] = c.p1[1]; c.p1[0] = p0a; c.p1[1] = p0b; }
}
__device__ __forceinline__ void conv_init(ConvCtx& c, const bf16* zc, bf16* xn, const float* conv_w, int chunk, int tid) {
    c.zc = zc; c.xn = xn; c.cg = tid & 127; c.ts = chunk * 64 + (tid >> 7) * 16;
#pragma unroll
    for (int j = 0; j < 2; ++j) { c.w0[j] = *(const f32x4*)(conv_w + 8 * c.cg + 4 * j); c.w1[j] = *(const f32x4*)(conv_w + CW + 8 * c.cg + 4 * j); c.w2[j] = *(const f32x4*)(conv_w + 2 * CW + 8 * c.cg + 4 * j);
        c.p2[j] = (f32x4){0.f, 0.f, 0.f, 0.f}; c.p1[j] = c.p2[j]; }
    if (c.ts >= 2) { unpack8(*(const v4u*)(zc + (size_t)(c.ts - 2) * (2 * CW) + CW + 8 * c.cg), c.p2[0], c.p2[1]); unpack8(*(const v4u*)(zc + (size_t)(c.ts - 1) * (2 * CW) + CW + 8 * c.cg), c.p1[0], c.p1[1]); }
}
template <bool CONV>
__device__ __forceinline__ void swa_unit(LAS unsigned char* lds, int n, int g, const bf16* qb, const bf16* kb, const bf16* vb, const float* sinks, bf16* A2, int tid, int lane, int wave, ConvCtx& cc, int batch0) {
    LAS unsigned char* Kl = lds; LAS unsigned char* Vl = lds + 32768;
#pragma unroll
    for (int i = 0; i < 4; ++i) { const int id = tid + 512 * i, row = id >> 3, ch = id & 7; const int tok = (n - 1) * 128 + row;
        v4u kv = (v4u){0u, 0u, 0u, 0u}, vv = (v4u){0u, 0u, 0u, 0u};
        if (tok >= 0) { kv = *(const v4u*)(kb + (size_t)tok * KVW + g * 64 + ch * 8); vv = *(const v4u*)(vb + (size_t)tok * KVW + g * 64 + ch * 8); }
        *(LAS v4u*)(Kl + row * 128 + ((ch ^ ((row >> 1) & 7)) << 4)) = kv;
        *(LAS v4u*)(Vl + row * 128 + ((ch ^ (((row >> 1) & 1) << 2)) << 4)) = vv; }
    __syncthreads();
    const int ql = lane & 31, h = lane >> 5, hq = g * 4 + (wave & 3);
    const float sinkl = sinks[hq] * LOG2E;
    const int li = lane & 15, qp = li >> 2, pp = li & 3, g1 = (lane >> 4) & 1;
    const float NEG = -__builtin_inff();
#pragma unroll 1
    for (int st = 0; st < 2; ++st) {
        const int r0 = (wave >> 2) * 64 + 32 * st; const size_t tok = (size_t)n * 128 + r0 + ql;
        bf16x8 qf[4];
#pragma unroll
        for (int ks = 0; ks < 4; ++ks) qf[ks] = *(const bf16x8*)(qb + tok * AW + hq * 64 + 16 * ks + 8 * h);
        v4u zb[4], zp[4];
        if (CONV) conv_issue(cc, batch0 + st, zb, zp);
        f32x16 S[5];
#pragma unroll
        for (int t = 0; t < 5; ++t) { const int c = r0 + 32 * t + ql; S[t] = (f32x16){};
#pragma unroll
            for (int ks = 0; ks < 4; ++ks) { const bf16x8 kf = *(const LAS bf16x8*)(Kl + c * 128 + (((2 * ks + h) ^ ((c >> 1) & 7)) << 4));
                S[t] = __builtin_amdgcn_mfma_f32_32x32x16_bf16(kf, qf[ks], S[t], 0, 0, 0); } }
#pragma unroll
        for (int r = 0; r < 16; ++r) { const int cc = (r & 3) + 8 * (r >> 2) + 4 * h; if (!(cc > ql)) S[0][r] = NEG; if (!(cc <= ql)) S[4][r] = NEG; }
        if (n == 0) {
#pragma unroll
            for (int t = 0; t < 5; ++t)
#pragma unroll
                for (int r = 0; r < 16; ++r) { const int cc = (r & 3) + 8 * (r >> 2) + 4 * h; if (r0 + 32 * t + cc < 128) S[t][r] = NEG; } }
        float mx = sinkl;
#pragma unroll
        for (int t = 0; t < 5; ++t)
#pragma unroll
            for (int r = 0; r < 16; ++r) mx = fmaxf(mx, S[t][r]);
        mx = fmaxf(mx, __shfl_xor(mx, 32));
        float l = 0.f;
#pragma unroll
        for (int t = 0; t < 5; ++t)
#pragma unroll
            for (int r = 0; r < 16; ++r) { const float p = fast_exp2(S[t][r] - mx); S[t][r] = p; l += p; }
        l += __shfl_xor(l, 32); l += fast_exp2(sinkl - mx);
        f32x16 O[2]; O[0] = (f32x16){}; O[1] = (f32x16){};
#pragma unroll
        for (int t = 0; t < 5; ++t)
#pragma unroll
            for (int s = 0; s < 2; ++s) {
                v4u pw; pw.x = cvt_pk_bf16(S[t][8 * s + 0], S[t][8 * s + 1]); pw.y = cvt_pk_bf16(S[t][8 * s + 2], S[t][8 * s + 3]);
                pw.z = cvt_pk_bf16(S[t][8 * s + 4], S[t][8 * s + 5]); pw.w = cvt_pk_bf16(S[t][8 * s + 6], S[t][8 * s + 7]);
                const bf16x8 pf = __builtin_bit_cast(bf16x8, pw);
                const int krow = r0 + 32 * t + 16 * s + 4 * h + qp;
#pragma unroll
                for (int db = 0; db < 2; ++db) { const int chunk = (4 * db + 2 * g1 + (pp >> 1)) ^ (((qp >> 1) & 1) << 2);
                    const LAS unsigned char* va = Vl + krow * 128 + (chunk << 4) + (pp & 1) * 8;
                    const s16x4 lo = vtr(va), hi = vtr(va + 8 * 128);
                    const bf16x8 vf = (bf16x8){lo[0], lo[1], lo[2], lo[3], hi[0], hi[1], hi[2], hi[3]};
                    O[db] = __builtin_amdgcn_mfma_f32_32x32x16_bf16(vf, pf, O[db], 0, 0, 0); } }
        const float inv = 1.0f / l;
#pragma unroll
        for (int db = 0; db < 2; ++db)
#pragma unroll
            for (int pr = 0; pr < 2; ++pr) { const int ra = 8 * pr, rb = 8 * pr + 4;
                unsigned ax = cvt_pk_bf16(O[db][ra + 0] * inv, O[db][ra + 1] * inv), ay = cvt_pk_bf16(O[db][ra + 2] * inv, O[db][ra + 3] * inv);
                unsigned bx_ = cvt_pk_bf16(O[db][rb + 0] * inv, O[db][rb + 1] * inv), by = cvt_pk_bf16(O[db][rb + 2] * inv, O[db][rb + 3] * inv);
                { auto r = __builtin_amdgcn_permlane32_swap(ax, bx_, false, false); ax = r[0]; bx_ = r[1]; }
                { auto r = __builtin_amdgcn_permlane32_swap(ay, by, false, false); ay = r[0]; by = r[1]; }
                *(v4u*)(A2 + tok * DM + hq * 64 + 32 * db + 16 * pr + 8 * h) = (v4u){ax, ay, bx_, by}; }
        if (CONV) conv_finish(cc, batch0 + st, zb, zp);
    }
    __syncthreads();
}
__device__ __forceinline__ void swa_pair(LAS unsigned char* lds, int n, int g0, const bf16* qb, const bf16* kb, const bf16* vb, const float* sinks, bf16* A2, int tid, int lane, int wave, ConvCtx& cc) {
    constexpr bool CONV = true;
    { v4u kr[2][4], vr[2][4];
#pragma unroll
      for (int u = 0; u < 2; ++u)
#pragma unroll
        for (int i = 0; i < 4; ++i) { const int id = tid + 512 * i, row = id >> 3, ch = id & 7; const int tok = (n - 1) * 128 + row;
            kr[u][i] = (v4u){0u, 0u, 0u, 0u}; vr[u][i] = (v4u){0u, 0u, 0u, 0u};
            if (tok >= 0) { kr[u][i] = *(const v4u*)(kb + (size_t)tok * KVW + (g0 + u) * 64 + ch * 8); vr[u][i] = *(const v4u*)(vb + (size_t)tok * KVW + (g0 + u) * 64 + ch * 8); } }
#pragma unroll
      for (int u = 0; u < 2; ++u)
#pragma unroll
        for (int i = 0; i < 4; ++i) { const int id = tid + 512 * i, row = id >> 3, ch = id & 7;
            *(LAS v4u*)(lds + 65536 * u + row * 128 + ((ch ^ ((row >> 1) & 7)) << 4)) = kr[u][i];
            *(LAS v4u*)(lds + 65536 * u + 32768 + row * 128 + ((ch ^ (((row >> 1) & 1) << 2)) << 4)) = vr[u][i]; } }
    const int ql = lane & 31, h = lane >> 5;
    const float sink0 = sinks[g0 * 4 + (wave & 3)] * LOG2E, sink1 = sinks[(g0 + 1) * 4 + (wave & 3)] * LOG2E;
    bf16x8 qf[4];
    { const size_t tok = (size_t)n * 128 + (wave >> 2) * 64 + ql;
#pragma unroll
      for (int ks = 0; ks < 4; ++ks) qf[ks] = *(const bf16x8*)(qb + tok * AW + (g0 * 4 + (wave & 3)) * 64 + 16 * ks + 8 * h); }
    __syncthreads();
    const int li = lane & 15, qp = li >> 2, pp = li & 3, g1 = (lane >> 4) & 1;
    const float NEG = -__builtin_inff();
#pragma unroll 1
    for (int idx = 0; idx < 4; ++idx) {
        const int st = idx & 1, hq = (g0 + (idx >> 1)) * 4 + (wave & 3); const float sinkl = (idx >> 1) ? sink1 : sink0;
        const LAS unsigned char* Kl = lds + 65536 * (idx >> 1); const LAS unsigned char* Vl = Kl + 32768;
        const int r0 = (wave >> 2) * 64 + 32 * st; const size_t tok = (size_t)n * 128 + r0 + ql;
        v4u zb[4], zp[4];
        if (CONV) conv_issue(cc, idx, zb, zp);
        f32x16 S[5];
#pragma unroll
        for (int t = 0; t < 5; ++t) { const int c = r0 + 32 * t + ql; S[t] = (f32x16){};
#pragma unroll
            for (int ks = 0; ks < 4; ++ks) { const bf16x8 kf = *(const LAS bf16x8*)(Kl + c * 128 + (((2 * ks + h) ^ ((c >> 1) & 7)) << 4));
                S[t] = __builtin_amdgcn_mfma_f32_32x32x16_bf16(kf, qf[ks], S[t], 0, 0, 0); } }
        if (idx < 3) { const int nst = (idx + 1) & 1, nhq = (g0 + ((idx + 1) >> 1)) * 4 + (wave & 3); const size_t ntok = (size_t)n * 128 + (wave >> 2) * 64 + 32 * nst + ql;
#pragma unroll
            for (int ks = 0; ks < 4; ++ks) qf[ks] = *(const bf16x8*)(qb + ntok * AW + nhq * 64 + 16 * ks + 8 * h); }
#pragma unroll
        for (int r = 0; r < 16; ++r) { const int cc = (r & 3) + 8 * (r >> 2) + 4 * h; if (!(cc > ql)) S[0][r] = NEG; if (!(cc <= ql)) S[4][r] = NEG; }
        if (n == 0) {
#pragma unroll
            for (int t = 0; t < 5; ++t)
#pragma unroll
                for (int r = 0; r < 16; ++r) { const int cc = (r & 3) + 8 * (r >> 2) + 4 * h; if (r0 + 32 * t + cc < 128) S[t][r] = NEG; } }
        float mx = sinkl;
#pragma unroll
        for (int t = 0; t < 5; ++t)
#pragma unroll
            for (int r = 0; r < 16; ++r) mx = fmaxf(mx, S[t][r]);
        mx = fmaxf(mx, __shfl_xor(mx, 32));
        float l = 0.f;
#pragma unroll
        for (int t = 0; t < 5; ++t)
#pragma unroll
            for (int r = 0; r < 16; ++r) { const float p = fast_exp2(S[t][r] - mx); S[t][r] = p; l += p; }
        l += __shfl_xor(l, 32); l += fast_exp2(sinkl - mx);
        f32x16 O[2]; O[0] = (f32x16){}; O[1] = (f32x16){};
#pragma unroll
        for (int t = 0; t < 5; ++t)
#pragma unroll
            for (int s = 0; s < 2; ++s) {
                v4u pw; pw.x = cvt_pk_bf16(S[t][8 * s + 0], S[t][8 * s + 1]); pw.y = cvt_pk_bf16(S[t][8 * s + 2], S[t][8 * s + 3]);
                pw.z = cvt_pk_bf16(S[t][8 * s + 4], S[t][8 * s + 5]); pw.w = cvt_pk_bf16(S[t][8 * s + 6], S[t][8 * s + 7]);
                const bf16x8 pf = __builtin_bit_cast(bf16x8, pw);
                const int krow = r0 + 32 * t + 16 * s + 4 * h + qp;
#pragma unroll
                for (int db = 0; db < 2; ++db) { const int chunk = (4 * db + 2 * g1 + (pp >> 1)) ^ (((qp >> 1) & 1) << 2);
                    const LAS unsigned char* va = Vl + krow * 128 + (chunk << 4) + (pp & 1) * 8;
                    const s16x4 lo = vtr(va), hi = vtr(va + 8 * 128);
                    const bf16x8 vf = (bf16x8){lo[0], lo[1], lo[2], lo[3], hi[0], hi[1], hi[2], hi[3]};
                    O[db] = __builtin_amdgcn_mfma_f32_32x32x16_bf16(vf, pf, O[db], 0, 0, 0); } }
        const float inv = 1.0f / l;
#pragma unroll
        for (int db = 0; db < 2; ++db)
#pragma unroll
            for (int pr = 0; pr < 2; ++pr) { const int ra = 8 * pr, rb = 8 * pr + 4;
                unsigned ax = cvt_pk_bf16(O[db][ra + 0] * inv, O[db][ra + 1] * inv), ay = cvt_pk_bf16(O[db][ra + 2] * inv, O[db][ra + 3] * inv);
                unsigned bx_ = cvt_pk_bf16(O[db][rb + 0] * inv, O[db][rb + 1] * inv), by = cvt_pk_bf16(O[db][rb + 2] * inv, O[db][rb + 3] * inv);
                { auto r = __builtin_amdgcn_permlane32_swap(ax, bx_, false, false); ax = r[0]; bx_ = r[1]; }
                { auto r = __builtin_amdgcn_permlane32_swap(ay, by, false, false); ay = r[0]; by = r[1]; }
                *(v4u*)(A2 + tok * DM + hq * 64 + 32 * db + 16 * pr + 8 * h) = (v4u){ax, ay, bx_, by}; }
        if (CONV) conv_finish(cc, idx, zb, zp);
    }
    __syncthreads();
}
__device__ __forceinline__ void wave_gemm_64x32_k128(const bf16* A, int lda, const bf16* Bt, int ldb, bf16* C, int ldc, int lane) {
    const int fr = lane & 15, fq = lane >> 4;
    f32x4 acc[4][2];
#pragma unroll
    for (int mi = 0; mi < 4; ++mi)
#pragma unroll
        for (int ni = 0; ni < 2; ++ni) acc[mi][ni] = (f32x4){0.f, 0.f, 0.f, 0.f};
#pragma unroll
    for (int ks = 0; ks < 4; ++ks) { bf16x8 a[4], b[2];
#pragma unroll
        for (int mi = 0; mi < 4; ++mi) a[mi] = *(const bf16x8*)(A + (size_t)(16 * mi + fr) * lda + 32 * ks + 8 * fq);
#pragma unroll
        for (int ni = 0; ni < 2; ++ni) b[ni] = *(const bf16x8*)(Bt + (size_t)(16 * ni + fr) * ldb + 32 * ks + 8 * fq);
#pragma unroll
        for (int mi = 0; mi < 4; ++mi)
#pragma unroll
            for (int ni = 0; ni < 2; ++ni) acc[mi][ni] = __builtin_amdgcn_mfma_f32_16x16x32_bf16(b[ni], a[mi], acc[mi][ni], 0, 0, 0); }
#pragma unroll
    for (int mi = 0; mi < 4; ++mi)
#pragma unroll
        for (int ni = 0; ni < 2; ++ni) { v2u w; w.x = cvt_pk_bf16(acc[mi][ni][0], acc[mi][ni][1]); w.y = cvt_pk_bf16(acc[mi][ni][2], acc[mi][ni][3]);
            st8_wt(C + (size_t)(16 * mi + fr) * ldc + 16 * ni + 4 * fq, w); }
}

constexpr int NPHASE = 10;
struct Args { const float* in[18]; float* out; unsigned char* ws; int ph_lo, ph_hi, li, pad; };

__global__ void __launch_bounds__(512, 2) hyb_fwd(Args args) {
    extern __shared__ __attribute__((aligned(16))) unsigned char lds_raw[];
    LAS unsigned char* lds = (LAS unsigned char*)lds_raw;
    volatile LAS unsigned* MISC = (volatile LAS unsigned*)(lds + MISC_OFF);
    const int tid = threadIdx.x, lane = tid & 63, wave = __builtin_amdgcn_readfirstlane(tid >> 6);
    const int G = gridDim.x, bx = blockIdx.x;
    unsigned char* ws = args.ws;
    unsigned* ctl = (unsigned*)(ws + WS_CTL);
    const float* x = args.in[0]; const float* mem = args.in[1]; const float* g_mix = args.in[2]; const float* w_in = args.in[3]; const float* conv_w = args.in[4];
    const float* sinks = args.in[5]; const float* w_attn_o = args.in[6]; const float* w_conv_o = args.in[7]; const float* w_out = args.in[8]; const float* g_xattn = args.in[9];
    const float* g_mem = args.in[10]; const float* w_xq = args.in[11]; const float* w_xkv = args.in[12]; const float* w_xo = args.in[13]; const float* g_ffn = args.in[14];
    const float* w_gate_up = args.in[15]; const float* w_down = args.in[16]; const float* g_final = args.in[17];
    float* out = args.out;
    float* ss1 = (float*)(ws + WS_SS); float* ss2 = ss1 + SEQ; float* ss3 = ss2 + SEQ;
    float* cs = (float*)(ws + WS_CS);
    bf16* kvb = (bf16*)(ws + WS_KVB); bf16* memn = (bf16*)(ws + WS_MEMN); bf16* wxqp = (bf16*)(ws + WS_WXQ); bf16* wxot = (bf16*)(ws + WS_WXOT);
    bf16* WguT = (bf16*)(ws + WS_WGUT); bf16* WdT = (bf16*)(ws + WS_WDT); bf16* XN = (bf16*)(ws + WS_XN);
    bf16* WinT = (bf16*)(ws + WS_WINT); bf16* WacT = (bf16*)(ws + WS_WACT); bf16* WoutT = (bf16*)(ws + WS_WOUTT); bf16* WxkvT = (bf16*)(ws + WS_WXKVT);
    bf16* WqKT = (bf16*)(ws + WS_WQKT); bf16* VWoT = (bf16*)(ws + WS_VWOT);
    bf16* qb = (bf16*)(ws + WS_Q); bf16* kb = (bf16*)(ws + WS_K); bf16* vb = (bf16*)(ws + WS_V); bf16* zc = (bf16*)(ws + WS_ZC);
    bf16* Pb = (bf16*)(ws + WS_P); bf16* act = (bf16*)(ws + WS_ACT);
    bf16* sgr = (bf16*)out; bf16* sgc = sgr + (size_t)SEQ * DM;
    bf16* merged = sgr;

    for (int u = tid; u < (LDS_BYTES - LDSCTL_OFF) / 4; u += 512) ((LAS unsigned*)(lds + LDSCTL_OFF))[u] = 0u;
    __syncthreads();
    XcdBarrier bar; bar.bar = ctl + CW_BAR; bar.x = 0; bar.st = nullptr;
    if (MK_N_LAUNCHES == 1) bar = xcd_barrier_post(ctl + CW_BAR, MISC + 8);
    if (tid == 0) __hip_atomic_store(ctl + CW_XID + 64 * (bx & 63) + (bx >> 6), xb_xcc_id() + 1u, __ATOMIC_RELAXED, __HIP_MEMORY_SCOPE_AGENT);
    const int lo = args.ph_lo, hi = args.ph_hi;
    const bool tailfill = (G == 256);
#define IN(k) (lo <= (k) && (k) < hi)
#ifdef PROBE_PHASE
    int n_stamp = 0;
#define STAMP() do { if (bx == 0 && tid == 0) { ((volatile LAS unsigned long long*)(lds + MISC_OFF + 128))[n_stamp] = __builtin_amdgcn_s_memrealtime(); ((volatile LAS unsigned long long*)(lds + MISC_OFF + 256))[n_stamp] = __builtin_amdgcn_s_memtime(); } ++n_stamp; } while (0)
#define SUBSTAMP(i) do { __builtin_amdgcn_s_waitcnt(0); if (bx == 0 && tid == 0) ((volatile LAS unsigned long long*)(lds + MISC_OFF + 128))[40 + (i)] = __builtin_amdgcn_s_memrealtime(); } while (0)
#else
#define STAMP() do { } while (0)
#define SUBSTAMP(i) do { } while (0)
#endif
#define SEAM(k) do { if (IN(k) && IN((k) + 1)) xcd_barrier(bar); STAMP(); } while (0)
    const bool grp = (G == 256) && (MK_N_LAUNCHES == 1);
    const int pm_own = 8 * (bx & 7) + ((bx >> 3) & 7), jmem = bx >> 6;
    unsigned* gcnt = ctl + CW_GRP + 64 * (bx & 63); unsigned* glob = ctl + CW_GLOB; unsigned* gtmo = ctl + CW_BAR + XB_TMO;
    unsigned gepoch = 0; bool same_xcd = false;
#define GSEAM(k, extra) do { if (IN(k) && IN((k) + 1)) { if (grp) { gepoch += 4u; group_barrier(gcnt, gepoch, (extra), gtmo, same_xcd); } else xcd_barrier(bar); } STAMP(); } while (0)
    STAMP();

    const TpPtrs TP{w_in, w_attn_o, w_conv_o, w_out, w_xkv, w_xo, w_gate_up, w_down, g_ffn, WinT, WacT, WoutT, WxkvT, wxot, WguT, WdT};
    if (IN(0)) {
        LAS float* scr = (LAS float*)(lds + wave * 16384);
        const int gw = bx * 8 + wave, NGW = G * 8;
        SUBSTAMP(0);
        tp_run(gw, tailfill ? TP_NEARLY : TP_NITEMS, NGW, TP, scr, lane);
        SUBSTAMP(1);
        rms_rows_to_bf16(x, g_mix, XN, gw, SEQ, NGW, lane);
        SUBSTAMP(2);
        rms_rows_to_bf16(mem, g_mem, memn, gw, NMEM, NGW, lane);
        for (int k = gw; k < DM; k += NGW) { const float gs = g_xattn[k] * C2X; const f32x4* src = (const f32x4*)(w_xq + (size_t)k * XW) + lane; v2u* dst = (v2u*)(wxqp + (size_t)k * XW) + lane;
#pragma unroll
            for (int j = 0; j < 2; ++j) { const f32x4 v = src[64 * j]; v2u w; w.x = cvt_pk_bf16(v.x * gs, v.y * gs); w.y = cvt_pk_bf16(v.z * gs, v.w * gs); dst[64 * j] = w; } }
        const int gt = bx * 512 + tid, NGT = G * 512;
        for (int e = gt; e < SEQ * 8; e += NGT) { const int pos = e >> 3, i = e & 7;
            const float inv_freq = (i == 0) ? 1.0f : (i == 1) ? 0.19392274f : (i == 2) ? 0.037606031f : (i == 3) ? 0.0072926646f : (i == 4) ? 0.0014142136f : (i == 5) ? 0.00027424819f : (i == 6) ? 5.3182957e-05f : 1.0313385e-05f;
            const float ang = (float)pos * inv_freq; float sn, cn; sincosf(ang, &sn, &cn);
            cs[(size_t)pos * 16 + i] = cn; cs[(size_t)pos * 16 + 8 + i] = sn; }
        for (int e = gt; e < 3 * SEQ; e += NGT) ss1[e] = 0.f;
        SUBSTAMP(3);
    }
    SEAM(0);

    if (IN(1)) {
        { pg8::Prob g{memn, WxkvT, DM, DM, DM, 0}; pg8::StaticOrder S; S.init(NMEM, 2 * XW, G, (bx >= 128 && bx < 132) ? bx - 128 : -1);
          EpiStoreBf16 E{kvb, 2 * XW};
          pg8::gemm_phase<EpiStoreBf16, pg8::StaticOrder, PG8_ALIGN, PG8_SP2>(lds, g, S, E); }
        if (tailfill && bx >= 132) { tp_run3(TP_NEARLY + (bx - 132) * 8 + wave, TP_NITEMS, (256 - 132) * 8, TP, (LAS float*)(lds + wave * 16384), lane); __syncthreads(); }
        { pg8::Prob g{XN, WinT, DM, DM, DM, 0}; pg8::StaticOrder S; S.init(SEQ, NIN, G, bx);
          EpiInProj E{qb, kb, vb, zc, sgr, sgc, cs};
          pg8::gemm_phase<EpiInProj, pg8::StaticOrder, PG8_ALIGN, PG8_SP2>(lds, g, S, E); }
    }
    SEAM(1);

    if (grp && IN(2)) {
        if (tid == 0) { unsigned* xt = ctl + CW_XID + 64 * (bx & 63); const unsigned a0 = xb_ld(xt), a1 = xb_ld(xt + 1), a2 = xb_ld(xt + 2), a3 = xb_ld(xt + 3);
            MISC[12] = (a0 != 0u && a0 == a1 && a0 == a2 && a0 == a3) ? 1u : 0u; }
        __syncthreads();
        same_xcd = __builtin_amdgcn_readfirstlane(MISC[12]) != 0u;
    }
    if (IN(2)) {
        SUBSTAMP(4);
        ConvCtx cc;
        if (grp) {
            conv_init(cc, zc, XN, conv_w, 4 * pm_own + jmem, tid);
            swa_pair(lds, 2 * pm_own + (jmem >> 1), (2 * jmem) & 3, qb, kb, vb, sinks, XN, tid, lane, wave, cc);
        } else {
            for (int u = bx; u < (SEQ / 128) * 4; u += G) swa_unit<false>(lds, u >> 2, u & 3, qb, kb, vb, sinks, XN, tid, lane, wave, cc, 0);
            for (int ch = bx; ch < SEQ / 64; ch += G) { conv_init(cc, zc, XN, conv_w, ch, tid);
#pragma unroll 1
                for (int b = 0; b < 4; ++b) { v4u zb[4], zp[4]; conv_issue(cc, b, zb, zp); conv_finish(cc, b, zb, zp); } }
        }
        SUBSTAMP(5);
        const bool pp_all = !grp; const int pp_w = ((bx >> 4) << 3) + (bx & 7);
        for (int job = pp_all ? bx * 8 + wave : (((bx >> 3) & 1) ? pp_w * 8 + wave : 2048); job < 2048; job += (pp_all ? G * 8 : 1024)) { const int idx = job & 1023;
            if (job < 1024) { const int mt = idx >> 6, nt = idx & 63, m0 = 64 * mt, n0 = 32 * nt, hh = m0 >> 8, j0 = m0 & 255;
                wave_gemm_64x32_k128(kvb + (size_t)j0 * (2 * XW) + 128 * hh, 2 * XW, wxqp + (size_t)n0 * XW + 128 * hh, XW, WqKT + (size_t)m0 * DM + n0, DM, lane); }
            else { const int mt = idx >> 5, nt = idx & 31, m0 = 64 * mt, n0 = 32 * nt, hh = n0 >> 8, j0 = n0 & 255;
                wave_gemm_64x32_k128(wxot + (size_t)m0 * XW + 128 * hh, XW, kvb + (size_t)j0 * (2 * XW) + XW + 128 * hh, 2 * XW, VWoT + (size_t)m0 * (4 * NMEM) + n0, 4 * NMEM, lane); } }
    }
    SUBSTAMP(7);
    GSEAM(2, glob);

    if (IN(3)) { pg8::Prob g{XN, WacT, DM, DM, AW, AW}; pg8::StaticOrder S; S.init(SEQ, DM, G, bx, 2);
        EpiMerge E{sgr, sgc, merged};
        pg8::gemm_phase<EpiMerge, pg8::StaticOrder, PG8_ALIGN, PG8_SP2>(lds, g, S, E); }
    GSEAM(3, nullptr);

    if (IN(4)) { pg8::Prob g{merged, WoutT, DM, DM, DM, 0}; pg8::StaticOrder S; S.init(SEQ, DM, G, bx);
        EpiResid<true> E{x, XN, ss1};
        pg8::gemm_phase<EpiResid<true>, pg8::StaticOrder, PG8_ALIGN, PG8_SP2>(lds, g, S, E); }
    GSEAM(4, glob + 64);

    if (IN(5)) { if (grp) wait_global(glob, 256u, gtmo);
        pg8::Prob g{XN, WqKT, DM, DM, DM, 0}; pg8::StaticOrder S; S.init(SEQ, 4 * NMEM, G, bx);
        EpiSoftmax E{ss1, Pb};
        if ((SEQ / 256) * 4 <= G) pg8::gemm_phase<EpiSoftmax, pg8::StaticOrder, false, PG8_SP2>(lds, g, S, E); }
    GSEAM(5, nullptr);

    if (IN(6)) { pg8::Prob g{Pb, VWoT, 4 * NMEM, 4 * NMEM, 4 * NMEM, 0}; pg8::StaticOrder S; S.init(SEQ, DM, G, bx);
        EpiResid<false> E{nullptr, XN, ss2};
        pg8::gemm_phase<EpiResid<false>, pg8::StaticOrder, PG8_ALIGN, PG8_SP2>(lds, g, S, E); }
    GSEAM(6, nullptr);

    if (IN(7)) { pg8::Prob g{XN, WguT, DM, DM, DM, 0}; pg8::StaticOrder S; S.init(SEQ, 2 * DFF, G, bx);
        EpiSwiGLU E{ss2, act};
        pg8::gemm_phase<EpiSwiGLU, pg8::StaticOrder, PG8_ALIGN, PG8_SP2>(lds, g, S, E); }
    GSEAM(7, nullptr);

    if (IN(8)) { pg8::Prob g{act, WdT, 64, DFF, DFF, 0, 256 * 64 * 2, (size_t)256 * DFF}; pg8::StaticOrder S; S.init(SEQ, DM, G, bx);
        if (grp) { EpiFinal E{XN, ss3, out, g_final, gcnt, gepoch + 4u, glob + 64, gtmo, same_xcd}; gepoch += 4u;
            pg8::gemm_phase<EpiFinal, pg8::StaticOrder, PG8_ALIGN, PG8_SP2>(lds, g, S, E); }
        else { EpiResid<false> E{nullptr, XN, ss3};
            pg8::gemm_phase<EpiResid<false>, pg8::StaticOrder, PG8_ALIGN, PG8_SP2>(lds, g, S, E); } }
    if (!grp) { GSEAM(8, nullptr); } else { STAMP(); }

    if (IN(9) && !grp) {
        if (grp) wait_global(glob + 64, 256u, gtmo);
        const int m0 = grp ? 256 * pm_own + 64 * jmem + wave : bx * 8 + wave, m_end = grp ? 256 * pm_own + 64 * jmem + 64 : SEQ, NGW = grp ? 8 : G * 8;
        f32x4 gg[4][2];
#pragma unroll
        for (int j = 0; j < 4; ++j) { gg[j][0] = ((const f32x4*)g_final + 2 * lane)[128 * j]; gg[j][1] = ((const f32x4*)g_final + 2 * lane)[128 * j + 1]; }
        v4u hv[4];
        if (m0 < m_end) {
#pragma unroll
            for (int j = 0; j < 4; ++j) hv[j] = ((const v4u*)(XN + (size_t)m0 * DM) + lane)[64 * j]; }
        for (int m = m0; m < m_end; m += NGW) { const int nx = m + NGW; const bool more = nx < m_end; v4u hn[4];
            if (more) {
#pragma unroll
                for (int j = 0; j < 4; ++j) hn[j] = ((const v4u*)(XN + (size_t)nx * DM) + lane)[64 * j]; }
            const float rs = 1.0f / sqrtf(ss3[m] * (1.0f / DM) + EPS); f32x4* o = (f32x4*)(out + (size_t)m * DM) + 2 * lane;
#pragma unroll
            for (int j = 0; j < 4; ++j) { f32x4 v0, v1; unpack8(hv[j], v0, v1); o[128 * j] = v0 * rs * gg[j][0]; o[128 * j + 1] = v1 * rs * gg[j][1]; }
            if (more) {
#pragma unroll
                for (int j = 0; j < 4; ++j) hv[j] = hn[j]; } } }
#ifdef PROBE_PHASE
    STAMP();
    if (bx == 0 && tid == 0) { volatile LAS unsigned long long* st = (volatile LAS unsigned long long*)(lds + MISC_OFF + 128);
        volatile LAS unsigned long long* sc = (volatile LAS unsigned long long*)(lds + MISC_OFF + 256);
        unsigned long long span = st[PROBE_PHASE + 1] - st[PROBE_PHASE]; const unsigned long long t0 = __builtin_amdgcn_s_memrealtime();
#ifdef PROBE_SUB
        span = st[40 + PROBE_SUB + 1] - st[40 + PROBE_SUB];
#endif
#ifdef PROBE_CLOCK
        span = (sc[PROBE_PHASE + 1] - sc[PROBE_PHASE]) * 1250ull / span;
#endif
        while (__builtin_amdgcn_s_memrealtime() - t0 < 8ull * span) __builtin_amdgcn_s_sleep(8); }
#endif
#ifdef DBG_STOP
    if (IN(10)) { const size_t gt = (size_t)bx * 512 + tid, NGT = (size_t)G * 512;
        for (size_t e = gt; e < (size_t)SEQ * DM; e += NGT) {
#if DBG_DUMP == 0
            out[e] = __builtin_bit_cast(float, (unsigned)XN[e] << 16);
#elif DBG_DUMP == 1
            out[e] = __builtin_bit_cast(float, (unsigned)XN[e] << 16);
#elif DBG_DUMP == 2
            out[e] = __builtin_bit_cast(float, (unsigned)merged[e] << 16);
#elif DBG_DUMP == 3
            { const size_t r = e / DM, c = e % DM; out[e] = __builtin_bit_cast(float, (unsigned)(c < 1024 ? qb[r * 1024 + c] : (c < 1280 ? kb[r * 256 + c - 1024] : (c < 1536 ? vb[r * 256 + c - 1280] : zc[r * 2048 + ((c - 1536) & 2047)]))) << 16); }
#elif DBG_DUMP == 5
            { const size_t n1 = (size_t)1024 * 2048, n2 = 2 * n1, n3 = n2 + 256 * 1024; out[e] = (e < n1) ? __builtin_bit_cast(float, (unsigned)WqKT[e] << 16) : (e < n2) ? __builtin_bit_cast(float, (unsigned)VWoT[e - n1] << 16) : (e < n3) ? __builtin_bit_cast(float, (unsigned)kvb[e - n2] << 16) : 0.f; }
#elif DBG_DUMP == 6
            out[e] = (e < (size_t)256 * 1024) ? __builtin_bit_cast(float, (unsigned)kvb[e] << 16) : (e < (size_t)256 * 1024 + 256 * 2048) ? __builtin_bit_cast(float, (unsigned)memn[e - 256 * 1024] << 16) : 0.f;
#elif DBG_DUMP == 7
            out[e] = (e < (size_t)2048 * 512) ? __builtin_bit_cast(float, (unsigned)wxqp[e] << 16) : (e < (size_t)2 * 2048 * 512) ? __builtin_bit_cast(float, (unsigned)wxot[e - 2048 * 512] << 16) : 0.f;
#elif DBG_DUMP == 4
            { const size_t r = e / DM, c = e % DM; out[e] = __builtin_bit_cast(float, (unsigned)(c < 1024 ? Pb[r * 1024 + c] : (bf16)0) << 16); }
#endif
        } }
#endif
#undef IN
#undef SEAM
#undef GSEAM
}

extern "C" void kernel_launch(void* const* d_in, const int* in_sizes, int n_in, void* d_out, int out_size, void* d_ws, size_t ws_size, hipStream_t stream) {
    static int grid = 0;
    if (grid == 0) {
        if (n_in != 18 || in_sizes[0] != SEQ * DM || out_size != SEQ * DM || ws_size < WS_END) { fprintf(stderr, "kernel_launch: unexpected shapes / workspace (n_in %d, in0 %d, out %d, ws %zu); nothing launched\n", n_in, n_in > 0 ? in_sizes[0] : -1, out_size, ws_size); grid = -1; return; }
        int dev = 0, cus = 0;
        if (hipGetDevice(&dev) != hipSuccess || hipDeviceGetAttribute(&cus, hipDeviceAttributeMultiprocessorCount, dev) != hipSuccess) { fprintf(stderr, "kernel_launch: device query failed\n"); grid = -1; return; }
        if (hipFuncSetAttribute((const void*)hyb_fwd, hipFuncAttributeMaxDynamicSharedMemorySize, LDS_BYTES) != hipSuccess) { fprintf(stderr, "kernel_launch: hipFuncSetAttribute failed\n"); grid = -1; return; }
        int per_cu = 0;
        if (hipOccupancyMaxActiveBlocksPerMultiprocessor(&per_cu, (const void*)hyb_fwd, 512, LDS_BYTES) != hipSuccess || per_cu < 1) fprintf(stderr, "kernel_launch: note: occupancy query reports %d workgroups per CU\n", per_cu);
        (void)hipGetLastError();
        grid = cus;
    }
    if (grid < 0) return;
    if (hipMemsetAsync((char*)d_ws + WS_CTL, 0, CTL_ZERO_BYTES, stream) != hipSuccess) { fprintf(stderr, "kernel_launch: memset failed\n"); return; }
    Args a{};
    for (int i = 0; i < 18; ++i) a.in[i] = (const float*)d_in[i];
    a.out = (float*)d_out; a.ws = (unsigned char*)d_ws;
#ifdef DBG_STOP
    const int nl = DBG_STOP + 2;
#else
    const int nl = MK_N_LAUNCHES;
#endif
    for (int li = 0; li < nl; ++li) {
        a.ph_lo = (MK_N_LAUNCHES == 1) ? 0 : li; a.ph_hi = (MK_N_LAUNCHES == 1) ? NPHASE : li + 1; a.li = li; a.pad = 0;
#ifdef DBG_STOP
        if (li == nl - 1) { a.ph_lo = 10; a.ph_hi = 11; }
#endif
        hipLaunchKernelGGL(hyb_fwd, dim3(grid), dim3(512), LDS_BYTES, stream, a);
        const hipError_t le = hipPeekAtLastError();
        if (le != hipSuccess) { fprintf(stderr, "kernel_launch: launch %d failed: %s\n", li, hipGetErrorName(le)); break; }
    }
}
```

```cpp
#include <hip/hip_runtime.h>
#include <cstdio>
#include <cstdint>

#ifndef MK_N_LAUNCHES
#define MK_N_LAUNCHES 1
#endif

#define GAS __attribute__((address_space(1)))
#define LAS __attribute__((address_space(3)))
typedef unsigned short bf16;
typedef unsigned v4u __attribute__((ext_vector_type(4)));
typedef unsigned v2u __attribute__((ext_vector_type(2)));
typedef float f32x4 __attribute__((ext_vector_type(4)));
typedef float f32x16 __attribute__((ext_vector_type(16)));
typedef short bf16x8 __attribute__((ext_vector_type(8)));
typedef short s16x4 __attribute__((ext_vector_type(4)));

constexpr int SEQ = 16384, DM = 2048, NIN = 8704, AW = 1024, KVW = 256, CW = 1024, XW = 512, NMEM = 256, DFF = 5632;
constexpr float EPS = 1e-6f;
constexpr float LOG2E = 1.4426950408889634f;
constexpr float QSCALE = 0.125f * 1.4426950408889634f;
constexpr float C2X = 0.08838834764831845f * 1.4426950408889634f;

constexpr size_t MiB = 1u << 20;
constexpr size_t WS_CTL = 0, CTL_ZERO_BYTES = 256 * 1024;
constexpr size_t WS_SS = 1 * MiB;
constexpr size_t WS_CS = 2 * MiB;
constexpr size_t WS_KVB = 3 * MiB;
constexpr size_t WS_MEMN = 4 * MiB;
constexpr size_t WS_WXQ = 5 * MiB;
constexpr size_t WS_WXOT = 7 * MiB;
constexpr size_t WS_WGUT = 16 * MiB;
constexpr size_t WS_WDT = 60 * MiB;
constexpr size_t WS_XN = 82 * MiB;
constexpr size_t WS_WACT = 146 * MiB;
constexpr size_t WS_WOUTT = 154 * MiB;
constexpr size_t WS_WQKT = 162 * MiB;
constexpr size_t WS_VWOT = 166 * MiB;
constexpr size_t WS_Q = 170 * MiB, WS_K = 202 * MiB, WS_V = 210 * MiB, WS_ZC = 218 * MiB;
constexpr size_t WS_P = WS_Q;
constexpr size_t WS_ACT = 314 * MiB;
constexpr size_t WS_WINT = 314 * MiB;
constexpr size_t WS_WXKVT = 348 * MiB;
constexpr size_t WS_END = 490 * MiB;
static_assert(WS_ACT + (size_t)SEQ * DFF * 2 <= WS_END && WS_ZC + (size_t)SEQ * 3 * CW * 2 <= WS_ACT, "d_ws map");

constexpr int CW_BAR = 4096;
constexpr int CW_GRP = 16384;
constexpr int CW_XID = 49152;
constexpr int CW_GLOB = 32768;

constexpr int RING_BYTES = 131072;
constexpr int LDSCTL_OFF = RING_BYTES, MISC_OFF = LDSCTL_OFF + 320;
constexpr int LDS_BYTES = 147456;

#define RLX_AGENT __ATOMIC_RELAXED, __HIP_MEMORY_SCOPE_AGENT
#define LDS_WAIT() asm volatile("s_waitcnt lgkmcnt(0)" ::: "memory")
#define VM_WAIT() asm volatile("s_waitcnt vmcnt(0)" ::: "memory")

typedef float f32x2_t __attribute__((ext_vector_type(2))); typedef __bf16 bf16x2_t __attribute__((ext_vector_type(2)));
__device__ __forceinline__ unsigned cvt_pk_bf16(float lo, float hi) { f32x2_t v = {lo, hi}; bf16x2_t b = __builtin_convertvector(v, bf16x2_t); return __builtin_bit_cast(unsigned, b); }
__device__ __forceinline__ float bf_lo(unsigned u) { return __builtin_bit_cast(float, u << 16); }
__device__ __forceinline__ float bf_hi(unsigned u) { return __builtin_bit_cast(float, u & 0xffff0000u); }
__device__ __forceinline__ float fast_exp2(float x) { return __builtin_amdgcn_exp2f(x); }
__device__ __forceinline__ float fast_rcp(float x) { return __builtin_amdgcn_rcpf(x); }
__device__ __forceinline__ void st16_wt(void* p, v4u v) { asm volatile("global_store_dwordx4 %0, %1, off sc1\n\ts_nop 1" :: "v"(p), "v"(v) : "memory"); }
__device__ __forceinline__ void st8_wt(void* p, v2u v) { __hip_atomic_store((unsigned long long*)p, ((unsigned long long)v.y << 32) | v.x, __ATOMIC_RELAXED, __HIP_MEMORY_SCOPE_AGENT); }

namespace pg8 {
typedef unsigned short bf16_t;
constexpr int BM = 256, BK = 64, HALF = 128, HTB = HALF * BK * 2, STAGE_BYTES = 8 * HTB, NXCD = 8, WGM = 8;

__host__ __device__ __forceinline__ int lds_byte(int r, int c) { const int st = (r >> 4) * 2 + (c >> 5), rr = r & 15, cc = c & 31, ob = rr * 64 + cc * 2; return st * 1024 + (ob ^ (((ob >> 9) & 1) << 5)); }
__host__ __device__ __forceinline__ void stage_rc(int b, int& R, int& C) { const int st = b / 1024, sb = b % 1024, swz = sb ^ (((sb >> 9) & 1) << 5); R = (st >> 1) * 16 + swz / 64; C = (st & 1) * 32 + (swz % 64) / 2; }
__host__ __device__ __forceinline__ int perm32(int rho) { const int n = rho >> 4, i = rho & 15; return 8 * (i >> 2) + 4 * n + (i & 3); }

struct Unit { int pm, pn, z; };
struct Prob {
    const bf16_t* A; const bf16_t* Bt; int lda, ldb, K, zoff;
    int akstep = 0; size_t apanel = 0;
    __device__ __forceinline__ const char* a_ptr(const Unit& u) const { return (const char*)(A + (apanel ? (size_t)u.pm * apanel : (size_t)u.pm * BM * lda) + (size_t)u.z * zoff); }
    __device__ __forceinline__ const char* b_ptr(const Unit& u) const { return (const char*)(Bt + (size_t)u.pn * BM * ldb + (size_t)u.z * zoff); }
};

__device__ __forceinline__ bool tile_of(long L, int nM, int nN, int& pm, int& pn) {
    const int nwg = nM * nN; if (L >= nwg) return false;
    int wgid = (int)L; { const int q = nwg / NXCD, r = nwg % NXCD, xcd = wgid % NXCD, off = wgid / NXCD; wgid = (xcd < r ? xcd * (q + 1) : r * (q + 1) + (xcd - r) * q) + off; }
    const int nig = WGM * nN, gid = wgid / nig, fm = gid * WGM, gsz = (nM - fm) < WGM ? (nM - fm) : WGM;
    pm = fm + ((wgid % nig) % gsz); pn = (wgid % nig) / gsz; return true;
}
struct StaticOrder {
    int nM, nN, G, c, ZS;
    __device__ __forceinline__ void init(int M, int N, int G_, int c_, int ZS_ = 1) { nM = M / BM; nN = N / BM; G = G_; c = c_; ZS = ZS_; }
    __device__ __forceinline__ bool next(int i, Unit& u) const {
        if (c < 0) return false;
        const int ti = (ZS == 2) ? (i >> 1) : i; u.z = (ZS == 2) ? (i & 1) : 0;
        return tile_of((long)ti * G + c, nM, nN, u.pm, u.pn);
    }
};

template <class Epi, class Sched, bool ALIGN_EPI = false, bool SP2 = false>
__device__ __forceinline__ void gemm_phase(LAS unsigned char* lds, const Prob g, const Sched& S, const Epi& E) {
    const int tid = threadIdx.x, wid = __builtin_amdgcn_readfirstlane(tid >> 6), lane = tid & 63, wr = wid >> 2, wc = wid & 3, fr = lane & 15, fq = lane >> 4;
    const int K = g.K, nt = K / BK;
    unsigned voffA[2], voffB[2];
#pragma unroll
    for (int i = 0; i < 2; ++i) { int R, C; stage_rc(tid * 16 + i * 8192, R, C); const int Rb = Epi::PERM ? ((R & ~31) + perm32(R & 31)) : R;
        voffA[i] = (unsigned)(R * g.lda + C) * 2u; voffB[i] = (unsigned)(Rb * g.ldb + C) * 2u; }
    const size_t kstep = (size_t)(BK * 2), kstepA = g.akstep ? (size_t)g.akstep : kstep;
    const size_t hstepA = (size_t)HALF * g.lda * 2, hstepB = (size_t)HALF * g.ldb * 2;
    const unsigned ldsw = (unsigned)wid * 1024u;
    const int aoff = lds_byte(wr * 64 + fr, fq * 8), boff = lds_byte(wc * 32 + fr, fq * 8);
#define PG8_SA(b, h) (((b) * 2 + (h)) * HTB)
#define PG8_SB(b, h) ((4 + (b) * 2 + (h)) * HTB)
#define PG8_STAGE(bufoff, gbase, voff) do { _Pragma("unroll") for (int _i = 0; _i < 2; ++_i) \
        __builtin_amdgcn_global_load_lds((const unsigned*)((const char*)(gbase) + (voff)[_i]), (LAS unsigned*)(lds + (bufoff) + ldsw + _i * 8192), 16, 0, 0); } while (0)
#define PG8_LDA(dst, b, h) do { _Pragma("unroll") for (int m = 0; m < 4; ++m) _Pragma("unroll") for (int k = 0; k < 2; ++k) dst[m][k] = *(const LAS bf16x8*)(lds + PG8_SA(b, h) + aoff + m * 2048 + k * 1024); } while (0)
#define PG8_LDB(dst, b, h) do { _Pragma("unroll") for (int n = 0; n < 2; ++n) _Pragma("unroll") for (int k = 0; k < 2; ++k) dst[n][k] = *(const LAS bf16x8*)(lds + PG8_SB(b, h) + boff + n * 2048 + k * 1024); } while (0)
#define PG8_MMA(ai, bj, At, Bt) do { __builtin_amdgcn_s_setprio(1); _Pragma("unroll") for (int m = 0; m < 4; ++m) _Pragma("unroll") for (int n = 0; n < 2; ++n) _Pragma("unroll") for (int k = 0; k < 2; ++k) \
        acc[ai][bj][m][n] = __builtin_amdgcn_mfma_f32_16x16x32_bf16(Bt[n][k], At[m][k], acc[ai][bj][m][n], 0, 0, 0); __builtin_amdgcn_s_setprio(0); } while (0)
#define PG8_WAIT_V(n) asm volatile("s_waitcnt vmcnt(" #n ")" ::: "memory")
#define PG8_WAIT_L(n) asm volatile("s_waitcnt lgkmcnt(" #n ")" ::: "memory")
#define PG8_BAR __builtin_amdgcn_s_barrier()
#define PG8_SCHED __builtin_amdgcn_sched_barrier(0)
    Unit cur, nxt; int ui = 0;
    if (!S.next(0, cur)) return;
    f32x4 acc[2][2][4][2];
#pragma unroll
    for (int a = 0; a < 2; ++a)
#pragma unroll
        for (int b = 0; b < 2; ++b)
#pragma unroll
            for (int m = 0; m < 4; ++m)
#pragma unroll
                for (int n = 0; n < 2; ++n) acc[a][b][m][n] = (f32x4){0.f, 0.f, 0.f, 0.f};
    bf16x8 At[4][2], B0[2][2], B1[2][2];
    const char* cA = g.a_ptr(cur); const char* cB = g.b_ptr(cur);
    if constexpr (SP2) {
        PG8_STAGE(PG8_SB(0, 0), cB, voffB); PG8_STAGE(PG8_SB(0, 1), cB + hstepB, voffB); PG8_STAGE(PG8_SA(0, 0), cA, voffA); PG8_STAGE(PG8_SA(0, 1), cA + hstepA, voffA);
        if (wr == 1) PG8_BAR;
        PG8_WAIT_V(2); PG8_BAR;
        PG8_STAGE(PG8_SB(1, 0), cB + kstep, voffB); PG8_STAGE(PG8_SA(1, 0), cA + kstepA, voffA); PG8_STAGE(PG8_SB(1, 1), cB + hstepB + kstep, voffB);
        PG8_WAIT_V(6); PG8_BAR;
    } else {
        PG8_STAGE(PG8_SB(0, 0), cB, voffB); PG8_STAGE(PG8_SA(0, 0), cA, voffA); PG8_STAGE(PG8_SB(0, 1), cB + hstepB, voffB); PG8_STAGE(PG8_SA(0, 1), cA + hstepA, voffA);
        if (wr == 1) PG8_BAR;
        PG8_WAIT_V(4); PG8_BAR;
        PG8_STAGE(PG8_SB(1, 0), cB + kstep, voffB); PG8_STAGE(PG8_SA(1, 0), cA + kstepA, voffA); PG8_STAGE(PG8_SB(1, 1), cB + hstepB + kstep, voffB);
        PG8_WAIT_V(6); PG8_BAR;
    }
    for (;;) {
        const bool has_next = S.next(ui + 1, nxt);
        const char* nA = has_next ? g.a_ptr(nxt) : cA; const char* nB = has_next ? g.b_ptr(nxt) : cB;
        for (int t = 0; t < nt; t += 2) {
            const bool last = (t == nt - 2);
            const char* a1 = cA + (size_t)(t + 1) * kstepA;
            const char* a2 = last ? nA : cA + (size_t)(t + 2) * kstepA; const char* b2 = last ? nB : cB + (size_t)(t + 2) * kstep;
            const char* a3 = a2 + kstepA; const char* b3 = b2 + kstep;
            if constexpr (SP2) {
            PG8_LDB(B0, 0, 0); PG8_LDB(B1, 0, 1); PG8_SCHED; PG8_LDA(At, 0, 0); PG8_STAGE(PG8_SA(1, 1), a1 + hstepA, voffA);
            PG8_WAIT_V(8); PG8_WAIT_L(0); PG8_BAR; PG8_MMA(0, 0, At, B0); PG8_MMA(0, 1, At, B1); PG8_BAR; PG8_SCHED;
            PG8_LDA(At, 0, 1); PG8_STAGE(PG8_SB(0, 0), b2, voffB); PG8_STAGE(PG8_SB(0, 1), b2 + hstepB, voffB); PG8_STAGE(PG8_SA(0, 0), a2, voffA);
            PG8_WAIT_V(8); PG8_WAIT_L(0); PG8_BAR; PG8_MMA(1, 0, At, B0); PG8_MMA(1, 1, At, B1); PG8_BAR; PG8_SCHED;
            PG8_LDB(B0, 1, 0); PG8_LDB(B1, 1, 1); PG8_SCHED; PG8_LDA(At, 1, 0); PG8_STAGE(PG8_SA(0, 1), a2 + hstepA, voffA);
            PG8_WAIT_V(8); PG8_WAIT_L(0); PG8_BAR; PG8_MMA(0, 0, At, B0); PG8_MMA(0, 1, At, B1); PG8_BAR; PG8_SCHED;
            PG8_LDA(At, 1, 1); PG8_STAGE(PG8_SB(1, 0), b3, voffB); PG8_STAGE(PG8_SB(1, 1), b3 + hstepB, voffB); PG8_STAGE(PG8_SA(1, 0), a3, voffA);
            PG8_WAIT_V(8); PG8_WAIT_L(0); PG8_BAR; PG8_MMA(1, 0, At, B0); PG8_MMA(1, 1, At, B1); PG8_BAR; PG8_SCHED;
            } else {
            PG8_LDB(B0, 0, 0); PG8_SCHED; PG8_LDA(At, 0, 0); PG8_STAGE(PG8_SA(1, 1), a1 + hstepA, voffA);
            PG8_WAIT_L(8); PG8_BAR; PG8_WAIT_L(0); PG8_MMA(0, 0, At, B0); PG8_BAR; PG8_SCHED;
            PG8_LDB(B1, 0, 1); PG8_STAGE(PG8_SB(0, 0), b2, voffB);
            PG8_BAR; PG8_WAIT_L(0); PG8_MMA(0, 1, At, B1); PG8_BAR;
            PG8_LDA(At, 0, 1); PG8_STAGE(PG8_SA(0, 0), a2, voffA);
            PG8_BAR; PG8_WAIT_L(0); PG8_MMA(1, 0, At, B0); PG8_BAR; PG8_SCHED;
            PG8_STAGE(PG8_SB(0, 1), b2 + hstepB, voffB);
            PG8_WAIT_V(6); PG8_BAR; PG8_MMA(1, 1, At, B1); PG8_BAR;
            PG8_LDB(B0, 1, 0); PG8_SCHED; PG8_LDA(At, 1, 0); PG8_STAGE(PG8_SA(0, 1), a2 + hstepA, voffA);
            PG8_WAIT_L(8); PG8_BAR; PG8_WAIT_L(0); PG8_MMA(0, 0, At, B0); PG8_BAR; PG8_SCHED;
            PG8_LDB(B1, 1, 1); PG8_STAGE(PG8_SB(1, 0), b3, voffB);
            PG8_BAR; PG8_WAIT_L(0); PG8_MMA(0, 1, At, B1); PG8_BAR;
            PG8_LDA(At, 1, 1); PG8_STAGE(PG8_SA(1, 0), a3, voffA);
            PG8_BAR; PG8_WAIT_L(0); PG8_MMA(1, 0, At, B0); PG8_BAR; PG8_SCHED;
            PG8_STAGE(PG8_SB(1, 1), b3 + hstepB, voffB);
            PG8_WAIT_V(6); PG8_BAR; PG8_MMA(1, 1, At, B1); PG8_BAR;
            }
        }
        if constexpr (ALIGN_EPI) { if (wr == 0) PG8_BAR; }
        if constexpr (!Epi::AFTER_DRAIN) { if (!(Epi::LAST_FUSED && !has_next)) E(acc, cur, wr, wc, fr, fq); }
        if (!has_next) break;
        if (!E.keep(cur)) {
#pragma unroll
        for (int a = 0; a < 2; ++a)
#pragma unroll
            for (int b = 0; b < 2; ++b)
#pragma unroll
                for (int m = 0; m < 4; ++m)
#pragma unroll
                    for (int n = 0; n < 2; ++n) acc[a][b][m][n] = (f32x4){0.f, 0.f, 0.f, 0.f};
        }
        cur = nxt; cA = nA; cB = nB; ++ui;
        if constexpr (ALIGN_EPI) { if (wr == 1) PG8_BAR; }
    }
    PG8_WAIT_V(0);
    if constexpr (!ALIGN_EPI) { if (wr == 0) PG8_BAR; }
    PG8_BAR;
    if constexpr (Epi::AFTER_DRAIN || Epi::LAST_FUSED) { E.fused(acc, cur, wr, wc, fr, fq, lds, wid, lane); }
#undef PG8_SA
#undef PG8_SB
#undef PG8_STAGE
#undef PG8_LDA
#undef PG8_LDB
#undef PG8_MMA
#undef PG8_WAIT_V
#undef PG8_WAIT_L
#undef PG8_BAR
#undef PG8_SCHED
}
}

#ifndef PG8_SP2
#define PG8_SP2 true
#endif
#ifndef PG8_ALIGN
#define PG8_ALIGN true
#endif

typedef f32x4 Acc[2][2][4][2];

__device__ __forceinline__ v4u pack8(f32x4 v0, f32x4 v1) { v4u w; w.x = cvt_pk_bf16(v0[0], v0[1]); w.y = cvt_pk_bf16(v0[2], v0[3]); w.z = cvt_pk_bf16(v1[0], v1[1]); w.w = cvt_pk_bf16(v1[2], v1[3]); return w; }
__device__ __forceinline__ void unpack8(v4u w, f32x4& v0, f32x4& v1) { v0 = (f32x4){bf_lo(w.x), bf_hi(w.x), bf_lo(w.y), bf_hi(w.y)}; v1 = (f32x4){bf_lo(w.z), bf_hi(w.z), bf_lo(w.w), bf_hi(w.w)}; }

struct EpiInProj {
    static constexpr bool PERM = true, AFTER_DRAIN = false, LAST_FUSED = false;
    bf16 *q, *k, *v, *zc, *sgr, *sgc; const float* cs;
    __device__ __forceinline__ bool keep(const pg8::Unit&) const { return false; }
    __device__ __forceinline__ void operator()(Acc& acc, const pg8::Unit& u, int wr, int wc, int fr, int fq) const {
        const int row0 = u.pm * 256 + wr * 64 + fr, ct = wc * 32 + 8 * fq;
        if (u.pn < 5) {
            const bool isq = u.pn < 4; bf16* base = isq ? q + u.pn * 256 : k; const int ld = isq ? AW : KVW; const float sc = isq ? QSCALE : 1.f;
            const bool rl = ((wc & 1) == 0) && (fq < 2);
#pragma unroll
            for (int ai = 0; ai < 2; ++ai)
#pragma unroll
                for (int m = 0; m < 4; ++m) { const int row = row0 + ai * 128 + m * 16;
                    f32x4 c4 = (f32x4){1.f, 1.f, 1.f, 1.f}, s4 = (f32x4){0.f, 0.f, 0.f, 0.f};
                    if (rl) { c4 = *(const f32x4*)(cs + (size_t)row * 16 + 4 * fq); s4 = *(const f32x4*)(cs + (size_t)row * 16 + 8 + 4 * fq); }
#pragma unroll
                    for (int bj = 0; bj < 2; ++bj) { const f32x4 t1 = acc[ai][bj][m][0], t2 = acc[ai][bj][m][1];
                        const f32x4 v0 = (t1 * c4 - t2 * s4) * sc, v1 = (t2 * c4 + t1 * s4) * sc;
                        *(v4u*)(base + (size_t)row * ld + bj * 128 + ct) = pack8(v0, v1); } }
        } else if (u.pn < 10) {
            bf16* base = (u.pn == 5) ? v : zc + (u.pn - 6) * 256; const int ld = (u.pn == 5) ? KVW : 2 * CW;
#pragma unroll
            for (int ai = 0; ai < 2; ++ai)
#pragma unroll
                for (int m = 0; m < 4; ++m) { const int row = row0 + ai * 128 + m * 16;
#pragma unroll
                    for (int bj = 0; bj < 2; ++bj) *(v4u*)(base + (size_t)row * ld + bj * 128 + ct) = pack8(acc[ai][bj][m][0], acc[ai][bj][m][1]); }
        } else if (u.pn < 18) {
            const int t = u.pn - 10;
#pragma unroll
            for (int ai = 0; ai < 2; ++ai)
#pragma unroll
                for (int m = 0; m < 4; ++m) { const int row = row0 + ai * 128 + m * 16;
                    *(v4u*)(zc + (size_t)row * (2 * CW) + CW + t * 128 + ct) = pack8(acc[ai][0][m][0] * acc[ai][1][m][0], acc[ai][0][m][1] * acc[ai][1][m][1]); }
        } else {
            const int t = u.pn - 18;
#pragma unroll
            for (int ai = 0; ai < 2; ++ai)
#pragma unroll
                for (int m = 0; m < 4; ++m) { const int row = row0 + ai * 128 + m * 16; f32x4 rr[2], ss[2];
#pragma unroll
                    for (int n = 0; n < 2; ++n)
#pragma unroll
                        for (int e = 0; e < 4; ++e) { const float ga = acc[ai][0][m][n][e], gc = acc[ai][1][m][n][e];
                            const float ea = fast_exp2(fminf(ga, 80.f)), ec = fast_exp2(fminf(gc, 80.f));
                            const float ia = fast_rcp(1.f + ea), ic = fast_rcp(1.f + ec);
                            rr[n][e] = (1.f + ec) * ia; ss[n][e] = ic; }
                    *(v4u*)(sgr + (size_t)row * DM + t * 128 + ct) = pack8(rr[0], rr[1]);
                    *(v4u*)(sgc + (size_t)row * DM + t * 128 + ct) = pack8(ss[0], ss[1]); }
        }
    }
};
struct EpiStoreBf16 {
    static constexpr bool PERM = true, AFTER_DRAIN = false, LAST_FUSED = false;
    bf16* O; int ldc;
    __device__ __forceinline__ bool keep(const pg8::Unit&) const { return false; }
    __device__ __forceinline__ void operator()(Acc& acc, const pg8::Unit& u, int wr, int wc, int fr, int fq) const {
        const int row0 = u.pm * 256 + wr * 64 + fr, col0 = u.pn * 256 + wc * 32 + 8 * fq;
#pragma unroll
        for (int ai = 0; ai < 2; ++ai)
#pragma unroll
            for (int m = 0; m < 4; ++m) { const int row = row0 + ai * 128 + m * 16;
#pragma unroll
                for (int bj = 0; bj < 2; ++bj) *(v4u*)(O + (size_t)row * ldc + col0 + bj * 128) = pack8(acc[ai][bj][m][0], acc[ai][bj][m][1]); }
    }
};
struct EpiMerge {
    static constexpr bool PERM = true, AFTER_DRAIN = false, LAST_FUSED = false;
    const bf16 *sgr, *sgc; bf16* merged;
    __device__ __forceinline__ bool keep(const pg8::Unit& u) const { return u.z == 0; }
    __device__ __forceinline__ void operator()(Acc& acc, const pg8::Unit& u, int wr, int wc, int fr, int fq) const {
        const int row0 = u.pm * 256 + wr * 64 + fr, col0 = u.pn * 256 + wc * 32 + 8 * fq;
        const bf16* gsrc = ((u.z == 0) ? sgr : sgc) + (size_t)row0 * DM + col0;
        v4u gw[2][4][2];
#pragma unroll
        for (int ai = 0; ai < 2; ++ai)
#pragma unroll
            for (int m = 0; m < 4; ++m)
#pragma unroll
                for (int bj = 0; bj < 2; ++bj) gw[ai][m][bj] = *(const v4u*)(gsrc + (size_t)(ai * 128 + m * 16) * DM + bj * 128);
#pragma unroll
        for (int ai = 0; ai < 2; ++ai)
#pragma unroll
            for (int m = 0; m < 4; ++m) { const int row = row0 + ai * 128 + m * 16;
#pragma unroll
                for (int bj = 0; bj < 2; ++bj) { f32x4 g0, g1; unpack8(gw[ai][m][bj], g0, g1);
                    const f32x4 v0 = acc[ai][bj][m][0] * g0, v1 = acc[ai][bj][m][1] * g1;
                    if (u.z == 0) { acc[ai][bj][m][0] = v0; acc[ai][bj][m][1] = v1; }
                    else *(v4u*)(merged + (size_t)row * DM + col0 + bj * 128) = pack8(v0, v1); } }
    }
};
template <bool BASE_F32> struct EpiResid {
    static constexpr bool PERM = true, AFTER_DRAIN = false, LAST_FUSED = false;
    const float* basef; bf16* hb; float* ss;
    __device__ __forceinline__ bool keep(const pg8::Unit&) const { return false; }
    __device__ __forceinline__ void operator()(Acc& acc, const pg8::Unit& u, int wr, int wc, int fr, int fq) const {
        const int row0 = u.pm * 256 + wr * 64 + fr, col0 = u.pn * 256 + wc * 32 + 8 * fq;
        const size_t off0 = (size_t)row0 * DM + col0;
        constexpr int NPRE = BASE_F32 ? 4 : 8;
        f32x4 pf[BASE_F32 ? 4 : 1][2][2]; v4u pb[BASE_F32 ? 1 : 8][2];
#pragma unroll
        for (int g = 0; g < NPRE; ++g)
#pragma unroll
            for (int bj = 0; bj < 2; ++bj) { const size_t off = off0 + (size_t)((g >> 2) * 128 + (g & 3) * 16) * DM + bj * 128;
                if (BASE_F32) { pf[g][bj][0] = __builtin_nontemporal_load((const f32x4*)(basef + off)); pf[g][bj][1] = __builtin_nontemporal_load((const f32x4*)(basef + off + 4)); } else pb[g][bj] = *(const v4u*)(hb + off); }
#pragma unroll
        for (int g = 0; g < 8; ++g) { const int ai = g >> 2, m = g & 3; const int row = row0 + ai * 128 + m * 16; float sq = 0.f;
#pragma unroll
            for (int bj = 0; bj < 2; ++bj) { const size_t off = (size_t)row * DM + col0 + bj * 128; f32x4 b0, b1;
                if (BASE_F32) { b0 = pf[g & 3][bj][0]; b1 = pf[g & 3][bj][1]; } else unpack8(pb[g][bj], b0, b1);
                const f32x4 v0 = acc[ai][bj][m][0] + b0, v1 = acc[ai][bj][m][1] + b1;
                *(v4u*)(hb + off) = pack8(v0, v1);
                sq += (v0[0] * v0[0] + v0[1] * v0[1]) + (v0[2] * v0[2] + v0[3] * v0[3]) + (v1[0] * v1[0] + v1[1] * v1[1]) + (v1[2] * v1[2] + v1[3] * v1[3]); }
            if (BASE_F32 && g + 4 < 8) {
#pragma unroll
                for (int bj = 0; bj < 2; ++bj) { const size_t off = off0 + (size_t)(128 + m * 16) * DM + bj * 128; pf[g & 3][bj][0] = __builtin_nontemporal_load((const f32x4*)(basef + off)); pf[g & 3][bj][1] = __builtin_nontemporal_load((const f32x4*)(basef + off + 4)); } }
            sq += __shfl_xor(sq, 16); sq += __shfl_xor(sq, 32);
            if (fq == 0) atomicAdd(ss + row, sq); }
    }
};
struct EpiSoftmax {
    static constexpr bool PERM = true, AFTER_DRAIN = true, LAST_FUSED = false;
    const float* ss; bf16* P;
    __device__ __forceinline__ bool keep(const pg8::Unit&) const { return false; }
    __device__ __forceinline__ void fused(Acc& acc, const pg8::Unit& u, int wr, int wc, int fr, int fq, LAS unsigned char* lds, int wid, int lane) const {
        LAS float* Pm = (LAS float*)lds; LAS float* Ps = (LAS float*)(lds + 4096);
        const int rl0 = wr * 64 + fr, col0 = u.pn * 256 + wc * 32 + 8 * fq;
#pragma unroll
        for (int ai = 0; ai < 2; ++ai)
#pragma unroll
            for (int m = 0; m < 4; ++m) { const int rl = rl0 + ai * 128 + m * 16; const float rs = 1.0f / sqrtf(ss[u.pm * 256 + rl] * (1.0f / DM) + EPS); float mx = -3.0e38f;
#pragma unroll
                for (int bj = 0; bj < 2; ++bj)
#pragma unroll
                    for (int n = 0; n < 2; ++n) { f32x4 s = acc[ai][bj][m][n] * rs; acc[ai][bj][m][n] = s; mx = fmaxf(mx, fmaxf(fmaxf(s[0], s[1]), fmaxf(s[2], s[3]))); }
                mx = fmaxf(mx, __shfl_xor(mx, 16)); mx = fmaxf(mx, __shfl_xor(mx, 32));
                if (fq == 0) Pm[rl * 4 + wc] = mx; }
        asm volatile("s_waitcnt lgkmcnt(0)" ::: "memory"); __builtin_amdgcn_s_barrier(); asm volatile("" ::: "memory");
#pragma unroll
        for (int ai = 0; ai < 2; ++ai)
#pragma unroll
            for (int m = 0; m < 4; ++m) { const int rl = rl0 + ai * 128 + m * 16; const f32x4 pm4 = *(const LAS f32x4*)(Pm + rl * 4);
                const float mx = fmaxf(fmaxf(pm4[0], pm4[1]), fmaxf(pm4[2], pm4[3])); float sm = 0.f;
#pragma unroll
                for (int bj = 0; bj < 2; ++bj)
#pragma unroll
                    for (int n = 0; n < 2; ++n) { f32x4 s = acc[ai][bj][m][n];
#pragma unroll
                        for (int e = 0; e < 4; ++e) { s[e] = fast_exp2(s[e] - mx); sm += s[e]; }
                        acc[ai][bj][m][n] = s; }
                sm += __shfl_xor(sm, 16); sm += __shfl_xor(sm, 32);
                if (fq == 0) Ps[rl * 4 + wc] = sm; }
        asm volatile("s_waitcnt lgkmcnt(0)" ::: "memory"); __builtin_amdgcn_s_barrier(); asm volatile("" ::: "memory");
#pragma unroll
        for (int ai = 0; ai < 2; ++ai)
#pragma unroll
            for (int m = 0; m < 4; ++m) { const int rl = rl0 + ai * 128 + m * 16; const f32x4 ps4 = *(const LAS f32x4*)(Ps + rl * 4);
                const float inv = 1.0f / ((ps4[0] + ps4[1]) + (ps4[2] + ps4[3])); const size_t rowoff = (size_t)(u.pm * 256 + rl) * (4 * NMEM) + col0;
#pragma unroll
                for (int bj = 0; bj < 2; ++bj) *(v4u*)(P + rowoff + bj * 128) = pack8(acc[ai][bj][m][0] * inv, acc[ai][bj][m][1] * inv); }
    }
};
struct EpiSwiGLU {
    static constexpr bool PERM = true, AFTER_DRAIN = false, LAST_FUSED = false;
    const float* ss; bf16* act;
    __device__ __forceinline__ bool keep(const pg8::Unit&) const { return false; }
    __device__ __forceinline__ void operator()(Acc& acc, const pg8::Unit& u, int wr, int wc, int fr, int fq) const {
        const int row0 = u.pm * 256 + wr * 64 + fr, col0 = u.pn * 128 + wc * 32 + 8 * fq;
#pragma unroll
        for (int ai = 0; ai < 2; ++ai)
#pragma unroll
            for (int m = 0; m < 4; ++m) { const int row = row0 + ai * 128 + m * 16; const float rs = 1.0f / sqrtf(ss[row] * (1.0f / DM) + EPS); f32x4 o[2];
                const float nrl = -rs * LOG2E, rs2 = rs * rs;
#pragma unroll
                for (int n = 0; n < 2; ++n)
#pragma unroll
                    for (int e = 0; e < 4; ++e) { const float a = acc[ai][0][m][n][e], b = acc[ai][1][m][n][e];
                        o[n][e] = (a * b) * (rs2 * fast_rcp(1.f + fast_exp2(a * nrl))); }
                *(v4u*)(act + ((((size_t)u.pm * (DFF / 64) + (col0 >> 6)) * 256 + (row - u.pm * 256)) << 6) + (col0 & 63)) = pack8(o[0], o[1]); }
    }
};

#define XB_TMO      128
#define XB_XCNT(j)  (256  + 64 * (j))
#define XB_XSUB(j)  (1280 + 64 * (j))
#define XB_XGEN(j)  (2304 + 64 * (j))
#define XB_TOP      3328
#define XB_TOPGEN   3392
#define XCD_BAR_WORDS 3456
#define XB_SPIN_CAP (1u << 18)

__device__ __forceinline__ unsigned xb_ld(unsigned* p)              { return __hip_atomic_load(p, __ATOMIC_RELAXED, __HIP_MEMORY_SCOPE_AGENT); }
__device__ __forceinline__ unsigned xb_add(unsigned* p, unsigned v) { return __hip_atomic_fetch_add(p, v, __ATOMIC_RELAXED, __HIP_MEMORY_SCOPE_AGENT); }
__device__ __forceinline__ unsigned xb_xcc_id() { return (unsigned)__builtin_amdgcn_s_getreg((3 << 11) | 20) & 0xFu; }
#define XB_SPIN(cond, bar) do { unsigned _sp = 0; while (cond) { __builtin_amdgcn_s_sleep(1); \
    if ((++_sp & 255u) == 0u) { if (xb_ld(&(bar)[XB_TMO])) break; if (_sp > XB_SPIN_CAP) { atomicAdd(&(bar)[XB_TMO], 1u); break; } } } } while (0)

struct XcdBarrier { unsigned* bar; unsigned x; volatile LAS unsigned* st; };

__device__ __forceinline__ XcdBarrier xcd_barrier_post(unsigned* bar, volatile LAS unsigned* st) {
    XcdBarrier b; b.bar = bar; b.x = xb_xcc_id(); b.st = st;
    if (threadIdx.x == 0) (void)xb_add(&bar[XB_XCNT(b.x)], 1u);
    return b;
}
__device__ __forceinline__ void xcd_barrier_complete(unsigned* bar, unsigned x, unsigned& nloc, unsigned& nx) {
    const unsigned G = gridDim.x * gridDim.y * gridDim.z;
    unsigned sum, cnt, mine, sp = 0u;
    for (;;) {
        sum = 0u; cnt = 0u; mine = 0u;
#pragma unroll
        for (unsigned j = 0; j < 16; ++j) { const unsigned c = xb_ld(&bar[XB_XCNT(j)]); sum += c; cnt += (c > 0u) ? 1u : 0u; mine = (j == x) ? c : mine; }
        if (sum == G) break;
        __builtin_amdgcn_s_sleep(1);
        if ((++sp & 255u) == 0u) { if (xb_ld(&bar[XB_TMO])) break; if (sp > XB_SPIN_CAP) { atomicAdd(&bar[XB_TMO], 1u); break; } }
    }
    nloc = mine > 0u ? mine : 1u; nx = cnt > 0u ? cnt : 1u;
}
__device__ __forceinline__ void xcd_barrier(const XcdBarrier& b) {
    asm volatile("s_waitcnt vmcnt(0)" ::: "memory");
    __syncthreads();
    if (threadIdx.x == 0) {
        unsigned* bar = b.bar;
        __builtin_amdgcn_s_waitcnt(0);
        unsigned nloc = b.st[0], nx = b.st[1];
        if (nloc == 0u) { xcd_barrier_complete(bar, b.x, nloc, nx); b.st[0] = nloc; b.st[1] = nx; }
        const unsigned old = xb_add(&bar[XB_XSUB(b.x)], 1u);
        const unsigned gen = old / nloc;
        if (old + 1u == (gen + 1u) * nloc) {
            __builtin_amdgcn_fence(__ATOMIC_RELEASE, "agent");
            asm volatile("s_waitcnt vmcnt(0)" ::: "memory");
            const unsigned og = xb_add(&bar[XB_TOP], 1u);
            const unsigned tg = og / nx;
            if (og + 1u == (tg + 1u) * nx) xb_add(&bar[XB_TOPGEN], 1u);
            else XB_SPIN(xb_ld(&bar[XB_TOPGEN]) == tg, bar);
            __builtin_amdgcn_fence(__ATOMIC_ACQUIRE, "agent");
            xb_add(&bar[XB_XGEN(b.x)], 1u);
            asm volatile("s_waitcnt vmcnt(0)" ::: "memory");
        } else {
            XB_SPIN(xb_ld(&bar[XB_XGEN(b.x)]) == gen, bar);
            __builtin_amdgcn_fence(__ATOMIC_ACQUIRE, "agent");
            asm volatile("s_waitcnt vmcnt(0)" ::: "memory");
        }
    }
    __syncthreads();
}


__device__ __forceinline__ void group_barrier(unsigned* cnt, unsigned target, unsigned* extra, unsigned* tmo, bool same_xcd) {
    asm volatile("s_waitcnt vmcnt(0)" ::: "memory");
    __syncthreads();
    if (threadIdx.x == 0) {
        __builtin_amdgcn_s_waitcnt(0);
        if (!same_xcd) { __builtin_amdgcn_fence(__ATOMIC_RELEASE, "agent"); asm volatile("s_waitcnt vmcnt(0)" ::: "memory"); }
        (void)xb_add(cnt, 1u);
        if (extra) (void)xb_add(extra, 1u);
        unsigned sp = 0;
        while (xb_ld(cnt) < target) { __builtin_amdgcn_s_sleep(1); if ((++sp & 255u) == 0u) { if (xb_ld(tmo)) break; if (sp > XB_SPIN_CAP) { atomicAdd(tmo, 1u); break; } } }
        __builtin_amdgcn_fence(__ATOMIC_ACQUIRE, "agent");
        asm volatile("s_waitcnt vmcnt(0)" ::: "memory");
    }
    __syncthreads();
}
__device__ __forceinline__ void wait_global(unsigned* cnt, unsigned target, unsigned* tmo) {
    if (threadIdx.x == 0) {
        unsigned sp = 0;
        while (xb_ld(cnt) < target) { __builtin_amdgcn_s_sleep(1); if ((++sp & 255u) == 0u) { if (xb_ld(tmo)) break; if (sp > XB_SPIN_CAP) { atomicAdd(tmo, 1u); break; } } }
        __builtin_amdgcn_fence(__ATOMIC_ACQUIRE, "agent");
        asm volatile("s_waitcnt vmcnt(0)" ::: "memory");
    }
    __syncthreads();
}

struct EpiFinal {
    static constexpr bool PERM = true, AFTER_DRAIN = false, LAST_FUSED = true;
    bf16* hb; float* ss; float* out; const float* gfin; unsigned* gcnt; unsigned target; unsigned* glob1; unsigned* tmo; bool same_xcd;
    __device__ __forceinline__ bool keep(const pg8::Unit&) const { return false; }
    __device__ __forceinline__ void operator()(Acc& acc, const pg8::Unit& u, int wr, int wc, int fr, int fq) const { const EpiResid<false> E{nullptr, hb, ss}; E(acc, u, wr, wc, fr, fq); }
    __device__ __forceinline__ void fused(Acc& acc, const pg8::Unit& u, int wr, int wc, int fr, int fq, LAS unsigned char* lds, int wid, int lane) const {
        const int row0 = u.pm * 256 + wr * 64 + fr, col0 = u.pn * 256 + wc * 32 + 8 * fq;
        const size_t off0 = (size_t)row0 * DM + col0;
        v4u pb[8][2];
#pragma unroll
        for (int g = 0; g < 8; ++g)
#pragma unroll
            for (int bj = 0; bj < 2; ++bj) pb[g][bj] = *(const v4u*)(hb + off0 + (size_t)((g >> 2) * 128 + (g & 3) * 16) * DM + bj * 128);
#pragma unroll
        for (int g = 0; g < 8; ++g) { const int ai = g >> 2, m = g & 3; const int row = row0 + ai * 128 + m * 16; float sq = 0.f;
#pragma unroll
            for (int bj = 0; bj < 2; ++bj) { f32x4 b0, b1; unpack8(pb[g][bj], b0, b1);
                const f32x4 v0 = acc[ai][bj][m][0] + b0, v1 = acc[ai][bj][m][1] + b1; acc[ai][bj][m][0] = v0; acc[ai][bj][m][1] = v1;
                sq += (v0[0] * v0[0] + v0[1] * v0[1]) + (v0[2] * v0[2] + v0[3] * v0[3]) + (v1[0] * v1[0] + v1[1] * v1[1]) + (v1[2] * v1[2] + v1[3] * v1[3]); }
            sq += __shfl_xor(sq, 16); sq += __shfl_xor(sq, 32);
            if (fq == 0) atomicAdd(ss + row, sq); }
        group_barrier(gcnt, target, nullptr, tmo, same_xcd);
        wait_global(glob1, 256u, tmo);
        const int col1 = col0 - 1024;
        { f32x4 gv[2][2];
#pragma unroll
          for (int bj = 0; bj < 2; ++bj) { gv[bj][0] = *(const f32x4*)(gfin + col0 + bj * 128); gv[bj][1] = *(const f32x4*)(gfin + col0 + bj * 128 + 4); }
#pragma unroll
          for (int g = 0; g < 8; ++g) { const int ai = g >> 2, m = g & 3; const int row = row0 + ai * 128 + m * 16; const float rs = 1.0f / sqrtf(ss[row] * (1.0f / DM) + EPS);
#pragma unroll
            for (int bj = 0; bj < 2; ++bj) { float* o = out + (size_t)row * DM + col0 + bj * 128; __builtin_nontemporal_store(acc[ai][bj][m][0] * rs * gv[bj][0], (f32x4*)o); __builtin_nontemporal_store(acc[ai][bj][m][1] * rs * gv[bj][1], (f32x4*)(o + 4)); } } }
        asm volatile("" ::: "memory");
        { f32x4 gw[2][2];
#pragma unroll
          for (int bj = 0; bj < 2; ++bj) { gw[bj][0] = *(const f32x4*)(gfin + col1 + bj * 128); gw[bj][1] = *(const f32x4*)(gfin + col1 + bj * 128 + 4); }
#pragma unroll
          for (int g = 0; g < 8; ++g)
#pragma unroll
            for (int bj = 0; bj < 2; ++bj) pb[g][bj] = *(const v4u*)(hb + off0 - 1024 + (size_t)((g >> 2) * 128 + (g & 3) * 16) * DM + bj * 128);
#pragma unroll
          for (int g = 0; g < 8; ++g) { const int ai = g >> 2, m = g & 3; const int row = row0 + ai * 128 + m * 16; const float rs = 1.0f / sqrtf(ss[row] * (1.0f / DM) + EPS);
#pragma unroll
            for (int bj = 0; bj < 2; ++bj) { f32x4 b0, b1; unpack8(pb[g][bj], b0, b1); float* o1 = out + (size_t)row * DM + col1 + bj * 128; __builtin_nontemporal_store(b0 * rs * gw[bj][0], (f32x4*)o1); __builtin_nontemporal_store(b1 * rs * gw[bj][1], (f32x4*)(o1 + 4)); } } }
    }
};

__device__ __forceinline__ float wave_sum(float v) {
#pragma unroll
    for (int o = 1; o < 64; o <<= 1) v += __shfl_xor(v, o);
    return v;
}
__device__ __forceinline__ int rope_sigma(int p) { return (p < 16) ? ((p & 3) + 4 * ((p >> 3) & 1) + 8 * ((p >> 2) & 1)) : p; }
struct TpItem { const float* src; bf16* dst; const float* ks; int ldw, ldd, perm; float cscale; };
struct TpPtrs { const float *w_in, *w_attn_o, *w_conv_o, *w_out, *w_xkv, *w_xo, *w_gate_up, *w_down, *g_ffn; bf16 *WinT, *WacT, *WoutT, *WxkvT, *wxot, *WguT, *WdT; };
constexpr int TP_I0 = 32 * 272, TP_I1 = 16 * 64, TP_I2 = 16 * 64, TP_I3 = 32 * 64, TP_I4 = 32 * 32, TP_I7 = 8 * 64, TP_I5 = 32 * 352, TP_I6 = 88 * 64;
constexpr int TP_NEARLY = TP_I0 + TP_I1 + TP_I2 + TP_I3 + TP_I4 + TP_I7, TP_NITEMS = TP_NEARLY + TP_I5 + TP_I6;
__device__ __forceinline__ TpItem tp_mk(const float* W, int ldw, int src_col0, int k0, bf16* dst, int ldd, int dst_row0, int dst_col0, const float* kscale, int perm, float cscale = 1.f) {
    TpItem d; d.cscale = cscale; d.src = W + (size_t)k0 * ldw + src_col0; d.dst = dst + (size_t)dst_row0 * ldd + dst_col0 + k0; d.ks = kscale ? kscale + k0 : nullptr; d.ldw = ldw; d.ldd = ldd; d.perm = perm; return d; }
__device__ __forceinline__ TpItem tp_desc(int it, const TpPtrs& P) {
    int r = it;
    if (r < TP_I0) { const int kb_ = r / 272, Gp = r % 272; int src, perm = 0;
        if (Gp < 40) { src = 32 * Gp; perm = ((Gp & 1) == 0) ? 1 : 0; }
        else if (Gp < 80) { src = 32 * Gp; }
        else if (Gp < 144) { const int gg = Gp - 80, t = gg >> 3, i32 = gg & 7; src = (i32 < 4) ? (2560 + 128 * t + 32 * i32) : (3584 + 128 * t + 32 * (i32 - 4)); }
        else { const int gg = Gp - 144, t = gg >> 3, i32 = gg & 7; src = (i32 < 4) ? (4608 + 128 * t + 32 * i32) : (6656 + 128 * t + 32 * (i32 - 4)); }
        return tp_mk(P.w_in, NIN, src, 64 * kb_, P.WinT, DM, 32 * Gp, 0, nullptr, perm, Gp >= 144 ? -LOG2E : 1.f); } r -= TP_I0;
    if (r < TP_I1) { const int kb_ = r / 64, Gp = r % 64; return tp_mk(P.w_attn_o, DM, 32 * Gp, 64 * kb_, P.WacT, DM, 32 * Gp, 0, nullptr, 0); } r -= TP_I1;
    if (r < TP_I2) { const int kb_ = r / 64, Gp = r % 64; return tp_mk(P.w_conv_o, DM, 32 * Gp, 64 * kb_, P.WacT, DM, 32 * Gp, 1024, nullptr, 0); } r -= TP_I2;
    if (r < TP_I3) { const int kb_ = r / 64, Gp = r % 64; return tp_mk(P.w_out, DM, 32 * Gp, 64 * kb_, P.WoutT, DM, 32 * Gp, 0, nullptr, 0); } r -= TP_I3;
    if (r < TP_I4) { const int kb_ = r / 32, Gp = r % 32; return tp_mk(P.w_xkv, 2 * XW, 32 * Gp, 64 * kb_, P.WxkvT, DM, 32 * Gp, 0, nullptr, 0); } r -= TP_I4;
    if (r < TP_I7) { const int kb_ = r / 64, Gp = r % 64; return tp_mk(P.w_xo, DM, 32 * Gp, 64 * kb_, P.wxot, XW, 32 * Gp, 0, nullptr, 0); } r -= TP_I7;
    if (r < TP_I5) { const int kb_ = r / 352, Gp = r % 352; const int t = Gp >> 3, i32 = Gp & 7; const int src = (i32 < 4) ? (128 * t + 32 * i32) : (DFF + 128 * t + 32 * (i32 - 4));
        return tp_mk(P.w_gate_up, 2 * DFF, src, 64 * kb_, P.WguT, DM, 32 * Gp, 0, P.g_ffn, 0); } r -= TP_I5;
    { const int kb_ = r / 64, Gp = r % 64; return tp_mk(P.w_down, DM, 32 * Gp, 64 * kb_, P.WdT, DFF, 32 * Gp, 0, nullptr, 0); }
}
__device__ __forceinline__ void tp_load(const TpItem& d, float (&tv)[32], int lane) {
    const float* sp = d.src + (size_t)(lane >> 5) * d.ldw + (lane & 31);
#pragma unroll
    for (int i = 0; i < 32; ++i) tv[i] = __builtin_nontemporal_load(sp + (size_t)(2 * i) * d.ldw);
}
__device__ __forceinline__ void tp_finish(const TpItem& d, const float (&tv)[32], LAS float* scr, int lane) {
#pragma unroll
    for (int i = 0; i < 32; ++i) scr[(2 * i + (lane >> 5)) * 33 + (lane & 31)] = tv[i];
    LDS_WAIT(); asm volatile("" ::: "memory");
    const int c = lane & 7;
    float sc[8];
#pragma unroll
    for (int i = 0; i < 8; ++i) sc[i] = d.ks ? d.ks[8 * c + i] * d.cscale : d.cscale;
#pragma unroll
    for (int j = 0; j < 4; ++j) { const int nd = (lane >> 3) + 8 * j; const int scol = d.perm ? rope_sigma(nd) : nd; const LAS float* s = scr + (8 * c) * 33 + scol;
        v4u o; o.x = cvt_pk_bf16(s[0 * 33] * sc[0], s[1 * 33] * sc[1]); o.y = cvt_pk_bf16(s[2 * 33] * sc[2], s[3 * 33] * sc[3]);
        o.z = cvt_pk_bf16(s[4 * 33] * sc[4], s[5 * 33] * sc[5]); o.w = cvt_pk_bf16(s[6 * 33] * sc[6], s[7 * 33] * sc[7]);
        *(v4u*)(d.dst + (size_t)nd * d.ldd + 8 * c) = o; }
    LDS_WAIT(); asm volatile("" ::: "memory");
}
__device__ __forceinline__ void tp_run(int it0, int it_end, int stride, const TpPtrs& P, LAS float* scr, int lane) {
    if (it0 >= it_end) return;
    TpItem d = tp_desc(it0, P); float tv[32]; tp_load(d, tv, lane);
    for (int it = it0; it < it_end; it += stride) {
        const int nx = it + stride; const bool more = nx < it_end; TpItem dn = d; float tn[32];
        if (more) { dn = tp_desc(nx, P); tp_load(dn, tn, lane); }
        tp_finish(d, tv, scr, lane);
        if (more) { d = dn;
#pragma unroll
            for (int i = 0; i < 32; ++i) tv[i] = tn[i]; }
    }
}
__device__ __forceinline__ void tp_run3(int it0, int it_end, int stride, const TpPtrs& P, LAS float* scr, int lane) {
    if (it0 >= it_end) return;
    TpItem d0 = tp_desc(it0, P), d1 = d0; float t0[32], t1[32]; tp_load(d0, t0, lane);
    if (it0 + stride < it_end) { d1 = tp_desc(it0 + stride, P); tp_load(d1, t1, lane); }
    for (int it = it0; it < it_end; it += stride) {
        const int n2 = it + 2 * stride; const bool more2 = n2 < it_end; TpItem d2 = d0; float t2[32];
        if (more2) { d2 = tp_desc(n2, P); tp_load(d2, t2, lane); }
        tp_finish(d0, t0, scr, lane);
        d0 = d1; d1 = d2;
#pragma unroll
        for (int i = 0; i < 32; ++i) { t0[i] = t1[i]; t1[i] = t2[i]; }
    }
}
__device__ __forceinline__ void rms_rows_to_bf16(const float* xb, const float* g, bf16* ob, int m0, int m_end, int stride, int lane) {
    if (m0 >= m_end) return;
    f32x4 v[8];
    { const f32x4* xr = (const f32x4*)(xb + (size_t)m0 * DM) + lane;
#pragma unroll
      for (int j = 0; j < 8; ++j) v[j] = __builtin_nontemporal_load(xr + 64 * j); }
    f32x4 gg[8];
#pragma unroll
    for (int j = 0; j < 8; ++j) gg[j] = ((const f32x4*)g + lane)[64 * j];
    for (int m = m0; m < m_end; m += stride) {
        const int nx = m + stride; const bool more = nx < m_end; f32x4 vn[8];
        if (more) { const f32x4* xr = (const f32x4*)(xb + (size_t)nx * DM) + lane;
#pragma unroll
            for (int j = 0; j < 8; ++j) vn[j] = __builtin_nontemporal_load(xr + 64 * j); }
        float s = 0.f;
#pragma unroll
        for (int j = 0; j < 8; ++j) s += (v[j].x * v[j].x + v[j].y * v[j].y) + (v[j].z * v[j].z + v[j].w * v[j].w);
        const float rstd = 1.0f / sqrtf(wave_sum(s) * (1.0f / DM) + EPS);
        v2u* o8 = (v2u*)(ob + (size_t)m * DM) + lane;
#pragma unroll
        for (int j = 0; j < 8; ++j) { v2u w; w.x = cvt_pk_bf16(v[j].x * rstd * gg[j].x, v[j].y * rstd * gg[j].y); w.y = cvt_pk_bf16(v[j].z * rstd * gg[j].z, v[j].w * rstd * gg[j].w); o8[64 * j] = w; }
        if (more) {
#pragma unroll
            for (int j = 0; j < 8; ++j) v[j] = vn[j]; }
    }
}

__device__ __forceinline__ s16x4 vtr(const LAS unsigned char* p) { typedef short v4i16_t __attribute__((ext_vector_type(4))); return __builtin_bit_cast(s16x4, __builtin_amdgcn_ds_read_tr16_b64_v4i16((LAS v4i16_t*)p)); }

struct ConvCtx { const bf16* zc; bf16* xn; int ts, cg; f32x4 w0[2], w1[2], w2[2], p1[2], p2[2]; };
__device__ __forceinline__ void conv_issue(const ConvCtx& c, int batch, v4u (&zb)[4], v4u (&zp)[4]) {
#pragma unroll
    for (int i = 0; i < 4; ++i) { const bf16* zr = c.zc + (size_t)(c.ts + 4 * batch + i) * (2 * CW) + 8 * c.cg; zb[i] = *(const v4u*)(zr); zp[i] = *(const v4u*)(zr + CW); }
}
__device__ __forceinline__ void conv_finish(ConvCtx& c, int batch, const v4u (&zb)[4], const v4u (&zp)[4]) {
#pragma unroll
    for (int i = 0; i < 4; ++i) { f32x4 cb0, cb1, p0a, p0b; unpack8(zb[i], cb0, cb1); unpack8(zp[i], p0a, p0b);
        const f32x4 y0 = cb0 * (c.w0[0] * c.p2[0] + c.w1[0] * c.p1[0] + c.w2[0] * p0a), y1 = cb1 * (c.w0[1] * c.p2[1] + c.w1[1] * c.p1[1] + c.w2[1] * p0b);
        *(v4u*)(c.xn + (size_t)(c.ts + 4 * batch + i) * DM + AW + 8 * c.cg) = pack8(y0, y1);
        c.p2[0] = c.p1[0]; c.p2[1] = c.p1[1]; c.p1[0] = p0a; c.p1[1] = p0b; }
}
__device__ __forceinline__ void conv_init(ConvCtx& c, const bf16* zc, bf16* xn, const float* conv_w, int chunk, int tid) {
    c.zc = zc; c.xn = xn; c.cg = tid & 127; c.ts = chunk * 64 + (tid >> 7) * 16;
#pragma unroll
    for (int j = 0; j < 2; ++j) { c.w0[j] = *(const f32x4*)(conv_w + 8 * c.cg + 4 * j); c.w1[j] = *(const f32x4*)(conv_w + CW + 8 * c.cg + 4 * j); c.w2[j] = *(const f32x4*)(conv_w + 2 * CW + 8 * c.cg + 4 * j);
        c.p2[j] = (f32x4){0.f, 0.f, 0.f, 0.f}; c.p1[j] = c.p2[j]; }
    if (c.ts >= 2) { unpack8(*(const v4u*)(zc + (size_t)(c.ts - 2) * (2 * CW) + CW + 8 * c.cg), c.p2[0], c.p2[1]); unpack8(*(const v4u*)(zc + (size_t)(c.ts - 1) * (2 * CW) + CW + 8 * c.cg), c.p1[0], c.p1[1]); }
}
template <bool CONV>
__device__ __forceinline__ void swa_unit(LAS unsigned char* lds, int n, int g, const bf16* qb, const bf16* kb, const bf16* vb, const float* sinks, bf16* A2, int tid, int lane, int wave, ConvCtx& cc, int batch0) {
    LAS unsigned char* Kl = lds; LAS unsigned char* Vl = lds + 32768;
#pragma unroll
    for (int i = 0; i < 4; ++i) { const int id = tid + 512 * i, row = id >> 3, ch = id & 7; const int tok = (n - 1) * 128 + row;
        v4u kv = (v4u){0u, 0u, 0u, 0u}, vv = (v4u){0u, 0u, 0u, 0u};
        if (tok >= 0) { kv = *(const v4u*)(kb + (size_t)tok * KVW + g * 64 + ch * 8); vv = *(const v4u*)(vb + (size_t)tok * KVW + g * 64 + ch * 8); }
        *(LAS v4u*)(Kl + row * 128 + ((ch ^ ((row >> 1) & 7)) << 4)) = kv;
        *(LAS v4u*)(Vl + row * 128 + ((ch ^ (((row >> 1) & 1) << 2)) << 4)) = vv; }
    __syncthreads();
    const int ql = lane & 31, h = lane >> 5, hq = g * 4 + (wave & 3);
    const float sinkl = sinks[hq] * LOG2E;
    const int li = lane & 15, qp = li >> 2, pp = li & 3, g1 = (lane >> 4) & 1;
    const float NEG = -__builtin_inff();
#pragma unroll 1
    for (int st = 0; st < 2; ++st) {
        const int r0 = (wave >> 2) * 64 + 32 * st; const size_t tok = (size_t)n * 128 + r0 + ql;
        bf16x8 qf[4];
#pragma unroll
        for (int ks = 0; ks < 4; ++ks) qf[ks] = *(const bf16x8*)(qb + tok * AW + hq * 64 + 16 * ks + 8 * h);
        v4u zb[4], zp[4];
        if (CONV) conv_issue(cc, batch0 + st, zb, zp);
        f32x16 S[5];
#pragma unroll
        for (int t = 0; t < 5; ++t) { const int c = r0 + 32 * t + ql; S[t] = (f32x16){};
#pragma unroll
            for (int ks = 0; ks < 4; ++ks) { const bf16x8 kf = *(const LAS bf16x8*)(Kl + c * 128 + (((2 * ks + h) ^ ((c >> 1) & 7)) << 4));
                S[t] = __builtin_amdgcn_mfma_f32_32x32x16_bf16(kf, qf[ks], S[t], 0, 0, 0); } }
#pragma unroll
        for (int r = 0; r < 16; ++r) { const int cc = (r & 3) + 8 * (r >> 2) + 4 * h; if (!(cc > ql)) S[0][r] = NEG; if (!(cc <= ql)) S[4][r] = NEG; }
        if (n == 0) {
#pragma unroll
            for (int t = 0; t < 5; ++t)
#pragma unroll
                for (int r = 0; r < 16; ++r) { const int cc = (r & 3) + 8 * (r >> 2) + 4 * h; if (r0 + 32 * t + cc < 128) S[t][r] = NEG; } }
        float mx = sinkl;
#pragma unroll
        for (int t = 0; t < 5; ++t)
#pragma unroll
            for (int r = 0; r < 16; ++r) mx = fmaxf(mx, S[t][r]);
        mx = fmaxf(mx, __shfl_xor(mx, 32));
        float l = 0.f;
#pragma unroll
        for (int t = 0; t < 5; ++t)
#pragma unroll
            for (int r = 0; r < 16; ++r) { const float p = fast_exp2(S[t][r] - mx); S[t][r] = p; l += p; }
        l += __shfl_xor(l, 32); l += fast_exp2(sinkl - mx);
        f32x16 O[2]; O[0] = (f32x16){}; O[1] = (f32x16){};
#pragma unroll
        for (int t = 0; t < 5; ++t)
#pragma unroll
            for (int s = 0; s < 2; ++s) {
                v4u pw; pw.x = cvt_pk_bf16(S[t][8 * s + 0], S[t][8 * s + 1]); pw.y = cvt_pk_bf16(S[t][8 * s + 2], S[t][8 * s + 3]);
                pw.z = cvt_pk_bf16(S[t][8 * s + 4], S[t][8 * s + 5]); pw.w = cvt_pk_bf16(S[t][8 * s + 6], S[t][8 * s + 7]);
                const bf16x8 pf = __builtin_bit_cast(bf16x8, pw);
                const int krow = r0 + 32 * t + 16 * s + 4 * h + qp;
#pragma unroll
                for (int db = 0; db < 2; ++db) { const int chunk = (4 * db + 2 * g1 + (pp >> 1)) ^ (((qp >> 1) & 1) << 2);
                    const LAS unsigned char* va = Vl + krow * 128 + (chunk << 4) + (pp & 1) * 8;
                    const s16x4 lo = vtr(va), hi = vtr(va + 8 * 128);
                    const bf16x8 vf = (bf16x8){lo[0], lo[1], lo[2], lo[3], hi[0], hi[1], hi[2], hi[3]};
                    O[db] = __builtin_amdgcn_mfma_f32_32x32x16_bf16(vf, pf, O[db], 0, 0, 0); } }
        const float inv = 1.0f / l;
#pragma unroll
        for (int db = 0; db < 2; ++db)
#pragma unroll
            for (int pr = 0; pr < 2; ++pr) { const int ra = 8 * pr, rb = 8 * pr + 4;
                unsigned ax = cvt_pk_bf16(O[db][ra + 0] * inv, O[db][ra + 1] * inv), ay = cvt_pk_bf16(O[db][ra + 2] * inv, O[db][ra + 3] * inv);
                unsigned bx_ = cvt_pk_bf16(O[db][rb + 0] * inv, O[db][rb + 1] * inv), by = cvt_pk_bf16(O[db][rb + 2] * inv, O[db][rb + 3] * inv);
                { auto r = __builtin_amdgcn_permlane32_swap(ax, bx_, false, false); ax = r[0]; bx_ = r[1]; }
                { auto r = __builtin_amdgcn_permlane32_swap(ay, by, false, false); ay = r[0]; by = r[1]; }
                *(v4u*)(A2 + tok * DM + hq * 64 + 32 * db + 16 * pr + 8 * h) = (v4u){ax, ay, bx_, by}; }
        if (CONV) conv_finish(cc, batch0 + st, zb, zp);
    }
    __syncthreads();
}
__device__ __forceinline__ void wave_gemm_64x32_k128(const bf16* A, int lda, const bf16* Bt, int ldb, bf16* C, int ldc, int lane) {
    const int fr = lane & 15, fq = lane >> 4;
    f32x4 acc[4][2];
#pragma unroll
    for (int mi = 0; mi < 4; ++mi)
#pragma unroll
        for (int ni = 0; ni < 2; ++ni) acc[mi][ni] = (f32x4){0.f, 0.f, 0.f, 0.f};
#pragma unroll
    for (int ks = 0; ks < 4; ++ks) { bf16x8 a[4], b[2];
#pragma unroll
        for (int mi = 0; mi < 4; ++mi) a[mi] = *(const bf16x8*)(A + (size_t)(16 * mi + fr) * lda + 32 * ks + 8 * fq);
#pragma unroll
        for (int ni = 0; ni < 2; ++ni) b[ni] = *(const bf16x8*)(Bt + (size_t)(16 * ni + fr) * ldb + 32 * ks + 8 * fq);
#pragma unroll
        for (int mi = 0; mi < 4; ++mi)
#pragma unroll
            for (int ni = 0; ni < 2; ++ni) acc[mi][ni] = __builtin_amdgcn_mfma_f32_16x16x32_bf16(b[ni], a[mi], acc[mi][ni], 0, 0, 0); }
#pragma unroll
    for (int mi = 0; mi < 4; ++mi)
#pragma unroll
        for (int ni = 0; ni < 2; ++ni) { v2u w; w.x = cvt_pk_bf16(acc[mi][ni][0], acc[mi][ni][1]); w.y = cvt_pk_bf16(acc[mi][ni][2], acc[mi][ni][3]);
            st8_wt(C + (size_t)(16 * mi + fr) * ldc + 16 * ni + 4 * fq, w); }
}

constexpr int NPHASE = 10;
struct Args { const float* in[18]; float* out; unsigned char* ws; int ph_lo, ph_hi, li, pad; };

__global__ void __launch_bounds__(512, 2) hyb_fwd(Args args) {
    extern __shared__ __attribute__((aligned(16))) unsigned char lds_raw[];
    LAS unsigned char* lds = (LAS unsigned char*)lds_raw;
    volatile LAS unsigned* MISC = (volatile LAS unsigned*)(lds + MISC_OFF);
    const int tid = threadIdx.x, lane = tid & 63, wave = __builtin_amdgcn_readfirstlane(tid >> 6);
    const int G = gridDim.x, bx = blockIdx.x;
    unsigned char* ws = args.ws;
    unsigned* ctl = (unsigned*)(ws + WS_CTL);
    const float* x = args.in[0]; const float* mem = args.in[1]; const float* g_mix = args.in[2]; const float* w_in = args.in[3]; const float* conv_w = args.in[4];
    const float* sinks = args.in[5]; const float* w_attn_o = args.in[6]; const float* w_conv_o = args.in[7]; const float* w_out = args.in[8]; const float* g_xattn = args.in[9];
    const float* g_mem = args.in[10]; const float* w_xq = args.in[11]; const float* w_xkv = args.in[12]; const float* w_xo = args.in[13]; const float* g_ffn = args.in[14];
    const float* w_gate_up = args.in[15]; const float* w_down = args.in[16]; const float* g_final = args.in[17];
    float* out = args.out;
    float* ss1 = (float*)(ws + WS_SS); float* ss2 = ss1 + SEQ; float* ss3 = ss2 + SEQ;
    float* cs = (float*)(ws + WS_CS);
    bf16* kvb = (bf16*)(ws + WS_KVB); bf16* memn = (bf16*)(ws + WS_MEMN); bf16* wxqp = (bf16*)(ws + WS_WXQ); bf16* wxot = (bf16*)(ws + WS_WXOT);
    bf16* WguT = (bf16*)(ws + WS_WGUT); bf16* WdT = (bf16*)(ws + WS_WDT); bf16* XN = (bf16*)(ws + WS_XN);
    bf16* WinT = (bf16*)(ws + WS_WINT); bf16* WacT = (bf16*)(ws + WS_WACT); bf16* WoutT = (bf16*)(ws + WS_WOUTT); bf16* WxkvT = (bf16*)(ws + WS_WXKVT);
    bf16* WqKT = (bf16*)(ws + WS_WQKT); bf16* VWoT = (bf16*)(ws + WS_VWOT);
    bf16* qb = (bf16*)(ws + WS_Q); bf16* kb = (bf16*)(ws + WS_K); bf16* vb = (bf16*)(ws + WS_V); bf16* zc = (bf16*)(ws + WS_ZC);
    bf16* Pb = (bf16*)(ws + WS_P); bf16* act = (bf16*)(ws + WS_ACT);
    bf16* sgr = (bf16*)out; bf16* sgc = sgr + (size_t)SEQ * DM;
    bf16* merged = sgr;

    for (int u = tid; u < (LDS_BYTES - LDSCTL_OFF) / 4; u += 512) ((LAS unsigned*)(lds + LDSCTL_OFF))[u] = 0u;
    __syncthreads();
    XcdBarrier bar; bar.bar = ctl + CW_BAR; bar.x = 0; bar.st = nullptr;
    if (MK_N_LAUNCHES == 1) bar = xcd_barrier_post(ctl + CW_BAR, MISC + 8);
    if (tid == 0) __hip_atomic_store(ctl + CW_XID + 64 * (bx & 63) + (bx >> 6), xb_xcc_id() + 1u, __ATOMIC_RELAXED, __HIP_MEMORY_SCOPE_AGENT);
    const int lo = args.ph_lo, hi = args.ph_hi;
    const bool tailfill = (G == 256);
#define IN(k) (lo <= (k) && (k) < hi)
#ifdef PROBE_PHASE
    int n_stamp = 0;
#define STAMP() do { if (bx == 0 && tid == 0) { ((volatile LAS unsigned long long*)(lds + MISC_OFF + 128))[n_stamp] = __builtin_amdgcn_s_memrealtime(); ((volatile LAS unsigned long long*)(lds + MISC_OFF + 256))[n_stamp] = __builtin_amdgcn_s_memtime(); } ++n_stamp; } while (0)
#define SUBSTAMP(i) do { __builtin_amdgcn_s_waitcnt(0); if (bx == 0 && tid == 0) ((volatile LAS unsigned long long*)(lds + MISC_OFF + 128))[40 + (i)] = __builtin_amdgcn_s_memrealtime(); } while (0)
#else
#define STAMP() do { } while (0)
#define SUBSTAMP(i) do { } while (0)
#endif
#define SEAM(k) do { if (IN(k) && IN((k) + 1)) xcd_barrier(bar); STAMP(); } while (0)
    const bool grp = (G == 256) && (MK_N_LAUNCHES == 1);
    const int pm_own = 8 * (bx & 7) + ((bx >> 3) & 7), jmem = bx >> 6;
    unsigned* gcnt = ctl + CW_GRP + 64 * (bx & 63); unsigned* glob = ctl + CW_GLOB; unsigned* gtmo = ctl + CW_BAR + XB_TMO;
    unsigned gepoch = 0; bool same_xcd = false;
#define GSEAM(k, extra) do { if (IN(k) && IN((k) + 1)) { if (grp) { gepoch += 4u; group_barrier(gcnt, gepoch, (extra), gtmo, same_xcd); } else xcd_barrier(bar); } STAMP(); } while (0)
    STAMP();

    const TpPtrs TP{w_in, w_attn_o, w_conv_o, w_out, w_xkv, w_xo, w_gate_up, w_down, g_ffn, WinT, WacT, WoutT, WxkvT, wxot, WguT, WdT};
    if (IN(0)) {
        LAS float* scr = (LAS float*)(lds + wave * 16384);
        const int gw = bx * 8 + wave, NGW = G * 8;
        SUBSTAMP(0);
        if (bx & 1) rms_rows_to_bf16(x, g_mix, XN, gw, SEQ, NGW, lane);
        tp_run(gw, tailfill ? TP_NEARLY : TP_NITEMS, NGW, TP, scr, lane);
        SUBSTAMP(1);
        if (!(bx & 1)) rms_rows_to_bf16(x, g_mix, XN, gw, SEQ, NGW, lane);
        SUBSTAMP(2);
        rms_rows_to_bf16(mem, g_mem, memn, gw, NMEM, NGW, lane);
        for (int k = gw; k < DM; k += NGW) { const float gs = g_xattn[k] * C2X; const f32x4* src = (const f32x4*)(w_xq + (size_t)k * XW) + lane; v2u* dst = (v2u*)(wxqp + (size_t)k * XW) + lane;
#pragma unroll
            for (int j = 0; j < 2; ++j) { const f32x4 v = src[64 * j]; v2u w; w.x = cvt_pk_bf16(v.x * gs, v.y * gs); w.y = cvt_pk_bf16(v.z * gs, v.w * gs); dst[64 * j] = w; } }
        const int gt = bx * 512 + tid, NGT = G * 512;
        for (int e = gt; e < SEQ * 8; e += NGT) { const int pos = e >> 3, i = e & 7;
            const float inv_freq = (i == 0) ? 1.0f : (i == 1) ? 0.19392274f : (i == 2) ? 0.037606031f : (i == 3) ? 0.0072926646f : (i == 4) ? 0.0014142136f : (i == 5) ? 0.00027424819f : (i == 6) ? 5.3182957e-05f : 1.0313385e-05f;
            const float ang = (float)pos * inv_freq; float sn, cn; sincosf(ang, &sn, &cn);
            cs[(size_t)pos * 16 + i] = cn; cs[(size_t)pos * 16 + 8 + i] = sn; }
        for (int e = gt; e < 3 * SEQ; e += NGT) ss1[e] = 0.f;
        SUBSTAMP(3);
    }
    SEAM(0);

    if (IN(1)) {
        { pg8::Prob g{memn, WxkvT, DM, DM, DM, 0}; pg8::StaticOrder S; S.init(NMEM, 2 * XW, G, (bx >= 128 && bx < 132) ? bx - 128 : -1);
          EpiStoreBf16 E{kvb, 2 * XW};
          pg8::gemm_phase<EpiStoreBf16, pg8::StaticOrder, PG8_ALIGN, PG8_SP2>(lds, g, S, E); }
        if (tailfill && bx >= 132) { tp_run3(TP_NEARLY + (bx - 132) * 8 + wave, TP_NITEMS, (256 - 132) * 8, TP, (LAS float*)(lds + wave * 16384), lane); __syncthreads(); }
        { pg8::Prob g{XN, WinT, DM, DM, DM, 0}; pg8::StaticOrder S; S.init(SEQ, NIN, G, bx);
          EpiInProj E{qb, kb, vb, zc, sgr, sgc, cs};
          pg8::gemm_phase<EpiInProj, pg8::StaticOrder, PG8_ALIGN, PG8_SP2>(lds, g, S, E); }
    }
    SEAM(1);

    if (grp && IN(2)) {
        if (tid == 0) { unsigned* xt = ctl + CW_XID + 64 * (bx & 63); const unsigned a0 = xb_ld(xt), a1 = xb_ld(xt + 1), a2 = xb_ld(xt + 2), a3 = xb_ld(xt + 3);
            MISC[12] = (a0 != 0u && a0 == a1 && a0 == a2 && a0 == a3) ? 1u : 0u; }
        __syncthreads();
        same_xcd = __builtin_amdgcn_readfirstlane(MISC[12]) != 0u;
    }
    if (IN(2)) {
        SUBSTAMP(4);
        ConvCtx cc;
        if (grp) {
            conv_init(cc, zc, XN, conv_w, 4 * pm_own + jmem, tid);
            swa_unit<true>(lds, 2 * pm_own + ((2 * jmem) >> 2), (2 * jmem) & 3, qb, kb, vb, sinks, XN, tid, lane, wave, cc, 0);
            swa_unit<true>(lds, 2 * pm_own + ((2 * jmem + 1) >> 2), (2 * jmem + 1) & 3, qb, kb, vb, sinks, XN, tid, lane, wave, cc, 2);
        } else {
            for (int u = bx; u < (SEQ / 128) * 4; u += G) swa_unit<false>(lds, u >> 2, u & 3, qb, kb, vb, sinks, XN, tid, lane, wave, cc, 0);
            for (int ch = bx; ch < SEQ / 64; ch += G) { conv_init(cc, zc, XN, conv_w, ch, tid);
#pragma unroll 1
                for (int b = 0; b < 4; ++b) { v4u zb[4], zp[4]; conv_issue(cc, b, zb, zp); conv_finish(cc, b, zb, zp); } }
        }
        SUBSTAMP(5);
        const bool pp_all = !grp; const int pp_w = ((bx >> 4) << 3) + (bx & 7);
        for (int job = pp_all ? bx * 8 + wave : (((bx >> 3) & 1) ? pp_w * 8 + wave : 2048); job < 2048; job += (pp_all ? G * 8 : 1024)) { const int idx = job & 1023;
            if (job < 1024) { const int mt = idx >> 6, nt = idx & 63, m0 = 64 * mt, n0 = 32 * nt, hh = m0 >> 8, j0 = m0 & 255;
                wave_gemm_64x32_k128(kvb + (size_t)j0 * (2 * XW) + 128 * hh, 2 * XW, wxqp + (size_t)n0 * XW + 128 * hh, XW, WqKT + (size_t)m0 * DM + n0, DM, lane); }
            else { const int mt = idx >> 5, nt = idx & 31, m0 = 64 * mt, n0 = 32 * nt, hh = n0 >> 8, j0 = n0 & 255;
                wave_gemm_64x32_k128(wxot + (size_t)m0 * XW + 128 * hh, XW, kvb + (size_t)j0 * (2 * XW) + XW + 128 * hh, 2 * XW, VWoT + (size_t)m0 * (4 * NMEM) + n0, 4 * NMEM, lane); } }
    }
    SUBSTAMP(7);
    GSEAM(2, glob);

    if (IN(3)) { pg8::Prob g{XN, WacT, DM, DM, AW, AW}; pg8::StaticOrder S; S.init(SEQ, DM, G, bx, 2);
        EpiMerge E{sgr, sgc, merged};
        pg8::gemm_phase<EpiMerge, pg8::StaticOrder, PG8_ALIGN, PG8_SP2>(lds, g, S, E); }
    GSEAM(3, nullptr);

    if (IN(4)) { pg8::Prob g{merged, WoutT, DM, DM, DM, 0}; pg8::StaticOrder S; S.init(SEQ, DM, G, bx);
        EpiResid<true> E{x, XN, ss1};
        pg8::gemm_phase<EpiResid<true>, pg8::StaticOrder, PG8_ALIGN, PG8_SP2>(lds, g, S, E); }
    GSEAM(4, glob + 64);

    if (IN(5)) { if (grp) wait_global(glob, 256u, gtmo);
        pg8::Prob g{XN, WqKT, DM, DM, DM, 0}; pg8::StaticOrder S; S.init(SEQ, 4 * NMEM, G, bx);
        EpiSoftmax E{ss1, Pb};
        if ((SEQ / 256) * 4 <= G) pg8::gemm_phase<EpiSoftmax, pg8::StaticOrder, false, PG8_SP2>(lds, g, S, E); }
    GSEAM(5, nullptr);

    if (IN(6)) { pg8::Prob g{Pb, VWoT, 4 * NMEM, 4 * NMEM, 4 * NMEM, 0}; pg8::StaticOrder S; S.init(SEQ, DM, G, bx);
        EpiResid<false> E{nullptr, XN, ss2};
        pg8::gemm_phase<EpiResid<false>, pg8::StaticOrder, PG8_ALIGN, PG8_SP2>(lds, g, S, E); }
    GSEAM(6, nullptr);

    if (IN(7)) { pg8::Prob g{XN, WguT, DM, DM, DM, 0}; pg8::StaticOrder S; S.init(SEQ, 2 * DFF, G, bx);
        EpiSwiGLU E{ss2, act};
        pg8::gemm_phase<EpiSwiGLU, pg8::StaticOrder, PG8_ALIGN, PG8_SP2>(lds, g, S, E); }
    GSEAM(7, nullptr);

    if (IN(8)) { pg8::Prob g{act, WdT, 64, DFF, DFF, 0, 256 * 64 * 2, (size_t)256 * DFF}; pg8::StaticOrder S; S.init(SEQ, DM, G, bx);
        if (grp) { EpiFinal E{XN, ss3, out, g_final, gcnt, gepoch + 4u, glob + 64, gtmo, same_xcd}; gepoch += 4u;
            pg8::gemm_phase<EpiFinal, pg8::StaticOrder, PG8_ALIGN, PG8_SP2>(lds, g, S, E); }
        else { EpiResid<false> E{nullptr, XN, ss3};
            pg8::gemm_phase<EpiResid<false>, pg8::StaticOrder, PG8_ALIGN, PG8_SP2>(lds, g, S, E); } }
    if (!grp) { GSEAM(8, nullptr); } else { STAMP(); }

    if (IN(9) && !grp) {
        if (grp) wait_global(glob + 64, 256u, gtmo);
        const int m0 = grp ? 256 * pm_own + 64 * jmem + wave : bx * 8 + wave, m_end = grp ? 256 * pm_own + 64 * jmem + 64 : SEQ, NGW = grp ? 8 : G * 8;
        f32x4 gg[4][2];
#pragma unroll
        for (int j = 0; j < 4; ++j) { gg[j][0] = ((const f32x4*)g_final + 2 * lane)[128 * j]; gg[j][1] = ((const f32x4*)g_final + 2 * lane)[128 * j + 1]; }
        v4u hv[4];
        if (m0 < m_end) {
#pragma unroll
            for (int j = 0; j < 4; ++j) hv[j] = ((const v4u*)(XN + (size_t)m0 * DM) + lane)[64 * j]; }
        for (int m = m0; m < m_end; m += NGW) { const int nx = m + NGW; const bool more = nx < m_end; v4u hn[4];
            if (more) {
#pragma unroll
                for (int j = 0; j < 4; ++j) hn[j] = ((const v4u*)(XN + (size_t)nx * DM) + lane)[64 * j]; }
            const float rs = 1.0f / sqrtf(ss3[m] * (1.0f / DM) + EPS); f32x4* o = (f32x4*)(out + (size_t)m * DM) + 2 * lane;
#pragma unroll
            for (int j = 0; j < 4; ++j) { f32x4 v0, v1; unpack8(hv[j], v0, v1); o[128 * j] = v0 * rs * gg[j][0]; o[128 * j + 1] = v1 * rs * gg[j][1]; }
            if (more) {
#pragma unroll
                for (int j = 0; j < 4; ++j) hv[j] = hn[j]; } } }
#ifdef PROBE_PHASE
    STAMP();
    if (bx == 0 && tid == 0) { volatile LAS unsigned long long* st = (volatile LAS unsigned long long*)(lds + MISC_OFF + 128);
        volatile LAS unsigned long long* sc = (volatile LAS unsigned long long*)(lds + MISC_OFF + 256);
        unsigned long long span = st[PROBE_PHASE + 1] - st[PROBE_PHASE]; const unsigned long long t0 = __builtin_amdgcn_s_memrealtime();
#ifdef PROBE_SUB
        span = st[40 + PROBE_SUB + 1] - st[40 + PROBE_SUB];
#endif
#ifdef PROBE_CLOCK
        span = (sc[PROBE_PHASE + 1] - sc[PROBE_PHASE]) * 1250ull / span;
#endif
        while (__builtin_amdgcn_s_memrealtime() - t0 < 8ull * span) __builtin_amdgcn_s_sleep(8); }
#endif
#ifdef DBG_STOP
    if (IN(10)) { const size_t gt = (size_t)bx * 512 + tid, NGT = (size_t)G * 512;
        for (size_t e = gt; e < (size_t)SEQ * DM; e += NGT) {
#if DBG_DUMP == 0
            out[e] = __builtin_bit_cast(float, (unsigned)XN[e] << 16);
#elif DBG_DUMP == 1
            out[e] = __builtin_bit_cast(float, (unsigned)XN[e] << 16);
#elif DBG_DUMP == 2
            out[e] = __builtin_bit_cast(float, (unsigned)merged[e] << 16);
#elif DBG_DUMP == 3
            { const size_t r = e / DM, c = e % DM; out[e] = __builtin_bit_cast(float, (unsigned)(c < 1024 ? qb[r * 1024 + c] : (c < 1280 ? kb[r * 256 + c - 1024] : (c < 1536 ? vb[r * 256 + c - 1280] : zc[r * 2048 + ((c - 1536) & 2047)]))) << 16); }
#elif DBG_DUMP == 5
            { const size_t n1 = (size_t)1024 * 2048, n2 = 2 * n1, n3 = n2 + 256 * 1024; out[e] = (e < n1) ? __builtin_bit_cast(float, (unsigned)WqKT[e] << 16) : (e < n2) ? __builtin_bit_cast(float, (unsigned)VWoT[e - n1] << 16) : (e < n3) ? __builtin_bit_cast(float, (unsigned)kvb[e - n2] << 16) : 0.f; }
#elif DBG_DUMP == 6
            out[e] = (e < (size_t)256 * 1024) ? __builtin_bit_cast(float, (unsigned)kvb[e] << 16) : (e < (size_t)256 * 1024 + 256 * 2048) ? __builtin_bit_cast(float, (unsigned)memn[e - 256 * 1024] << 16) : 0.f;
#elif DBG_DUMP == 7
            out[e] = (e < (size_t)2048 * 512) ? __builtin_bit_cast(float, (unsigned)wxqp[e] << 16) : (e < (size_t)2 * 2048 * 512) ? __builtin_bit_cast(float, (unsigned)wxot[e - 2048 * 512] << 16) : 0.f;
#elif DBG_DUMP == 4
            { const size_t r = e / DM, c = e % DM; out[e] = __builtin_bit_cast(float, (unsigned)(c < 1024 ? Pb[r * 1024 + c] : (bf16)0) << 16); }
#endif
        } }
#endif
#undef IN
#undef SEAM
#undef GSEAM
}

extern "C" void kernel_launch(void* const* d_in, const int* in_sizes, int n_in, void* d_out, int out_size, void* d_ws, size_t ws_size, hipStream_t stream) {
    static int grid = 0;
    if (grid == 0) {
        if (n_in != 18 || in_sizes[0] != SEQ * DM || out_size != SEQ * DM || ws_size < WS_END) { fprintf(stderr, "kernel_launch: unexpected shapes / workspace (n_in %d, in0 %d, out %d, ws %zu); nothing launched\n", n_in, n_in > 0 ? in_sizes[0] : -1, out_size, ws_size); grid = -1; return; }
        int dev = 0, cus = 0;
        if (hipGetDevice(&dev) != hipSuccess || hipDeviceGetAttribute(&cus, hipDeviceAttributeMultiprocessorCount, dev) != hipSuccess) { fprintf(stderr, "kernel_launch: device query failed\n"); grid = -1; return; }
        if (hipFuncSetAttribute((const void*)hyb_fwd, hipFuncAttributeMaxDynamicSharedMemorySize, LDS_BYTES) != hipSuccess) { fprintf(stderr, "kernel_launch: hipFuncSetAttribute failed\n"); grid = -1; return; }
        int per_cu = 0;
        if (hipOccupancyMaxActiveBlocksPerMultiprocessor(&per_cu, (const void*)hyb_fwd, 512, LDS_BYTES) != hipSuccess || per_cu < 1) fprintf(stderr, "kernel_launch: note: occupancy query reports %d workgroups per CU\n", per_cu);
        (void)hipGetLastError();
        grid = cus;
    }
    if (grid < 0) return;
    if (hipMemsetAsync((char*)d_ws + WS_CTL, 0, CTL_ZERO_BYTES, stream) != hipSuccess) { fprintf(stderr, "kernel_launch: memset failed\n"); return; }
    Args a{};
    for (int i = 0; i < 18; ++i) a.in[i] = (const float*)d_in[i];
    a.out = (float*)d_out; a.ws = (unsigned char*)d_ws;
#ifdef DBG_STOP
    const int nl = DBG_STOP + 2;
#else
    const int nl = MK_N_LAUNCHES;
#endif
    for (int li = 0; li < nl; ++li) {
        a.ph_lo = (MK_N_LAUNCHES == 1) ? 0 : li; a.ph_hi = (MK_N_LAUNCHES == 1) ? NPHASE : li + 1; a.li = li; a.pad = 0;
#ifdef DBG_STOP
        if (li == nl - 1) { a.ph_lo = 10; a.ph_hi = 11; }
#endif
        hipLaunchKernelGGL(hyb_fwd, dim3(grid), dim3(512), LDS_BYTES, stream, a);
        const hipError_t le = hipPeekAtLastError();
        if (le != hipSuccess) { fprintf(stderr, "kernel_launch: launch %d failed: %s\n", li, hipGetErrorName(le)); break; }
    }
}
```

```cpp
#include <hip/hip_runtime.h>
#include <cstdio>
#include <cstdint>

#ifndef MK_N_LAUNCHES
#define MK_N_LAUNCHES 1
#endif

#define GAS __attribute__((address_space(1)))
#define LAS __attribute__((address_space(3)))
typedef unsigned short bf16;
typedef unsigned v4u __attribute__((ext_vector_type(4)));
typedef unsigned v2u __attribute__((ext_vector_type(2)));
typedef float f32x4 __attribute__((ext_vector_type(4)));
typedef float f32x16 __attribute__((ext_vector_type(16)));
typedef short bf16x8 __attribute__((ext_vector_type(8)));
typedef short s16x4 __attribute__((ext_vector_type(4)));

constexpr int SEQ = 16384, DM = 2048, NIN = 8704, AW = 1024, KVW = 256, CW = 1024, XW = 512, NMEM = 256, DFF = 5632;
constexpr float EPS = 1e-6f;
constexpr float LOG2E = 1.4426950408889634f;
constexpr float QSCALE = 0.125f * 1.4426950408889634f;
constexpr float C2X = 0.08838834764831845f * 1.4426950408889634f;

constexpr size_t MiB = 1u << 20;
constexpr size_t WS_CTL = 0, CTL_ZERO_BYTES = 256 * 1024;
constexpr size_t WS_SS = 1 * MiB;
constexpr size_t WS_CS = 2 * MiB;
constexpr size_t WS_KVB = 3 * MiB;
constexpr size_t WS_MEMN = 4 * MiB;
constexpr size_t WS_WXQ = 5 * MiB;
constexpr size_t WS_WXOT = 7 * MiB;
constexpr size_t WS_WGUT = 16 * MiB;
constexpr size_t WS_WDT = 60 * MiB;
constexpr size_t WS_XN = 82 * MiB;
constexpr size_t WS_WACT = 146 * MiB;
constexpr size_t WS_WOUTT = 154 * MiB;
constexpr size_t WS_WQKT = 162 * MiB;
constexpr size_t WS_VWOT = 166 * MiB;
constexpr size_t WS_Q = 170 * MiB, WS_K = 202 * MiB, WS_V = 210 * MiB, WS_ZC = 218 * MiB;
constexpr size_t WS_P = WS_Q;
constexpr size_t WS_ACT = 314 * MiB;
constexpr size_t WS_WINT = 314 * MiB;
constexpr size_t WS_WXKVT = 348 * MiB;
constexpr size_t WS_END = 490 * MiB;
static_assert(WS_ACT + (size_t)SEQ * DFF * 2 <= WS_END && WS_ZC + (size_t)SEQ * 3 * CW * 2 <= WS_ACT, "d_ws map");

constexpr int CW_BAR = 4096;
constexpr int CW_GRP = 16384;
constexpr int CW_XID = 49152;
constexpr int CW_GLOB = 32768;

constexpr int RING_BYTES = 131072;
constexpr int LDSCTL_OFF = RING_BYTES, MISC_OFF = LDSCTL_OFF + 320;
constexpr int LDS_BYTES = 147456;

#define RLX_AGENT __ATOMIC_RELAXED, __HIP_MEMORY_SCOPE_AGENT
#define LDS_WAIT() asm volatile("s_waitcnt lgkmcnt(0)" ::: "memory")
#define VM_WAIT() asm volatile("s_waitcnt vmcnt(0)" ::: "memory")

typedef float f32x2_t __attribute__((ext_vector_type(2))); typedef __bf16 bf16x2_t __attribute__((ext_vector_type(2)));
__device__ __forceinline__ unsigned cvt_pk_bf16(float lo, float hi) { f32x2_t v = {lo, hi}; bf16x2_t b = __builtin_convertvector(v, bf16x2_t); return __builtin_bit_cast(unsigned, b); }
__device__ __forceinline__ float bf_lo(unsigned u) { return __builtin_bit_cast(float, u << 16); }
__device__ __forceinline__ float bf_hi(unsigned u) { return __builtin_bit_cast(float, u & 0xffff0000u); }
__device__ __forceinline__ float fast_exp2(float x) { return __builtin_amdgcn_exp2f(x); }
__device__ __forceinline__ float fast_rcp(float x) { return __builtin_amdgcn_rcpf(x); }
__device__ __forceinline__ void st16_wt(void* p, v4u v) { asm volatile("global_store_dwordx4 %0, %1, off sc1\n\ts_nop 1" :: "v"(p), "v"(v) : "memory"); }
__device__ __forceinline__ void st8_wt(void* p, v2u v) { __hip_atomic_store((unsigned long long*)p, ((unsigned long long)v.y << 32) | v.x, __ATOMIC_RELAXED, __HIP_MEMORY_SCOPE_AGENT); }

namespace pg8 {
typedef unsigned short bf16_t;
constexpr int BM = 256, BK = 64, HALF = 128, HTB = HALF * BK * 2, STAGE_BYTES = 8 * HTB, NXCD = 8, WGM = 8;

__host__ __device__ __forceinline__ int lds_byte(int r, int c) { const int st = (r >> 4) * 2 + (c >> 5), rr = r & 15, cc = c & 31, ob = rr * 64 + cc * 2; return st * 1024 + (ob ^ (((ob >> 9) & 1) << 5)); }
__host__ __device__ __forceinline__ void stage_rc(int b, int& R, int& C) { const int st = b / 1024, sb = b % 1024, swz = sb ^ (((sb >> 9) & 1) << 5); R = (st >> 1) * 16 + swz / 64; C = (st & 1) * 32 + (swz % 64) / 2; }
__host__ __device__ __forceinline__ int perm32(int rho) { const int n = rho >> 4, i = rho & 15; return 8 * (i >> 2) + 4 * n + (i & 3); }

struct Unit { int pm, pn, z; };
struct Prob {
    const bf16_t* A; const bf16_t* Bt; int lda, ldb, K, zoff;
    int akstep = 0; size_t apanel = 0;
    __device__ __forceinline__ const char* a_ptr(const Unit& u) const { return (const char*)(A + (apanel ? (size_t)u.pm * apanel : (size_t)u.pm * BM * lda) + (size_t)u.z * zoff); }
    __device__ __forceinline__ const char* b_ptr(const Unit& u) const { return (const char*)(Bt + (size_t)u.pn * BM * ldb + (size_t)u.z * zoff); }
};

__device__ __forceinline__ bool tile_of(long L, int nM, int nN, int& pm, int& pn) {
    const int nwg = nM * nN; if (L >= nwg) return false;
    int wgid = (int)L; { const int q = nwg / NXCD, r = nwg % NXCD, xcd = wgid % NXCD, off = wgid / NXCD; wgid = (xcd < r ? xcd * (q + 1) : r * (q + 1) + (xcd - r) * q) + off; }
    const int nig = WGM * nN, gid = wgid / nig, fm = gid * WGM, gsz = (nM - fm) < WGM ? (nM - fm) : WGM;
    pm = fm + ((wgid % nig) % gsz); pn = (wgid % nig) / gsz; return true;
}
struct StaticOrder {
    int nM, nN, G, c, ZS, rev;
    __device__ __forceinline__ void init(int M, int N, int G_, int c_, int ZS_ = 1, bool reversed = false) { nM = M / BM; nN = N / BM; G = G_; c = c_; ZS = ZS_;
        rev = (reversed && c_ >= 0 && c_ < nM * nN) ? (nM * nN - 1 - c_) / G_ + 1 : 0; }
    __device__ __forceinline__ bool next(int i, Unit& u) const {
        if (c < 0) return false;
        int ti = (ZS == 2) ? (i >> 1) : i; u.z = (ZS == 2) ? (i & 1) : 0;
        if (rev) { if (ti >= rev) return false; ti = rev - 1 - ti; }
        return tile_of((long)ti * G + c, nM, nN, u.pm, u.pn);
    }
};

template <class Epi, class Sched, bool ALIGN_EPI = false, bool SP2 = false>
__device__ __forceinline__ void gemm_phase(LAS unsigned char* lds, const Prob g, const Sched& S, const Epi& E) {
    const int tid = threadIdx.x, wid = __builtin_amdgcn_readfirstlane(tid >> 6), lane = tid & 63, wr = wid >> 2, wc = wid & 3, fr = lane & 15, fq = lane >> 4;
    const int K = g.K, nt = K / BK;
    unsigned voffA[2], voffB[2];
#pragma unroll
    for (int i = 0; i < 2; ++i) { int R, C; stage_rc(tid * 16 + i * 8192, R, C); const int Rb = Epi::PERM ? ((R & ~31) + perm32(R & 31)) : R;
        voffA[i] = (unsigned)(R * g.lda + C) * 2u; voffB[i] = (unsigned)(Rb * g.ldb + C) * 2u; }
    const size_t kstep = (size_t)(BK * 2), kstepA = g.akstep ? (size_t)g.akstep : kstep;
    const size_t hstepA = (size_t)HALF * g.lda * 2, hstepB = (size_t)HALF * g.ldb * 2;
    const unsigned ldsw = (unsigned)wid * 1024u;
    const int aoff = lds_byte(wr * 64 + fr, fq * 8), boff = lds_byte(wc * 32 + fr, fq * 8);
#define PG8_SA(b, h) (((b) * 2 + (h)) * HTB)
#define PG8_SB(b, h) ((4 + (b) * 2 + (h)) * HTB)
#define PG8_STAGE(bufoff, gbase, voff) do { _Pragma("unroll") for (int _i = 0; _i < 2; ++_i) \
        __builtin_amdgcn_global_load_lds((const unsigned*)((const char*)(gbase) + (voff)[_i]), (LAS unsigned*)(lds + (bufoff) + ldsw + _i * 8192), 16, 0, 0); } while (0)
#define PG8_LDA(dst, b, h) do { _Pragma("unroll") for (int m = 0; m < 4; ++m) _Pragma("unroll") for (int k = 0; k < 2; ++k) dst[m][k] = *(const LAS bf16x8*)(lds + PG8_SA(b, h) + aoff + m * 2048 + k * 1024); } while (0)
#define PG8_LDB(dst, b, h) do { _Pragma("unroll") for (int n = 0; n < 2; ++n) _Pragma("unroll") for (int k = 0; k < 2; ++k) dst[n][k] = *(const LAS bf16x8*)(lds + PG8_SB(b, h) + boff + n * 2048 + k * 1024); } while (0)
#define PG8_MMA(ai, bj, At, Bt) do { __builtin_amdgcn_s_setprio(1); _Pragma("unroll") for (int m = 0; m < 4; ++m) _Pragma("unroll") for (int n = 0; n < 2; ++n) _Pragma("unroll") for (int k = 0; k < 2; ++k) \
        acc[ai][bj][m][n] = __builtin_amdgcn_mfma_f32_16x16x32_bf16(Bt[n][k], At[m][k], acc[ai][bj][m][n], 0, 0, 0); __builtin_amdgcn_s_setprio(0); } while (0)
#define PG8_WAIT_V(n) asm volatile("s_waitcnt vmcnt(" #n ")" ::: "memory")
#define PG8_WAIT_L(n) asm volatile("s_waitcnt lgkmcnt(" #n ")" ::: "memory")
#define PG8_BAR __builtin_amdgcn_s_barrier()
#define PG8_SCHED __builtin_amdgcn_sched_barrier(0)
    Unit cur, nxt; int ui = 0;
    if (!S.next(0, cur)) return;
    f32x4 acc[2][2][4][2];
#pragma unroll
    for (int a = 0; a < 2; ++a)
#pragma unroll
        for (int b = 0; b < 2; ++b)
#pragma unroll
            for (int m = 0; m < 4; ++m)
#pragma unroll
                for (int n = 0; n < 2; ++n) acc[a][b][m][n] = (f32x4){0.f, 0.f, 0.f, 0.f};
    bf16x8 At[4][2], B0[2][2], B1[2][2];
    const char* cA = g.a_ptr(cur); const char* cB = g.b_ptr(cur);
    if constexpr (SP2) {
        PG8_STAGE(PG8_SB(0, 0), cB, voffB); PG8_STAGE(PG8_SB(0, 1), cB + hstepB, voffB); PG8_STAGE(PG8_SA(0, 0), cA, voffA); PG8_STAGE(PG8_SA(0, 1), cA + hstepA, voffA);
        if (wr == 1) PG8_BAR;
        PG8_WAIT_V(2); PG8_BAR;
        PG8_STAGE(PG8_SB(1, 0), cB + kstep, voffB); PG8_STAGE(PG8_SA(1, 0), cA + kstepA, voffA); PG8_STAGE(PG8_SB(1, 1), cB + hstepB + kstep, voffB);
        PG8_WAIT_V(6); PG8_BAR;
    } else {
        PG8_STAGE(PG8_SB(0, 0), cB, voffB); PG8_STAGE(PG8_SA(0, 0), cA, voffA); PG8_STAGE(PG8_SB(0, 1), cB + hstepB, voffB); PG8_STAGE(PG8_SA(0, 1), cA + hstepA, voffA);
        if (wr == 1) PG8_BAR;
        PG8_WAIT_V(4); PG8_BAR;
        PG8_STAGE(PG8_SB(1, 0), cB + kstep, voffB); PG8_STAGE(PG8_SA(1, 0), cA + kstepA, voffA); PG8_STAGE(PG8_SB(1, 1), cB + hstepB + kstep, voffB);
        PG8_WAIT_V(6); PG8_BAR;
    }
    for (;;) {
        const bool has_next = S.next(ui + 1, nxt);
        const char* nA = has_next ? g.a_ptr(nxt) : cA; const char* nB = has_next ? g.b_ptr(nxt) : cB;
        for (int t = 0; t < nt; t += 2) {
            const bool last = (t == nt - 2);
            const char* a1 = cA + (size_t)(t + 1) * kstepA;
            const char* a2 = last ? nA : cA + (size_t)(t + 2) * kstepA; const char* b2 = last ? nB : cB + (size_t)(t + 2) * kstep;
            const char* a3 = a2 + kstepA; const char* b3 = b2 + kstep;
            if constexpr (SP2) {
            PG8_LDB(B0, 0, 0); PG8_LDB(B1, 0, 1); PG8_SCHED; PG8_LDA(At, 0, 0); PG8_STAGE(PG8_SA(1, 1), a1 + hstepA, voffA);
            PG8_WAIT_V(8); PG8_WAIT_L(0); PG8_BAR; PG8_MMA(0, 0, At, B0); PG8_MMA(0, 1, At, B1); PG8_BAR; PG8_SCHED;
            PG8_LDA(At, 0, 1); PG8_STAGE(PG8_SB(0, 0), b2, voffB); PG8_STAGE(PG8_SB(0, 1), b2 + hstepB, voffB); PG8_STAGE(PG8_SA(0, 0), a2, voffA);
            PG8_WAIT_V(8); PG8_WAIT_L(0); PG8_BAR; PG8_MMA(1, 0, At, B0); PG8_MMA(1, 1, At, B1); PG8_BAR; PG8_SCHED;
            PG8_LDB(B0, 1, 0); PG8_LDB(B1, 1, 1); PG8_SCHED; PG8_LDA(At, 1, 0); PG8_STAGE(PG8_SA(0, 1), a2 + hstepA, voffA);
            PG8_WAIT_V(8); PG8_WAIT_L(0); PG8_BAR; PG8_MMA(0, 0, At, B0); PG8_MMA(0, 1, At, B1); PG8_BAR; PG8_SCHED;
            PG8_LDA(At, 1, 1); PG8_STAGE(PG8_SB(1, 0), b3, voffB); PG8_STAGE(PG8_SB(1, 1), b3 + hstepB, voffB); PG8_STAGE(PG8_SA(1, 0), a3, voffA);
            PG8_WAIT_V(8); PG8_WAIT_L(0); PG8_BAR; PG8_MMA(1, 0, At, B0); PG8_MMA(1, 1, At, B1); PG8_BAR; PG8_SCHED;
            } else {
            PG8_LDB(B0, 0, 0); PG8_SCHED; PG8_LDA(At, 0, 0); PG8_STAGE(PG8_SA(1, 1), a1 + hstepA, voffA);
            PG8_WAIT_L(8); PG8_BAR; PG8_WAIT_L(0); PG8_MMA(0, 0, At, B0); PG8_BAR; PG8_SCHED;
            PG8_LDB(B1, 0, 1); PG8_STAGE(PG8_SB(0, 0), b2, voffB);
            PG8_BAR; PG8_WAIT_L(0); PG8_MMA(0, 1, At, B1); PG8_BAR;
            PG8_LDA(At, 0, 1); PG8_STAGE(PG8_SA(0, 0), a2, voffA);
            PG8_BAR; PG8_WAIT_L(0); PG8_MMA(1, 0, At, B0); PG8_BAR; PG8_SCHED;
            PG8_STAGE(PG8_SB(0, 1), b2 + hstepB, voffB);
            PG8_WAIT_V(6); PG8_BAR; PG8_MMA(1, 1, At, B1); PG8_BAR;
            PG8_LDB(B0, 1, 0); PG8_SCHED; PG8_LDA(At, 1, 0); PG8_STAGE(PG8_SA(0, 1), a2 + hstepA, voffA);
            PG8_WAIT_L(8); PG8_BAR; PG8_WAIT_L(0); PG8_MMA(0, 0, At, B0); PG8_BAR; PG8_SCHED;
            PG8_LDB(B1, 1, 1); PG8_STAGE(PG8_SB(1, 0), b3, voffB);
            PG8_BAR; PG8_WAIT_L(0); PG8_MMA(0, 1, At, B1); PG8_BAR;
            PG8_LDA(At, 1, 1); PG8_STAGE(PG8_SA(1, 0), a3, voffA);
            PG8_BAR; PG8_WAIT_L(0); PG8_MMA(1, 0, At, B0); PG8_BAR; PG8_SCHED;
            PG8_STAGE(PG8_SB(1, 1), b3 + hstepB, voffB);
            PG8_WAIT_V(6); PG8_BAR; PG8_MMA(1, 1, At, B1); PG8_BAR;
            }
        }
        if constexpr (ALIGN_EPI) { if (wr == 0) PG8_BAR; }
        if constexpr (!Epi::AFTER_DRAIN) { if (!(Epi::LAST_FUSED && !has_next)) E(acc, cur, wr, wc, fr, fq); }
        if (!has_next) break;
        if (!E.keep(cur)) {
#pragma unroll
        for (int a = 0; a < 2; ++a)
#pragma unroll
            for (int b = 0; b < 2; ++b)
#pragma unroll
                for (int m = 0; m < 4; ++m)
#pragma unroll
                    for (int n = 0; n < 2; ++n) acc[a][b][m][n] = (f32x4){0.f, 0.f, 0.f, 0.f};
        }
        cur = nxt; cA = nA; cB = nB; ++ui;
        if constexpr (ALIGN_EPI) { if (wr == 1) PG8_BAR; }
    }
    PG8_WAIT_V(0);
    if constexpr (!ALIGN_EPI) { if (wr == 0) PG8_BAR; }
    PG8_BAR;
    if constexpr (Epi::AFTER_DRAIN || Epi::LAST_FUSED) { E.fused(acc, cur, wr, wc, fr, fq, lds, wid, lane); }
#undef PG8_SA
#undef PG8_SB
#undef PG8_STAGE
#undef PG8_LDA
#undef PG8_LDB
#undef PG8_MMA
#undef PG8_WAIT_V
#undef PG8_WAIT_L
#undef PG8_BAR
#undef PG8_SCHED
}
}

#ifndef PG8_SP2
#define PG8_SP2 true
#endif
#ifndef PG8_ALIGN
#define PG8_ALIGN true
#endif

typedef f32x4 Acc[2][2][4][2];

__device__ __forceinline__ v4u pack8(f32x4 v0, f32x4 v1) { v4u w; w.x = cvt_pk_bf16(v0[0], v0[1]); w.y = cvt_pk_bf16(v0[2], v0[3]); w.z = cvt_pk_bf16(v1[0], v1[1]); w.w = cvt_pk_bf16(v1[2], v1[3]); return w; }
__device__ __forceinline__ void unpack8(v4u w, f32x4& v0, f32x4& v1) { v0 = (f32x4){bf_lo(w.x), bf_hi(w.x), bf_lo(w.y), bf_hi(w.y)}; v1 = (f32x4){bf_lo(w.z), bf_hi(w.z), bf_lo(w.w), bf_hi(w.w)}; }

struct EpiInProj {
    static constexpr bool PERM = true, AFTER_DRAIN = false, LAST_FUSED = false;
    bf16 *q, *k, *v, *zc, *sgr, *sgc; const float* cs;
    __device__ __forceinline__ bool keep(const pg8::Unit&) const { return false; }
    __device__ __forceinline__ void operator()(Acc& acc, const pg8::Unit& u, int wr, int wc, int fr, int fq) const {
        const int row0 = u.pm * 256 + wr * 64 + fr, ct = wc * 32 + 8 * fq;
        if (u.pn < 5) {
            const bool isq = u.pn < 4; bf16* base = isq ? q + u.pn * 256 : k; const int ld = isq ? AW : KVW; const float sc = isq ? QSCALE : 1.f;
            const bool rl = ((wc & 1) == 0) && (fq < 2);
#pragma unroll
            for (int ai = 0; ai < 2; ++ai)
#pragma unroll
                for (int m = 0; m < 4; ++m) { const int row = row0 + ai * 128 + m * 16;
                    f32x4 c4 = (f32x4){1.f, 1.f, 1.f, 1.f}, s4 = (f32x4){0.f, 0.f, 0.f, 0.f};
                    if (rl) { c4 = *(const f32x4*)(cs + (size_t)row * 16 + 4 * fq); s4 = *(const f32x4*)(cs + (size_t)row * 16 + 8 + 4 * fq); }
#pragma unroll
                    for (int bj = 0; bj < 2; ++bj) { const f32x4 t1 = acc[ai][bj][m][0], t2 = acc[ai][bj][m][1];
                        const f32x4 v0 = (t1 * c4 - t2 * s4) * sc, v1 = (t2 * c4 + t1 * s4) * sc;
                        *(v4u*)(base + (size_t)row * ld + bj * 128 + ct) = pack8(v0, v1); } }
        } else if (u.pn < 10) {
            bf16* base = (u.pn == 5) ? v : zc + (u.pn - 6) * 256; const int ld = (u.pn == 5) ? KVW : 2 * CW;
#pragma unroll
            for (int ai = 0; ai < 2; ++ai)
#pragma unroll
                for (int m = 0; m < 4; ++m) { const int row = row0 + ai * 128 + m * 16;
#pragma unroll
                    for (int bj = 0; bj < 2; ++bj) *(v4u*)(base + (size_t)row * ld + bj * 128 + ct) = pack8(acc[ai][bj][m][0], acc[ai][bj][m][1]); }
        } else if (u.pn < 18) {
            const int t = u.pn - 10;
#pragma unroll
            for (int ai = 0; ai < 2; ++ai)
#pragma unroll
                for (int m = 0; m < 4; ++m) { const int row = row0 + ai * 128 + m * 16;
                    *(v4u*)(zc + (size_t)row * (2 * CW) + CW + t * 128 + ct) = pack8(acc[ai][0][m][0] * acc[ai][1][m][0], acc[ai][0][m][1] * acc[ai][1][m][1]); }
        } else {
            const int t = u.pn - 18;
#pragma unroll
            for (int ai = 0; ai < 2; ++ai)
#pragma unroll
                for (int m = 0; m < 4; ++m) { const int row = row0 + ai * 128 + m * 16; f32x4 rr[2], ss[2];
#pragma unroll
                    for (int n = 0; n < 2; ++n)
#pragma unroll
                        for (int e = 0; e < 4; ++e) { const float ga = acc[ai][0][m][n][e], gc = acc[ai][1][m][n][e];
                            const float ea = fast_exp2(fminf(ga, 80.f)), ec = fast_exp2(fminf(gc, 80.f));
                            const float ia = fast_rcp(1.f + ea), ic = fast_rcp(1.f + ec);
                            rr[n][e] = (1.f + ec) * ia; ss[n][e] = ic; }
                    *(v4u*)(sgr + (size_t)row * DM + t * 128 + ct) = pack8(rr[0], rr[1]);
                    *(v4u*)(sgc + (size_t)row * DM + t * 128 + ct) = pack8(ss[0], ss[1]); }
        }
    }
};
struct EpiStoreBf16 {
    static constexpr bool PERM = true, AFTER_DRAIN = false, LAST_FUSED = false;
    bf16* O; int ldc;
    __device__ __forceinline__ bool keep(const pg8::Unit&) const { return false; }
    __device__ __forceinline__ void operator()(Acc& acc, const pg8::Unit& u, int wr, int wc, int fr, int fq) const {
        const int row0 = u.pm * 256 + wr * 64 + fr, col0 = u.pn * 256 + wc * 32 + 8 * fq;
#pragma unroll
        for (int ai = 0; ai < 2; ++ai)
#pragma unroll
            for (int m = 0; m < 4; ++m) { const int row = row0 + ai * 128 + m * 16;
#pragma unroll
                for (int bj = 0; bj < 2; ++bj) *(v4u*)(O + (size_t)row * ldc + col0 + bj * 128) = pack8(acc[ai][bj][m][0], acc[ai][bj][m][1]); }
    }
};
struct EpiMerge {
    static constexpr bool PERM = true, AFTER_DRAIN = false, LAST_FUSED = false;
    const bf16 *sgr, *sgc; bf16* merged;
    __device__ __forceinline__ bool keep(const pg8::Unit& u) const { return u.z == 0; }
    __device__ __forceinline__ void operator()(Acc& acc, const pg8::Unit& u, int wr, int wc, int fr, int fq) const {
        const int row0 = u.pm * 256 + wr * 64 + fr, col0 = u.pn * 256 + wc * 32 + 8 * fq;
        const bf16* gsrc = ((u.z == 0) ? sgr : sgc) + (size_t)row0 * DM + col0;
        v4u gw[2][4][2];
#pragma unroll
        for (int ai = 0; ai < 2; ++ai)
#pragma unroll
            for (int m = 0; m < 4; ++m)
#pragma unroll
                for (int bj = 0; bj < 2; ++bj) gw[ai][m][bj] = *(const v4u*)(gsrc + (size_t)(ai * 128 + m * 16) * DM + bj * 128);
#pragma unroll
        for (int ai = 0; ai < 2; ++ai)
#pragma unroll
            for (int m = 0; m < 4; ++m) { const int row = row0 + ai * 128 + m * 16;
#pragma unroll
                for (int bj = 0; bj < 2; ++bj) { f32x4 g0, g1; unpack8(gw[ai][m][bj], g0, g1);
                    const f32x4 v0 = acc[ai][bj][m][0] * g0, v1 = acc[ai][bj][m][1] * g1;
                    if (u.z == 0) { acc[ai][bj][m][0] = v0; acc[ai][bj][m][1] = v1; }
                    else *(v4u*)(merged + (size_t)row * DM + col0 + bj * 128) = pack8(v0, v1); } }
    }
};
template <bool BASE_F32> struct EpiResid {
    static constexpr bool PERM = true, AFTER_DRAIN = false, LAST_FUSED = false;
    const float* basef; bf16* hb; float* ss;
    __device__ __forceinline__ bool keep(const pg8::Unit&) const { return false; }
    __device__ __forceinline__ void operator()(Acc& acc, const pg8::Unit& u, int wr, int wc, int fr, int fq) const {
        const int row0 = u.pm * 256 + wr * 64 + fr, col0 = u.pn * 256 + wc * 32 + 8 * fq;
        const size_t off0 = (size_t)row0 * DM + col0;
        constexpr int NPRE = BASE_F32 ? 4 : 8;
        f32x4 pf[BASE_F32 ? 4 : 1][2][2]; v4u pb[BASE_F32 ? 1 : 8][2];
#pragma unroll
        for (int g = 0; g < NPRE; ++g)
#pragma unroll
            for (int bj = 0; bj < 2; ++bj) { const size_t off = off0 + (size_t)((g >> 2) * 128 + (g & 3) * 16) * DM + bj * 128;
                if (BASE_F32) { pf[g][bj][0] = __builtin_nontemporal_load((const f32x4*)(basef + off)); pf[g][bj][1] = __builtin_nontemporal_load((const f32x4*)(basef + off + 4)); } else pb[g][bj] = *(const v4u*)(hb + off); }
#pragma unroll
        for (int g = 0; g < 8; ++g) { const int ai = g >> 2, m = g & 3; const int row = row0 + ai * 128 + m * 16; float sq = 0.f;
#pragma unroll
            for (int bj = 0; bj < 2; ++bj) { const size_t off = (size_t)row * DM + col0 + bj * 128; f32x4 b0, b1;
                if (BASE_F32) { b0 = pf[g & 3][bj][0]; b1 = pf[g & 3][bj][1]; } else unpack8(pb[g][bj], b0, b1);
                const f32x4 v0 = acc[ai][bj][m][0] + b0, v1 = acc[ai][bj][m][1] + b1;
                *(v4u*)(hb + off) = pack8(v0, v1);
                sq += (v0[0] * v0[0] + v0[1] * v0[1]) + (v0[2] * v0[2] + v0[3] * v0[3]) + (v1[0] * v1[0] + v1[1] * v1[1]) + (v1[2] * v1[2] + v1[3] * v1[3]); }
            if (BASE_F32 && g + 4 < 8) {
#pragma unroll
                for (int bj = 0; bj < 2; ++bj) { const size_t off = off0 + (size_t)(128 + m * 16) * DM + bj * 128; pf[g & 3][bj][0] = __builtin_nontemporal_load((const f32x4*)(basef + off)); pf[g & 3][bj][1] = __builtin_nontemporal_load((const f32x4*)(basef + off + 4)); } }
            sq += __shfl_xor(sq, 16); sq += __shfl_xor(sq, 32);
            if (fq == 0) atomicAdd(ss + row, sq); }
    }
};
struct EpiSoftmax {
    static constexpr bool PERM = true, AFTER_DRAIN = true, LAST_FUSED = false;
    const float* ss; bf16* P;
    __device__ __forceinline__ bool keep(const pg8::Unit&) const { return false; }
    __device__ __forceinline__ void fused(Acc& acc, const pg8::Unit& u, int wr, int wc, int fr, int fq, LAS unsigned char* lds, int wid, int lane) const {
        LAS float* Pm = (LAS float*)lds; LAS float* Ps = (LAS float*)(lds + 4096);
        const int rl0 = wr * 64 + fr, col0 = u.pn * 256 + wc * 32 + 8 * fq;
#pragma unroll
        for (int ai = 0; ai < 2; ++ai)
#pragma unroll
            for (int m = 0; m < 4; ++m) { const int rl = rl0 + ai * 128 + m * 16; const float rs = 1.0f / sqrtf(ss[u.pm * 256 + rl] * (1.0f / DM) + EPS); float mx = -3.0e38f;
#pragma unroll
                for (int bj = 0; bj < 2; ++bj)
#pragma unroll
                    for (int n = 0; n < 2; ++n) { f32x4 s = acc[ai][bj][m][n] * rs; acc[ai][bj][m][n] = s; mx = fmaxf(mx, fmaxf(fmaxf(s[0], s[1]), fmaxf(s[2], s[3]))); }
                mx = fmaxf(mx, __shfl_xor(mx, 16)); mx = fmaxf(mx, __shfl_xor(mx, 32));
                if (fq == 0) Pm[rl * 4 + wc] = mx; }
        asm volatile("s_waitcnt lgkmcnt(0)" ::: "memory"); __builtin_amdgcn_s_barrier(); asm volatile("" ::: "memory");
#pragma unroll
        for (int ai = 0; ai < 2; ++ai)
#pragma unroll
            for (int m = 0; m < 4; ++m) { const int rl = rl0 + ai * 128 + m * 16; const f32x4 pm4 = *(const LAS f32x4*)(Pm + rl * 4);
                const float mx = fmaxf(fmaxf(pm4[0], pm4[1]), fmaxf(pm4[2], pm4[3])); float sm = 0.f;
#pragma unroll
                for (int bj = 0; bj < 2; ++bj)
#pragma unroll
                    for (int n = 0; n < 2; ++n) { f32x4 s = acc[ai][bj][m][n];
#pragma unroll
                        for (int e = 0; e < 4; ++e) { s[e] = fast_exp2(s[e] - mx); sm += s[e]; }
                        acc[ai][bj][m][n] = s; }
                sm += __shfl_xor(sm, 16); sm += __shfl_xor(sm, 32);
                if (fq == 0) Ps[rl * 4 + wc] = sm; }
        asm volatile("s_waitcnt lgkmcnt(0)" ::: "memory"); __builtin_amdgcn_s_barrier(); asm volatile("" ::: "memory");
#pragma unroll
        for (int ai = 0; ai < 2; ++ai)
#pragma unroll
            for (int m = 0; m < 4; ++m) { const int rl = rl0 + ai * 128 + m * 16; const f32x4 ps4 = *(const LAS f32x4*)(Ps + rl * 4);
                const float inv = 1.0f / ((ps4[0] + ps4[1]) + (ps4[2] + ps4[3])); const size_t rowoff = (size_t)(u.pm * 256 + rl) * (4 * NMEM) + col0;
#pragma unroll
                for (int bj = 0; bj < 2; ++bj) *(v4u*)(P + rowoff + bj * 128) = pack8(acc[ai][bj][m][0] * inv, acc[ai][bj][m][1] * inv); }
    }
};
struct EpiSwiGLU {
    static constexpr bool PERM = true, AFTER_DRAIN = false, LAST_FUSED = false;
    const float* ss; bf16* act;
    __device__ __forceinline__ bool keep(const pg8::Unit&) const { return false; }
    __device__ __forceinline__ void operator()(Acc& acc, const pg8::Unit& u, int wr, int wc, int fr, int fq) const {
        const int row0 = u.pm * 256 + wr * 64 + fr, col0 = u.pn * 128 + wc * 32 + 8 * fq;
#pragma unroll
        for (int ai = 0; ai < 2; ++ai)
#pragma unroll
            for (int m = 0; m < 4; ++m) { const int row = row0 + ai * 128 + m * 16; const float rs = 1.0f / sqrtf(ss[row] * (1.0f / DM) + EPS); f32x4 o[2];
                const float nrl = -rs * LOG2E, rs2 = rs * rs;
#pragma unroll
                for (int n = 0; n < 2; ++n)
#pragma unroll
                    for (int e = 0; e < 4; ++e) { const float a = acc[ai][0][m][n][e], b = acc[ai][1][m][n][e];
                        o[n][e] = (a * b) * (rs2 * fast_rcp(1.f + fast_exp2(a * nrl))); }
                *(v4u*)(act + ((((size_t)u.pm * (DFF / 64) + (col0 >> 6)) * 256 + (row - u.pm * 256)) << 6) + (col0 & 63)) = pack8(o[0], o[1]); }
    }
};

#define XB_TMO      128
#define XB_XCNT(j)  (256  + 64 * (j))
#define XB_XSUB(j)  (1280 + 64 * (j))
#define XB_XGEN(j)  (2304 + 64 * (j))
#define XB_TOP      3328
#define XB_TOPGEN   3392
#define XCD_BAR_WORDS 3456
#define XB_SPIN_CAP (1u << 18)

__device__ __forceinline__ unsigned xb_ld(unsigned* p)              { return __hip_atomic_load(p, __ATOMIC_RELAXED, __HIP_MEMORY_SCOPE_AGENT); }
__device__ __forceinline__ unsigned xb_add(unsigned* p, unsigned v) { return __hip_atomic_fetch_add(p, v, __ATOMIC_RELAXED, __HIP_MEMORY_SCOPE_AGENT); }
__device__ __forceinline__ unsigned xb_xcc_id() { return (unsigned)__builtin_amdgcn_s_getreg((3 << 11) | 20) & 0xFu; }
#define XB_SPIN(cond, bar) do { unsigned _sp = 0; while (cond) { __builtin_amdgcn_s_sleep(1); \
    if ((++_sp & 255u) == 0u) { if (xb_ld(&(bar)[XB_TMO])) break; if (_sp > XB_SPIN_CAP) { atomicAdd(&(bar)[XB_TMO], 1u); break; } } } } while (0)

struct XcdBarrier { unsigned* bar; unsigned x; volatile LAS unsigned* st; };

__device__ __forceinline__ XcdBarrier xcd_barrier_post(unsigned* bar, volatile LAS unsigned* st) {
    XcdBarrier b; b.bar = bar; b.x = xb_xcc_id(); b.st = st;
    if (threadIdx.x == 0) (void)xb_add(&bar[XB_XCNT(b.x)], 1u);
    return b;
}
__device__ __forceinline__ void xcd_barrier_complete(unsigned* bar, unsigned x, unsigned& nloc, unsigned& nx) {
    const unsigned G = gridDim.x * gridDim.y * gridDim.z;
    unsigned sum, cnt, mine, sp = 0u;
    for (;;) {
        sum = 0u; cnt = 0u; mine = 0u;
#pragma unroll
        for (unsigned j = 0; j < 16; ++j) { const unsigned c = xb_ld(&bar[XB_XCNT(j)]); sum += c; cnt += (c > 0u) ? 1u : 0u; mine = (j == x) ? c : mine; }
        if (sum == G) break;
        __builtin_amdgcn_s_sleep(1);
        if ((++sp & 255u) == 0u) { if (xb_ld(&bar[XB_TMO])) break; if (sp > XB_SPIN_CAP) { atomicAdd(&bar[XB_TMO], 1u); break; } }
    }
    nloc = mine > 0u ? mine : 1u; nx = cnt > 0u ? cnt : 1u;
}
__device__ __forceinline__ void xcd_barrier(const XcdBarrier& b) {
    asm volatile("s_waitcnt vmcnt(0)" ::: "memory");
    __syncthreads();
    if (threadIdx.x == 0) {
        unsigned* bar = b.bar;
        __builtin_amdgcn_s_waitcnt(0);
        unsigned nloc = b.st[0], nx = b.st[1];
        if (nloc == 0u) { xcd_barrier_complete(bar, b.x, nloc, nx); b.st[0] = nloc; b.st[1] = nx; }
        const unsigned old = xb_add(&bar[XB_XSUB(b.x)], 1u);
        const unsigned gen = old / nloc;
        if (old + 1u == (gen + 1u) * nloc) {
            __builtin_amdgcn_fence(__ATOMIC_RELEASE, "agent");
            asm volatile("s_waitcnt vmcnt(0)" ::: "memory");
            const unsigned og = xb_add(&bar[XB_TOP], 1u);
            const unsigned tg = og / nx;
            if (og + 1u == (tg + 1u) * nx) xb_add(&bar[XB_TOPGEN], 1u);
            else XB_SPIN(xb_ld(&bar[XB_TOPGEN]) == tg, bar);
            __builtin_amdgcn_fence(__ATOMIC_ACQUIRE, "agent");
            xb_add(&bar[XB_XGEN(b.x)], 1u);
            asm volatile("s_waitcnt vmcnt(0)" ::: "memory");
        } else {
            XB_SPIN(xb_ld(&bar[XB_XGEN(b.x)]) == gen, bar);
            __builtin_amdgcn_fence(__ATOMIC_ACQUIRE, "agent");
            asm volatile("s_waitcnt vmcnt(0)" ::: "memory");
        }
    }
    __syncthreads();
}


__device__ __forceinline__ void group_barrier(unsigned* cnt, unsigned target, unsigned* extra, unsigned* tmo, bool same_xcd) {
    asm volatile("s_waitcnt vmcnt(0)" ::: "memory");
    __syncthreads();
    if (threadIdx.x == 0) {
        __builtin_amdgcn_s_waitcnt(0);
        if (!same_xcd) { __builtin_amdgcn_fence(__ATOMIC_RELEASE, "agent"); asm volatile("s_waitcnt vmcnt(0)" ::: "memory"); }
        (void)xb_add(cnt, 1u);
        if (extra) (void)xb_add(extra, 1u);
        unsigned sp = 0;
        while (xb_ld(cnt) < target) { __builtin_amdgcn_s_sleep(1); if ((++sp & 255u) == 0u) { if (xb_ld(tmo)) break; if (sp > XB_SPIN_CAP) { atomicAdd(tmo, 1u); break; } } }
        __builtin_amdgcn_fence(__ATOMIC_ACQUIRE, "agent");
        asm volatile("s_waitcnt vmcnt(0)" ::: "memory");
    }
    __syncthreads();
}
__device__ __forceinline__ void wait_global(unsigned* cnt, unsigned target, unsigned* tmo) {
    if (threadIdx.x == 0) {
        unsigned sp = 0;
        while (xb_ld(cnt) < target) { __builtin_amdgcn_s_sleep(1); if ((++sp & 255u) == 0u) { if (xb_ld(tmo)) break; if (sp > XB_SPIN_CAP) { atomicAdd(tmo, 1u); break; } } }
        __builtin_amdgcn_fence(__ATOMIC_ACQUIRE, "agent");
        asm volatile("s_waitcnt vmcnt(0)" ::: "memory");
    }
    __syncthreads();
}

struct EpiFinal {
    static constexpr bool PERM = true, AFTER_DRAIN = false, LAST_FUSED = true;
    bf16* hb; float* ss; float* out; const float* gfin; unsigned* gcnt; unsigned target; unsigned* glob1; unsigned* tmo; bool same_xcd;
    __device__ __forceinline__ bool keep(const pg8::Unit&) const { return false; }
    __device__ __forceinline__ void operator()(Acc& acc, const pg8::Unit& u, int wr, int wc, int fr, int fq) const { const EpiResid<false> E{nullptr, hb, ss}; E(acc, u, wr, wc, fr, fq); }
    __device__ __forceinline__ void fused(Acc& acc, const pg8::Unit& u, int wr, int wc, int fr, int fq, LAS unsigned char* lds, int wid, int lane) const {
        const int row0 = u.pm * 256 + wr * 64 + fr, col0 = u.pn * 256 + wc * 32 + 8 * fq;
        const size_t off0 = (size_t)row0 * DM + col0;
        v4u pb[8][2];
#pragma unroll
        for (int g = 0; g < 8; ++g)
#pragma unroll
            for (int bj = 0; bj < 2; ++bj) pb[g][bj] = *(const v4u*)(hb + off0 + (size_t)((g >> 2) * 128 + (g & 3) * 16) * DM + bj * 128);
#pragma unroll
        for (int g = 0; g < 8; ++g) { const int ai = g >> 2, m = g & 3; const int row = row0 + ai * 128 + m * 16; float sq = 0.f;
#pragma unroll
            for (int bj = 0; bj < 2; ++bj) { f32x4 b0, b1; unpack8(pb[g][bj], b0, b1);
                const f32x4 v0 = acc[ai][bj][m][0] + b0, v1 = acc[ai][bj][m][1] + b1; acc[ai][bj][m][0] = v0; acc[ai][bj][m][1] = v1;
                sq += (v0[0] * v0[0] + v0[1] * v0[1]) + (v0[2] * v0[2] + v0[3] * v0[3]) + (v1[0] * v1[0] + v1[1] * v1[1]) + (v1[2] * v1[2] + v1[3] * v1[3]); }
            sq += __shfl_xor(sq, 16); sq += __shfl_xor(sq, 32);
            if (fq == 0) atomicAdd(ss + row, sq); }
        group_barrier(gcnt, target, nullptr, tmo, same_xcd);
        wait_global(glob1, 256u, tmo);
        const int col1 = col0 - 1024;
        { f32x4 gv[2][2];
#pragma unroll
          for (int bj = 0; bj < 2; ++bj) { gv[bj][0] = *(const f32x4*)(gfin + col0 + bj * 128); gv[bj][1] = *(const f32x4*)(gfin + col0 + bj * 128 + 4); }
#pragma unroll
          for (int g = 0; g < 8; ++g) { const int ai = g >> 2, m = g & 3; const int row = row0 + ai * 128 + m * 16; const float rs = 1.0f / sqrtf(ss[row] * (1.0f / DM) + EPS);
#pragma unroll
            for (int bj = 0; bj < 2; ++bj) { float* o = out + (size_t)row * DM + col0 + bj * 128; __builtin_nontemporal_store(acc[ai][bj][m][0] * rs * gv[bj][0], (f32x4*)o); __builtin_nontemporal_store(acc[ai][bj][m][1] * rs * gv[bj][1], (f32x4*)(o + 4)); } } }
        asm volatile("" ::: "memory");
        { f32x4 gw[2][2];
#pragma unroll
          for (int bj = 0; bj < 2; ++bj) { gw[bj][0] = *(const f32x4*)(gfin + col1 + bj * 128); gw[bj][1] = *(const f32x4*)(gfin + col1 + bj * 128 + 4); }
#pragma unroll
          for (int g = 0; g < 8; ++g)
#pragma unroll
            for (int bj = 0; bj < 2; ++bj) pb[g][bj] = *(const v4u*)(hb + off0 - 1024 + (size_t)((g >> 2) * 128 + (g & 3) * 16) * DM + bj * 128);
#pragma unroll
          for (int g = 0; g < 8; ++g) { const int ai = g >> 2, m = g & 3; const int row = row0 + ai * 128 + m * 16; const float rs = 1.0f / sqrtf(ss[row] * (1.0f / DM) + EPS);
#pragma unroll
            for (int bj = 0; bj < 2; ++bj) { f32x4 b0, b1; unpack8(pb[g][bj], b0, b1); float* o1 = out + (size_t)row * DM + col1 + bj * 128; __builtin_nontemporal_store(b0 * rs * gw[bj][0], (f32x4*)o1); __builtin_nontemporal_store(b1 * rs * gw[bj][1], (f32x4*)(o1 + 4)); } } }
    }
};

__device__ __forceinline__ float wave_sum(float v) {
#pragma unroll
    for (int o = 1; o < 64; o <<= 1) v += __shfl_xor(v, o);
    return v;
}
__device__ __forceinline__ int rope_sigma(int p) { return (p < 16) ? ((p & 3) + 4 * ((p >> 3) & 1) + 8 * ((p >> 2) & 1)) : p; }
struct TpItem { const float* src; bf16* dst; const float* ks; int ldw, ldd, perm; float cscale; };
struct TpPtrs { const float *w_in, *w_attn_o, *w_conv_o, *w_out, *w_xkv, *w_xo, *w_gate_up, *w_down, *g_ffn; bf16 *WinT, *WacT, *WoutT, *WxkvT, *wxot, *WguT, *WdT; };
constexpr int TP_I0 = 32 * 272, TP_I1 = 16 * 64, TP_I2 = 16 * 64, TP_I3 = 32 * 64, TP_I4 = 32 * 32, TP_I7 = 8 * 64, TP_I5 = 32 * 352, TP_I6 = 88 * 64;
constexpr int TP_NEARLY = TP_I0 + TP_I1 + TP_I2 + TP_I3 + TP_I4 + TP_I7, TP_NITEMS = TP_NEARLY + TP_I5 + TP_I6;
__device__ __forceinline__ TpItem tp_mk(const float* W, int ldw, int src_col0, int k0, bf16* dst, int ldd, int dst_row0, int dst_col0, const float* kscale, int perm, float cscale = 1.f) {
    TpItem d; d.cscale = cscale; d.src = W + (size_t)k0 * ldw + src_col0; d.dst = dst + (size_t)dst_row0 * ldd + dst_col0 + k0; d.ks = kscale ? kscale + k0 : nullptr; d.ldw = ldw; d.ldd = ldd; d.perm = perm; return d; }
__device__ __forceinline__ TpItem tp_desc(int it, const TpPtrs& P) {
    int r = it;
    if (r < TP_I0) { const int kb_ = r / 272, Gp = r % 272; int src, perm = 0;
        if (Gp < 40) { src = 32 * Gp; perm = ((Gp & 1) == 0) ? 1 : 0; }
        else if (Gp < 80) { src = 32 * Gp; }
        else if (Gp < 144) { const int gg = Gp - 80, t = gg >> 3, i32 = gg & 7; src = (i32 < 4) ? (2560 + 128 * t + 32 * i32) : (3584 + 128 * t + 32 * (i32 - 4)); }
        else { const int gg = Gp - 144, t = gg >> 3, i32 = gg & 7; src = (i32 < 4) ? (4608 + 128 * t + 32 * i32) : (6656 + 128 * t + 32 * (i32 - 4)); }
        return tp_mk(P.w_in, NIN, src, 64 * kb_, P.WinT, DM, 32 * Gp, 0, nullptr, perm, Gp >= 144 ? -LOG2E : 1.f); } r -= TP_I0;
    if (r < TP_I1) { const int kb_ = r / 64, Gp = r % 64; return tp_mk(P.w_attn_o, DM, 32 * Gp, 64 * kb_, P.WacT, DM, 32 * Gp, 0, nullptr, 0); } r -= TP_I1;
    if (r < TP_I2) { const int kb_ = r / 64, Gp = r % 64; return tp_mk(P.w_conv_o, DM, 32 * Gp, 64 * kb_, P.WacT, DM, 32 * Gp, 1024, nullptr, 0); } r -= TP_I2;
    if (r < TP_I3) { const int kb_ = r / 64, Gp = r % 64; return tp_mk(P.w_out, DM, 32 * Gp, 64 * kb_, P.WoutT, DM, 32 * Gp, 0, nullptr, 0); } r -= TP_I3;
    if (r < TP_I4) { const int kb_ = r / 32, Gp = r % 32; return tp_mk(P.w_xkv, 2 * XW, 32 * Gp, 64 * kb_, P.WxkvT, DM, 32 * Gp, 0, nullptr, 0); } r -= TP_I4;
    if (r < TP_I7) { const int kb_ = r / 64, Gp = r % 64; return tp_mk(P.w_xo, DM, 32 * Gp, 64 * kb_, P.wxot, XW, 32 * Gp, 0, nullptr, 0); } r -= TP_I7;
    if (r < TP_I5) { const int kb_ = r / 352, Gp = r % 352; const int t = Gp >> 3, i32 = Gp & 7; const int src = (i32 < 4) ? (128 * t + 32 * i32) : (DFF + 128 * t + 32 * (i32 - 4));
        return tp_mk(P.w_gate_up, 2 * DFF, src, 64 * kb_, P.WguT, DM, 32 * Gp, 0, P.g_ffn, 0); } r -= TP_I5;
    { const int kb_ = r / 64, Gp = r % 64; return tp_mk(P.w_down, DM, 32 * Gp, 64 * kb_, P.WdT, DFF, 32 * Gp, 0, nullptr, 0); }
}
__device__ __forceinline__ void tp_load(const TpItem& d, float (&tv)[32], int lane) {
    const float* sp = d.src + (size_t)(lane >> 5) * d.ldw + (lane & 31);
#pragma unroll
    for (int i = 0; i < 32; ++i) tv[i] = __builtin_nontemporal_load(sp + (size_t)(2 * i) * d.ldw);
}
__device__ __forceinline__ void tp_finish(const TpItem& d, const float (&tv)[32], LAS float* scr, int lane) {
#pragma unroll
    for (int i = 0; i < 32; ++i) scr[(2 * i + (lane >> 5)) * 33 + (lane & 31)] = tv[i];
    LDS_WAIT(); asm volatile("" ::: "memory");
    const int c = lane & 7;
    float sc[8];
#pragma unroll
    for (int i = 0; i < 8; ++i) sc[i] = d.ks ? d.ks[8 * c + i] * d.cscale : d.cscale;
#pragma unroll
    for (int j = 0; j < 4; ++j) { const int nd = (lane >> 3) + 8 * j; const int scol = d.perm ? rope_sigma(nd) : nd; const LAS float* s = scr + (8 * c) * 33 + scol;
        v4u o; o.x = cvt_pk_bf16(s[0 * 33] * sc[0], s[1 * 33] * sc[1]); o.y = cvt_pk_bf16(s[2 * 33] * sc[2], s[3 * 33] * sc[3]);
        o.z = cvt_pk_bf16(s[4 * 33] * sc[4], s[5 * 33] * sc[5]); o.w = cvt_pk_bf16(s[6 * 33] * sc[6], s[7 * 33] * sc[7]);
        *(v4u*)(d.dst + (size_t)nd * d.ldd + 8 * c) = o; }
    LDS_WAIT(); asm volatile("" ::: "memory");
}
__device__ __forceinline__ void tp_run(int it0, int it_end, int stride, const TpPtrs& P, LAS float* scr, int lane) {
    if (it0 >= it_end) return;
    TpItem d = tp_desc(it0, P); float tv[32]; tp_load(d, tv, lane);
    for (int it = it0; it < it_end; it += stride) {
        const int nx = it + stride; const bool more = nx < it_end; TpItem dn = d; float tn[32];
        if (more) { dn = tp_desc(nx, P); tp_load(dn, tn, lane); }
        tp_finish(d, tv, scr, lane);
        if (more) { d = dn;
#pragma unroll
            for (int i = 0; i < 32; ++i) tv[i] = tn[i]; }
    }
}
__device__ __forceinline__ void tp_run3(int it0, int it_end, int stride, const TpPtrs& P, LAS float* scr, int lane) {
    if (it0 >= it_end) return;
    TpItem d0 = tp_desc(it0, P), d1 = d0; float t0[32], t1[32]; tp_load(d0, t0, lane);
    if (it0 + stride < it_end) { d1 = tp_desc(it0 + stride, P); tp_load(d1, t1, lane); }
    for (int it = it0; it < it_end; it += stride) {
        const int n2 = it + 2 * stride; const bool more2 = n2 < it_end; TpItem d2 = d0; float t2[32];
        if (more2) { d2 = tp_desc(n2, P); tp_load(d2, t2, lane); }
        tp_finish(d0, t0, scr, lane);
        d0 = d1; d1 = d2;
#pragma unroll
        for (int i = 0; i < 32; ++i) { t0[i] = t1[i]; t1[i] = t2[i]; }
    }
}
__device__ __forceinline__ void rms_rows_to_bf16(const float* xb, const float* g, bf16* ob, int m0, int m_end, int stride, int lane) {
    if (m0 >= m_end) return;
    f32x4 v[8];
    { const f32x4* xr = (const f32x4*)(xb + (size_t)m0 * DM) + lane;
#pragma unroll
      for (int j = 0; j < 8; ++j) v[j] = __builtin_nontemporal_load(xr + 64 * j); }
    f32x4 gg[8];
#pragma unroll
    for (int j = 0; j < 8; ++j) gg[j] = ((const f32x4*)g + lane)[64 * j];
    for (int m = m0; m < m_end; m += stride) {
        const int nx = m + stride; const bool more = nx < m_end; f32x4 vn[8];
        if (more) { const f32x4* xr = (const f32x4*)(xb + (size_t)nx * DM) + lane;
#pragma unroll
            for (int j = 0; j < 8; ++j) vn[j] = __builtin_nontemporal_load(xr + 64 * j); }
        float s = 0.f;
#pragma unroll
        for (int j = 0; j < 8; ++j) s += (v[j].x * v[j].x + v[j].y * v[j].y) + (v[j].z * v[j].z + v[j].w * v[j].w);
        const float rstd = 1.0f / sqrtf(wave_sum(s) * (1.0f / DM) + EPS);
        v2u* o8 = (v2u*)(ob + (size_t)m * DM) + lane;
#pragma unroll
        for (int j = 0; j < 8; ++j) { v2u w; w.x = cvt_pk_bf16(v[j].x * rstd * gg[j].x, v[j].y * rstd * gg[j].y); w.y = cvt_pk_bf16(v[j].z * rstd * gg[j].z, v[j].w * rstd * gg[j].w); o8[64 * j] = w; }
        if (more) {
#pragma unroll
            for (int j = 0; j < 8; ++j) v[j] = vn[j]; }
    }
}

__device__ __forceinline__ s16x4 vtr(const LAS unsigned char* p) { typedef short v4i16_t __attribute__((ext_vector_type(4))); return __builtin_bit_cast(s16x4, __builtin_amdgcn_ds_read_tr16_b64_v4i16((LAS v4i16_t*)p)); }

struct ConvCtx { const bf16* zc; bf16* xn; int ts, cg; f32x4 w0[2], w1[2], w2[2], p1[2], p2[2]; };
__device__ __forceinline__ void conv_issue(const ConvCtx& c, int batch, v4u (&zb)[4], v4u (&zp)[4]) {
#pragma unroll
    for (int i = 0; i < 4; ++i) { const bf16* zr = c.zc + (size_t)(c.ts + 4 * batch + i) * (2 * CW) + 8 * c.cg; zb[i] = *(const v4u*)(zr); zp[i] = *(const v4u*)(zr + CW); }
}
__device__ __forceinline__ void conv_finish(ConvCtx& c, int batch, const v4u (&zb)[4], const v4u (&zp)[4]) {
#pragma unroll
    for (int i = 0; i < 4; ++i) { f32x4 cb0, cb1, p0a, p0b; unpack8(zb[i], cb0, cb1); unpack8(zp[i], p0a, p0b);
        const f32x4 y0 = cb0 * (c.w0[0] * c.p2[0] + c.w1[0] * c.p1[0] + c.w2[0] * p0a), y1 = cb1 * (c.w0[1] * c.p2[1] + c.w1[1] * c.p1[1] + c.w2[1] * p0b);
        *(v4u*)(c.xn + (size_t)(c.ts + 4 * batch + i) * DM + AW + 8 * c.cg) = pack8(y0, y1);
        c.p2[0] = c.p1[0]; c.p2[1] = c.p1[1]; c.p1[0] = p0a; c.p1[1] = p0b; }
}
__device__ __forceinline__ void conv_init(ConvCtx& c, const bf16* zc, bf16* xn, const float* conv_w, int chunk, int tid) {
    c.zc = zc; c.xn = xn; c.cg = tid & 127; c.ts = chunk * 64 + (tid >> 7) * 16;
#pragma unroll
    for (int j = 0; j < 2; ++j) { c.w0[j] = *(const f32x4*)(conv_w + 8 * c.cg + 4 * j); c.w1[j] = *(const f32x4*)(conv_w + CW + 8 * c.cg + 4 * j); c.w2[j] = *(const f32x4*)(conv_w + 2 * CW + 8 * c.cg + 4 * j);
        c.p2[j] = (f32x4){0.f, 0.f, 0.f, 0.f}; c.p1[j] = c.p2[j]; }
    if (c.ts >= 2) { unpack8(*(const v4u*)(zc + (size_t)(c.ts - 2) * (2 * CW) + CW + 8 * c.cg), c.p2[0], c.p2[1]); unpack8(*(const v4u*)(zc + (size_t)(c.ts - 1) * (2 * CW) + CW + 8 * c.cg), c.p1[0], c.p1[1]); }
}
template <bool CONV>
__device__ __forceinline__ void swa_unit(LAS unsigned char* lds, int n, int g, const bf16* qb, const bf16* kb, const bf16* vb, const float* sinks, bf16* A2, int tid, int lane, int wave, ConvCtx& cc, int batch0) {
    LAS unsigned char* Kl = lds; LAS unsigned char* Vl = lds + 32768;
#pragma unroll
    for (int i = 0; i < 4; ++i) { const int id = tid + 512 * i, row = id >> 3, ch = id & 7; const int tok = (n - 1) * 128 + row;
        v4u kv = (v4u){0u, 0u, 0u, 0u}, vv = (v4u){0u, 0u, 0u, 0u};
        if (tok >= 0) { kv = *(const v4u*)(kb + (size_t)tok * KVW + g * 64 + ch * 8); vv = *(const v4u*)(vb + (size_t)tok * KVW + g * 64 + ch * 8); }
        *(LAS v4u*)(Kl + row * 128 + ((ch ^ ((row >> 1) & 7)) << 4)) = kv;
        *(LAS v4u*)(Vl + row * 128 + ((ch ^ (((row >> 1) & 1) << 2)) << 4)) = vv; }
    __syncthreads();
    const int ql = lane & 31, h = lane >> 5, hq = g * 4 + (wave & 3);
    const float sinkl = sinks[hq] * LOG2E;
    const int li = lane & 15, qp = li >> 2, pp = li & 3, g1 = (lane >> 4) & 1;
    const float NEG = -__builtin_inff();
#pragma unroll 1
    for (int st = 0; st < 2; ++st) {
        const int r0 = (wave >> 2) * 64 + 32 * st; const size_t tok = (size_t)n * 128 + r0 + ql;
        bf16x8 qf[4];
#pragma unroll
        for (int ks = 0; ks < 4; ++ks) qf[ks] = *(const bf16x8*)(qb + tok * AW + hq * 64 + 16 * ks + 8 * h);
        v4u zb[4], zp[4];
        if (CONV) conv_issue(cc, batch0 + st, zb, zp);
        f32x16 S[5];
#pragma unroll
        for (int t = 0; t < 5; ++t) { const int c = r0 + 32 * t + ql; S[t] = (f32x16){};
#pragma unroll
            for (int ks = 0; ks < 4; ++ks) { const bf16x8 kf = *(const LAS bf16x8*)(Kl + c * 128 + (((2 * ks + h) ^ ((c >> 1) & 7)) << 4));
                S[t] = __builtin_amdgcn_mfma_f32_32x32x16_bf16(kf, qf[ks], S[t], 0, 0, 0); } }
#pragma unroll
        for (int r = 0; r < 16; ++r) { const int cc = (r & 3) + 8 * (r >> 2) + 4 * h; if (!(cc > ql)) S[0][r] = NEG; if (!(cc <= ql)) S[4][r] = NEG; }
        if (n == 0) {
#pragma unroll
            for (int t = 0; t < 5; ++t)
#pragma unroll
                for (int r = 0; r < 16; ++r) { const int cc = (r & 3) + 8 * (r >> 2) + 4 * h; if (r0 + 32 * t + cc < 128) S[t][r] = NEG; } }
        float mx = sinkl;
#pragma unroll
        for (int t = 0; t < 5; ++t)
#pragma unroll
            for (int r = 0; r < 16; ++r) mx = fmaxf(mx, S[t][r]);
        mx = fmaxf(mx, __shfl_xor(mx, 32));
        float l = 0.f;
#pragma unroll
        for (int t = 0; t < 5; ++t)
#pragma unroll
            for (int r = 0; r < 16; ++r) { const float p = fast_exp2(S[t][r] - mx); S[t][r] = p; l += p; }
        l += __shfl_xor(l, 32); l += fast_exp2(sinkl - mx);
        f32x16 O[2]; O[0] = (f32x16){}; O[1] = (f32x16){};
#pragma unroll
        for (int t = 0; t < 5; ++t)
#pragma unroll
            for (int s = 0; s < 2; ++s) {
                v4u pw; pw.x = cvt_pk_bf16(S[t][8 * s + 0], S[t][8 * s + 1]); pw.y = cvt_pk_bf16(S[t][8 * s + 2], S[t][8 * s + 3]);
                pw.z = cvt_pk_bf16(S[t][8 * s + 4], S[t][8 * s + 5]); pw.w = cvt_pk_bf16(S[t][8 * s + 6], S[t][8 * s + 7]);
                const bf16x8 pf = __builtin_bit_cast(bf16x8, pw);
                const int krow = r0 + 32 * t + 16 * s + 4 * h + qp;
#pragma unroll
                for (int db = 0; db < 2; ++db) { const int chunk = (4 * db + 2 * g1 + (pp >> 1)) ^ (((qp >> 1) & 1) << 2);
                    const LAS unsigned char* va = Vl + krow * 128 + (chunk << 4) + (pp & 1) * 8;
                    const s16x4 lo = vtr(va), hi = vtr(va + 8 * 128);
                    const bf16x8 vf = (bf16x8){lo[0], lo[1], lo[2], lo[3], hi[0], hi[1], hi[2], hi[3]};
                    O[db] = __builtin_amdgcn_mfma_f32_32x32x16_bf16(vf, pf, O[db], 0, 0, 0); } }
        const float inv = 1.0f / l;
#pragma unroll
        for (int db = 0; db < 2; ++db)
#pragma unroll
            for (int pr = 0; pr < 2; ++pr) { const int ra = 8 * pr, rb = 8 * pr + 4;
                unsigned ax = cvt_pk_bf16(O[db][ra + 0] * inv, O[db][ra + 1] * inv), ay = cvt_pk_bf16(O[db][ra + 2] * inv, O[db][ra + 3] * inv);
                unsigned bx_ = cvt_pk_bf16(O[db][rb + 0] * inv, O[db][rb + 1] * inv), by = cvt_pk_bf16(O[db][rb + 2] * inv, O[db][rb + 3] * inv);
                { auto r = __builtin_amdgcn_permlane32_swap(ax, bx_, false, false); ax = r[0]; bx_ = r[1]; }
                { auto r = __builtin_amdgcn_permlane32_swap(ay, by, false, false); ay = r[0]; by = r[1]; }
                *(v4u*)(A2 + tok * DM + hq * 64 + 32 * db + 16 * pr + 8 * h) = (v4u){ax, ay, bx_, by}; }
        if (CONV) conv_finish(cc, batch0 + st, zb, zp);
    }
    __syncthreads();
}
__device__ __forceinline__ void wave_gemm_64x32_k128(const bf16* A, int lda, const bf16* Bt, int ldb, bf16* C, int ldc, int lane) {
    const int fr = lane & 15, fq = lane >> 4;
    f32x4 acc[4][2];
#pragma unroll
    for (int mi = 0; mi < 4; ++mi)
#pragma unroll
        for (int ni = 0; ni < 2; ++ni) acc[mi][ni] = (f32x4){0.f, 0.f, 0.f, 0.f};
#pragma unroll
    for (int ks = 0; ks < 4; ++ks) { bf16x8 a[4], b[2];
#pragma unroll
        for (int mi = 0; mi < 4; ++mi) a[mi] = *(const bf16x8*)(A + (size_t)(16 * mi + fr) * lda + 32 * ks + 8 * fq);
#pragma unroll
        for (int ni = 0; ni < 2; ++ni) b[ni] = *(const bf16x8*)(Bt + (size_t)(16 * ni + fr) * ldb + 32 * ks + 8 * fq);
#pragma unroll
        for (int mi = 0; mi < 4; ++mi)
#pragma unroll
            for (int ni = 0; ni < 2; ++ni) acc[mi][ni] = __builtin_amdgcn_mfma_f32_16x16x32_bf16(b[ni], a[mi], acc[mi][ni], 0, 0, 0); }
#pragma unroll
    for (int mi = 0; mi < 4; ++mi)
#pragma unroll
        for (int ni = 0; ni < 2; ++ni) { v2u w; w.x = cvt_pk_bf16(acc[mi][ni][0], acc[mi][ni][1]); w.y = cvt_pk_bf16(acc[mi][ni][2], acc[mi][ni][3]);
            st8_wt(C + (size_t)(16 * mi + fr) * ldc + 16 * ni + 4 * fq, w); }
}

constexpr int NPHASE = 10;
struct Args { const float* in[18]; float* out; unsigned char* ws; int ph_lo, ph_hi, li, pad; };

__global__ void __launch_bounds__(512, 2) hyb_fwd(Args args) {
    extern __shared__ __attribute__((aligned(16))) unsigned char lds_raw[];
    LAS unsigned char* lds = (LAS unsigned char*)lds_raw;
    volatile LAS unsigned* MISC = (volatile LAS unsigned*)(lds + MISC_OFF);
    const int tid = threadIdx.x, lane = tid & 63, wave = __builtin_amdgcn_readfirstlane(tid >> 6);
    const int G = gridDim.x, bx = blockIdx.x;
    unsigned char* ws = args.ws;
    unsigned* ctl = (unsigned*)(ws + WS_CTL);
    const float* x = args.in[0]; const float* mem = args.in[1]; const float* g_mix = args.in[2]; const float* w_in = args.in[3]; const float* conv_w = args.in[4];
    const float* sinks = args.in[5]; const float* w_attn_o = args.in[6]; const float* w_conv_o = args.in[7]; const float* w_out = args.in[8]; const float* g_xattn = args.in[9];
    const float* g_mem = args.in[10]; const float* w_xq = args.in[11]; const float* w_xkv = args.in[12]; const float* w_xo = args.in[13]; const float* g_ffn = args.in[14];
    const float* w_gate_up = args.in[15]; const float* w_down = args.in[16]; const float* g_final = args.in[17];
    float* out = args.out;
    float* ss1 = (float*)(ws + WS_SS); float* ss2 = ss1 + SEQ; float* ss3 = ss2 + SEQ;
    float* cs = (float*)(ws + WS_CS);
    bf16* kvb = (bf16*)(ws + WS_KVB); bf16* memn = (bf16*)(ws + WS_MEMN); bf16* wxqp = (bf16*)(ws + WS_WXQ); bf16* wxot = (bf16*)(ws + WS_WXOT);
    bf16* WguT = (bf16*)(ws + WS_WGUT); bf16* WdT = (bf16*)(ws + WS_WDT); bf16* XN = (bf16*)(ws + WS_XN);
    bf16* WinT = (bf16*)(ws + WS_WINT); bf16* WacT = (bf16*)(ws + WS_WACT); bf16* WoutT = (bf16*)(ws + WS_WOUTT); bf16* WxkvT = (bf16*)(ws + WS_WXKVT);
    bf16* WqKT = (bf16*)(ws + WS_WQKT); bf16* VWoT = (bf16*)(ws + WS_VWOT);
    bf16* qb = (bf16*)(ws + WS_Q); bf16* kb = (bf16*)(ws + WS_K); bf16* vb = (bf16*)(ws + WS_V); bf16* zc = (bf16*)(ws + WS_ZC);
    bf16* Pb = (bf16*)(ws + WS_P); bf16* act = (bf16*)(ws + WS_ACT);
    bf16* sgr = (bf16*)out; bf16* sgc = sgr + (size_t)SEQ * DM;
    bf16* merged = sgr;

    for (int u = tid; u < (LDS_BYTES - LDSCTL_OFF) / 4; u += 512) ((LAS unsigned*)(lds + LDSCTL_OFF))[u] = 0u;
    __syncthreads();
    XcdBarrier bar; bar.bar = ctl + CW_BAR; bar.x = 0; bar.st = nullptr;
    if (MK_N_LAUNCHES == 1) bar = xcd_barrier_post(ctl + CW_BAR, MISC + 8);
    if (tid == 0) __hip_atomic_store(ctl + CW_XID + 64 * (bx & 63) + (bx >> 6), xb_xcc_id() + 1u, __ATOMIC_RELAXED, __HIP_MEMORY_SCOPE_AGENT);
    const int lo = args.ph_lo, hi = args.ph_hi;
    const bool tailfill = (G == 256);
#define IN(k) (lo <= (k) && (k) < hi)
#ifdef PROBE_PHASE
    int n_stamp = 0;
#define STAMP() do { if (bx == 0 && tid == 0) { ((volatile LAS unsigned long long*)(lds + MISC_OFF + 128))[n_stamp] = __builtin_amdgcn_s_memrealtime(); ((volatile LAS unsigned long long*)(lds + MISC_OFF + 256))[n_stamp] = __builtin_amdgcn_s_memtime(); } ++n_stamp; } while (0)
#define SUBSTAMP(i) do { __builtin_amdgcn_s_waitcnt(0); if (bx == 0 && tid == 0) ((volatile LAS unsigned long long*)(lds + MISC_OFF + 128))[40 + (i)] = __builtin_amdgcn_s_memrealtime(); } while (0)
#else
#define STAMP() do { } while (0)
#define SUBSTAMP(i) do { } while (0)
#endif
#define SEAM(k) do { if (IN(k) && IN((k) + 1)) xcd_barrier(bar); STAMP(); } while (0)
    const bool grp = (G == 256) && (MK_N_LAUNCHES == 1);
    const int pm_own = 8 * (bx & 7) + ((bx >> 3) & 7), jmem = bx >> 6;
    unsigned* gcnt = ctl + CW_GRP + 64 * (bx & 63); unsigned* glob = ctl + CW_GLOB; unsigned* gtmo = ctl + CW_BAR + XB_TMO;
    unsigned gepoch = 0; bool same_xcd = false;
#define GSEAM(k, extra) do { if (IN(k) && IN((k) + 1)) { if (grp) { gepoch += 4u; group_barrier(gcnt, gepoch, (extra), gtmo, same_xcd); } else xcd_barrier(bar); } STAMP(); } while (0)
    STAMP();

    const TpPtrs TP{w_in, w_attn_o, w_conv_o, w_out, w_xkv, w_xo, w_gate_up, w_down, g_ffn, WinT, WacT, WoutT, WxkvT, wxot, WguT, WdT};
    if (IN(0)) {
        LAS float* scr = (LAS float*)(lds + wave * 16384);
        const int gw = bx * 8 + wave, NGW = G * 8;
        SUBSTAMP(0);
        if (bx & 1) rms_rows_to_bf16(x, g_mix, XN, gw, SEQ, NGW, lane);
        tp_run(gw, tailfill ? TP_NEARLY : TP_NITEMS, NGW, TP, scr, lane);
        SUBSTAMP(1);
        if (!(bx & 1)) rms_rows_to_bf16(x, g_mix, XN, gw, SEQ, NGW, lane);
        SUBSTAMP(2);
        rms_rows_to_bf16(mem, g_mem, memn, gw, NMEM, NGW, lane);
        for (int k = gw; k < DM; k += NGW) { const float gs = g_xattn[k] * C2X; const f32x4* src = (const f32x4*)(w_xq + (size_t)k * XW) + lane; v2u* dst = (v2u*)(wxqp + (size_t)k * XW) + lane;
#pragma unroll
            for (int j = 0; j < 2; ++j) { const f32x4 v = src[64 * j]; v2u w; w.x = cvt_pk_bf16(v.x * gs, v.y * gs); w.y = cvt_pk_bf16(v.z * gs, v.w * gs); dst[64 * j] = w; } }
        const int gt = bx * 512 + tid, NGT = G * 512;
        for (int e = gt; e < SEQ * 8; e += NGT) { const int pos = e >> 3, i = e & 7;
            const float inv_freq = (i == 0) ? 1.0f : (i == 1) ? 0.19392274f : (i == 2) ? 0.037606031f : (i == 3) ? 0.0072926646f : (i == 4) ? 0.0014142136f : (i == 5) ? 0.00027424819f : (i == 6) ? 5.3182957e-05f : 1.0313385e-05f;
            const float ang = (float)pos * inv_freq; float sn, cn; sincosf(ang, &sn, &cn);
            cs[(size_t)pos * 16 + i] = cn; cs[(size_t)pos * 16 + 8 + i] = sn; }
        for (int e = gt; e < 3 * SEQ; e += NGT) ss1[e] = 0.f;
        SUBSTAMP(3);
    }
    SEAM(0);

    if (IN(1)) {
        { pg8::Prob g{memn, WxkvT, DM, DM, DM, 0}; pg8::StaticOrder S; S.init(NMEM, 2 * XW, G, (bx >= 128 && bx < 132) ? bx - 128 : -1);
          EpiStoreBf16 E{kvb, 2 * XW};
          pg8::gemm_phase<EpiStoreBf16, pg8::StaticOrder, PG8_ALIGN, PG8_SP2>(lds, g, S, E); }
        if (tailfill && bx >= 132) { tp_run3(TP_NEARLY + (bx - 132) * 8 + wave, TP_NITEMS, (256 - 132) * 8, TP, (LAS float*)(lds + wave * 16384), lane); __syncthreads(); }
        { pg8::Prob g{XN, WinT, DM, DM, DM, 0}; pg8::StaticOrder S; S.init(SEQ, NIN, G, bx, 1, true);
          EpiInProj E{qb, kb, vb, zc, sgr, sgc, cs};
          pg8::gemm_phase<EpiInProj, pg8::StaticOrder, PG8_ALIGN, PG8_SP2>(lds, g, S, E); }
    }
    SEAM(1);

    if (grp && IN(2)) {
        if (tid == 0) { unsigned* xt = ctl + CW_XID + 64 * (bx & 63); const unsigned a0 = xb_ld(xt), a1 = xb_ld(xt + 1), a2 = xb_ld(xt + 2), a3 = xb_ld(xt + 3);
            MISC[12] = (a0 != 0u && a0 == a1 && a0 == a2 && a0 == a3) ? 1u : 0u; }
        __syncthreads();
        same_xcd = __builtin_amdgcn_readfirstlane(MISC[12]) != 0u;
    }
    if (IN(2)) {
        SUBSTAMP(4);
        ConvCtx cc;
        if (grp) {
            conv_init(cc, zc, XN, conv_w, 4 * pm_own + jmem, tid);
            swa_unit<true>(lds, 2 * pm_own + ((2 * jmem) >> 2), (2 * jmem) & 3, qb, kb, vb, sinks, XN, tid, lane, wave, cc, 0);
            swa_unit<true>(lds, 2 * pm_own + ((2 * jmem + 1) >> 2), (2 * jmem + 1) & 3, qb, kb, vb, sinks, XN, tid, lane, wave, cc, 2);
        } else {
            for (int u = bx; u < (SEQ / 128) * 4; u += G) swa_unit<false>(lds, u >> 2, u & 3, qb, kb, vb, sinks, XN, tid, lane, wave, cc, 0);
            for (int ch = bx; ch < SEQ / 64; ch += G) { conv_init(cc, zc, XN, conv_w, ch, tid);
#pragma unroll 1
                for (int b = 0; b < 4; ++b) { v4u zb[4], zp[4]; conv_issue(cc, b, zb, zp); conv_finish(cc, b, zb, zp); } }
        }
        SUBSTAMP(5);
        const bool pp_all = !grp; const int pp_w = ((bx >> 4) << 3) + (bx & 7);
        for (int job = pp_all ? bx * 8 + wave : (((bx >> 3) & 1) ? pp_w * 8 + wave : 2048); job < 2048; job += (pp_all ? G * 8 : 1024)) { const int idx = job & 1023;
            if (job < 1024) { const int mt = idx >> 6, nt = idx & 63, m0 = 64 * mt, n0 = 32 * nt, hh = m0 >> 8, j0 = m0 & 255;
                wave_gemm_64x32_k128(kvb + (size_t)j0 * (2 * XW) + 128 * hh, 2 * XW, wxqp + (size_t)n0 * XW + 128 * hh, XW, WqKT + (size_t)m0 * DM + n0, DM, lane); }
            else { const int mt = idx >> 5, nt = idx & 31, m0 = 64 * mt, n0 = 32 * nt, hh = n0 >> 8, j0 = n0 & 255;
                wave_gemm_64x32_k128(wxot + (size_t)m0 * XW + 128 * hh, XW, kvb + (size_t)j0 * (2 * XW) + XW + 128 * hh, 2 * XW, VWoT + (size_t)m0 * (4 * NMEM) + n0, 4 * NMEM, lane); } }
    }
    SUBSTAMP(7);
    GSEAM(2, glob);

    if (IN(3)) { pg8::Prob g{XN, WacT, DM, DM, AW, AW}; pg8::StaticOrder S; S.init(SEQ, DM, G, bx, 2);
        EpiMerge E{sgr, sgc, merged};
        pg8::gemm_phase<EpiMerge, pg8::StaticOrder, PG8_ALIGN, PG8_SP2>(lds, g, S, E); }
    GSEAM(3, nullptr);

    if (IN(4)) { pg8::Prob g{merged, WoutT, DM, DM, DM, 0}; pg8::StaticOrder S; S.init(SEQ, DM, G, bx);
        EpiResid<true> E{x, XN, ss1};
        pg8::gemm_phase<EpiResid<true>, pg8::StaticOrder, PG8_ALIGN, PG8_SP2>(lds, g, S, E); }
    GSEAM(4, glob + 64);

    if (IN(5)) { if (grp) wait_global(glob, 256u, gtmo);
        pg8::Prob g{XN, WqKT, DM, DM, DM, 0}; pg8::StaticOrder S; S.init(SEQ, 4 * NMEM, G, bx);
        EpiSoftmax E{ss1, Pb};
        if ((SEQ / 256) * 4 <= G) pg8::gemm_phase<EpiSoftmax, pg8::StaticOrder, false, PG8_SP2>(lds, g, S, E); }
    GSEAM(5, nullptr);

    if (IN(6)) { pg8::Prob g{Pb, VWoT, 4 * NMEM, 4 * NMEM, 4 * NMEM, 0}; pg8::StaticOrder S; S.init(SEQ, DM, G, bx);
        EpiResid<false> E{nullptr, XN, ss2};
        pg8::gemm_phase<EpiResid<false>, pg8::StaticOrder, PG8_ALIGN, PG8_SP2>(lds, g, S, E); }
    GSEAM(6, nullptr);

    if (IN(7)) { pg8::Prob g{XN, WguT, DM, DM, DM, 0}; pg8::StaticOrder S; S.init(SEQ, 2 * DFF, G, bx);
        EpiSwiGLU E{ss2, act};
        pg8::gemm_phase<EpiSwiGLU, pg8::StaticOrder, PG8_ALIGN, PG8_SP2>(lds, g, S, E); }
    GSEAM(7, nullptr);

    if (IN(8)) { pg8::Prob g{act, WdT, 64, DFF, DFF, 0, 256 * 64 * 2, (size_t)256 * DFF}; pg8::StaticOrder S; S.init(SEQ, DM, G, bx);
        if (grp) { EpiFinal E{XN, ss3, out, g_final, gcnt, gepoch + 4u, glob + 64, gtmo, same_xcd}; gepoch += 4u;
            pg8::gemm_phase<EpiFinal, pg8::StaticOrder, PG8_ALIGN, PG8_SP2>(lds, g, S, E); }
        else { EpiResid<false> E{nullptr, XN, ss3};
            pg8::gemm_phase<EpiResid<false>, pg8::StaticOrder, PG8_ALIGN, PG8_SP2>(lds, g, S, E); } }
    if (!grp) { GSEAM(8, nullptr); } else { STAMP(); }

    if (IN(9) && !grp) {
        if (grp) wait_global(glob + 64, 256u, gtmo);
        const int m0 = grp ? 256 * pm_own + 64 * jmem + wave : bx * 8 + wave, m_end = grp ? 256 * pm_own + 64 * jmem + 64 : SEQ, NGW = grp ? 8 : G * 8;
        f32x4 gg[4][2];
#pragma unroll
        for (int j = 0; j < 4; ++j) { gg[j][0] = ((const f32x4*)g_final + 2 * lane)[128 * j]; gg[j][1] = ((const f32x4*)g_final + 2 * lane)[128 * j + 1]; }
        v4u hv[4];
        if (m0 < m_end) {
#pragma unroll
            for (int j = 0; j < 4; ++j) hv[j] = ((const v4u*)(XN + (size_t)m0 * DM) + lane)[64 * j]; }
        for (int m = m0; m < m_end; m += NGW) { const int nx = m + NGW; const bool more = nx < m_end; v4u hn[4];
            if (more) {
#pragma unroll
                for (int j = 0; j < 4; ++j) hn[j] = ((const v4u*)(XN + (size_t)nx * DM) + lane)[64 * j]; }
            const float rs = 1.0f / sqrtf(ss3[m] * (1.0f / DM) + EPS); f32x4* o = (f32x4*)(out + (size_t)m * DM) + 2 * lane;
#pragma unroll
            for (int j = 0; j < 4; ++j) { f32x4 v0, v1; unpack8(hv[j], v0, v1); o[128 * j] = v0 * rs * gg[j][0]; o[128 * j + 1] = v1 * rs * gg[j][1]; }
            if (more) {
#pragma unroll
                for (int j = 0; j < 4; ++j) hv[j] = hn[j]; } } }
#ifdef PROBE_PHASE
    STAMP();
    if (bx == 0 && tid == 0) { volatile LAS unsigned long long* st = (volatile LAS unsigned long long*)(lds + MISC_OFF + 128);
        volatile LAS unsigned long long* sc = (volatile LAS unsigned long long*)(lds + MISC_OFF + 256);
        unsigned long long span = st[PROBE_PHASE + 1] - st[PROBE_PHASE]; const unsigned long long t0 = __builtin_amdgcn_s_memrealtime();
#ifdef PROBE_SUB
        span = st[40 + PROBE_SUB + 1] - st[40 + PROBE_SUB];
#endif
#ifdef PROBE_CLOCK
        span = (sc[PROBE_PHASE + 1] - sc[PROBE_PHASE]) * 1250ull / span;
#endif
        while (__builtin_amdgcn_s_memrealtime() - t0 < 8ull * span) __builtin_amdgcn_s_sleep(8); }
#endif
#ifdef DBG_STOP
    if (IN(10)) { const size_t gt = (size_t)bx * 512 + tid, NGT = (size_t)G * 512;
        for (size_t e = gt; e < (size_t)SEQ * DM; e += NGT) {
#if DBG_DUMP == 0
            out[e] = __builtin_bit_cast(float, (unsigned)XN[e] << 16);
#elif DBG_DUMP == 1
            out[e] = __builtin_bit_cast(float, (unsigned)XN[e] << 16);
#elif DBG_DUMP == 2
            out[e] = __builtin_bit_cast(float, (unsigned)merged[e] << 16);
#elif DBG_DUMP == 3
            { const size_t r = e / DM, c = e % DM; out[e] = __builtin_bit_cast(float, (unsigned)(c < 1024 ? qb[r * 1024 + c] : (c < 1280 ? kb[r * 256 + c - 1024] : (c < 1536 ? vb[r * 256 + c - 1280] : zc[r * 2048 + ((c - 1536) & 2047)]))) << 16); }
#elif DBG_DUMP == 5
            { const size_t n1 = (size_t)1024 * 2048, n2 = 2 * n1, n3 = n2 + 256 * 1024; out[e] = (e < n1) ? __builtin_bit_cast(float, (unsigned)WqKT[e] << 16) : (e < n2) ? __builtin_bit_cast(float, (unsigned)VWoT[e - n1] << 16) : (e < n3) ? __builtin_bit_cast(float, (unsigned)kvb[e - n2] << 16) : 0.f; }
#elif DBG_DUMP == 6
            out[e] = (e < (size_t)256 * 1024) ? __builtin_bit_cast(float, (unsigned)kvb[e] << 16) : (e < (size_t)256 * 1024 + 256 * 2048) ? __builtin_bit_cast(float, (unsigned)memn[e - 256 * 1024] << 16) : 0.f;
#elif DBG_DUMP == 7
            out[e] = (e < (size_t)2048 * 512) ? __builtin_bit_cast(float, (unsigned)wxqp[e] << 16) : (e < (size_t)2 * 2048 * 512) ? __builtin_bit_cast(float, (unsigned)wxot[e - 2048 * 512] << 16) : 0.f;
#elif DBG_DUMP == 4
            { const size_t r = e / DM, c = e % DM; out[e] = __builtin_bit_cast(float, (unsigned)(c < 1024 ? Pb[r * 1024 + c] : (bf16)0) << 16); }
#endif
        } }
#endif
#undef IN
#undef SEAM
#undef GSEAM
}

extern "C" void kernel_launch(void* const* d_in, const int* in_sizes, int n_in, void* d_out, int out_size, void* d_ws, size_t ws_size, hipStream_t stream) {
    static int grid = 0;
    if (grid == 0) {
        if (n_in != 18 || in_sizes[0] != SEQ * DM || out_size != SEQ * DM || ws_size < WS_END) { fprintf(stderr, "kernel_launch: unexpected shapes / workspace (n_in %d, in0 %d, out %d, ws %zu); nothing launched\n", n_in, n_in > 0 ? in_sizes[0] : -1, out_size, ws_size); grid = -1; return; }
        int dev = 0, cus = 0;
        if (hipGetDevice(&dev) != hipSuccess || hipDeviceGetAttribute(&cus, hipDeviceAttributeMultiprocessorCount, dev) != hipSuccess) { fprintf(stderr, "kernel_launch: device query failed\n"); grid = -1; return; }
        if (hipFuncSetAttribute((const void*)hyb_fwd, hipFuncAttributeMaxDynamicSharedMemorySize, LDS_BYTES) != hipSuccess) { fprintf(stderr, "kernel_launch: hipFuncSetAttribute failed\n"); grid = -1; return; }
        int per_cu = 0;
        if (hipOccupancyMaxActiveBlocksPerMultiprocessor(&per_cu, (const void*)hyb_fwd, 512, LDS_BYTES) != hipSuccess || per_cu < 1) fprintf(stderr, "kernel_launch: note: occupancy query reports %d workgroups per CU\n", per_cu);
        (void)hipGetLastError();
        grid = cus;
    }
    if (grid < 0) return;
    if (hipMemsetAsync((char*)d_ws + WS_CTL, 0, CTL_ZERO_BYTES, stream) != hipSuccess) { fprintf(stderr, "kernel_launch: memset failed\n"); return; }
    Args a{};
    for (int i = 0; i < 18; ++i) a.in[i] = (const float*)d_in[i];
    a.out = (float*)d_out; a.ws = (unsigned char*)d_ws;
#ifdef DBG_STOP
    const int nl = DBG_STOP + 2;
#else
    const int nl = MK_N_LAUNCHES;
#endif
    for (int li = 0; li < nl; ++li) {
        a.ph_lo = (MK_N_LAUNCHES == 1) ? 0 : li; a.ph_hi = (MK_N_LAUNCHES == 1) ? NPHASE : li + 1; a.li = li; a.pad = 0;
#ifdef DBG_STOP
        if (li == nl - 1) { a.ph_lo = 10; a.ph_hi = 11; }
#endif
        hipLaunchKernelGGL(hyb_fwd, dim3(grid), dim3(512), LDS_BYTES, stream, a);
        const hipError_t le = hipPeekAtLastError();
        if (le != hipSuccess) { fprintf(stderr, "kernel_launch: launch %d failed: %s\n", li, hipGetErrorName(le)); break; }
    }
}
```

```cpp
#include <hip/hip_runtime.h>
#include <cstdio>
#include <cstdint>

#ifndef MK_N_LAUNCHES
#define MK_N_LAUNCHES 1
#endif

#define GAS __attribute__((address_space(1)))
#define LAS __attribute__((address_space(3)))
typedef unsigned short bf16;
typedef unsigned v4u __attribute__((ext_vector_type(4)));
typedef unsigned v2u __attribute__((ext_vector_type(2)));
typedef float f32x4 __attribute__((ext_vector_type(4)));
typedef float f32x16 __attribute__((ext_vector_type(16)));
typedef short bf16x8 __attribute__((ext_vector_type(8)));
typedef short s16x4 __attribute__((ext_vector_type(4)));

constexpr int SEQ = 16384, DM = 2048, NIN = 8704, AW = 1024, KVW = 256, CW = 1024, XW = 512, NMEM = 256, DFF = 5632;
constexpr float EPS = 1e-6f;
constexpr float LOG2E = 1.4426950408889634f;
constexpr float QSCALE = 0.125f * 1.4426950408889634f;
constexpr float C2X = 0.08838834764831845f * 1.4426950408889634f;

constexpr size_t MiB = 1u << 20;
constexpr size_t WS_CTL = 0, CTL_ZERO_BYTES = 256 * 1024;
constexpr size_t WS_SS = 1 * MiB;
constexpr size_t WS_CS = 2 * MiB;
constexpr size_t WS_KVB = 3 * MiB;
constexpr size_t WS_MEMN = 4 * MiB;
constexpr size_t WS_WXQ = 5 * MiB;
constexpr size_t WS_WXOT = 7 * MiB;
constexpr size_t WS_WGUT = 16 * MiB;
constexpr size_t WS_WDT = 60 * MiB;
constexpr size_t WS_XN = 82 * MiB;
constexpr size_t WS_WACT = 146 * MiB;
constexpr size_t WS_WOUTT = 154 * MiB;
constexpr size_t WS_WQKT = 162 * MiB;
constexpr size_t WS_VWOT = 166 * MiB;
constexpr size_t WS_Q = 170 * MiB, WS_K = 202 * MiB, WS_V = 210 * MiB, WS_ZC = 218 * MiB;
constexpr size_t WS_P = WS_Q;
constexpr size_t WS_ACT = 314 * MiB;
constexpr size_t WS_WINT = 314 * MiB;
constexpr size_t WS_WXKVT = 348 * MiB;
constexpr size_t WS_END = 490 * MiB;
static_assert(WS_ACT + (size_t)SEQ * DFF * 2 <= WS_END && WS_ZC + (size_t)SEQ * 3 * CW * 2 <= WS_ACT, "d_ws map");

constexpr int CW_BAR = 4096;
constexpr int CW_GRP = 16384;
constexpr int CW_XID = 49152;
constexpr int CW_GLOB = 32768;

constexpr int RING_BYTES = 131072;
constexpr int LDSCTL_OFF = RING_BYTES, MISC_OFF = LDSCTL_OFF + 320;
constexpr int LDS_BYTES = 147456;

#define RLX_AGENT __ATOMIC_RELAXED, __HIP_MEMORY_SCOPE_AGENT
#define LDS_WAIT() asm volatile("s_waitcnt lgkmcnt(0)" ::: "memory")
#define VM_WAIT() asm volatile("s_waitcnt vmcnt(0)" ::: "memory")

typedef float f32x2_t __attribute__((ext_vector_type(2))); typedef __bf16 bf16x2_t __attribute__((ext_vector_type(2)));
__device__ __forceinline__ unsigned cvt_pk_bf16(float lo, float hi) { f32x2_t v = {lo, hi}; bf16x2_t b = __builtin_convertvector(v, bf16x2_t); return __builtin_bit_cast(unsigned, b); }
__device__ __forceinline__ float bf_lo(unsigned u) { return __builtin_bit_cast(float, u << 16); }
__device__ __forceinline__ float bf_hi(unsigned u) { return __builtin_bit_cast(float, u & 0xffff0000u); }
__device__ __forceinline__ float fast_exp2(float x) { return __builtin_amdgcn_exp2f(x); }
__device__ __forceinline__ float fast_rcp(float x) { return __builtin_amdgcn_rcpf(x); }
__device__ __forceinline__ void st16_wt(void* p, v4u v) { asm volatile("global_store_dwordx4 %0, %1, off sc1\n\ts_nop 1" :: "v"(p), "v"(v) : "memory"); }
__device__ __forceinline__ void st8_wt(void* p, v2u v) { __hip_atomic_store((unsigned long long*)p, ((unsigned long long)v.y << 32) | v.x, __ATOMIC_RELAXED, __HIP_MEMORY_SCOPE_AGENT); }

namespace pg8 {
typedef unsigned short bf16_t;
constexpr int BM = 256, BK = 64, HALF = 128, HTB = HALF * BK * 2, STAGE_BYTES = 8 * HTB, NXCD = 8, WGM = 8;

__host__ __device__ __forceinline__ int lds_byte(int r, int c) { const int st = (r >> 4) * 2 + (c >> 5), rr = r & 15, cc = c & 31, ob = rr * 64 + cc * 2; return st * 1024 + (ob ^ (((ob >> 9) & 1) << 5)); }
__host__ __device__ __forceinline__ void stage_rc(int b, int& R, int& C) { const int st = b / 1024, sb = b % 1024, swz = sb ^ (((sb >> 9) & 1) << 5); R = (st >> 1) * 16 + swz / 64; C = (st & 1) * 32 + (swz % 64) / 2; }
__host__ __device__ __forceinline__ int perm32(int rho) { const int n = rho >> 4, i = rho & 15; return 8 * (i >> 2) + 4 * n + (i & 3); }

struct Unit { int pm, pn, z; };
struct Prob {
    const bf16_t* A; const bf16_t* Bt; int lda, ldb, K, zoff;
    int akstep = 0; size_t apanel = 0;
    __device__ __forceinline__ const char* a_ptr(const Unit& u) const { return (const char*)(A + (apanel ? (size_t)u.pm * apanel : (size_t)u.pm * BM * lda) + (size_t)u.z * zoff); }
    __device__ __forceinline__ const char* b_ptr(const Unit& u) const { return (const char*)(Bt + (size_t)u.pn * BM * ldb + (size_t)u.z * zoff); }
};

__device__ __forceinline__ bool tile_of(long L, int nM, int nN, int& pm, int& pn) {
    const int nwg = nM * nN; if (L >= nwg) return false;
    int wgid = (int)L; { const int q = nwg / NXCD, r = nwg % NXCD, xcd = wgid % NXCD, off = wgid / NXCD; wgid = (xcd < r ? xcd * (q + 1) : r * (q + 1) + (xcd - r) * q) + off; }
    const int nig = WGM * nN, gid = wgid / nig, fm = gid * WGM, gsz = (nM - fm) < WGM ? (nM - fm) : WGM;
    pm = fm + ((wgid % nig) % gsz); pn = (wgid % nig) / gsz; return true;
}
struct StaticOrder {
    int nM, nN, G, c, ZS, rev;
    __device__ __forceinline__ void init(int M, int N, int G_, int c_, int ZS_ = 1, bool reversed = false) { nM = M / BM; nN = N / BM; G = G_; c = c_; ZS = ZS_;
        rev = (reversed && c_ >= 0 && c_ < nM * nN) ? (nM * nN - 1 - c_) / G_ + 1 : 0; }
    __device__ __forceinline__ bool next(int i, Unit& u) const {
        if (c < 0) return false;
        int ti = (ZS == 2) ? (i >> 1) : i; u.z = (ZS == 2) ? (i & 1) : 0;
        if (rev) { if (ti >= rev) return false; ti = rev - 1 - ti; }
        return tile_of((long)ti * G + c, nM, nN, u.pm, u.pn);
    }
};

template <class Epi, class Sched, bool ALIGN_EPI = false, bool SP2 = false>
__device__ __forceinline__ void gemm_phase(LAS unsigned char* lds, const Prob g, const Sched& S, const Epi& E) {
    const int tid = threadIdx.x, wid = __builtin_amdgcn_readfirstlane(tid >> 6), lane = tid & 63, wr = wid >> 2, wc = wid & 3, fr = lane & 15, fq = lane >> 4;
    const int K = g.K, nt = K / BK;
    unsigned voffA[2], voffB[2];
#pragma unroll
    for (int i = 0; i < 2; ++i) { int R, C; stage_rc(tid * 16 + i * 8192, R, C); const int Rb = Epi::PERM ? ((R & ~31) + perm32(R & 31)) : R;
        voffA[i] = (unsigned)(R * g.lda + C) * 2u; voffB[i] = (unsigned)(Rb * g.ldb + C) * 2u; }
    const size_t kstep = (size_t)(BK * 2), kstepA = g.akstep ? (size_t)g.akstep : kstep;
    const size_t hstepA = (size_t)HALF * g.lda * 2, hstepB = (size_t)HALF * g.ldb * 2;
    const unsigned ldsw = (unsigned)wid * 1024u;
    const int aoff = lds_byte(wr * 64 + fr, fq * 8), boff = lds_byte(wc * 32 + fr, fq * 8);
#define PG8_SA(b, h) (((b) * 2 + (h)) * HTB)
#define PG8_SB(b, h) ((4 + (b) * 2 + (h)) * HTB)
#define PG8_STAGE(bufoff, gbase, voff) do { _Pragma("unroll") for (int _i = 0; _i < 2; ++_i) \
        __builtin_amdgcn_global_load_lds((const unsigned*)((const char*)(gbase) + (voff)[_i]), (LAS unsigned*)(lds + (bufoff) + ldsw + _i * 8192), 16, 0, 0); } while (0)
#define PG8_LDA(dst, b, h) do { _Pragma("unroll") for (int m = 0; m < 4; ++m) _Pragma("unroll") for (int k = 0; k < 2; ++k) dst[m][k] = *(const LAS bf16x8*)(lds + PG8_SA(b, h) + aoff + m * 2048 + k * 1024); } while (0)
#define PG8_LDB(dst, b, h) do { _Pragma("unroll") for (int n = 0; n < 2; ++n) _Pragma("unroll") for (int k = 0; k < 2; ++k) dst[n][k] = *(const LAS bf16x8*)(lds + PG8_SB(b, h) + boff + n * 2048 + k * 1024); } while (0)
#define PG8_MMA(ai, bj, At, Bt) do { __builtin_amdgcn_s_setprio(1); _Pragma("unroll") for (int m = 0; m < 4; ++m) _Pragma("unroll") for (int n = 0; n < 2; ++n) _Pragma("unroll") for (int k = 0; k < 2; ++k) \
        acc[ai][bj][m][n] = __builtin_amdgcn_mfma_f32_16x16x32_bf16(Bt[n][k], At[m][k], acc[ai][bj][m][n], 0, 0, 0); __builtin_amdgcn_s_setprio(0); } while (0)
#define PG8_WAIT_V(n) asm volatile("s_waitcnt vmcnt(" #n ")" ::: "memory")
#define PG8_WAIT_L(n) asm volatile("s_waitcnt lgkmcnt(" #n ")" ::: "memory")
#define PG8_BAR __builtin_amdgcn_s_barrier()
#define PG8_SCHED __builtin_amdgcn_sched_barrier(0)
    Unit cur, nxt; int ui = 0;
    if (!S.next(0, cur)) return;
    f32x4 acc[2][2][4][2];
#pragma unroll
    for (int a = 0; a < 2; ++a)
#pragma unroll
        for (int b = 0; b < 2; ++b)
#pragma unroll
            for (int m = 0; m < 4; ++m)
#pragma unroll
                for (int n = 0; n < 2; ++n) acc[a][b][m][n] = (f32x4){0.f, 0.f, 0.f, 0.f};
    bf16x8 At[4][2], B0[2][2], B1[2][2];
    const char* cA = g.a_ptr(cur); const char* cB = g.b_ptr(cur);
    if constexpr (SP2) {
        PG8_STAGE(PG8_SB(0, 0), cB, voffB); PG8_STAGE(PG8_SB(0, 1), cB + hstepB, voffB); PG8_STAGE(PG8_SA(0, 0), cA, voffA); PG8_STAGE(PG8_SA(0, 1), cA + hstepA, voffA);
        if (wr == 1) PG8_BAR;
        PG8_WAIT_V(2); PG8_BAR;
        PG8_STAGE(PG8_SB(1, 0), cB + kstep, voffB); PG8_STAGE(PG8_SA(1, 0), cA + kstepA, voffA); PG8_STAGE(PG8_SB(1, 1), cB + hstepB + kstep, voffB);
        PG8_WAIT_V(6); PG8_BAR;
    } else {
        PG8_STAGE(PG8_SB(0, 0), cB, voffB); PG8_STAGE(PG8_SA(0, 0), cA, voffA); PG8_STAGE(PG8_SB(0, 1), cB + hstepB, voffB); PG8_STAGE(PG8_SA(0, 1), cA + hstepA, voffA);
        if (wr == 1) PG8_BAR;
        PG8_WAIT_V(4); PG8_BAR;
        PG8_STAGE(PG8_SB(1, 0), cB + kstep, voffB); PG8_STAGE(PG8_SA(1, 0), cA + kstepA, voffA); PG8_STAGE(PG8_SB(1, 1), cB + hstepB + kstep, voffB);
        PG8_WAIT_V(6); PG8_BAR;
    }
    for (;;) {
        const bool has_next = S.next(ui + 1, nxt);
        const char* nA = has_next ? g.a_ptr(nxt) : cA; const char* nB = has_next ? g.b_ptr(nxt) : cB;
        for (int t = 0; t < nt; t += 2) {
            const bool last = (t == nt - 2);
            const char* a1 = cA + (size_t)(t + 1) * kstepA;
            const char* a2 = last ? nA : cA + (size_t)(t + 2) * kstepA; const char* b2 = last ? nB : cB + (size_t)(t + 2) * kstep;
            const char* a3 = a2 + kstepA; const char* b3 = b2 + kstep;
            if constexpr (SP2) {
            PG8_LDB(B0, 0, 0); PG8_LDB(B1, 0, 1); PG8_SCHED; PG8_LDA(At, 0, 0); PG8_STAGE(PG8_SA(1, 1), a1 + hstepA, voffA);
            PG8_WAIT_V(8); PG8_WAIT_L(0); PG8_BAR; PG8_MMA(0, 0, At, B0); PG8_MMA(0, 1, At, B1); PG8_BAR; PG8_SCHED;
            PG8_LDA(At, 0, 1); PG8_STAGE(PG8_SB(0, 0), b2, voffB); PG8_STAGE(PG8_SB(0, 1), b2 + hstepB, voffB); PG8_STAGE(PG8_SA(0, 0), a2, voffA);
            PG8_WAIT_V(8); PG8_WAIT_L(0); PG8_BAR; PG8_MMA(1, 0, At, B0); PG8_MMA(1, 1, At, B1); PG8_BAR; PG8_SCHED;
            PG8_LDB(B0, 1, 0); PG8_LDB(B1, 1, 1); PG8_SCHED; PG8_LDA(At, 1, 0); PG8_STAGE(PG8_SA(0, 1), a2 + hstepA, voffA);
            PG8_WAIT_V(8); PG8_WAIT_L(0); PG8_BAR; PG8_MMA(0, 0, At, B0); PG8_MMA(0, 1, At, B1); PG8_BAR; PG8_SCHED;
            PG8_LDA(At, 1, 1); PG8_STAGE(PG8_SB(1, 0), b3, voffB); PG8_STAGE(PG8_SB(1, 1), b3 + hstepB, voffB); PG8_STAGE(PG8_SA(1, 0), a3, voffA);
            PG8_WAIT_V(8); PG8_WAIT_L(0); PG8_BAR; PG8_MMA(1, 0, At, B0); PG8_MMA(1, 1, At, B1); PG8_BAR; PG8_SCHED;
            } else {
            PG8_LDB(B0, 0, 0); PG8_SCHED; PG8_LDA(At, 0, 0); PG8_STAGE(PG8_SA(1, 1), a1 + hstepA, voffA);
            PG8_WAIT_L(8); PG8_BAR; PG8_WAIT_L(0); PG8_MMA(0, 0, At, B0); PG8_BAR; PG8_SCHED;
            PG8_LDB(B1, 0, 1); PG8_STAGE(PG8_SB(0, 0), b2, voffB);
            PG8_BAR; PG8_WAIT_L(0); PG8_MMA(0, 1, At, B1); PG8_BAR;
            PG8_LDA(At, 0, 1); PG8_STAGE(PG8_SA(0, 0), a2, voffA);
            PG8_BAR; PG8_WAIT_L(0); PG8_MMA(1, 0, At, B0); PG8_BAR; PG8_SCHED;
            PG8_STAGE(PG8_SB(0, 1), b2 + hstepB, voffB);
            PG8_WAIT_V(6); PG8_BAR; PG8_MMA(1, 1, At, B1); PG8_BAR;
            PG8_LDB(B0, 1, 0); PG8_SCHED; PG8_LDA(At, 1, 0); PG8_STAGE(PG8_SA(0, 1), a2 + hstepA, voffA);
            PG8_WAIT_L(8); PG8_BAR; PG8_WAIT_L(0); PG8_MMA(0, 0, At, B0); PG8_BAR; PG8_SCHED;
            PG8_LDB(B1, 1, 1); PG8_STAGE(PG8_SB(1, 0), b3, voffB);
            PG8_BAR; PG8_WAIT_L(0); PG8_MMA(0, 1, At, B1); PG8_BAR;
            PG8_LDA(At, 1, 1); PG8_STAGE(PG8_SA(1, 0), a3, voffA);
            PG8_BAR; PG8_WAIT_L(0); PG8_MMA(1, 0, At, B0); PG8_BAR; PG8_SCHED;
            PG8_STAGE(PG8_SB(1, 1), b3 + hstepB, voffB);
            PG8_WAIT_V(6); PG8_BAR; PG8_MMA(1, 1, At, B1); PG8_BAR;
            }
        }
        if constexpr (ALIGN_EPI) { if (wr == 0) PG8_BAR; }
        if constexpr (!Epi::AFTER_DRAIN) { if (!(Epi::LAST_FUSED && !has_next)) E(acc, cur, wr, wc, fr, fq); }
        if (!has_next) break;
        if (!E.keep(cur)) {
#pragma unroll
        for (int a = 0; a < 2; ++a)
#pragma unroll
            for (int b = 0; b < 2; ++b)
#pragma unroll
                for (int m = 0; m < 4; ++m)
#pragma unroll
                    for (int n = 0; n < 2; ++n) acc[a][b][m][n] = (f32x4){0.f, 0.f, 0.f, 0.f};
        }
        cur = nxt; cA = nA; cB = nB; ++ui;
        if constexpr (ALIGN_EPI) { if (wr == 1) PG8_BAR; }
    }
    PG8_WAIT_V(0);
    if constexpr (!ALIGN_EPI) { if (wr == 0) PG8_BAR; }
    PG8_BAR;
    if constexpr (Epi::AFTER_DRAIN || Epi::LAST_FUSED) { E.fused(acc, cur, wr, wc, fr, fq, lds, wid, lane); }
#undef PG8_SA
#undef PG8_SB
#undef PG8_STAGE
#undef PG8_LDA
#undef PG8_LDB
#undef PG8_MMA
#undef PG8_WAIT_V
#undef PG8_WAIT_L
#undef PG8_BAR
#undef PG8_SCHED
}
}

#ifndef PG8_SP2
#define PG8_SP2 true
#endif
#ifndef PG8_ALIGN
#define PG8_ALIGN true
#endif

typedef f32x4 Acc[2][2][4][2];

__device__ __forceinline__ v4u pack8(f32x4 v0, f32x4 v1) { v4u w; w.x = cvt_pk_bf16(v0[0], v0[1]); w.y = cvt_pk_bf16(v0[2], v0[3]); w.z = cvt_pk_bf16(v1[0], v1[1]); w.w = cvt_pk_bf16(v1[2], v1[3]); return w; }
__device__ __forceinline__ void unpack8(v4u w, f32x4& v0, f32x4& v1) { v0 = (f32x4){bf_lo(w.x), bf_hi(w.x), bf_lo(w.y), bf_hi(w.y)}; v1 = (f32x4){bf_lo(w.z), bf_hi(w.z), bf_lo(w.w), bf_hi(w.w)}; }

struct EpiInProj {
    static constexpr bool PERM = true, AFTER_DRAIN = false, LAST_FUSED = false;
    bf16 *q, *k, *v, *zc, *sgr, *sgc; const float* cs;
    __device__ __forceinline__ bool keep(const pg8::Unit&) const { return false; }
    __device__ __forceinline__ void operator()(Acc& acc, const pg8::Unit& u, int wr, int wc, int fr, int fq) const {
        const int row0 = u.pm * 256 + wr * 64 + fr, ct = wc * 32 + 8 * fq;
        if (u.pn < 5) {
            const bool isq = u.pn < 4; bf16* base = isq ? q + u.pn * 256 : k; const int ld = isq ? AW : KVW; const float sc = isq ? QSCALE : 1.f;
            const bool rl = ((wc & 1) == 0) && (fq < 2);
#pragma unroll
            for (int ai = 0; ai < 2; ++ai)
#pragma unroll
                for (int m = 0; m < 4; ++m) { const int row = row0 + ai * 128 + m * 16;
                    f32x4 c4 = (f32x4){1.f, 1.f, 1.f, 1.f}, s4 = (f32x4){0.f, 0.f, 0.f, 0.f};
                    if (rl) { c4 = *(const f32x4*)(cs + (size_t)row * 16 + 4 * fq); s4 = *(const f32x4*)(cs + (size_t)row * 16 + 8 + 4 * fq); }
#pragma unroll
                    for (int bj = 0; bj < 2; ++bj) { const f32x4 t1 = acc[ai][bj][m][0], t2 = acc[ai][bj][m][1];
                        const f32x4 v0 = (t1 * c4 - t2 * s4) * sc, v1 = (t2 * c4 + t1 * s4) * sc;
                        *(v4u*)(base + (size_t)row * ld + bj * 128 + ct) = pack8(v0, v1); } }
        } else if (u.pn < 10) {
            bf16* base = (u.pn == 5) ? v : zc + (u.pn - 6) * 256; const int ld = (u.pn == 5) ? KVW : 2 * CW;
#pragma unroll
            for (int ai = 0; ai < 2; ++ai)
#pragma unroll
                for (int m = 0; m < 4; ++m) { const int row = row0 + ai * 128 + m * 16;
#pragma unroll
                    for (int bj = 0; bj < 2; ++bj) *(v4u*)(base + (size_t)row * ld + bj * 128 + ct) = pack8(acc[ai][bj][m][0], acc[ai][bj][m][1]); }
        } else if (u.pn < 18) {
            const int t = u.pn - 10;
#pragma unroll
            for (int ai = 0; ai < 2; ++ai)
#pragma unroll
                for (int m = 0; m < 4; ++m) { const int row = row0 + ai * 128 + m * 16;
                    *(v4u*)(zc + (size_t)row * (2 * CW) + CW + t * 128 + ct) = pack8(acc[ai][0][m][0] * acc[ai][1][m][0], acc[ai][0][m][1] * acc[ai][1][m][1]); }
        } else {
            const int t = u.pn - 18;
#pragma unroll
            for (int ai = 0; ai < 2; ++ai)
#pragma unroll
                for (int m = 0; m < 4; ++m) { const int row = row0 + ai * 128 + m * 16; f32x4 rr[2], ss[2];
#pragma unroll
                    for (int n = 0; n < 2; ++n)
#pragma unroll
                        for (int e = 0; e < 4; ++e) { const float ga = acc[ai][0][m][n][e], gc = acc[ai][1][m][n][e];
                            const float ea = fast_exp2(fminf(ga, 80.f)), ec = fast_exp2(fminf(gc, 80.f));
                            const float ia = fast_rcp(1.f + ea), ic = fast_rcp(1.f + ec);
                            rr[n][e] = (1.f + ec) * ia; ss[n][e] = ic; }
                    *(v4u*)(sgr + (size_t)row * DM + t * 128 + ct) = pack8(rr[0], rr[1]);
                    *(v4u*)(sgc + (size_t)row * DM + t * 128 + ct) = pack8(ss[0], ss[1]); }
        }
    }
};
struct EpiStoreBf16 {
    static constexpr bool PERM = true, AFTER_DRAIN = false, LAST_FUSED = false;
    bf16* O; int ldc;
    __device__ __forceinline__ bool keep(const pg8::Unit&) const { return false; }
    __device__ __forceinline__ void operator()(Acc& acc, const pg8::Unit& u, int wr, int wc, int fr, int fq) const {
        const int row0 = u.pm * 256 + wr * 64 + fr, col0 = u.pn * 256 + wc * 32 + 8 * fq;
#pragma unroll
        for (int ai = 0; ai < 2; ++ai)
#pragma unroll
            for (int m = 0; m < 4; ++m) { const int row = row0 + ai * 128 + m * 16;
#pragma unroll
                for (int bj = 0; bj < 2; ++bj) *(v4u*)(O + (size_t)row * ldc + col0 + bj * 128) = pack8(acc[ai][bj][m][0], acc[ai][bj][m][1]); }
    }
};
struct EpiMerge {
    static constexpr bool PERM = true, AFTER_DRAIN = false, LAST_FUSED = false;
    const bf16 *sgr, *sgc; bf16* merged;
    __device__ __forceinline__ bool keep(const pg8::Unit& u) const { return u.z == 0; }
    __device__ __forceinline__ void operator()(Acc& acc, const pg8::Unit& u, int wr, int wc, int fr, int fq) const {
        const int row0 = u.pm * 256 + wr * 64 + fr, col0 = u.pn * 256 + wc * 32 + 8 * fq;
        const bf16* gsrc = ((u.z == 0) ? sgr : sgc) + (size_t)row0 * DM + col0;
        v4u gw[2][4][2];
#pragma unroll
        for (int ai = 0; ai < 2; ++ai)
#pragma unroll
            for (int m = 0; m < 4; ++m)
#pragma unroll
                for (int bj = 0; bj < 2; ++bj) gw[ai][m][bj] = *(const v4u*)(gsrc + (size_t)(ai * 128 + m * 16) * DM + bj * 128);
#pragma unroll
        for (int ai = 0; ai < 2; ++ai)
#pragma unroll
            for (int m = 0; m < 4; ++m) { const int row = row0 + ai * 128 + m * 16;
#pragma unroll
                for (int bj = 0; bj < 2; ++bj) { f32x4 g0, g1; unpack8(gw[ai][m][bj], g0, g1);
                    const f32x4 v0 = acc[ai][bj][m][0] * g0, v1 = acc[ai][bj][m][1] * g1;
                    if (u.z == 0) { acc[ai][bj][m][0] = v0; acc[ai][bj][m][1] = v1; }
                    else *(v4u*)(merged + (size_t)row * DM + col0 + bj * 128) = pack8(v0, v1); } }
    }
};
template <bool BASE_F32> struct EpiResid {
    static constexpr bool PERM = true, AFTER_DRAIN = false, LAST_FUSED = false;
    const float* basef; bf16* hb; float* ss;
    __device__ __forceinline__ bool keep(const pg8::Unit&) const { return false; }
    __device__ __forceinline__ void operator()(Acc& acc, const pg8::Unit& u, int wr, int wc, int fr, int fq) const {
        const int row0 = u.pm * 256 + wr * 64 + fr, col0 = u.pn * 256 + wc * 32 + 8 * fq;
        const size_t off0 = (size_t)row0 * DM + col0;
        constexpr int NPRE = BASE_F32 ? 4 : 8;
        f32x4 pf[BASE_F32 ? 4 : 1][2][2]; v4u pb[BASE_F32 ? 1 : 8][2];
#pragma unroll
        for (int g = 0; g < NPRE; ++g)
#pragma unroll
            for (int bj = 0; bj < 2; ++bj) { const size_t off = off0 + (size_t)((g >> 2) * 128 + (g & 3) * 16) * DM + bj * 128;
                if (BASE_F32) { pf[g][bj][0] = __builtin_nontemporal_load((const f32x4*)(basef + off)); pf[g][bj][1] = __builtin_nontemporal_load((const f32x4*)(basef + off + 4)); } else pb[g][bj] = *(const v4u*)(hb + off); }
#pragma unroll
        for (int g = 0; g < 8; ++g) { const int ai = g >> 2, m = g & 3; const int row = row0 + ai * 128 + m * 16; float sq = 0.f;
#pragma unroll
            for (int bj = 0; bj < 2; ++bj) { const size_t off = (size_t)row * DM + col0 + bj * 128; f32x4 b0, b1;
                if (BASE_F32) { b0 = pf[g & 3][bj][0]; b1 = pf[g & 3][bj][1]; } else unpack8(pb[g][bj], b0, b1);
                const f32x4 v0 = acc[ai][bj][m][0] + b0, v1 = acc[ai][bj][m][1] + b1;
                *(v4u*)(hb + off) = pack8(v0, v1);
                sq += (v0[0] * v0[0] + v0[1] * v0[1]) + (v0[2] * v0[2] + v0[3] * v0[3]) + (v1[0] * v1[0] + v1[1] * v1[1]) + (v1[2] * v1[2] + v1[3] * v1[3]); }
            if (BASE_F32 && g + 4 < 8) {
#pragma unroll
                for (int bj = 0; bj < 2; ++bj) { const size_t off = off0 + (size_t)(128 + m * 16) * DM + bj * 128; pf[g & 3][bj][0] = __builtin_nontemporal_load((const f32x4*)(basef + off)); pf[g & 3][bj][1] = __builtin_nontemporal_load((const f32x4*)(basef + off + 4)); } }
            sq += __shfl_xor(sq, 16); sq += __shfl_xor(sq, 32);
            if (fq == 0) atomicAdd(ss + row, sq); }
    }
};
struct EpiSoftmax {
    static constexpr bool PERM = true, AFTER_DRAIN = true, LAST_FUSED = false;
    const float* ss; bf16* P;
    __device__ __forceinline__ bool keep(const pg8::Unit&) const { return false; }
    __device__ __forceinline__ void fused(Acc& acc, const pg8::Unit& u, int wr, int wc, int fr, int fq, LAS unsigned char* lds, int wid, int lane) const {
        LAS float* Pm = (LAS float*)lds; LAS float* Ps = (LAS float*)(lds + 4096);
        const int rl0 = wr * 64 + fr, col0 = u.pn * 256 + wc * 32 + 8 * fq;
#pragma unroll
        for (int ai = 0; ai < 2; ++ai)
#pragma unroll
            for (int m = 0; m < 4; ++m) { const int rl = rl0 + ai * 128 + m * 16; const float rs = 1.0f / sqrtf(ss[u.pm * 256 + rl] * (1.0f / DM) + EPS); float mx = -3.0e38f;
#pragma unroll
                for (int bj = 0; bj < 2; ++bj)
#pragma unroll
                    for (int n = 0; n < 2; ++n) { f32x4 s = acc[ai][bj][m][n] * rs; acc[ai][bj][m][n] = s; mx = fmaxf(mx, fmaxf(fmaxf(s[0], s[1]), fmaxf(s[2], s[3]))); }
                mx = fmaxf(mx, __shfl_xor(mx, 16)); mx = fmaxf(mx, __shfl_xor(mx, 32));
                if (fq == 0) Pm[rl * 4 + wc] = mx; }
        asm volatile("s_waitcnt lgkmcnt(0)" ::: "memory"); __builtin_amdgcn_s_barrier(); asm volatile("" ::: "memory");
#pragma unroll
        for (int ai = 0; ai < 2; ++ai)
#pragma unroll
            for (int m = 0; m < 4; ++m) { const int rl = rl0 + ai * 128 + m * 16; const f32x4 pm4 = *(const LAS f32x4*)(Pm + rl * 4);
                const float mx = fmaxf(fmaxf(pm4[0], pm4[1]), fmaxf(pm4[2], pm4[3])); float sm = 0.f;
#pragma unroll
                for (int bj = 0; bj < 2; ++bj)
#pragma unroll
                    for (int n = 0; n < 2; ++n) { f32x4 s = acc[ai][bj][m][n];
#pragma unroll
                        for (int e = 0; e < 4; ++e) { s[e] = fast_exp2(s[e] - mx); sm += s[e]; }
                        acc[ai][bj][m][n] = s; }
                sm += __shfl_xor(sm, 16); sm += __shfl_xor(sm, 32);
                if (fq == 0) Ps[rl * 4 + wc] = sm; }
        asm volatile("s_waitcnt lgkmcnt(0)" ::: "memory"); __builtin_amdgcn_s_barrier(); asm volatile("" ::: "memory");
#pragma unroll
        for (int ai = 0; ai < 2; ++ai)
#pragma unroll
            for (int m = 0; m < 4; ++m) { const int rl = rl0 + ai * 128 + m * 16; const f32x4 ps4 = *(const LAS f32x4*)(Ps + rl * 4);
                const float inv = 1.0f / ((ps4[0] + ps4[1]) + (ps4[2] + ps4[3])); const size_t rowoff = (size_t)(u.pm * 256 + rl) * (4 * NMEM) + col0;
#pragma unroll
                for (int bj = 0; bj < 2; ++bj) *(v4u*)(P + rowoff + bj * 128) = pack8(acc[ai][bj][m][0] * inv, acc[ai][bj][m][1] * inv); }
    }
};
struct EpiSwiGLU {
    static constexpr bool PERM = true, AFTER_DRAIN = false, LAST_FUSED = false;
    const float* ss; bf16* act;
    __device__ __forceinline__ bool keep(const pg8::Unit&) const { return false; }
    __device__ __forceinline__ void operator()(Acc& acc, const pg8::Unit& u, int wr, int wc, int fr, int fq) const {
        const int row0 = u.pm * 256 + wr * 64 + fr, col0 = u.pn * 128 + wc * 32 + 8 * fq;
#pragma unroll
        for (int ai = 0; ai < 2; ++ai)
#pragma unroll
            for (int m = 0; m < 4; ++m) { const int row = row0 + ai * 128 + m * 16; const float rs = 1.0f / sqrtf(ss[row] * (1.0f / DM) + EPS); f32x4 o[2];
                const float nrl = -rs * LOG2E, rs2 = rs * rs;
#pragma unroll
                for (int n = 0; n < 2; ++n)
#pragma unroll
                    for (int e = 0; e < 4; ++e) { const float a = acc[ai][0][m][n][e], b = acc[ai][1][m][n][e];
                        o[n][e] = (a * b) * (rs2 * fast_rcp(1.f + fast_exp2(a * nrl))); }
                *(v4u*)(act + ((((size_t)u.pm * (DFF / 64) + (col0 >> 6)) * 256 + (row - u.pm * 256)) << 6) + (col0 & 63)) = pack8(o[0], o[1]); }
    }
};

#define XB_TMO      128
#define XB_XCNT(j)  (256  + 64 * (j))
#define XB_XSUB(j)  (1280 + 64 * (j))
#define XB_XGEN(j)  (2304 + 64 * (j))
#define XB_TOP      3328
#define XB_TOPGEN   3392
#define XCD_BAR_WORDS 3456
#define XB_SPIN_CAP (1u << 18)

__device__ __forceinline__ unsigned xb_ld(unsigned* p)              { return __hip_atomic_load(p, __ATOMIC_RELAXED, __HIP_MEMORY_SCOPE_AGENT); }
__device__ __forceinline__ unsigned xb_add(unsigned* p, unsigned v) { return __hip_atomic_fetch_add(p, v, __ATOMIC_RELAXED, __HIP_MEMORY_SCOPE_AGENT); }
__device__ __forceinline__ unsigned xb_xcc_id() { return (unsigned)__builtin_amdgcn_s_getreg((3 << 11) | 20) & 0xFu; }
#define XB_SPIN(cond, bar) do { unsigned _sp = 0; while (cond) { __builtin_amdgcn_s_sleep(1); \
    if ((++_sp & 255u) == 0u) { if (xb_ld(&(bar)[XB_TMO])) break; if (_sp > XB_SPIN_CAP) { atomicAdd(&(bar)[XB_TMO], 1u); break; } } } } while (0)

struct XcdBarrier { unsigned* bar; unsigned x; volatile LAS unsigned* st; };

__device__ __forceinline__ XcdBarrier xcd_barrier_post(unsigned* bar, volatile LAS unsigned* st) {
    XcdBarrier b; b.bar = bar; b.x = xb_xcc_id(); b.st = st;
    if (threadIdx.x == 0) (void)xb_add(&bar[XB_XCNT(b.x)], 1u);
    return b;
}
__device__ __forceinline__ void xcd_barrier_complete(unsigned* bar, unsigned x, unsigned& nloc, unsigned& nx) {
    const unsigned G = gridDim.x * gridDim.y * gridDim.z;
    unsigned sum, cnt, mine, sp = 0u;
    for (;;) {
        sum = 0u; cnt = 0u; mine = 0u;
#pragma unroll
        for (unsigned j = 0; j < 16; ++j) { const unsigned c = xb_ld(&bar[XB_XCNT(j)]); sum += c; cnt += (c > 0u) ? 1u : 0u; mine = (j == x) ? c : mine; }
        if (sum == G) break;
        __builtin_amdgcn_s_sleep(1);
        if ((++sp & 255u) == 0u) { if (xb_ld(&bar[XB_TMO])) break; if (sp > XB_SPIN_CAP) { atomicAdd(&bar[XB_TMO], 1u); break; } }
    }
    nloc = mine > 0u ? mine : 1u; nx = cnt > 0u ? cnt : 1u;
}
__device__ __forceinline__ void xcd_barrier(const XcdBarrier& b) {
    asm volatile("s_waitcnt vmcnt(0)" ::: "memory");
    __syncthreads();
    if (threadIdx.x == 0) {
        unsigned* bar = b.bar;
        __builtin_amdgcn_s_waitcnt(0);
        unsigned nloc = b.st[0], nx = b.st[1];
        if (nloc == 0u) { xcd_barrier_complete(bar, b.x, nloc, nx); b.st[0] = nloc; b.st[1] = nx; }
        const unsigned old = xb_add(&bar[XB_XSUB(b.x)], 1u);
        const unsigned gen = old / nloc;
        if (old + 1u == (gen + 1u) * nloc) {
            __builtin_amdgcn_fence(__ATOMIC_RELEASE, "agent");
            asm volatile("s_waitcnt vmcnt(0)" ::: "memory");
            const unsigned og = xb_add(&bar[XB_TOP], 1u);
            const unsigned tg = og / nx;
            if (og + 1u == (tg + 1u) * nx) xb_add(&bar[XB_TOPGEN], 1u);
            else XB_SPIN(xb_ld(&bar[XB_TOPGEN]) == tg, bar);
            __builtin_amdgcn_fence(__ATOMIC_ACQUIRE, "agent");
            xb_add(&bar[XB_XGEN(b.x)], 1u);
            asm volatile("s_waitcnt vmcnt(0)" ::: "memory");
        } else {
            XB_SPIN(xb_ld(&bar[XB_XGEN(b.x)]) == gen, bar);
            __builtin_amdgcn_fence(__ATOMIC_ACQUIRE, "agent");
            asm volatile("s_waitcnt vmcnt(0)" ::: "memory");
        }
    }
    __syncthreads();
}


__device__ __forceinline__ void group_barrier(unsigned* cnt, unsigned target, unsigned* extra, unsigned* tmo, bool same_xcd) {
    asm volatile("s_waitcnt vmcnt(0)" ::: "memory");
    __syncthreads();
    if (threadIdx.x == 0) {
        __builtin_amdgcn_s_waitcnt(0);
        if (!same_xcd) { __builtin_amdgcn_fence(__ATOMIC_RELEASE, "agent"); asm volatile("s_waitcnt vmcnt(0)" ::: "memory"); }
        (void)xb_add(cnt, 1u);
        if (extra) (void)xb_add(extra, 1u);
        unsigned sp = 0;
        while (xb_ld(cnt) < target) { __builtin_amdgcn_s_sleep(1); if ((++sp & 255u) == 0u) { if (xb_ld(tmo)) break; if (sp > XB_SPIN_CAP) { atomicAdd(tmo, 1u); break; } } }
        __builtin_amdgcn_fence(__ATOMIC_ACQUIRE, "agent");
        asm volatile("s_waitcnt vmcnt(0)" ::: "memory");
    }
    __syncthreads();
}
__device__ __forceinline__ void wait_global(unsigned* cnt, unsigned target, unsigned* tmo) {
    if (threadIdx.x == 0) {
        unsigned sp = 0;
        while (xb_ld(cnt) < target) { __builtin_amdgcn_s_sleep(1); if ((++sp & 255u) == 0u) { if (xb_ld(tmo)) break; if (sp > XB_SPIN_CAP) { atomicAdd(tmo, 1u); break; } } }
        __builtin_amdgcn_fence(__ATOMIC_ACQUIRE, "agent");
        asm volatile("s_waitcnt vmcnt(0)" ::: "memory");
    }
    __syncthreads();
}

struct EpiFinal {
    static constexpr bool PERM = true, AFTER_DRAIN = false, LAST_FUSED = true;
    bf16* hb; float* ss; float* out; const float* gfin; unsigned* gcnt; unsigned target; unsigned* glob1; unsigned* tmo; bool same_xcd;
    __device__ __forceinline__ bool keep(const pg8::Unit&) const { return false; }
    __device__ __forceinline__ void operator()(Acc& acc, const pg8::Unit& u, int wr, int wc, int fr, int fq) const { const EpiResid<false> E{nullptr, hb, ss}; E(acc, u, wr, wc, fr, fq); }
    __device__ __forceinline__ void fused(Acc& acc, const pg8::Unit& u, int wr, int wc, int fr, int fq, LAS unsigned char* lds, int wid, int lane) const {
        const int row0 = u.pm * 256 + wr * 64 + fr, col0 = u.pn * 256 + wc * 32 + 8 * fq;
        const size_t off0 = (size_t)row0 * DM + col0;
        v4u pb[8][2];
#pragma unroll
        for (int g = 0; g < 8; ++g)
#pragma unroll
            for (int bj = 0; bj < 2; ++bj) pb[g][bj] = *(const v4u*)(hb + off0 + (size_t)((g >> 2) * 128 + (g & 3) * 16) * DM + bj * 128);
#pragma unroll
        for (int g = 0; g < 8; ++g) { const int ai = g >> 2, m = g & 3; const int row = row0 + ai * 128 + m * 16; float sq = 0.f;
#pragma unroll
            for (int bj = 0; bj < 2; ++bj) { f32x4 b0, b1; unpack8(pb[g][bj], b0, b1);
                const f32x4 v0 = acc[ai][bj][m][0] + b0, v1 = acc[ai][bj][m][1] + b1; acc[ai][bj][m][0] = v0; acc[ai][bj][m][1] = v1;
                sq += (v0[0] * v0[0] + v0[1] * v0[1]) + (v0[2] * v0[2] + v0[3] * v0[3]) + (v1[0] * v1[0] + v1[1] * v1[1]) + (v1[2] * v1[2] + v1[3] * v1[3]); }
            sq += __shfl_xor(sq, 16); sq += __shfl_xor(sq, 32);
            if (fq == 0) atomicAdd(ss + row, sq); }
        group_barrier(gcnt, target, nullptr, tmo, same_xcd);
        wait_global(glob1, 256u, tmo);
        const int col1 = col0 - 1024;
        { f32x4 gv[2][2];
#pragma unroll
          for (int bj = 0; bj < 2; ++bj) { gv[bj][0] = *(const f32x4*)(gfin + col0 + bj * 128); gv[bj][1] = *(const f32x4*)(gfin + col0 + bj * 128 + 4); }
#pragma unroll
          for (int g = 0; g < 8; ++g) { const int ai = g >> 2, m = g & 3; const int row = row0 + ai * 128 + m * 16; const float rs = 1.0f / sqrtf(ss[row] * (1.0f / DM) + EPS);
#pragma unroll
            for (int bj = 0; bj < 2; ++bj) { float* o = out + (size_t)row * DM + col0 + bj * 128; __builtin_nontemporal_store(acc[ai][bj][m][0] * rs * gv[bj][0], (f32x4*)o); __builtin_nontemporal_store(acc[ai][bj][m][1] * rs * gv[bj][1], (f32x4*)(o + 4)); } } }
        asm volatile("" ::: "memory");
        { f32x4 gw[2][2];
#pragma unroll
          for (int bj = 0; bj < 2; ++bj) { gw[bj][0] = *(const f32x4*)(gfin + col1 + bj * 128); gw[bj][1] = *(const f32x4*)(gfin + col1 + bj * 128 + 4); }
#pragma unroll
          for (int g = 0; g < 8; ++g)
#pragma unroll
            for (int bj = 0; bj < 2; ++bj) pb[g][bj] = *(const v4u*)(hb + off0 - 1024 + (size_t)((g >> 2) * 128 + (g & 3) * 16) * DM + bj * 128);
#pragma unroll
          for (int g = 0; g < 8; ++g) { const int ai = g >> 2, m = g & 3; const int row = row0 + ai * 128 + m * 16; const float rs = 1.0f / sqrtf(ss[row] * (1.0f / DM) + EPS);
#pragma unroll
            for (int bj = 0; bj < 2; ++bj) { f32x4 b0, b1; unpack8(pb[g][bj], b0, b1); float* o1 = out + (size_t)row * DM + col1 + bj * 128; __builtin_nontemporal_store(b0 * rs * gw[bj][0], (f32x4*)o1); __builtin_nontemporal_store(b1 * rs * gw[bj][1], (f32x4*)(o1 + 4)); } } }
    }
};

__device__ __forceinline__ float wave_sum(float v) {
#pragma unroll
    for (int o = 1; o < 64; o <<= 1) v += __shfl_xor(v, o);
    return v;
}
__device__ __forceinline__ int rope_sigma(int p) { return (p < 16) ? ((p & 3) + 4 * ((p >> 3) & 1) + 8 * ((p >> 2) & 1)) : p; }
struct TpItem { const float* src; bf16* dst; const float* ks; int ldw, ldd, perm; float cscale; };
struct TpPtrs { const float *w_in, *w_attn_o, *w_conv_o, *w_out, *w_xkv, *w_xo, *w_gate_up, *w_down, *g_ffn; bf16 *WinT, *WacT, *WoutT, *WxkvT, *wxot, *WguT, *WdT; };
constexpr int TP_I0 = 32 * 272, TP_I1 = 16 * 64, TP_I2 = 16 * 64, TP_I3 = 32 * 64, TP_I4 = 32 * 32, TP_I7 = 8 * 64, TP_I5 = 32 * 352, TP_I6 = 88 * 64;
constexpr int TP_NEARLY = TP_I0 + TP_I1 + TP_I2 + TP_I3 + TP_I4 + TP_I7, TP_NITEMS = TP_NEARLY + TP_I5 + TP_I6;
__device__ __forceinline__ TpItem tp_mk(const float* W, int ldw, int src_col0, int k0, bf16* dst, int ldd, int dst_row0, int dst_col0, const float* kscale, int perm, float cscale = 1.f) {
    TpItem d; d.cscale = cscale; d.src = W + (size_t)k0 * ldw + src_col0; d.dst = dst + (size_t)dst_row0 * ldd + dst_col0 + k0; d.ks = kscale ? kscale + k0 : nullptr; d.ldw = ldw; d.ldd = ldd; d.perm = perm; return d; }
__device__ __forceinline__ TpItem tp_desc(int it, const TpPtrs& P) {
    int r = it;
    if (r < TP_I0) { const int kb_ = r / 272, Gp = r % 272; int src, perm = 0;
        if (Gp < 40) { src = 32 * Gp; perm = ((Gp & 1) == 0) ? 1 : 0; }
        else if (Gp < 80) { src = 32 * Gp; }
        else if (Gp < 144) { const int gg = Gp - 80, t = gg >> 3, i32 = gg & 7; src = (i32 < 4) ? (2560 + 128 * t + 32 * i32) : (3584 + 128 * t + 32 * (i32 - 4)); }
        else { const int gg = Gp - 144, t = gg >> 3, i32 = gg & 7; src = (i32 < 4) ? (4608 + 128 * t + 32 * i32) : (6656 + 128 * t + 32 * (i32 - 4)); }
        return tp_mk(P.w_in, NIN, src, 64 * kb_, P.WinT, DM, 32 * Gp, 0, nullptr, perm, Gp >= 144 ? -LOG2E : 1.f); } r -= TP_I0;
    if (r < TP_I1) { const int kb_ = r / 64, Gp = r % 64; return tp_mk(P.w_attn_o, DM, 32 * Gp, 64 * kb_, P.WacT, DM, 32 * Gp, 0, nullptr, 0); } r -= TP_I1;
    if (r < TP_I2) { const int kb_ = r / 64, Gp = r % 64; return tp_mk(P.w_conv_o, DM, 32 * Gp, 64 * kb_, P.WacT, DM, 32 * Gp, 1024, nullptr, 0); } r -= TP_I2;
    if (r < TP_I3) { const int kb_ = r / 64, Gp = r % 64; return tp_mk(P.w_out, DM, 32 * Gp, 64 * kb_, P.WoutT, DM, 32 * Gp, 0, nullptr, 0); } r -= TP_I3;
    if (r < TP_I4) { const int kb_ = r / 32, Gp = r % 32; return tp_mk(P.w_xkv, 2 * XW, 32 * Gp, 64 * kb_, P.WxkvT, DM, 32 * Gp, 0, nullptr, 0); } r -= TP_I4;
    if (r < TP_I7) { const int kb_ = r / 64, Gp = r % 64; return tp_mk(P.w_xo, DM, 32 * Gp, 64 * kb_, P.wxot, XW, 32 * Gp, 0, nullptr, 0); } r -= TP_I7;
    if (r < TP_I5) { const int kb_ = r / 352, Gp = r % 352; const int t = Gp >> 3, i32 = Gp & 7; const int src = (i32 < 4) ? (128 * t + 32 * i32) : (DFF + 128 * t + 32 * (i32 - 4));
        return tp_mk(P.w_gate_up, 2 * DFF, src, 64 * kb_, P.WguT, DM, 32 * Gp, 0, P.g_ffn, 0); } r -= TP_I5;
    { const int kb_ = r / 64, Gp = r % 64; return tp_mk(P.w_down, DM, 32 * Gp, 64 * kb_, P.WdT, DFF, 32 * Gp, 0, nullptr, 0); }
}
__device__ __forceinline__ void tp_load(const TpItem& d, float (&tv)[32], int lane) {
    const float* sp = d.src + (size_t)(lane >> 5) * d.ldw + (lane & 31);
#pragma unroll
    for (int i = 0; i < 32; ++i) tv[i] = __builtin_nontemporal_load(sp + (size_t)(2 * i) * d.ldw);
}
__device__ __forceinline__ void tp_finish(const TpItem& d, const float (&tv)[32], LAS float* scr, int lane) {
#pragma unroll
    for (int i = 0; i < 32; ++i) scr[(2 * i + (lane >> 5)) * 33 + (lane & 31)] = tv[i];
    LDS_WAIT(); asm volatile("" ::: "memory");
    const int c = lane & 7;
    float sc[8];
#pragma unroll
    for (int i = 0; i < 8; ++i) sc[i] = d.ks ? d.ks[8 * c + i] * d.cscale : d.cscale;
#pragma unroll
    for (int j = 0; j < 4; ++j) { const int nd = (lane >> 3) + 8 * j; const int scol = d.perm ? rope_sigma(nd) : nd; const LAS float* s = scr + (8 * c) * 33 + scol;
        v4u o; o.x = cvt_pk_bf16(s[0 * 33] * sc[0], s[1 * 33] * sc[1]); o.y = cvt_pk_bf16(s[2 * 33] * sc[2], s[3 * 33] * sc[3]);
        o.z = cvt_pk_bf16(s[4 * 33] * sc[4], s[5 * 33] * sc[5]); o.w = cvt_pk_bf16(s[6 * 33] * sc[6], s[7 * 33] * sc[7]);
        *(v4u*)(d.dst + (size_t)nd * d.ldd + 8 * c) = o; }
    LDS_WAIT(); asm volatile("" ::: "memory");
}
__device__ __forceinline__ void tp_run(int it0, int it_end, int stride, const TpPtrs& P, LAS float* scr, int lane) {
    if (it0 >= it_end) return;
    TpItem d = tp_desc(it0, P); float tv[32]; tp_load(d, tv, lane);
    for (int it = it0; it < it_end; it += stride) {
        const int nx = it + stride; const bool more = nx < it_end; TpItem dn = d; float tn[32];
        if (more) { dn = tp_desc(nx, P); tp_load(dn, tn, lane); }
        tp_finish(d, tv, scr, lane);
        if (more) { d = dn;
#pragma unroll
            for (int i = 0; i < 32; ++i) tv[i] = tn[i]; }
    }
}
__device__ __forceinline__ void tp_run3(int it0, int it_end, int stride, const TpPtrs& P, LAS float* scr, int lane) {
    if (it0 >= it_end) return;
    TpItem d0 = tp_desc(it0, P), d1 = d0; float t0[32], t1[32]; tp_load(d0, t0, lane);
    if (it0 + stride < it_end) { d1 = tp_desc(it0 + stride, P); tp_load(d1, t1, lane); }
    for (int it = it0; it < it_end; it += stride) {
        const int n2 = it + 2 * stride; const bool more2 = n2 < it_end; TpItem d2 = d0; float t2[32];
        if (more2) { d2 = tp_desc(n2, P); tp_load(d2, t2, lane); }
        tp_finish(d0, t0, scr, lane);
        d0 = d1; d1 = d2;
#pragma unroll
        for (int i = 0; i < 32; ++i) { t0[i] = t1[i]; t1[i] = t2[i]; }
    }
}
__device__ __forceinline__ void rms_rows_to_bf16(const float* xb, const float* g, bf16* ob, int m0, int m_end, int stride, int lane) {
    if (m0 >= m_end) return;
    f32x4 v[8];
    { const f32x4* xr = (const f32x4*)(xb + (size_t)m0 * DM) + lane;
#pragma unroll
      for (int j = 0; j < 8; ++j) v[j] = __builtin_nontemporal_load(xr + 64 * j); }
    f32x4 gg[8];
#pragma unroll
    for (int j = 0; j < 8; ++j) gg[j] = ((const f32x4*)g + lane)[64 * j];
    for (int m = m0; m < m_end; m += stride) {
        const int nx = m + stride; const bool more = nx < m_end; f32x4 vn[8];
        if (more) { const f32x4* xr = (const f32x4*)(xb + (size_t)nx * DM) + lane;
#pragma unroll
            for (int j = 0; j < 8; ++j) vn[j] = __builtin_nontemporal_load(xr + 64 * j); }
        float s = 0.f;
#pragma unroll
        for (int j = 0; j < 8; ++j) s += (v[j].x * v[j].x + v[j].y * v[j].y) + (v[j].z * v[j].z + v[j].w * v[j].w);
        const float rstd = 1.0f / sqrtf(wave_sum(s) * (1.0f / DM) + EPS);
        v2u* o8 = (v2u*)(ob + (size_t)m * DM) + lane;
#pragma unroll
        for (int j = 0; j < 8; ++j) { v2u w; w.x = cvt_pk_bf16(v[j].x * rstd * gg[j].x, v[j].y * rstd * gg[j].y); w.y = cvt_pk_bf16(v[j].z * rstd * gg[j].z, v[j].w * rstd * gg[j].w); o8[64 * j] = w; }
        if (more) {
#pragma unroll
            for (int j = 0; j < 8; ++j) v[j] = vn[j]; }
    }
}

__device__ __forceinline__ s16x4 vtr(const LAS unsigned char* p) { typedef short v4i16_t __attribute__((ext_vector_type(4))); return __builtin_bit_cast(s16x4, __builtin_amdgcn_ds_read_tr16_b64_v4i16((LAS v4i16_t*)p)); }

struct ConvCtx { const bf16* zc; bf16* xn; int ts, cg; f32x4 w0[2], w1[2], w2[2], p1[2], p2[2]; };
__device__ __forceinline__ void conv_issue(const ConvCtx& c, int batch, v4u (&zb)[4], v4u (&zp)[4]) {
#pragma unroll
    for (int i = 0; i < 4; ++i) { const bf16* zr = c.zc + (size_t)(c.ts + 4 * batch + i) * (2 * CW) + 8 * c.cg; zb[i] = *(const v4u*)(zr); zp[i] = *(const v4u*)(zr + CW); }
}
__device__ __forceinline__ void conv_finish(ConvCtx& c, int batch, const v4u (&zb)[4], const v4u (&zp)[4]) {
#pragma unroll
    for (int i = 0; i < 4; ++i) { f32x4 cb0, cb1, p0a, p0b; unpack8(zb[i], cb0, cb1); unpack8(zp[i], p0a, p0b);
        const f32x4 y0 = cb0 * (c.w0[0] * c.p2[0] + c.w1[0] * c.p1[0] + c.w2[0] * p0a), y1 = cb1 * (c.w0[1] * c.p2[1] + c.w1[1] * c.p1[1] + c.w2[1] * p0b);
        *(v4u*)(c.xn + (size_t)(c.ts + 4 * batch + i) * DM + AW + 8 * c.cg) = pack8(y0, y1);
        c.p2[0] = c.p1[0]; c.p2[1] = c.p1[1]; c.p1[0] = p0a; c.p1[1] = p0b; }
}
__device__ __forceinline__ void conv_init(ConvCtx& c, const bf16* zc, bf16* xn, const float* conv_w, int chunk, int tid) {
    c.zc = zc; c.xn = xn; c.cg = tid & 127; c.ts = chunk * 64 + (tid >> 7) * 16;
#pragma unroll
    for (int j = 0; j < 2; ++j) { c.w0[j] = *(const f32x4*)(conv_w + 8 * c.cg + 4 * j); c.w1[j] = *(const f32x4*)(conv_w + CW + 8 * c.cg + 4 * j); c.w2[j] = *(const f32x4*)(conv_w + 2 * CW + 8 * c.cg + 4 * j);
        c.p2[j] = (f32x4){0.f, 0.f, 0.f, 0.f}; c.p1[j] = c.p2[j]; }
    if (c.ts >= 2) { unpack8(*(const v4u*)(zc + (size_t)(c.ts - 2) * (2 * CW) + CW + 8 * c.cg), c.p2[0], c.p2[1]); unpack8(*(const v4u*)(zc + (size_t)(c.ts - 1) * (2 * CW) + CW + 8 * c.cg), c.p1[0], c.p1[1]); }
}
template <bool CONV>
__device__ __forceinline__ void swa_unit(LAS unsigned char* lds, int n, int g, const bf16* qb, const bf16* kb, const bf16* vb, const float* sinks, bf16* A2, int tid, int lane, int wave, ConvCtx& cc, int batch0) {
    LAS unsigned char* Kl = lds; LAS unsigned char* Vl = lds + 32768;
#pragma unroll
    for (int i = 0; i < 4; ++i) { const int id = tid + 512 * i, row = id >> 3, ch = id & 7; const int tok = (n - 1) * 128 + row;
        v4u kv = (v4u){0u, 0u, 0u, 0u}, vv = (v4u){0u, 0u, 0u, 0u};
        if (tok >= 0) { kv = *(const v4u*)(kb + (size_t)tok * KVW + g * 64 + ch * 8); vv = *(const v4u*)(vb + (size_t)tok * KVW + g * 64 + ch * 8); }
        *(LAS v4u*)(Kl + row * 128 + ((ch ^ ((row >> 1) & 7)) << 4)) = kv;
        *(LAS v4u*)(Vl + row * 128 + ((ch ^ (((row >> 1) & 1) << 2)) << 4)) = vv; }
    __syncthreads();
    const int ql = lane & 31, h = lane >> 5, hq = g * 4 + (wave & 3);
    const float sinkl = sinks[hq] * LOG2E;
    const int li = lane & 15, qp = li >> 2, pp = li & 3, g1 = (lane >> 4) & 1;
    const float NEG = -__builtin_inff();
#pragma unroll 1
    for (int st = 0; st < 2; ++st) {
        const int r0 = (wave >> 2) * 64 + 32 * st; const size_t tok = (size_t)n * 128 + r0 + ql;
        bf16x8 qf[4];
#pragma unroll
        for (int ks = 0; ks < 4; ++ks) qf[ks] = *(const bf16x8*)(qb + tok * AW + hq * 64 + 16 * ks + 8 * h);
        v4u zb[4], zp[4];
        if (CONV) conv_issue(cc, batch0 + st, zb, zp);
        f32x16 S[5];
#pragma unroll
        for (int t = 0; t < 5; ++t) { const int c = r0 + 32 * t + ql; S[t] = (f32x16){};
#pragma unroll
            for (int ks = 0; ks < 4; ++ks) { const bf16x8 kf = *(const LAS bf16x8*)(Kl + c * 128 + (((2 * ks + h) ^ ((c >> 1) & 7)) << 4));
                S[t] = __builtin_amdgcn_mfma_f32_32x32x16_bf16(kf, qf[ks], S[t], 0, 0, 0); } }
#pragma unroll
        for (int r = 0; r < 16; ++r) { const int cc = (r & 3) + 8 * (r >> 2) + 4 * h; if (!(cc > ql)) S[0][r] = NEG; if (!(cc <= ql)) S[4][r] = NEG; }
        if (n == 0) {
#pragma unroll
            for (int t = 0; t < 5; ++t)
#pragma unroll
                for (int r = 0; r < 16; ++r) { const int cc = (r & 3) + 8 * (r >> 2) + 4 * h; if (r0 + 32 * t + cc < 128) S[t][r] = NEG; } }
        float mx = sinkl;
#pragma unroll
        for (int t = 0; t < 5; ++t)
#pragma unroll
            for (int r = 0; r < 16; ++r) mx = fmaxf(mx, S[t][r]);
        mx = fmaxf(mx, __shfl_xor(mx, 32));
        float l = 0.f;
#pragma unroll
        for (int t = 0; t < 5; ++t)
#pragma unroll
            for (int r = 0; r < 16; ++r) { const float p = fast_exp2(S[t][r] - mx); S[t][r] = p; l += p; }
        l += __shfl_xor(l, 32); l += fast_exp2(sinkl - mx);
        f32x16 O[2]; O[0] = (f32x16){}; O[1] = (f32x16){};
#pragma unroll
        for (int t = 0; t < 5; ++t)
#pragma unroll
            for (int s = 0; s < 2; ++s) {
                v4u pw; pw.x = cvt_pk_bf16(S[t][8 * s + 0], S[t][8 * s + 1]); pw.y = cvt_pk_bf16(S[t][8 * s + 2], S[t][8 * s + 3]);
                pw.z = cvt_pk_bf16(S[t][8 * s + 4], S[t][8 * s + 5]); pw.w = cvt_pk_bf16(S[t][8 * s + 6], S[t][8 * s + 7]);
                const bf16x8 pf = __builtin_bit_cast(bf16x8, pw);
                const int krow = r0 + 32 * t + 16 * s + 4 * h + qp;
#pragma unroll
                for (int db = 0; db < 2; ++db) { const int chunk = (4 * db + 2 * g1 + (pp >> 1)) ^ (((qp >> 1) & 1) << 2);
                    const LAS unsigned char* va = Vl + krow * 128 + (chunk << 4) + (pp & 1) * 8;
                    const s16x4 lo = vtr(va), hi = vtr(va + 8 * 128);
                    const bf16x8 vf = (bf16x8){lo[0], lo[1], lo[2], lo[3], hi[0], hi[1], hi[2], hi[3]};
                    O[db] = __builtin_amdgcn_mfma_f32_32x32x16_bf16(vf, pf, O[db], 0, 0, 0); } }
        const float inv = 1.0f / l;
#pragma unroll
        for (int db = 0; db < 2; ++db)
#pragma unroll
            for (int pr = 0; pr < 2; ++pr) { const int ra = 8 * pr, rb = 8 * pr + 4;
                unsigned ax = cvt_pk_bf16(O[db][ra + 0] * inv, O[db][ra + 1] * inv), ay = cvt_pk_bf16(O[db][ra + 2] * inv, O[db][ra + 3] * inv);
                unsigned bx_ = cvt_pk_bf16(O[db][rb + 0] * inv, O[db][rb + 1] * inv), by = cvt_pk_bf16(O[db][rb + 2] * inv, O[db][rb + 3] * inv);
                { auto r = __builtin_amdgcn_permlane32_swap(ax, bx_, false, false); ax = r[0]; bx_ = r[1]; }
                { auto r = __builtin_amdgcn_permlane32_swap(ay, by, false, false); ay = r[0]; by = r[1]; }
                *(v4u*)(A2 + tok * DM + hq * 64 + 32 * db + 16 * pr + 8 * h) = (v4u){ax, ay, bx_, by}; }
        if (CONV) conv_finish(cc, batch0 + st, zb, zp);
    }
    __syncthreads();
}
__device__ __forceinline__ void wave_gemm_64x32_k128(const bf16* A, int lda, const bf16* Bt, int ldb, bf16* C, int ldc, int lane) {
    const int fr = lane & 15, fq = lane >> 4;
    f32x4 acc[4][2];
#pragma unroll
    for (int mi = 0; mi < 4; ++mi)
#pragma unroll
        for (int ni = 0; ni < 2; ++ni) acc[mi][ni] = (f32x4){0.f, 0.f, 0.f, 0.f};
#pragma unroll
    for (int ks = 0; ks < 4; ++ks) { bf16x8 a[4], b[2];
#pragma unroll
        for (int mi = 0; mi < 4; ++mi) a[mi] = *(const bf16x8*)(A + (size_t)(16 * mi + fr) * lda + 32 * ks + 8 * fq);
#pragma unroll
        for (int ni = 0; ni < 2; ++ni) b[ni] = *(const bf16x8*)(Bt + (size_t)(16 * ni + fr) * ldb + 32 * ks + 8 * fq);
#pragma unroll
        for (int mi = 0; mi < 4; ++mi)
#pragma unroll
            for (int ni = 0; ni < 2; ++ni) acc[mi][ni] = __builtin_amdgcn_mfma_f32_16x16x32_bf16(b[ni], a[mi], acc[mi][ni], 0, 0, 0); }
#pragma unroll
    for (int mi = 0; mi < 4; ++mi)
#pragma unroll
        for (int ni = 0; ni < 2; ++ni) { v2u w; w.x = cvt_pk_bf16(acc[mi][ni][0], acc[mi][ni][1]); w.y = cvt_pk_bf16(acc[mi][ni][2], acc[mi][ni][3]);
            st8_wt(C + (size_t)(16 * mi + fr) * ldc + 16 * ni + 4 * fq, w); }
}

constexpr int NPHASE = 10;
struct Args { const float* in[18]; float* out; unsigned char* ws; int ph_lo, ph_hi, li, pad; };

__global__ void __launch_bounds__(512, 2) hyb_fwd(Args args) {
    extern __shared__ __attribute__((aligned(16))) unsigned char lds_raw[];
    LAS unsigned char* lds = (LAS unsigned char*)lds_raw;
    volatile LAS unsigned* MISC = (volatile LAS unsigned*)(lds + MISC_OFF);
    const int tid = threadIdx.x, lane = tid & 63, wave = __builtin_amdgcn_readfirstlane(tid >> 6);
    const int G = gridDim.x, bx = blockIdx.x;
    unsigned char* ws = args.ws;
    unsigned* ctl = (unsigned*)(ws + WS_CTL);
    const float* x = args.in[0]; const float* mem = args.in[1]; const float* g_mix = args.in[2]; const float* w_in = args.in[3]; const float* conv_w = args.in[4];
    const float* sinks = args.in[5]; const float* w_attn_o = args.in[6]; const float* w_conv_o = args.in[7]; const float* w_out = args.in[8]; const float* g_xattn = args.in[9];
    const float* g_mem = args.in[10]; const float* w_xq = args.in[11]; const float* w_xkv = args.in[12]; const float* w_xo = args.in[13]; const float* g_ffn = args.in[14];
    const float* w_gate_up = args.in[15]; const float* w_down = args.in[16]; const float* g_final = args.in[17];
    float* out = args.out;
    float* ss1 = (float*)(ws + WS_SS); float* ss2 = ss1 + SEQ; float* ss3 = ss2 + SEQ;
    float* cs = (float*)(ws + WS_CS);
    bf16* kvb = (bf16*)(ws + WS_KVB); bf16* memn = (bf16*)(ws + WS_MEMN); bf16* wxqp = (bf16*)(ws + WS_WXQ); bf16* wxot = (bf16*)(ws + WS_WXOT);
    bf16* WguT = (bf16*)(ws + WS_WGUT); bf16* WdT = (bf16*)(ws + WS_WDT); bf16* XN = (bf16*)(ws + WS_XN);
    bf16* WinT = (bf16*)(ws + WS_WINT); bf16* WacT = (bf16*)(ws + WS_WACT); bf16* WoutT = (bf16*)(ws + WS_WOUTT); bf16* WxkvT = (bf16*)(ws + WS_WXKVT);
    bf16* WqKT = (bf16*)(ws + WS_WQKT); bf16* VWoT = (bf16*)(ws + WS_VWOT);
    bf16* qb = (bf16*)(ws + WS_Q); bf16* kb = (bf16*)(ws + WS_K); bf16* vb = (bf16*)(ws + WS_V); bf16* zc = (bf16*)(ws + WS_ZC);
    bf16* Pb = (bf16*)(ws + WS_P); bf16* act = (bf16*)(ws + WS_ACT);
    bf16* sgr = (bf16*)out; bf16* sgc = sgr + (size_t)SEQ * DM;
    bf16* merged = sgr;

    for (int u = tid; u < (LDS_BYTES - LDSCTL_OFF) / 4; u += 512) ((LAS unsigned*)(lds + LDSCTL_OFF))[u] = 0u;
    __syncthreads();
    XcdBarrier bar; bar.bar = ctl + CW_BAR; bar.x = 0; bar.st = nullptr;
    if (MK_N_LAUNCHES == 1) bar = xcd_barrier_post(ctl + CW_BAR, MISC + 8);
    if (tid == 0) __hip_atomic_store(ctl + CW_XID + 64 * (bx & 63) + (bx >> 6), xb_xcc_id() + 1u, __ATOMIC_RELAXED, __HIP_MEMORY_SCOPE_AGENT);
    const int lo = args.ph_lo, hi = args.ph_hi;
    const bool tailfill = (G == 256);
#define IN(k) (lo <= (k) && (k) < hi)
#ifdef PROBE_PHASE
    int n_stamp = 0;
#define STAMP() do { if (bx == 0 && tid == 0) { ((volatile LAS unsigned long long*)(lds + MISC_OFF + 128))[n_stamp] = __builtin_amdgcn_s_memrealtime(); ((volatile LAS unsigned long long*)(lds + MISC_OFF + 256))[n_stamp] = __builtin_amdgcn_s_memtime(); } ++n_stamp; } while (0)
#define SUBSTAMP(i) do { __builtin_amdgcn_s_waitcnt(0); if (bx == 0 && tid == 0) ((volatile LAS unsigned long long*)(lds + MISC_OFF + 128))[40 + (i)] = __builtin_amdgcn_s_memrealtime(); } while (0)
#else
#define STAMP() do { } while (0)
#define SUBSTAMP(i) do { } while (0)
#endif
#define SEAM(k) do { if (IN(k) && IN((k) + 1)) xcd_barrier(bar); STAMP(); } while (0)
    const bool grp = (G == 256) && (MK_N_LAUNCHES == 1);
    const int pm_own = 8 * (bx & 7) + ((bx >> 3) & 7), jmem = bx >> 6;
    unsigned* gcnt = ctl + CW_GRP + 64 * (bx & 63); unsigned* glob = ctl + CW_GLOB; unsigned* gtmo = ctl + CW_BAR + XB_TMO;
    unsigned gepoch = 0; bool same_xcd = false;
#define GSEAM(k, extra) do { if (IN(k) && IN((k) + 1)) { if (grp) { gepoch += 4u; group_barrier(gcnt, gepoch, (extra), gtmo, same_xcd); } else xcd_barrier(bar); } STAMP(); } while (0)
    STAMP();

    const TpPtrs TP{w_in, w_attn_o, w_conv_o, w_out, w_xkv, w_xo, w_gate_up, w_down, g_ffn, WinT, WacT, WoutT, WxkvT, wxot, WguT, WdT};
    if (IN(0)) {
        LAS float* scr = (LAS float*)(lds + wave * 16384);
        const int gw = bx * 8 + wave, NGW = G * 8;
        SUBSTAMP(0);
        if (bx & 1) rms_rows_to_bf16(x, g_mix, XN, gw, SEQ, NGW, lane);
        tp_run(gw, tailfill ? TP_NEARLY : TP_NITEMS, NGW, TP, scr, lane);
        SUBSTAMP(1);
        if (!(bx & 1)) rms_rows_to_bf16(x, g_mix, XN, gw, SEQ, NGW, lane);
        SUBSTAMP(2);
        rms_rows_to_bf16(mem, g_mem, memn, gw, NMEM, NGW, lane);
        for (int k = gw; k < DM; k += NGW) { const float gs = g_xattn[k] * C2X; const f32x4* src = (const f32x4*)(w_xq + (size_t)k * XW) + lane; v2u* dst = (v2u*)(wxqp + (size_t)k * XW) + lane;
#pragma unroll
            for (int j = 0; j < 2; ++j) { const f32x4 v = src[64 * j]; v2u w; w.x = cvt_pk_bf16(v.x * gs, v.y * gs); w.y = cvt_pk_bf16(v.z * gs, v.w * gs); dst[64 * j] = w; } }
        const int gt = bx * 512 + tid, NGT = G * 512;
        for (int e = gt; e < SEQ * 8; e += NGT) { const int pos = e >> 3, i = e & 7;
            const float inv_freq = (i == 0) ? 1.0f : (i == 1) ? 0.19392274f : (i == 2) ? 0.037606031f : (i == 3) ? 0.0072926646f : (i == 4) ? 0.0014142136f : (i == 5) ? 0.00027424819f : (i == 6) ? 5.3182957e-05f : 1.0313385e-05f;
            const float ang = (float)pos * inv_freq; float sn, cn; sincosf(ang, &sn, &cn);
            cs[(size_t)pos * 16 + i] = cn; cs[(size_t)pos * 16 + 8 + i] = sn; }
        for (int e = gt; e < 3 * SEQ; e += NGT) ss1[e] = 0.f;
        SUBSTAMP(3);
    }
    SEAM(0);

    if (IN(1)) {
        { pg8::Prob g{memn, WxkvT, DM, DM, DM, 0}; pg8::StaticOrder S; S.init(NMEM, 2 * XW, G, (bx >= 128 && bx < 132) ? bx - 128 : -1);
          EpiStoreBf16 E{kvb, 2 * XW};
          pg8::gemm_phase<EpiStoreBf16, pg8::StaticOrder, PG8_ALIGN, PG8_SP2>(lds, g, S, E); }
        if (tailfill && bx >= 132) { tp_run3(TP_NEARLY + (bx - 132) * 8 + wave, TP_NITEMS, (256 - 132) * 8, TP, (LAS float*)(lds + wave * 16384), lane); __syncthreads(); }
        { pg8::Prob g{XN, WinT, DM, DM, DM, 0}; pg8::StaticOrder S; S.init(SEQ, NIN, G, bx, 1, true);
          EpiInProj E{qb, kb, vb, zc, sgr, sgc, cs};
          pg8::gemm_phase<EpiInProj, pg8::StaticOrder, PG8_ALIGN, PG8_SP2>(lds, g, S, E); }
    }
    SEAM(1);

    if (grp && IN(2)) {
        if (tid == 0) { unsigned* xt = ctl + CW_XID + 64 * (bx & 63); const unsigned a0 = xb_ld(xt), a1 = xb_ld(xt + 1), a2 = xb_ld(xt + 2), a3 = xb_ld(xt + 3);
            MISC[12] = (a0 != 0u && a0 == a1 && a0 == a2 && a0 == a3) ? 1u : 0u; }
        __syncthreads();
        same_xcd = __builtin_amdgcn_readfirstlane(MISC[12]) != 0u;
    }
    if (IN(2)) {
        SUBSTAMP(4);
        ConvCtx cc;
        if (grp) {
            conv_init(cc, zc, XN, conv_w, 4 * pm_own + jmem, tid);
            swa_unit<true>(lds, 2 * pm_own + ((2 * jmem) >> 2), (2 * jmem) & 3, qb, kb, vb, sinks, XN, tid, lane, wave, cc, 0);
            swa_unit<true>(lds, 2 * pm_own + ((2 * jmem + 1) >> 2), (2 * jmem + 1) & 3, qb, kb, vb, sinks, XN, tid, lane, wave, cc, 2);
        } else {
            for (int u = bx; u < (SEQ / 128) * 4; u += G) swa_unit<false>(lds, u >> 2, u & 3, qb, kb, vb, sinks, XN, tid, lane, wave, cc, 0);
            for (int ch = bx; ch < SEQ / 64; ch += G) { conv_init(cc, zc, XN, conv_w, ch, tid);
#pragma unroll 1
                for (int b = 0; b < 4; ++b) { v4u zb[4], zp[4]; conv_issue(cc, b, zb, zp); conv_finish(cc, b, zb, zp); } }
        }
        SUBSTAMP(5);
        const bool pp_all = !grp; const int pp_w = ((bx >> 4) << 3) + (bx & 7);
        for (int job = pp_all ? bx * 8 + wave : (((bx >> 3) & 1) ? pp_w * 8 + wave : 2048); job < 2048; job += (pp_all ? G * 8 : 1024)) { const int idx = job & 1023;
            if (job < 1024) { const int mt = idx >> 6, nt = idx & 63, m0 = 64 * mt, n0 = 32 * nt, hh = m0 >> 8, j0 = m0 & 255;
                wave_gemm_64x32_k128(kvb + (size_t)j0 * (2 * XW) + 128 * hh, 2 * XW, wxqp + (size_t)n0 * XW + 128 * hh, XW, WqKT + (size_t)m0 * DM + n0, DM, lane); }
            else { const int mt = idx >> 5, nt = idx & 31, m0 = 64 * mt, n0 = 32 * nt, hh = n0 >> 8, j0 = n0 & 255;
                wave_gemm_64x32_k128(wxot + (size_t)m0 * XW + 128 * hh, XW, kvb + (size_t)j0 * (2 * XW) + XW + 128 * hh, 2 * XW, VWoT + (size_t)m0 * (4 * NMEM) + n0, 4 * NMEM, lane); } }
    }
    SUBSTAMP(7);
    GSEAM(2, glob);

    if (IN(3)) { pg8::Prob g{XN, WacT, DM, DM, AW, AW}; pg8::StaticOrder S; S.init(SEQ, DM, G, bx, 2);
        EpiMerge E{sgr, sgc, merged};
        pg8::gemm_phase<EpiMerge, pg8::StaticOrder, PG8_ALIGN, PG8_SP2>(lds, g, S, E); }
    GSEAM(3, nullptr);

    if (IN(4)) { pg8::Prob g{merged, WoutT, DM, DM, DM, 0}; pg8::StaticOrder S; S.init(SEQ, DM, G, bx);
        EpiResid<true> E{x, XN, ss1};
        pg8::gemm_phase<EpiResid<true>, pg8::StaticOrder, PG8_ALIGN, PG8_SP2>(lds, g, S, E); }
    GSEAM(4, glob + 64);

    if (IN(5)) { if (grp) wait_global(glob, 256u, gtmo);
        pg8::Prob g{XN, WqKT, DM, DM, DM, 0}; pg8::StaticOrder S; S.init(SEQ, 4 * NMEM, G, bx);
        EpiSoftmax E{ss1, Pb};
        if ((SEQ / 256) * 4 <= G) pg8::gemm_phase<EpiSoftmax, pg8::StaticOrder, false, PG8_SP2>(lds, g, S, E); }
    GSEAM(5, nullptr);

    if (IN(6)) { pg8::Prob g{Pb, VWoT, 4 * NMEM, 4 * NMEM, 4 * NMEM, 0}; pg8::StaticOrder S; S.init(SEQ, DM, G, bx);
        EpiResid<false> E{nullptr, XN, ss2};
        pg8::gemm_phase<EpiResid<false>, pg8::StaticOrder, PG8_ALIGN, PG8_SP2>(lds, g, S, E); }
    GSEAM(6, nullptr);

    if (IN(7)) { pg8::Prob g{XN, WguT, DM, DM, DM, 0}; pg8::StaticOrder S; S.init(SEQ, 2 * DFF, G, bx, 1, true);
        EpiSwiGLU E{ss2, act};
        pg8::gemm_phase<EpiSwiGLU, pg8::StaticOrder, PG8_ALIGN, PG8_SP2>(lds, g, S, E); }
    GSEAM(7, nullptr);

    if (IN(8)) { pg8::Prob g{act, WdT, 64, DFF, DFF, 0, 256 * 64 * 2, (size_t)256 * DFF}; pg8::StaticOrder S; S.init(SEQ, DM, G, bx);
        if (grp) { EpiFinal E{XN, ss3, out, g_final, gcnt, gepoch + 4u, glob + 64, gtmo, same_xcd}; gepoch += 4u;
            pg8::gemm_phase<EpiFinal, pg8::StaticOrder, PG8_ALIGN, PG8_SP2>(lds, g, S, E); }
        else { EpiResid<false> E{nullptr, XN, ss3};
            pg8::gemm_phase<EpiResid<false>, pg8::StaticOrder, PG8_ALIGN, PG8_SP2>(lds, g, S, E); } }
    if (!grp) { GSEAM(8, nullptr); } else { STAMP(); }

    if (IN(9) && !grp) {
        if (grp) wait_global(glob + 64, 256u, gtmo);
        const int m0 = grp ? 256 * pm_own + 64 * jmem + wave : bx * 8 + wave, m_end = grp ? 256 * pm_own + 64 * jmem + 64 : SEQ, NGW = grp ? 8 : G * 8;
        f32x4 gg[4][2];
#pragma unroll
        for (int j = 0; j < 4; ++j) { gg[j][0] = ((const f32x4*)g_final + 2 * lane)[128 * j]; gg[j][1] = ((const f32x4*)g_final + 2 * lane)[128 * j + 1]; }
        v4u hv[4];
        if (m0 < m_end) {
#pragma unroll
            for (int j = 0; j < 4; ++j) hv[j] = ((const v4u*)(XN + (size_t)m0 * DM) + lane)[64 * j]; }
        for (int m = m0; m < m_end; m += NGW) { const int nx = m + NGW; const bool more = nx < m_end; v4u hn[4];
            if (more) {
#pragma unroll
                for (int j = 0; j < 4; ++j) hn[j] = ((const v4u*)(XN + (size_t)nx * DM) + lane)[64 * j]; }
            const float rs = 1.0f / sqrtf(ss3[m] * (1.0f / DM) + EPS); f32x4* o = (f32x4*)(out + (size_t)m * DM) + 2 * lane;
#pragma unroll
            for (int j = 0; j < 4; ++j) { f32x4 v0, v1; unpack8(hv[j], v0, v1); o[128 * j] = v0 * rs * gg[j][0]; o[128 * j + 1] = v1 * rs * gg[j][1]; }
            if (more) {
#pragma unroll
                for (int j = 0; j < 4; ++j) hv[j] = hn[j]; } } }
#ifdef PROBE_PHASE
    STAMP();
    if (bx == 0 && tid == 0) { volatile LAS unsigned long long* st = (volatile LAS unsigned long long*)(lds + MISC_OFF + 128);
        volatile LAS unsigned long long* sc = (volatile LAS unsigned long long*)(lds + MISC_OFF + 256);
        unsigned long long span = st[PROBE_PHASE + 1] - st[PROBE_PHASE]; const unsigned long long t0 = __builtin_amdgcn_s_memrealtime();
#ifdef PROBE_SUB
        span = st[40 + PROBE_SUB + 1] - st[40 + PROBE_SUB];
#endif
#ifdef PROBE_CLOCK
        span = (sc[PROBE_PHASE + 1] - sc[PROBE_PHASE]) * 1250ull / span;
#endif
        while (__builtin_amdgcn_s_memrealtime() - t0 < 8ull * span) __builtin_amdgcn_s_sleep(8); }
#endif
#ifdef DBG_STOP
    if (IN(10)) { const size_t gt = (size_t)bx * 512 + tid, NGT = (size_t)G * 512;
        for (size_t e = gt; e < (size_t)SEQ * DM; e += NGT) {
#if DBG_DUMP == 0
            out[e] = __builtin_bit_cast(float, (unsigned)XN[e] << 16);
#elif DBG_DUMP == 1
            out[e] = __builtin_bit_cast(float, (unsigned)XN[e] << 16);
#elif DBG_DUMP == 2
            out[e] = __builtin_bit_cast(float, (unsigned)merged[e] << 16);
#elif DBG_DUMP == 3
            { const size_t r = e / DM, c = e % DM; out[e] = __builtin_bit_cast(float, (unsigned)(c < 1024 ? qb[r * 1024 + c] : (c < 1280 ? kb[r * 256 + c - 1024] : (c < 1536 ? vb[r * 256 + c - 1280] : zc[r * 2048 + ((c - 1536) & 2047)]))) << 16); }
#elif DBG_DUMP == 5
            { const size_t n1 = (size_t)1024 * 2048, n2 = 2 * n1, n3 = n2 + 256 * 1024; out[e] = (e < n1) ? __builtin_bit_cast(float, (unsigned)WqKT[e] << 16) : (e < n2) ? __builtin_bit_cast(float, (unsigned)VWoT[e - n1] << 16) : (e < n3) ? __builtin_bit_cast(float, (unsigned)kvb[e - n2] << 16) : 0.f; }
#elif DBG_DUMP == 6
            out[e] = (e < (size_t)256 * 1024) ? __builtin_bit_cast(float, (unsigned)kvb[e] << 16) : (e < (size_t)256 * 1024 + 256 * 2048) ? __builtin_bit_cast(float, (unsigned)memn[e - 256 * 1024] << 16) : 0.f;
#elif DBG_DUMP == 7
            out[e] = (e < (size_t)2048 * 512) ? __builtin_bit_cast(float, (unsigned)wxqp[e] << 16) : (e < (size_t)2 * 2048 * 512) ? __builtin_bit_cast(float, (unsigned)wxot[e - 2048 * 512] << 16) : 0.f;
#elif DBG_DUMP == 4
            { const size_t r = e / DM, c = e % DM; out[e] = __builtin_bit_cast(float, (unsigned)(c < 1024 ? Pb[r * 1024 + c] : (bf16)0) << 16); }
#endif
        } }
#endif
#undef IN
#undef SEAM
#undef GSEAM
}

extern "C" void kernel_launch(void* const* d_in, const int* in_sizes, int n_in, void* d_out, int out_size, void* d_ws, size_t ws_size, hipStream_t stream) {
    static int grid = 0;
    if (grid == 0) {
        if (n_in != 18 || in_sizes[0] != SEQ * DM || out_size != SEQ * DM || ws_size < WS_END) { fprintf(stderr, "kernel_launch: unexpected shapes / workspace (n_in %d, in0 %d, out %d, ws %zu); nothing launched\n", n_in, n_in > 0 ? in_sizes[0] : -1, out_size, ws_size); grid = -1; return; }
        int dev = 0, cus = 0;
        if (hipGetDevice(&dev) != hipSuccess || hipDeviceGetAttribute(&cus, hipDeviceAttributeMultiprocessorCount, dev) != hipSuccess) { fprintf(stderr, "kernel_launch: device query failed\n"); grid = -1; return; }
        if (hipFuncSetAttribute((const void*)hyb_fwd, hipFuncAttributeMaxDynamicSharedMemorySize, LDS_BYTES) != hipSuccess) { fprintf(stderr, "kernel_launch: hipFuncSetAttribute failed\n"); grid = -1; return; }
        int per_cu = 0;
        if (hipOccupancyMaxActiveBlocksPerMultiprocessor(&per_cu, (const void*)hyb_fwd, 512, LDS_BYTES) != hipSuccess || per_cu < 1) fprintf(stderr, "kernel_launch: note: occupancy query reports %d workgroups per CU\n", per_cu);
        (void)hipGetLastError();
        grid = cus;
    }
    if (grid < 0) return;
    if (hipMemsetAsync((char*)d_ws + WS_CTL, 0, CTL_ZERO_BYTES, stream) != hipSuccess) { fprintf(stderr, "kernel_launch: memset failed\n"); return; }
    Args a{};
    for (int i = 0; i < 18; ++i) a.in[i] = (const float*)d_in[i];
    a.out = (float*)d_out; a.ws = (unsigned char*)d_ws;
#ifdef DBG_STOP
    const int nl = DBG_STOP + 2;
#else
    const int nl = MK_N_LAUNCHES;
#endif
    for (int li = 0; li < nl; ++li) {
        a.ph_lo = (MK_N_LAUNCHES == 1) ? 0 : li; a.ph_hi = (MK_N_LAUNCHES == 1) ? NPHASE : li + 1; a.li = li; a.pad = 0;
#ifdef DBG_STOP
        if (li == nl - 1) { a.ph_lo = 10; a.ph_hi = 11; }
#endif
        hipLaunchKernelGGL(hyb_fwd, dim3(grid), dim3(512), LDS_BYTES, stream, a);
        const hipError_t le = hipPeekAtLastError();
        if (le != hipSuccess) { fprintf(stderr, "kernel_launch: launch %d failed: %s\n", li, hipGetErrorName(le)); break; }
    }
}
```

```cpp
#include <hip/hip_runtime.h>
#include <cstdio>
#include <cstdint>

#ifndef MK_N_LAUNCHES
#define MK_N_LAUNCHES 1
#endif

#define GAS __attribute__((address_space(1)))
#define LAS __attribute__((address_space(3)))
typedef unsigned short bf16;
typedef unsigned v4u __attribute__((ext_vector_type(4)));
typedef unsigned v2u __attribute__((ext_vector_type(2)));
typedef float f32x4 __attribute__((ext_vector_type(4)));
typedef float f32x16 __attribute__((ext_vector_type(16)));
typedef short bf16x8 __attribute__((ext_vector_type(8)));
typedef short s16x4 __attribute__((ext_vector_type(4)));

constexpr int SEQ = 16384, DM = 2048, NIN = 8704, AW = 1024, KVW = 256, CW = 1024, XW = 512, NMEM = 256, DFF = 5632;
constexpr float EPS = 1e-6f;
constexpr float LOG2E = 1.4426950408889634f;
constexpr float QSCALE = 0.125f * 1.4426950408889634f;
constexpr float C2X = 0.08838834764831845f * 1.4426950408889634f;

constexpr size_t MiB = 1u << 20;
constexpr size_t WS_CTL = 0, CTL_ZERO_BYTES = 256 * 1024;
constexpr size_t WS_SS = 1 * MiB;
constexpr size_t WS_CS = 2 * MiB;
constexpr size_t WS_KVB = 3 * MiB;
constexpr size_t WS_MEMN = 4 * MiB;
constexpr size_t WS_WXQ = 5 * MiB;
constexpr size_t WS_WXOT = 7 * MiB;
constexpr size_t WS_WGUT = 16 * MiB;
constexpr size_t WS_WDT = 60 * MiB;
constexpr size_t WS_XN = 82 * MiB;
constexpr size_t WS_WACT = 146 * MiB;
constexpr size_t WS_WOUTT = 154 * MiB;
constexpr size_t WS_WQKT = 162 * MiB;
constexpr size_t WS_VWOT = 166 * MiB;
constexpr size_t WS_Q = 170 * MiB, WS_K = 202 * MiB, WS_V = 210 * MiB, WS_ZC = 218 * MiB;
constexpr size_t WS_P = WS_Q;
constexpr size_t WS_ACT = 314 * MiB;
constexpr size_t WS_WINT = 314 * MiB;
constexpr size_t WS_WXKVT = 348 * MiB;
constexpr size_t WS_END = 490 * MiB;
static_assert(WS_ACT + (size_t)SEQ * DFF * 2 <= WS_END && WS_ZC + (size_t)SEQ * 3 * CW * 2 <= WS_ACT, "d_ws map");

constexpr int CW_BAR = 4096;
constexpr int CW_GRP = 16384;
constexpr int CW_XID = 49152;
constexpr int CW_GLOB = 32768;

constexpr int RING_BYTES = 131072;
constexpr int LDSCTL_OFF = RING_BYTES, MISC_OFF = LDSCTL_OFF + 320;
constexpr int LDS_BYTES = 147456;

#define RLX_AGENT __ATOMIC_RELAXED, __HIP_MEMORY_SCOPE_AGENT
#define LDS_WAIT() asm volatile("s_waitcnt lgkmcnt(0)" ::: "memory")
#define VM_WAIT() asm volatile("s_waitcnt vmcnt(0)" ::: "memory")

typedef float f32x2_t __attribute__((ext_vector_type(2))); typedef __bf16 bf16x2_t __attribute__((ext_vector_type(2)));
__device__ __forceinline__ unsigned cvt_pk_bf16(float lo, float hi) { f32x2_t v = {lo, hi}; bf16x2_t b = __builtin_convertvector(v, bf16x2_t); return __builtin_bit_cast(unsigned, b); }
__device__ __forceinline__ float bf_lo(unsigned u) { return __builtin_bit_cast(float, u << 16); }
__device__ __forceinline__ float bf_hi(unsigned u) { return __builtin_bit_cast(float, u & 0xffff0000u); }
__device__ __forceinline__ float fast_exp2(float x) { return __builtin_amdgcn_exp2f(x); }
__device__ __forceinline__ float fast_rcp(float x) { return __builtin_amdgcn_rcpf(x); }
__device__ __forceinline__ void st16_wt(void* p, v4u v) { asm volatile("global_store_dwordx4 %0, %1, off sc1\n\ts_nop 1" :: "v"(p), "v"(v) : "memory"); }
__device__ __forceinline__ void st8_wt(void* p, v2u v) { __hip_atomic_store((unsigned long long*)p, ((unsigned long long)v.y << 32) | v.x, __ATOMIC_RELAXED, __HIP_MEMORY_SCOPE_AGENT); }

namespace pg8 {
typedef unsigned short bf16_t;
constexpr int BM = 256, BK = 64, HALF = 128, HTB = HALF * BK * 2, STAGE_BYTES = 8 * HTB, NXCD = 8, WGM = 8;

__host__ __device__ __forceinline__ int lds_byte(int r, int c) { const int st = (r >> 4) * 2 + (c >> 5), rr = r & 15, cc = c & 31, ob = rr * 64 + cc * 2; return st * 1024 + (ob ^ (((ob >> 9) & 1) << 5)); }
__host__ __device__ __forceinline__ void stage_rc(int b, int& R, int& C) { const int st = b / 1024, sb = b % 1024, swz = sb ^ (((sb >> 9) & 1) << 5); R = (st >> 1) * 16 + swz / 64; C = (st & 1) * 32 + (swz % 64) / 2; }
__host__ __device__ __forceinline__ int perm32(int rho) { const int n = rho >> 4, i = rho & 15; return 8 * (i >> 2) + 4 * n + (i & 3); }

struct Unit { int pm, pn, z; };
struct Prob {
    const bf16_t* A; const bf16_t* Bt; int lda, ldb, K, zoff;
    int akstep = 0; size_t apanel = 0;
    __device__ __forceinline__ const char* a_ptr(const Unit& u) const { return (const char*)(A + (apanel ? (size_t)u.pm * apanel : (size_t)u.pm * BM * lda) + (size_t)u.z * zoff); }
    __device__ __forceinline__ const char* b_ptr(const Unit& u) const { return (const char*)(Bt + (size_t)u.pn * BM * ldb + (size_t)u.z * zoff); }
    __device__ __forceinline__ unsigned a_off(const Unit& u) const { return (unsigned)(((apanel ? (size_t)u.pm * apanel : (size_t)u.pm * BM * lda) + (size_t)u.z * zoff) * 2); }
    __device__ __forceinline__ unsigned b_off(const Unit& u) const { return (unsigned)(((size_t)u.pn * BM * ldb + (size_t)u.z * zoff) * 2); }
};

__device__ __forceinline__ bool tile_of(long L, int nM, int nN, int& pm, int& pn) {
    const int nwg = nM * nN; if (L >= nwg) return false;
    int wgid = (int)L; { const int q = nwg / NXCD, r = nwg % NXCD, xcd = wgid % NXCD, off = wgid / NXCD; wgid = (xcd < r ? xcd * (q + 1) : r * (q + 1) + (xcd - r) * q) + off; }
    const int nig = WGM * nN, gid = wgid / nig, fm = gid * WGM, gsz = (nM - fm) < WGM ? (nM - fm) : WGM;
    pm = fm + ((wgid % nig) % gsz); pn = (wgid % nig) / gsz; return true;
}
struct StaticOrder {
    int nM, nN, G, c, ZS, rev;
    __device__ __forceinline__ void init(int M, int N, int G_, int c_, int ZS_ = 1, bool reversed = false) { nM = M / BM; nN = N / BM; G = G_; c = c_; ZS = ZS_;
        rev = (reversed && c_ >= 0 && c_ < nM * nN) ? (nM * nN - 1 - c_) / G_ + 1 : 0; }
    __device__ __forceinline__ bool next(int i, Unit& u) const {
        if (c < 0) return false;
        int ti = (ZS == 2) ? (i >> 1) : i; u.z = (ZS == 2) ? (i & 1) : 0;
        if (rev) { if (ti >= rev) return false; ti = rev - 1 - ti; }
        return tile_of((long)ti * G + c, nM, nN, u.pm, u.pn);
    }
};

template <class Epi, class Sched, bool ALIGN_EPI = false, bool SP2 = false>
__device__ __forceinline__ void gemm_phase(LAS unsigned char* lds, const Prob g, const Sched& S, const Epi& E) {
    const int tid = threadIdx.x, wid = __builtin_amdgcn_readfirstlane(tid >> 6), lane = tid & 63, wr = wid >> 2, wc = wid & 3, fr = lane & 15, fq = lane >> 4;
    const int K = g.K, nt = K / BK;
    unsigned voffA[2], voffB[2];
#pragma unroll
    for (int i = 0; i < 2; ++i) { int R, C; stage_rc(tid * 16 + i * 8192, R, C); const int Rb = Epi::PERM ? ((R & ~31) + perm32(R & 31)) : R;
        voffA[i] = (unsigned)(R * g.lda + C) * 2u; voffB[i] = (unsigned)(Rb * g.ldb + C) * 2u; }
    const unsigned kstep = (unsigned)(BK * 2), kstepA = g.akstep ? (unsigned)g.akstep : kstep;
    const unsigned hstepA = (unsigned)HALF * g.lda * 2u, hstepB = (unsigned)HALF * g.ldb * 2u;
    const __amdgpu_buffer_rsrc_t rs_voffA = __builtin_amdgcn_make_buffer_rsrc((void*)g.A, (short)0, 0x7fffffff, 0x00020000);
    const __amdgpu_buffer_rsrc_t rs_voffB = __builtin_amdgcn_make_buffer_rsrc((void*)g.Bt, (short)0, 0x7fffffff, 0x00020000);
    const unsigned ldsw = (unsigned)wid * 1024u;
    const int aoff = lds_byte(wr * 64 + fr, fq * 8), boff = lds_byte(wc * 32 + fr, fq * 8);
#define PG8_SA(b, h) (((b) * 2 + (h)) * HTB)
#define PG8_SB(b, h) ((4 + (b) * 2 + (h)) * HTB)
#define PG8_STAGE(bufoff, gbase, voff) do { _Pragma("unroll") for (int _i = 0; _i < 2; ++_i) \
        __builtin_amdgcn_raw_ptr_buffer_load_lds(rs_##voff, (LAS void*)(lds + (bufoff) + ldsw + _i * 8192), 16, (voff)[_i], (gbase), 0, 0); } while (0)
#define PG8_LDA(dst, b, h) do { _Pragma("unroll") for (int m = 0; m < 4; ++m) _Pragma("unroll") for (int k = 0; k < 2; ++k) dst[m][k] = *(const LAS bf16x8*)(lds + PG8_SA(b, h) + aoff + m * 2048 + k * 1024); } while (0)
#define PG8_LDB(dst, b, h) do { _Pragma("unroll") for (int n = 0; n < 2; ++n) _Pragma("unroll") for (int k = 0; k < 2; ++k) dst[n][k] = *(const LAS bf16x8*)(lds + PG8_SB(b, h) + boff + n * 2048 + k * 1024); } while (0)
#define PG8_MMA(ai, bj, At, Bt) do { __builtin_amdgcn_s_setprio(1); _Pragma("unroll") for (int m = 0; m < 4; ++m) _Pragma("unroll") for (int n = 0; n < 2; ++n) _Pragma("unroll") for (int k = 0; k < 2; ++k) \
        acc[ai][bj][m][n] = __builtin_amdgcn_mfma_f32_16x16x32_bf16(Bt[n][k], At[m][k], acc[ai][bj][m][n], 0, 0, 0); __builtin_amdgcn_s_setprio(0); } while (0)
#define PG8_WAIT_V(n) asm volatile("s_waitcnt vmcnt(" #n ")" ::: "memory")
#define PG8_WAIT_L(n) asm volatile("s_waitcnt lgkmcnt(" #n ")" ::: "memory")
#define PG8_BAR __builtin_amdgcn_s_barrier()
#define PG8_SCHED __builtin_amdgcn_sched_barrier(0)
    Unit cur, nxt; int ui = 0;
    if (!S.next(0, cur)) return;
    f32x4 acc[2][2][4][2];
#pragma unroll
    for (int a = 0; a < 2; ++a)
#pragma unroll
        for (int b = 0; b < 2; ++b)
#pragma unroll
            for (int m = 0; m < 4; ++m)
#pragma unroll
                for (int n = 0; n < 2; ++n) acc[a][b][m][n] = (f32x4){0.f, 0.f, 0.f, 0.f};
    bf16x8 At[4][2], B0[2][2], B1[2][2];
    unsigned cA = g.a_off(cur), cB = g.b_off(cur);
    if constexpr (SP2) {
        PG8_STAGE(PG8_SB(0, 0), cB, voffB); PG8_STAGE(PG8_SB(0, 1), cB + hstepB, voffB); PG8_STAGE(PG8_SA(0, 0), cA, voffA); PG8_STAGE(PG8_SA(0, 1), cA + hstepA, voffA);
        if (wr == 1) PG8_BAR;
        PG8_WAIT_V(2); PG8_BAR;
        PG8_STAGE(PG8_SB(1, 0), cB + kstep, voffB); PG8_STAGE(PG8_SA(1, 0), cA + kstepA, voffA); PG8_STAGE(PG8_SB(1, 1), cB + hstepB + kstep, voffB);
        PG8_WAIT_V(6); PG8_BAR;
    } else {
        PG8_STAGE(PG8_SB(0, 0), cB, voffB); PG8_STAGE(PG8_SA(0, 0), cA, voffA); PG8_STAGE(PG8_SB(0, 1), cB + hstepB, voffB); PG8_STAGE(PG8_SA(0, 1), cA + hstepA, voffA);
        if (wr == 1) PG8_BAR;
        PG8_WAIT_V(4); PG8_BAR;
        PG8_STAGE(PG8_SB(1, 0), cB + kstep, voffB); PG8_STAGE(PG8_SA(1, 0), cA + kstepA, voffA); PG8_STAGE(PG8_SB(1, 1), cB + hstepB + kstep, voffB);
        PG8_WAIT_V(6); PG8_BAR;
    }
    for (;;) {
        const bool has_next = S.next(ui + 1, nxt);
        const unsigned nA = has_next ? g.a_off(nxt) : cA, nB = has_next ? g.b_off(nxt) : cB;
        for (int t = 0; t < nt; t += 2) {
            const bool last = (t == nt - 2);
            const unsigned a1 = cA + (unsigned)(t + 1) * kstepA;
            const unsigned a2 = last ? nA : cA + (unsigned)(t + 2) * kstepA, b2 = last ? nB : cB + (unsigned)(t + 2) * kstep;
            const unsigned a3 = a2 + kstepA, b3 = b2 + kstep;
            if constexpr (SP2) {
            PG8_LDB(B0, 0, 0); PG8_LDB(B1, 0, 1); PG8_SCHED; PG8_LDA(At, 0, 0); PG8_STAGE(PG8_SA(1, 1), a1 + hstepA, voffA);
            PG8_WAIT_V(8); PG8_WAIT_L(0); PG8_BAR; PG8_MMA(0, 0, At, B0); PG8_MMA(0, 1, At, B1); PG8_BAR; PG8_SCHED;
            PG8_LDA(At, 0, 1); PG8_STAGE(PG8_SB(0, 0), b2, voffB); PG8_STAGE(PG8_SB(0, 1), b2 + hstepB, voffB); PG8_STAGE(PG8_SA(0, 0), a2, voffA);
            PG8_WAIT_V(8); PG8_WAIT_L(0); PG8_BAR; PG8_MMA(1, 0, At, B0); PG8_MMA(1, 1, At, B1); PG8_BAR; PG8_SCHED;
            PG8_LDB(B0, 1, 0); PG8_LDB(B1, 1, 1); PG8_SCHED; PG8_LDA(At, 1, 0); PG8_STAGE(PG8_SA(0, 1), a2 + hstepA, voffA);
            PG8_WAIT_V(8); PG8_WAIT_L(0); PG8_BAR; PG8_MMA(0, 0, At, B0); PG8_MMA(0, 1, At, B1); PG8_BAR; PG8_SCHED;
            PG8_LDA(At, 1, 1); PG8_STAGE(PG8_SB(1, 0), b3, voffB); PG8_STAGE(PG8_SB(1, 1), b3 + hstepB, voffB); PG8_STAGE(PG8_SA(1, 0), a3, voffA);
            PG8_WAIT_V(8); PG8_WAIT_L(0); PG8_BAR; PG8_MMA(1, 0, At, B0); PG8_MMA(1, 1, At, B1); PG8_BAR; PG8_SCHED;
            } else {
            PG8_LDB(B0, 0, 0); PG8_SCHED; PG8_LDA(At, 0, 0); PG8_STAGE(PG8_SA(1, 1), a1 + hstepA, voffA);
            PG8_WAIT_L(8); PG8_BAR; PG8_WAIT_L(0); PG8_MMA(0, 0, At, B0); PG8_BAR; PG8_SCHED;
            PG8_LDB(B1, 0, 1); PG8_STAGE(PG8_SB(0, 0), b2, voffB);
            PG8_BAR; PG8_WAIT_L(0); PG8_MMA(0, 1, At, B1); PG8_BAR;
            PG8_LDA(At, 0, 1); PG8_STAGE(PG8_SA(0, 0), a2, voffA);
            PG8_BAR; PG8_WAIT_L(0); PG8_MMA(1, 0, At, B0); PG8_BAR; PG8_SCHED;
            PG8_STAGE(PG8_SB(0, 1), b2 + hstepB, voffB);
            PG8_WAIT_V(6); PG8_BAR; PG8_MMA(1, 1, At, B1); PG8_BAR;
            PG8_LDB(B0, 1, 0); PG8_SCHED; PG8_LDA(At, 1, 0); PG8_STAGE(PG8_SA(0, 1), a2 + hstepA, voffA);
            PG8_WAIT_L(8); PG8_BAR; PG8_WAIT_L(0); PG8_MMA(0, 0, At, B0); PG8_BAR; PG8_SCHED;
            PG8_LDB(B1, 1, 1); PG8_STAGE(PG8_SB(1, 0), b3, voffB);
            PG8_BAR; PG8_WAIT_L(0); PG8_MMA(0, 1, At, B1); PG8_BAR;
            PG8_LDA(At, 1, 1); PG8_STAGE(PG8_SA(1, 0), a3, voffA);
            PG8_BAR; PG8_WAIT_L(0); PG8_MMA(1, 0, At, B0); PG8_BAR; PG8_SCHED;
            PG8_STAGE(PG8_SB(1, 1), b3 + hstepB, voffB);
            PG8_WAIT_V(6); PG8_BAR; PG8_MMA(1, 1, At, B1); PG8_BAR;
            }
        }
        if constexpr (ALIGN_EPI) { if (wr == 0) PG8_BAR; }
        if constexpr (!Epi::AFTER_DRAIN) { if (!(Epi::LAST_FUSED && !has_next)) E(acc, cur, wr, wc, fr, fq); }
        if (!has_next) break;
        if (!E.keep(cur)) {
#pragma unroll
        for (int a = 0; a < 2; ++a)
#pragma unroll
            for (int b = 0; b < 2; ++b)
#pragma unroll
                for (int m = 0; m < 4; ++m)
#pragma unroll
                    for (int n = 0; n < 2; ++n) acc[a][b][m][n] = (f32x4){0.f, 0.f, 0.f, 0.f};
        }
        cur = nxt; cA = nA; cB = nB; ++ui;
        if constexpr (ALIGN_EPI) { if (wr == 1) PG8_BAR; }
    }
    PG8_WAIT_V(0);
    if constexpr (!ALIGN_EPI) { if (wr == 0) PG8_BAR; }
    PG8_BAR;
    if constexpr (Epi::AFTER_DRAIN || Epi::LAST_FUSED) { E.fused(acc, cur, wr, wc, fr, fq, lds, wid, lane); }
#undef PG8_SA
#undef PG8_SB
#undef PG8_STAGE
#undef PG8_LDA
#undef PG8_LDB
#undef PG8_MMA
#undef PG8_WAIT_V
#undef PG8_WAIT_L
#undef PG8_BAR
#undef PG8_SCHED
}
}

#ifndef PG8_SP2
#define PG8_SP2 true
#endif
#ifndef PG8_ALIGN
#define PG8_ALIGN true
#endif

typedef f32x4 Acc[2][2][4][2];

__device__ __forceinline__ v4u pack8(f32x4 v0, f32x4 v1) { v4u w; w.x = cvt_pk_bf16(v0[0], v0[1]); w.y = cvt_pk_bf16(v0[2], v0[3]); w.z = cvt_pk_bf16(v1[0], v1[1]); w.w = cvt_pk_bf16(v1[2], v1[3]); return w; }
__device__ __forceinline__ void unpack8(v4u w, f32x4& v0, f32x4& v1) { v0 = (f32x4){bf_lo(w.x), bf_hi(w.x), bf_lo(w.y), bf_hi(w.y)}; v1 = (f32x4){bf_lo(w.z), bf_hi(w.z), bf_lo(w.w), bf_hi(w.w)}; }

struct EpiInProj {
    static constexpr bool PERM = true, AFTER_DRAIN = false, LAST_FUSED = false;
    bf16 *q, *k, *v, *zc, *sgr, *sgc; const float* cs;
    __device__ __forceinline__ bool keep(const pg8::Unit&) const { return false; }
    __device__ __forceinline__ void operator()(Acc& acc, const pg8::Unit& u, int wr, int wc, int fr, int fq) const {
        const int row0 = u.pm * 256 + wr * 64 + fr, ct = wc * 32 + 8 * fq;
        if (u.pn < 5) {
            const bool isq = u.pn < 4; bf16* base = isq ? q + u.pn * 256 : k; const int ld = isq ? AW : KVW; const float sc = isq ? QSCALE : 1.f;
            const bool rl = ((wc & 1) == 0) && (fq < 2);
#pragma unroll
            for (int ai = 0; ai < 2; ++ai)
#pragma unroll
                for (int m = 0; m < 4; ++m) { const int row = row0 + ai * 128 + m * 16;
                    f32x4 c4 = (f32x4){1.f, 1.f, 1.f, 1.f}, s4 = (f32x4){0.f, 0.f, 0.f, 0.f};
                    if (rl) { c4 = *(const f32x4*)(cs + (size_t)row * 16 + 4 * fq); s4 = *(const f32x4*)(cs + (size_t)row * 16 + 8 + 4 * fq); }
#pragma unroll
                    for (int bj = 0; bj < 2; ++bj) { const f32x4 t1 = acc[ai][bj][m][0], t2 = acc[ai][bj][m][1];
                        const f32x4 v0 = (t1 * c4 - t2 * s4) * sc, v1 = (t2 * c4 + t1 * s4) * sc;
                        *(v4u*)(base + (size_t)row * ld + bj * 128 + ct) = pack8(v0, v1); } }
        } else if (u.pn < 10) {
            bf16* base = (u.pn == 5) ? v : zc + (u.pn - 6) * 256; const int ld = (u.pn == 5) ? KVW : 2 * CW;
#pragma unroll
            for (int ai = 0; ai < 2; ++ai)
#pragma unroll
                for (int m = 0; m < 4; ++m) { const int row = row0 + ai * 128 + m * 16;
#pragma unroll
                    for (int bj = 0; bj < 2; ++bj) *(v4u*)(base + (size_t)row * ld + bj * 128 + ct) = pack8(acc[ai][bj][m][0], acc[ai][bj][m][1]); }
        } else if (u.pn < 18) {
            const int t = u.pn - 10;
#pragma unroll
            for (int ai = 0; ai < 2; ++ai)
#pragma unroll
                for (int m = 0; m < 4; ++m) { const int row = row0 + ai * 128 + m * 16;
                    *(v4u*)(zc + (size_t)row * (2 * CW) + CW + t * 128 + ct) = pack8(acc[ai][0][m][0] * acc[ai][1][m][0], acc[ai][0][m][1] * acc[ai][1][m][1]); }
        } else {
            const int t = u.pn - 18;
#pragma unroll
            for (int ai = 0; ai < 2; ++ai)
#pragma unroll
                for (int m = 0; m < 4; ++m) { const int row = row0 + ai * 128 + m * 16; f32x4 rr[2], ss[2];
#pragma unroll
                    for (int n = 0; n < 2; ++n)
#pragma unroll
                        for (int e = 0; e < 4; ++e) { const float ga = acc[ai][0][m][n][e], gc = acc[ai][1][m][n][e];
                            const float ea = fast_exp2(fminf(ga, 80.f)), ec = fast_exp2(fminf(gc, 80.f));
                            const float ia = fast_rcp(1.f + ea), ic = fast_rcp(1.f + ec);
                            rr[n][e] = (1.f + ec) * ia; ss[n][e] = ic; }
                    *(v4u*)(sgr + (size_t)row * DM + t * 128 + ct) = pack8(rr[0], rr[1]);
                    *(v4u*)(sgc + (size_t)row * DM + t * 128 + ct) = pack8(ss[0], ss[1]); }
        }
    }
};
struct EpiStoreBf16 {
    static constexpr bool PERM = true, AFTER_DRAIN = false, LAST_FUSED = false;
    bf16* O; int ldc;
    __device__ __forceinline__ bool keep(const pg8::Unit&) const { return false; }
    __device__ __forceinline__ void operator()(Acc& acc, const pg8::Unit& u, int wr, int wc, int fr, int fq) const {
        const int row0 = u.pm * 256 + wr * 64 + fr, col0 = u.pn * 256 + wc * 32 + 8 * fq;
#pragma unroll
        for (int ai = 0; ai < 2; ++ai)
#pragma unroll
            for (int m = 0; m < 4; ++m) { const int row = row0 + ai * 128 + m * 16;
#pragma unroll
                for (int bj = 0; bj < 2; ++bj) *(v4u*)(O + (size_t)row * ldc + col0 + bj * 128) = pack8(acc[ai][bj][m][0], acc[ai][bj][m][1]); }
    }
};
struct EpiMerge {
    static constexpr bool PERM = true, AFTER_DRAIN = false, LAST_FUSED = false;
    const bf16 *sgr, *sgc; bf16* merged;
    __device__ __forceinline__ bool keep(const pg8::Unit& u) const { return u.z == 0; }
    __device__ __forceinline__ void operator()(Acc& acc, const pg8::Unit& u, int wr, int wc, int fr, int fq) const {
        const int row0 = u.pm * 256 + wr * 64 + fr, col0 = u.pn * 256 + wc * 32 + 8 * fq;
        const bf16* gsrc = ((u.z == 0) ? sgr : sgc) + (size_t)row0 * DM + col0;
        v4u gw[2][4][2];
#pragma unroll
        for (int ai = 0; ai < 2; ++ai)
#pragma unroll
            for (int m = 0; m < 4; ++m)
#pragma unroll
                for (int bj = 0; bj < 2; ++bj) gw[ai][m][bj] = __builtin_nontemporal_load((const v4u*)(gsrc + (size_t)(ai * 128 + m * 16) * DM + bj * 128));
#pragma unroll
        for (int ai = 0; ai < 2; ++ai)
#pragma unroll
            for (int m = 0; m < 4; ++m) { const int row = row0 + ai * 128 + m * 16;
#pragma unroll
                for (int bj = 0; bj < 2; ++bj) { f32x4 g0, g1; unpack8(gw[ai][m][bj], g0, g1);
                    const f32x4 v0 = acc[ai][bj][m][0] * g0, v1 = acc[ai][bj][m][1] * g1;
                    if (u.z == 0) { acc[ai][bj][m][0] = v0; acc[ai][bj][m][1] = v1; }
                    else *(v4u*)(merged + (size_t)row * DM + col0 + bj * 128) = pack8(v0, v1); } }
    }
};
template <bool BASE_F32> struct EpiResid {
    static constexpr bool PERM = true, AFTER_DRAIN = false, LAST_FUSED = false;
    const float* basef; bf16* hb; float* ss;
    __device__ __forceinline__ bool keep(const pg8::Unit&) const { return false; }
    __device__ __forceinline__ void operator()(Acc& acc, const pg8::Unit& u, int wr, int wc, int fr, int fq) const {
        const int row0 = u.pm * 256 + wr * 64 + fr, col0 = u.pn * 256 + wc * 32 + 8 * fq;
        const size_t off0 = (size_t)row0 * DM + col0;
        constexpr int NPRE = BASE_F32 ? 4 : 8;
        f32x4 pf[BASE_F32 ? 4 : 1][2][2]; v4u pb[BASE_F32 ? 1 : 8][2];
#pragma unroll
        for (int g = 0; g < NPRE; ++g)
#pragma unroll
            for (int bj = 0; bj < 2; ++bj) { const size_t off = off0 + (size_t)((g >> 2) * 128 + (g & 3) * 16) * DM + bj * 128;
                if (BASE_F32) { pf[g][bj][0] = __builtin_nontemporal_load((const f32x4*)(basef + off)); pf[g][bj][1] = __builtin_nontemporal_load((const f32x4*)(basef + off + 4)); } else pb[g][bj] = __builtin_nontemporal_load((const v4u*)(hb + off)); }
#pragma unroll
        for (int g = 0; g < 8; ++g) { const int ai = g >> 2, m = g & 3; const int row = row0 + ai * 128 + m * 16; float sq = 0.f;
#pragma unroll
            for (int bj = 0; bj < 2; ++bj) { const size_t off = (size_t)row * DM + col0 + bj * 128; f32x4 b0, b1;
                if (BASE_F32) { b0 = pf[g & 3][bj][0]; b1 = pf[g & 3][bj][1]; } else unpack8(pb[g][bj], b0, b1);
                const f32x4 v0 = acc[ai][bj][m][0] + b0, v1 = acc[ai][bj][m][1] + b1;
                *(v4u*)(hb + off) = pack8(v0, v1);
                sq += (v0[0] * v0[0] + v0[1] * v0[1]) + (v0[2] * v0[2] + v0[3] * v0[3]) + (v1[0] * v1[0] + v1[1] * v1[1]) + (v1[2] * v1[2] + v1[3] * v1[3]); }
            if (BASE_F32 && g + 4 < 8) {
#pragma unroll
                for (int bj = 0; bj < 2; ++bj) { const size_t off = off0 + (size_t)(128 + m * 16) * DM + bj * 128; pf[g & 3][bj][0] = __builtin_nontemporal_load((const f32x4*)(basef + off)); pf[g & 3][bj][1] = __builtin_nontemporal_load((const f32x4*)(basef + off + 4)); } }
            sq += __shfl_xor(sq, 16); sq += __shfl_xor(sq, 32);
            if (fq == 0) atomicAdd(ss + row, sq); }
    }
};
struct EpiSoftmax {
    static constexpr bool PERM = true, AFTER_DRAIN = true, LAST_FUSED = false;
    const float* ss; bf16* P;
    __device__ __forceinline__ bool keep(const pg8::Unit&) const { return false; }
    __device__ __forceinline__ void fused(Acc& acc, const pg8::Unit& u, int wr, int wc, int fr, int fq, LAS unsigned char* lds, int wid, int lane) const {
        LAS float* Pm = (LAS float*)lds; LAS float* Ps = (LAS float*)(lds + 4096);
        const int rl0 = wr * 64 + fr, col0 = u.pn * 256 + wc * 32 + 8 * fq;
#pragma unroll
        for (int ai = 0; ai < 2; ++ai)
#pragma unroll
            for (int m = 0; m < 4; ++m) { const int rl = rl0 + ai * 128 + m * 16; const float rs = 1.0f / sqrtf(ss[u.pm * 256 + rl] * (1.0f / DM) + EPS); float mx = -3.0e38f;
#pragma unroll
                for (int bj = 0; bj < 2; ++bj)
#pragma unroll
                    for (int n = 0; n < 2; ++n) { f32x4 s = acc[ai][bj][m][n] * rs; acc[ai][bj][m][n] = s; mx = fmaxf(mx, fmaxf(fmaxf(s[0], s[1]), fmaxf(s[2], s[3]))); }
                mx = fmaxf(mx, __shfl_xor(mx, 16)); mx = fmaxf(mx, __shfl_xor(mx, 32));
                if (fq == 0) Pm[rl * 4 + wc] = mx; }
        asm volatile("s_waitcnt lgkmcnt(0)" ::: "memory"); __builtin_amdgcn_s_barrier(); asm volatile("" ::: "memory");
#pragma unroll
        for (int ai = 0; ai < 2; ++ai)
#pragma unroll
            for (int m = 0; m < 4; ++m) { const int rl = rl0 + ai * 128 + m * 16; const f32x4 pm4 = *(const LAS f32x4*)(Pm + rl * 4);
                const float mx = fmaxf(fmaxf(pm4[0], pm4[1]), fmaxf(pm4[2], pm4[3])); float sm = 0.f;
#pragma unroll
                for (int bj = 0; bj < 2; ++bj)
#pragma unroll
                    for (int n = 0; n < 2; ++n) { f32x4 s = acc[ai][bj][m][n];
#pragma unroll
                        for (int e = 0; e < 4; ++e) { s[e] = fast_exp2(s[e] - mx); sm += s[e]; }
                        acc[ai][bj][m][n] = s; }
                sm += __shfl_xor(sm, 16); sm += __shfl_xor(sm, 32);
                if (fq == 0) Ps[rl * 4 + wc] = sm; }
        asm volatile("s_waitcnt lgkmcnt(0)" ::: "memory"); __builtin_amdgcn_s_barrier(); asm volatile("" ::: "memory");
#pragma unroll
        for (int ai = 0; ai < 2; ++ai)
#pragma unroll
            for (int m = 0; m < 4; ++m) { const int rl = rl0 + ai * 128 + m * 16; const f32x4 ps4 = *(const LAS f32x4*)(Ps + rl * 4);
                const float inv = 1.0f / ((ps4[0] + ps4[1]) + (ps4[2] + ps4[3])); const size_t rowoff = (size_t)(u.pm * 256 + rl) * (4 * NMEM) + col0;
#pragma unroll
                for (int bj = 0; bj < 2; ++bj) *(v4u*)(P + rowoff + bj * 128) = pack8(acc[ai][bj][m][0] * inv, acc[ai][bj][m][1] * inv); }
    }
};
struct EpiSwiGLU {
    static constexpr bool PERM = true, AFTER_DRAIN = false, LAST_FUSED = false;
    const float* ss; bf16* act;
    __device__ __forceinline__ bool keep(const pg8::Unit&) const { return false; }
    __device__ __forceinline__ void operator()(Acc& acc, const pg8::Unit& u, int wr, int wc, int fr, int fq) const {
        const int row0 = u.pm * 256 + wr * 64 + fr, col0 = u.pn * 128 + wc * 32 + 8 * fq;
        float ssv[8];
#pragma unroll
        for (int g = 0; g < 8; ++g) ssv[g] = ss[row0 + (g >> 2) * 128 + (g & 3) * 16];
#pragma unroll
        for (int ai = 0; ai < 2; ++ai)
#pragma unroll
            for (int m = 0; m < 4; ++m) { const int row = row0 + ai * 128 + m * 16; const float rs = 1.0f / sqrtf(ssv[ai * 4 + m] * (1.0f / DM) + EPS); f32x4 o[2];
                const float nrl = -rs * LOG2E, rs2 = rs * rs;
#pragma unroll
                for (int n = 0; n < 2; ++n)
#pragma unroll
                    for (int e = 0; e < 4; ++e) { const float a = acc[ai][0][m][n][e], b = acc[ai][1][m][n][e];
                        o[n][e] = (a * b) * (rs2 * fast_rcp(1.f + fast_exp2(a * nrl))); }
                *(v4u*)(act + ((((size_t)u.pm * (DFF / 64) + (col0 >> 6)) * 256 + (row - u.pm * 256)) << 6) + (col0 & 63)) = pack8(o[0], o[1]); }
    }
};

#define XB_TMO      128
#define XB_XCNT(j)  (256  + 64 * (j))
#define XB_XSUB(j)  (1280 + 64 * (j))
#define XB_XGEN(j)  (2304 + 64 * (j))
#define XB_TOP      3328
#define XB_TOPGEN   3392
#define XCD_BAR_WORDS 3456
#define XB_SPIN_CAP (1u << 18)

__device__ __forceinline__ unsigned xb_ld(unsigned* p)              { return __hip_atomic_load(p, __ATOMIC_RELAXED, __HIP_MEMORY_SCOPE_AGENT); }
__device__ __forceinline__ unsigned xb_add(unsigned* p, unsigned v) { return __hip_atomic_fetch_add(p, v, __ATOMIC_RELAXED, __HIP_MEMORY_SCOPE_AGENT); }
__device__ __forceinline__ unsigned xb_xcc_id() { return (unsigned)__builtin_amdgcn_s_getreg((3 << 11) | 20) & 0xFu; }
#define XB_SPIN(cond, bar) do { unsigned _sp = 0; while (cond) { __builtin_amdgcn_s_sleep(1); \
    if ((++_sp & 255u) == 0u) { if (xb_ld(&(bar)[XB_TMO])) break; if (_sp > XB_SPIN_CAP) { atomicAdd(&(bar)[XB_TMO], 1u); break; } } } } while (0)

struct XcdBarrier { unsigned* bar; unsigned x; volatile LAS unsigned* st; };

__device__ __forceinline__ XcdBarrier xcd_barrier_post(unsigned* bar, volatile LAS unsigned* st) {
    XcdBarrier b; b.bar = bar; b.x = xb_xcc_id(); b.st = st;
    if (threadIdx.x == 0) (void)xb_add(&bar[XB_XCNT(b.x)], 1u);
    return b;
}
__device__ __forceinline__ void xcd_barrier_complete(unsigned* bar, unsigned x, unsigned& nloc, unsigned& nx) {
    const unsigned G = gridDim.x * gridDim.y * gridDim.z;
    unsigned sum, cnt, mine, sp = 0u;
    for (;;) {
        sum = 0u; cnt = 0u; mine = 0u;
#pragma unroll
        for (unsigned j = 0; j < 16; ++j) { const unsigned c = xb_ld(&bar[XB_XCNT(j)]); sum += c; cnt += (c > 0u) ? 1u : 0u; mine = (j == x) ? c : mine; }
        if (sum == G) break;
        __builtin_amdgcn_s_sleep(1);
        if ((++sp & 255u) == 0u) { if (xb_ld(&bar[XB_TMO])) break; if (sp > XB_SPIN_CAP) { atomicAdd(&bar[XB_TMO], 1u); break; } }
    }
    nloc = mine > 0u ? mine : 1u; nx = cnt > 0u ? cnt : 1u;
}
__device__ __forceinline__ void xcd_barrier(const XcdBarrier& b) {
    asm volatile("s_waitcnt vmcnt(0)" ::: "memory");
    __syncthreads();
    if (threadIdx.x == 0) {
        unsigned* bar = b.bar;
        __builtin_amdgcn_s_waitcnt(0);
        unsigned nloc = b.st[0], nx = b.st[1];
        if (nloc == 0u) { xcd_barrier_complete(bar, b.x, nloc, nx); b.st[0] = nloc; b.st[1] = nx; }
        const unsigned old = xb_add(&bar[XB_XSUB(b.x)], 1u);
        const unsigned gen = old / nloc;
        if (old + 1u == (gen + 1u) * nloc) {
            __builtin_amdgcn_fence(__ATOMIC_RELEASE, "agent");
            asm volatile("s_waitcnt vmcnt(0)" ::: "memory");
            const unsigned og = xb_add(&bar[XB_TOP], 1u);
            const unsigned tg = og / nx;
            if (og + 1u == (tg + 1u) * nx) xb_add(&bar[XB_TOPGEN], 1u);
            else XB_SPIN(xb_ld(&bar[XB_TOPGEN]) == tg, bar);
            __builtin_amdgcn_fence(__ATOMIC_ACQUIRE, "agent");
            xb_add(&bar[XB_XGEN(b.x)], 1u);
            asm volatile("s_waitcnt vmcnt(0)" ::: "memory");
        } else {
            XB_SPIN(xb_ld(&bar[XB_XGEN(b.x)]) == gen, bar);
            __builtin_amdgcn_fence(__ATOMIC_ACQUIRE, "agent");
            asm volatile("s_waitcnt vmcnt(0)" ::: "memory");
        }
    }
    __syncthreads();
}


__device__ __forceinline__ void group_barrier(unsigned* cnt, unsigned target, unsigned* extra, unsigned* tmo, bool same_xcd) {
    asm volatile("s_waitcnt vmcnt(0)" ::: "memory");
    __syncthreads();
    if (threadIdx.x == 0) {
        __builtin_amdgcn_s_waitcnt(0);
        if (!same_xcd) { __builtin_amdgcn_fence(__ATOMIC_RELEASE, "agent"); asm volatile("s_waitcnt vmcnt(0)" ::: "memory"); }
        (void)xb_add(cnt, 1u);
        if (extra) (void)xb_add(extra, 1u);
        unsigned sp = 0;
        while (xb_ld(cnt) < target) { __builtin_amdgcn_s_sleep(1); if ((++sp & 255u) == 0u) { if (xb_ld(tmo)) break; if (sp > XB_SPIN_CAP) { atomicAdd(tmo, 1u); break; } } }
        __builtin_amdgcn_fence(__ATOMIC_ACQUIRE, "agent");
        asm volatile("s_waitcnt vmcnt(0)" ::: "memory");
    }
    __syncthreads();
}
__device__ __forceinline__ void wait_global(unsigned* cnt, unsigned target, unsigned* tmo) {
    if (threadIdx.x == 0) {
        unsigned sp = 0;
        while (xb_ld(cnt) < target) { __builtin_amdgcn_s_sleep(1); if ((++sp & 255u) == 0u) { if (xb_ld(tmo)) break; if (sp > XB_SPIN_CAP) { atomicAdd(tmo, 1u); break; } } }
        __builtin_amdgcn_fence(__ATOMIC_ACQUIRE, "agent");
        asm volatile("s_waitcnt vmcnt(0)" ::: "memory");
    }
    __syncthreads();
}

struct EpiFinal {
    static constexpr bool PERM = true, AFTER_DRAIN = false, LAST_FUSED = true;
    bf16* hb; float* ss; float* out; const float* gfin; unsigned* gcnt; unsigned target; unsigned* glob1; unsigned* tmo; bool same_xcd;
    __device__ __forceinline__ bool keep(const pg8::Unit&) const { return false; }
    __device__ __forceinline__ void operator()(Acc& acc, const pg8::Unit& u, int wr, int wc, int fr, int fq) const { const EpiResid<false> E{nullptr, hb, ss}; E(acc, u, wr, wc, fr, fq); }
    __device__ __forceinline__ void fused(Acc& acc, const pg8::Unit& u, int wr, int wc, int fr, int fq, LAS unsigned char* lds, int wid, int lane) const {
        const int row0 = u.pm * 256 + wr * 64 + fr, col0 = u.pn * 256 + wc * 32 + 8 * fq;
        const size_t off0 = (size_t)row0 * DM + col0;
        v4u pb[8][2];
#pragma unroll
        for (int g = 0; g < 8; ++g)
#pragma unroll
            for (int bj = 0; bj < 2; ++bj) pb[g][bj] = __builtin_nontemporal_load((const v4u*)(hb + off0 + (size_t)((g >> 2) * 128 + (g & 3) * 16) * DM + bj * 128));
#pragma unroll
        for (int g = 0; g < 8; ++g) { const int ai = g >> 2, m = g & 3; const int row = row0 + ai * 128 + m * 16; float sq = 0.f;
#pragma unroll
            for (int bj = 0; bj < 2; ++bj) { f32x4 b0, b1; unpack8(pb[g][bj], b0, b1);
                const f32x4 v0 = acc[ai][bj][m][0] + b0, v1 = acc[ai][bj][m][1] + b1; acc[ai][bj][m][0] = v0; acc[ai][bj][m][1] = v1;
                sq += (v0[0] * v0[0] + v0[1] * v0[1]) + (v0[2] * v0[2] + v0[3] * v0[3]) + (v1[0] * v1[0] + v1[1] * v1[1]) + (v1[2] * v1[2] + v1[3] * v1[3]); }
            sq += __shfl_xor(sq, 16); sq += __shfl_xor(sq, 32);
            if (fq == 0) atomicAdd(ss + row, sq); }
        group_barrier(gcnt, target, nullptr, tmo, same_xcd);
        wait_global(glob1, 256u, tmo);
        const int col1 = col0 - 1024;
        { f32x4 gv[2][2];
#pragma unroll
          for (int bj = 0; bj < 2; ++bj) { gv[bj][0] = *(const f32x4*)(gfin + col0 + bj * 128); gv[bj][1] = *(const f32x4*)(gfin + col0 + bj * 128 + 4); }
#pragma unroll
          for (int g = 0; g < 8; ++g) { const int ai = g >> 2, m = g & 3; const int row = row0 + ai * 128 + m * 16; const float rs = 1.0f / sqrtf(ss[row] * (1.0f / DM) + EPS);
#pragma unroll
            for (int bj = 0; bj < 2; ++bj) { float* o = out + (size_t)row * DM + col0 + bj * 128; *(f32x4*)o = acc[ai][bj][m][0] * rs * gv[bj][0]; *(f32x4*)(o + 4) = acc[ai][bj][m][1] * rs * gv[bj][1]; } } }
        asm volatile("" ::: "memory");
        { f32x4 gw[2][2];
#pragma unroll
          for (int bj = 0; bj < 2; ++bj) { gw[bj][0] = *(const f32x4*)(gfin + col1 + bj * 128); gw[bj][1] = *(const f32x4*)(gfin + col1 + bj * 128 + 4); }
#pragma unroll
          for (int g = 0; g < 8; ++g)
#pragma unroll
            for (int bj = 0; bj < 2; ++bj) pb[g][bj] = __builtin_nontemporal_load((const v4u*)(hb + off0 - 1024 + (size_t)((g >> 2) * 128 + (g & 3) * 16) * DM + bj * 128));
#pragma unroll
          for (int g = 0; g < 8; ++g) { const int ai = g >> 2, m = g & 3; const int row = row0 + ai * 128 + m * 16; const float rs = 1.0f / sqrtf(ss[row] * (1.0f / DM) + EPS);
#pragma unroll
            for (int bj = 0; bj < 2; ++bj) { f32x4 b0, b1; unpack8(pb[g][bj], b0, b1); float* o1 = out + (size_t)row * DM + col1 + bj * 128; *(f32x4*)o1 = b0 * rs * gw[bj][0]; *(f32x4*)(o1 + 4) = b1 * rs * gw[bj][1]; } } }
    }
};

__device__ __forceinline__ float wave_sum(float v) {
#pragma unroll
    for (int o = 1; o < 64; o <<= 1) v += __shfl_xor(v, o);
    return v;
}
__device__ __forceinline__ int rope_sigma(int p) { return (p < 16) ? ((p & 3) + 4 * ((p >> 3) & 1) + 8 * ((p >> 2) & 1)) : p; }
struct TpItem { const float* src; bf16* dst; const float* ks; int ldw, ldd, perm; float cscale; };
struct TpPtrs { const float *w_in, *w_attn_o, *w_conv_o, *w_out, *w_xkv, *w_xo, *w_gate_up, *w_down, *g_ffn; bf16 *WinT, *WacT, *WoutT, *WxkvT, *wxot, *WguT, *WdT; };
constexpr int TP_I0 = 32 * 272, TP_I1 = 16 * 64, TP_I2 = 16 * 64, TP_I3 = 32 * 64, TP_I4 = 32 * 32, TP_I7 = 8 * 64, TP_I5 = 32 * 352, TP_I6 = 88 * 64;
#ifndef TP_P2SHARE
#define TP_P2SHARE 8192
#endif
constexpr int TP_NEARLY = TP_I0 + TP_I1 + TP_I2 + TP_I3 + TP_I4 + TP_I7, TP_NITEMS = TP_NEARLY + TP_I5 + TP_I6;
constexpr int TP_MID = TP_I1 + TP_I2 + TP_I3;
template <int MAP> __device__ __forceinline__ int tp_map(int i) { return MAP == 1 ? (i < TP_I0 ? i : i + TP_MID) : MAP == 2 ? (i < TP_MID ? TP_I0 + i : TP_NEARLY + (i - TP_MID)) : i; }
__device__ __forceinline__ TpItem tp_mk(const float* W, int ldw, int src_col0, int k0, bf16* dst, int ldd, int dst_row0, int dst_col0, const float* kscale, int perm, float cscale = 1.f) {
    TpItem d; d.cscale = cscale; d.src = W + (size_t)k0 * ldw + src_col0; d.dst = dst + (size_t)dst_row0 * ldd + dst_col0 + k0; d.ks = kscale ? kscale + k0 : nullptr; d.ldw = ldw; d.ldd = ldd; d.perm = perm; return d; }
__device__ __forceinline__ TpItem tp_desc(int it, const TpPtrs& P) {
    int r = it;
    if (r < TP_I0) { const int kb_ = r / 272, Gp = r % 272; int src, perm = 0;
        if (Gp < 40) { src = 32 * Gp; perm = ((Gp & 1) == 0) ? 1 : 0; }
        else if (Gp < 80) { src = 32 * Gp; }
        else if (Gp < 144) { const int gg = Gp - 80, t = gg >> 3, i32 = gg & 7; src = (i32 < 4) ? (2560 + 128 * t + 32 * i32) : (3584 + 128 * t + 32 * (i32 - 4)); }
        else { const int gg = Gp - 144, t = gg >> 3, i32 = gg & 7; src = (i32 < 4) ? (4608 + 128 * t + 32 * i32) : (6656 + 128 * t + 32 * (i32 - 4)); }
        return tp_mk(P.w_in, NIN, src, 64 * kb_, P.WinT, DM, 32 * Gp, 0, nullptr, perm, Gp >= 144 ? -LOG2E : 1.f); } r -= TP_I0;
    if (r < TP_I1) { const int kb_ = r / 64, Gp = r % 64; return tp_mk(P.w_attn_o, DM, 32 * Gp, 64 * kb_, P.WacT, DM, 32 * Gp, 0, nullptr, 0); } r -= TP_I1;
    if (r < TP_I2) { const int kb_ = r / 64, Gp = r % 64; return tp_mk(P.w_conv_o, DM, 32 * Gp, 64 * kb_, P.WacT, DM, 32 * Gp, 1024, nullptr, 0); } r -= TP_I2;
    if (r < TP_I3) { const int kb_ = r / 64, Gp = r % 64; return tp_mk(P.w_out, DM, 32 * Gp, 64 * kb_, P.WoutT, DM, 32 * Gp, 0, nullptr, 0); } r -= TP_I3;
    if (r < TP_I4) { const int kb_ = r / 32, Gp = r % 32; return tp_mk(P.w_xkv, 2 * XW, 32 * Gp, 64 * kb_, P.WxkvT, DM, 32 * Gp, 0, nullptr, 0); } r -= TP_I4;
    if (r < TP_I7) { const int kb_ = r / 64, Gp = r % 64; return tp_mk(P.w_xo, DM, 32 * Gp, 64 * kb_, P.wxot, XW, 32 * Gp, 0, nullptr, 0); } r -= TP_I7;
    if (r < TP_I5) { const int kb_ = r / 352, Gp = r % 352; const int t = Gp >> 3, i32 = Gp & 7; const int src = (i32 < 4) ? (128 * t + 32 * i32) : (DFF + 128 * t + 32 * (i32 - 4));
        return tp_mk(P.w_gate_up, 2 * DFF, src, 64 * kb_, P.WguT, DM, 32 * Gp, 0, P.g_ffn, 0); } r -= TP_I5;
    { const int kb_ = r / 64, Gp = r % 64; return tp_mk(P.w_down, DM, 32 * Gp, 64 * kb_, P.WdT, DFF, 32 * Gp, 0, nullptr, 0); }
}
__device__ __forceinline__ void tp_load(const TpItem& d, float (&tv)[32], f32x4 (&kv)[2], const float* ksafe, int lane) {
    { const float* kp = (d.ks ? d.ks : ksafe) + 8 * (lane & 7); kv[0] = *(const f32x4*)kp; kv[1] = *(const f32x4*)(kp + 4); }
    const float* sp = d.src + (size_t)(lane >> 3) * d.ldw + 4 * (lane & 7);
#pragma unroll
    for (int q = 0; q < 8; ++q) { const f32x4 v = __builtin_nontemporal_load((const f32x4*)(sp + (size_t)(8 * q) * d.ldw)); tv[4 * q] = v.x; tv[4 * q + 1] = v.y; tv[4 * q + 2] = v.z; tv[4 * q + 3] = v.w; }
}
template <bool WT = false>
__device__ __forceinline__ void tp_finish(const TpItem& d, const float (&tv)[32], const f32x4 (&kv)[2], LAS float* scr, int lane) {
#pragma unroll
    for (int q = 0; q < 8; ++q)
#pragma unroll
        for (int e = 0; e < 4; ++e) scr[(8 * q + (lane >> 3)) * 33 + 4 * (lane & 7) + e] = tv[4 * q + e];
    LDS_WAIT(); asm volatile("" ::: "memory");
    const int c = lane & 7;
    float sc[8];
#pragma unroll
    for (int i = 0; i < 8; ++i) sc[i] = d.ks ? kv[i >> 2][i & 3] * d.cscale : d.cscale;
#pragma unroll
    for (int j = 0; j < 4; ++j) { const int nd = (lane >> 3) + 8 * j; const int scol = d.perm ? rope_sigma(nd) : nd; const LAS float* s = scr + (8 * c) * 33 + scol;
        v4u o; o.x = cvt_pk_bf16(s[0 * 33] * sc[0], s[1 * 33] * sc[1]); o.y = cvt_pk_bf16(s[2 * 33] * sc[2], s[3 * 33] * sc[3]);
        o.z = cvt_pk_bf16(s[4 * 33] * sc[4], s[5 * 33] * sc[5]); o.w = cvt_pk_bf16(s[6 * 33] * sc[6], s[7 * 33] * sc[7]);
        if (WT) st16_wt(d.dst + (size_t)nd * d.ldd + 8 * c, o); else *(v4u*)(d.dst + (size_t)nd * d.ldd + 8 * c) = o; }
    LDS_WAIT(); asm volatile("" ::: "memory");
}
template <int MAP = 0>
__device__ __forceinline__ void tp_run(int it0, int it_end, int stride, const TpPtrs& P, LAS float* scr, int lane) {
    if (it0 >= it_end) return;
    TpItem d = tp_desc(tp_map<MAP>(it0), P); float tv[32]; f32x4 kv[2]; tp_load(d, tv, kv, P.g_ffn, lane);
    for (int it = it0; it < it_end; it += stride) {
        const int nx = it + stride; const bool more = nx < it_end; TpItem dn = d; float tn[32]; f32x4 kn[2];
        if (more) { dn = tp_desc(tp_map<MAP>(nx), P); tp_load(dn, tn, kn, P.g_ffn, lane); }
        tp_finish(d, tv, kv, scr, lane);
        if (more) { d = dn; kv[0] = kn[0]; kv[1] = kn[1];
#pragma unroll
            for (int i = 0; i < 32; ++i) tv[i] = tn[i]; }
    }
}
template <bool WT = false, int MAP = 0>
__device__ __forceinline__ void tp_run3(int it0, int it_end, int stride, const TpPtrs& P, LAS float* scr, int lane) {
    if (it0 >= it_end) return;
    const int n = (it_end - 1 - it0) / stride + 1;
#define TP_ITEM(k) (it0 + ((k) < n ? (k) : n - 1) * stride)
    TpItem dA = tp_desc(tp_map<MAP>(TP_ITEM(0)), P), dB = tp_desc(tp_map<MAP>(TP_ITEM(1)), P), dC = dA; float tA[32], tB[32], tC[32]; f32x4 kA[2], kB[2], kC[2];
    tp_load(dA, tA, kA, P.g_ffn, lane); tp_load(dB, tB, kB, P.g_ffn, lane);
    for (int k = 0; k < n; k += 3) {
        dC = tp_desc(tp_map<MAP>(TP_ITEM(k + 2)), P); tp_load(dC, tC, kC, P.g_ffn, lane); tp_finish<WT>(dA, tA, kA, scr, lane);
        if (k + 1 >= n) break;
        dA = tp_desc(tp_map<MAP>(TP_ITEM(k + 3)), P); tp_load(dA, tA, kA, P.g_ffn, lane); tp_finish<WT>(dB, tB, kB, scr, lane);
        if (k + 2 >= n) break;
        dB = tp_desc(tp_map<MAP>(TP_ITEM(k + 4)), P); tp_load(dB, tB, kB, P.g_ffn, lane); tp_finish<WT>(dC, tC, kC, scr, lane);
    }
#undef TP_ITEM
}
__device__ __forceinline__ void rms_rows_to_bf16(const float* xb, const float* g, bf16* ob, int m0, int m_end, int stride, int lane) {
    if (m0 >= m_end) return;
    f32x4 v[8];
    { const f32x4* xr = (const f32x4*)(xb + (size_t)m0 * DM) + lane;
#pragma unroll
      for (int j = 0; j < 8; ++j) v[j] = __builtin_nontemporal_load(xr + 64 * j); }
    f32x4 gg[8];
#pragma unroll
    for (int j = 0; j < 8; ++j) gg[j] = ((const f32x4*)g + lane)[64 * j];
    for (int m = m0; m < m_end; m += stride) {
        const int nx = m + stride; const bool more = nx < m_end; f32x4 vn[8];
        if (more) { const f32x4* xr = (const f32x4*)(xb + (size_t)nx * DM) + lane;
#pragma unroll
            for (int j = 0; j < 8; ++j) vn[j] = __builtin_nontemporal_load(xr + 64 * j); }
        float s = 0.f;
#pragma unroll
        for (int j = 0; j < 8; ++j) s += (v[j].x * v[j].x + v[j].y * v[j].y) + (v[j].z * v[j].z + v[j].w * v[j].w);
        const float rstd = 1.0f / sqrtf(wave_sum(s) * (1.0f / DM) + EPS);
        v2u* o8 = (v2u*)(ob + (size_t)m * DM) + lane;
#pragma unroll
        for (int j = 0; j < 8; ++j) { v2u w; w.x = cvt_pk_bf16(v[j].x * rstd * gg[j].x, v[j].y * rstd * gg[j].y); w.y = cvt_pk_bf16(v[j].z * rstd * gg[j].z, v[j].w * rstd * gg[j].w); o8[64 * j] = w; }
        if (more) {
#pragma unroll
            for (int j = 0; j < 8; ++j) v[j] = vn[j]; }
    }
}

__device__ __forceinline__ s16x4 vtr(const LAS unsigned char* p) { typedef short v4i16_t __attribute__((ext_vector_type(4))); return __builtin_bit_cast(s16x4, __builtin_amdgcn_ds_read_tr16_b64_v4i16((LAS v4i16_t*)p)); }

struct ConvCtx { const bf16* zc; bf16* xn; int ts, cg; f32x4 w0[2], w1[2], w2[2], p1[2], p2[2]; };
__device__ __forceinline__ void conv_issue(const ConvCtx& c, int batch, v4u (&zb)[4], v4u (&zp)[4]) {
#pragma unroll
    for (int i = 0; i < 4; ++i) { const bf16* zr = c.zc + (size_t)(c.ts + 4 * batch + i) * (2 * CW) + 8 * c.cg; zb[i] = __builtin_nontemporal_load((const v4u*)(zr)); zp[i] = __builtin_nontemporal_load((const v4u*)(zr + CW)); }
}
__device__ __forceinline__ void conv_finish(ConvCtx& c, int batch, const v4u (&zb)[4], const v4u (&zp)[4]) {
#pragma unroll
    for (int i = 0; i < 4; ++i) { f32x4 cb0, cb1, p0a, p0b; unpack8(zb[i], cb0, cb1); unpack8(zp[i], p0a, p0b);
        const f32x4 y0 = cb0 * (c.w0[0] * c.p2[0] + c.w1[0] * c.p1[0] + c.w2[0] * p0a), y1 = cb1 * (c.w0[1] * c.p2[1] + c.w1[1] * c.p1[1] + c.w2[1] * p0b);
        *(v4u*)(c.xn + (size_t)(c.ts + 4 * batch + i) * DM + AW + 8 * c.cg) = pack8(y0, y1);
        c.p2[0] = c.p1[0]; c.p2[1] = c.p1[1]; c.p1[0] = p0a; c.p1[1] = p0b; }
}
__device__ __forceinline__ void conv_init(ConvCtx& c, const bf16* zc, bf16* xn, const float* conv_w, int chunk, int tid) {
    c.zc = zc; c.xn = xn; c.cg = tid & 127; c.ts = chunk * 64 + (tid >> 7) * 16;
#pragma unroll
    for (int j = 0; j < 2; ++j) { c.w0[j] = *(const f32x4*)(conv_w + 8 * c.cg + 4 * j); c.w1[j] = *(const f32x4*)(conv_w + CW + 8 * c.cg + 4 * j); c.w2[j] = *(const f32x4*)(conv_w + 2 * CW + 8 * c.cg + 4 * j);
        c.p2[j] = (f32x4){0.f, 0.f, 0.f, 0.f}; c.p1[j] = c.p2[j]; }
    if (c.ts >= 2) { unpack8(*(const v4u*)(zc + (size_t)(c.ts - 2) * (2 * CW) + CW + 8 * c.cg), c.p2[0], c.p2[1]); unpack8(*(const v4u*)(zc + (size_t)(c.ts - 1) * (2 * CW) + CW + 8 * c.cg), c.p1[0], c.p1[1]); }
}
template <bool CONV>
__device__ __forceinline__ void swa_unit(LAS unsigned char* lds, int n, int g, const bf16* qb, const bf16* kb, const bf16* vb, const float* sinks, bf16* A2, int tid, int lane, int wave, ConvCtx& cc, int batch0) {
    LAS unsigned char* Kl = lds; LAS unsigned char* Vl = lds + 32768;
#pragma unroll
    for (int i = 0; i < 4; ++i) { const int id = tid + 512 * i, row = id >> 3, ch = id & 7; const int tok = (n - 1) * 128 + row;
        v4u kv = (v4u){0u, 0u, 0u, 0u}, vv = (v4u){0u, 0u, 0u, 0u};
        if (tok >= 0) { kv = *(const v4u*)(kb + (size_t)tok * KVW + g * 64 + ch * 8); vv = *(const v4u*)(vb + (size_t)tok * KVW + g * 64 + ch * 8); }
        *(LAS v4u*)(Kl + row * 128 + ((ch ^ ((row >> 1) & 7)) << 4)) = kv;
        *(LAS v4u*)(Vl + row * 128 + ((ch ^ (((row >> 1) & 1) << 2)) << 4)) = vv; }
    __syncthreads();
    const int ql = lane & 31, h = lane >> 5, hq = g * 4 + (wave & 3);
    const float sinkl = sinks[hq] * LOG2E;
    const int li = lane & 15, qp = li >> 2, pp = li & 3, g1 = (lane >> 4) & 1;
    const float NEG = -__builtin_inff();
#pragma unroll 1
    for (int st = 0; st < 2; ++st) {
        const int r0 = (wave >> 2) * 64 + 32 * st; const size_t tok = (size_t)n * 128 + r0 + ql;
        bf16x8 qf[4];
#pragma unroll
        for (int ks = 0; ks < 4; ++ks) qf[ks] = *(const bf16x8*)(qb + tok * AW + hq * 64 + 16 * ks + 8 * h);
        v4u zb[4], zp[4];
        if (CONV) conv_issue(cc, batch0 + st, zb, zp);
        f32x16 S[5];
#pragma unroll
        for (int t = 0; t < 5; ++t) { const int c = r0 + 32 * t + ql; S[t] = (f32x16){};
#pragma unroll
            for (int ks = 0; ks < 4; ++ks) { const bf16x8 kf = *(const LAS bf16x8*)(Kl + c * 128 + (((2 * ks + h) ^ ((c >> 1) & 7)) << 4));
                S[t] = __builtin_amdgcn_mfma_f32_32x32x16_bf16(kf, qf[ks], S[t], 0, 0, 0); } }
#pragma unroll
        for (int r = 0; r < 16; ++r) { const int cc = (r & 3) + 8 * (r >> 2) + 4 * h; if (!(cc > ql)) S[0][r] = NEG; if (!(cc <= ql)) S[4][r] = NEG; }
        if (n == 0) {
#pragma unroll
            for (int t = 0; t < 5; ++t)
#pragma unroll
                for (int r = 0; r < 16; ++r) { const int cc = (r & 3) + 8 * (r >> 2) + 4 * h; if (r0 + 32 * t + cc < 128) S[t][r] = NEG; } }
        float mx = sinkl;
#pragma unroll
        for (int t = 0; t < 5; ++t)
#pragma unroll
            for (int r = 0; r < 16; ++r) mx = fmaxf(mx, S[t][r]);
        mx = fmaxf(mx, __shfl_xor(mx, 32));
        float l = 0.f;
#pragma unroll
        for (int t = 0; t < 5; ++t)
#pragma unroll
            for (int r = 0; r < 16; ++r) { const float p = fast_exp2(S[t][r] - mx); S[t][r] = p; l += p; }
        l += __shfl_xor(l, 32); l += fast_exp2(sinkl - mx);
        f32x16 O[2]; O[0] = (f32x16){}; O[1] = (f32x16){};
#pragma unroll
        for (int t = 0; t < 5; ++t)
#pragma unroll
            for (int s = 0; s < 2; ++s) {
                v4u pw; pw.x = cvt_pk_bf16(S[t][8 * s + 0], S[t][8 * s + 1]); pw.y = cvt_pk_bf16(S[t][8 * s + 2], S[t][8 * s + 3]);
                pw.z = cvt_pk_bf16(S[t][8 * s + 4], S[t][8 * s + 5]); pw.w = cvt_pk_bf16(S[t][8 * s + 6], S[t][8 * s + 7]);
                const bf16x8 pf = __builtin_bit_cast(bf16x8, pw);
                const int krow = r0 + 32 * t + 16 * s + 4 * h + qp;
#pragma unroll
                for (int db = 0; db < 2; ++db) { const int chunk = (4 * db + 2 * g1 + (pp >> 1)) ^ (((qp >> 1) & 1) << 2);
                    const LAS unsigned char* va = Vl + krow * 128 + (chunk << 4) + (pp & 1) * 8;
                    const s16x4 lo = vtr(va), hi = vtr(va + 8 * 128);
                    const bf16x8 vf = (bf16x8){lo[0], lo[1], lo[2], lo[3], hi[0], hi[1], hi[2], hi[3]};
                    O[db] = __builtin_amdgcn_mfma_f32_32x32x16_bf16(vf, pf, O[db], 0, 0, 0); } }
        const float inv = 1.0f / l;
#pragma unroll
        for (int db = 0; db < 2; ++db)
#pragma unroll
            for (int pr = 0; pr < 2; ++pr) { const int ra = 8 * pr, rb = 8 * pr + 4;
                unsigned ax = cvt_pk_bf16(O[db][ra + 0] * inv, O[db][ra + 1] * inv), ay = cvt_pk_bf16(O[db][ra + 2] * inv, O[db][ra + 3] * inv);
                unsigned bx_ = cvt_pk_bf16(O[db][rb + 0] * inv, O[db][rb + 1] * inv), by = cvt_pk_bf16(O[db][rb + 2] * inv, O[db][rb + 3] * inv);
                { auto r = __builtin_amdgcn_permlane32_swap(ax, bx_, false, false); ax = r[0]; bx_ = r[1]; }
                { auto r = __builtin_amdgcn_permlane32_swap(ay, by, false, false); ay = r[0]; by = r[1]; }
                *(v4u*)(A2 + tok * DM + hq * 64 + 32 * db + 16 * pr + 8 * h) = (v4u){ax, ay, bx_, by}; }
        if (CONV) conv_finish(cc, batch0 + st, zb, zp);
    }
    __syncthreads();
}
__device__ __forceinline__ void wave_gemm_64x32_k128(const bf16* A, int lda, const bf16* Bt, int ldb, bf16* C, int ldc, int lane) {
    const int fr = lane & 15, fq = lane >> 4;
    f32x4 acc[4][2];
#pragma unroll
    for (int mi = 0; mi < 4; ++mi)
#pragma unroll
        for (int ni = 0; ni < 2; ++ni) acc[mi][ni] = (f32x4){0.f, 0.f, 0.f, 0.f};
    bf16x8 a[4][4], b[4][2];
#pragma unroll
    for (int ks = 0; ks < 4; ++ks) {
#pragma unroll
        for (int mi = 0; mi < 4; ++mi) a[ks][mi] = *(const bf16x8*)(A + (size_t)(16 * mi + fr) * lda + 32 * ks + 8 * fq);
#pragma unroll
        for (int ni = 0; ni < 2; ++ni) b[ks][ni] = *(const bf16x8*)(Bt + (size_t)(16 * ni + fr) * ldb + 32 * ks + 8 * fq); }
#pragma unroll
    for (int ks = 0; ks < 4; ++ks)
#pragma unroll
        for (int mi = 0; mi < 4; ++mi)
#pragma unroll
            for (int ni = 0; ni < 2; ++ni) acc[mi][ni] = __builtin_amdgcn_mfma_f32_16x16x32_bf16(b[ks][ni], a[ks][mi], acc[mi][ni], 0, 0, 0);
#pragma unroll
    for (int mi = 0; mi < 4; ++mi)
#pragma unroll
        for (int ni = 0; ni < 2; ++ni) { v2u w; w.x = cvt_pk_bf16(acc[mi][ni][0], acc[mi][ni][1]); w.y = cvt_pk_bf16(acc[mi][ni][2], acc[mi][ni][3]);
            st8_wt(C + (size_t)(16 * mi + fr) * ldc + 16 * ni + 4 * fq, w); }
}

constexpr int NPHASE = 10;
struct Args { const float* in[18]; float* out; unsigned char* ws; int ph_lo, ph_hi, li, pad; };

__global__ void __launch_bounds__(512, 2) hyb_fwd(Args args) {
    extern __shared__ __attribute__((aligned(16))) unsigned char lds_raw[];
    LAS unsigned char* lds = (LAS unsigned char*)lds_raw;
    volatile LAS unsigned* MISC = (volatile LAS unsigned*)(lds + MISC_OFF);
    const int tid = threadIdx.x, lane = tid & 63, wave = __builtin_amdgcn_readfirstlane(tid >> 6);
    const int G = gridDim.x, bx = blockIdx.x;
    unsigned char* ws = args.ws;
    unsigned* ctl = (unsigned*)(ws + WS_CTL);
    const float* x = args.in[0]; const float* mem = args.in[1]; const float* g_mix = args.in[2]; const float* w_in = args.in[3]; const float* conv_w = args.in[4];
    const float* sinks = args.in[5]; const float* w_attn_o = args.in[6]; const float* w_conv_o = args.in[7]; const float* w_out = args.in[8]; const float* g_xattn = args.in[9];
    const float* g_mem = args.in[10]; const float* w_xq = args.in[11]; const float* w_xkv = args.in[12]; const float* w_xo = args.in[13]; const float* g_ffn = args.in[14];
    const float* w_gate_up = args.in[15]; const float* w_down = args.in[16]; const float* g_final = args.in[17];
    float* out = args.out;
    float* ss1 = (float*)(ws + WS_SS); float* ss2 = ss1 + SEQ; float* ss3 = ss2 + SEQ;
    float* cs = (float*)(ws + WS_CS);
    bf16* kvb = (bf16*)(ws + WS_KVB); bf16* memn = (bf16*)(ws + WS_MEMN); bf16* wxqp = (bf16*)(ws + WS_WXQ); bf16* wxot = (bf16*)(ws + WS_WXOT);
    bf16* WguT = (bf16*)(ws + WS_WGUT); bf16* WdT = (bf16*)(ws + WS_WDT); bf16* XN = (bf16*)(ws + WS_XN);
    bf16* WinT = (bf16*)(ws + WS_WINT); bf16* WacT = (bf16*)(ws + WS_WACT); bf16* WoutT = (bf16*)(ws + WS_WOUTT); bf16* WxkvT = (bf16*)(ws + WS_WXKVT);
    bf16* WqKT = (bf16*)(ws + WS_WQKT); bf16* VWoT = (bf16*)(ws + WS_VWOT);
    bf16* qb = (bf16*)(ws + WS_Q); bf16* kb = (bf16*)(ws + WS_K); bf16* vb = (bf16*)(ws + WS_V); bf16* zc = (bf16*)(ws + WS_ZC);
    bf16* Pb = (bf16*)(ws + WS_P); bf16* act = (bf16*)(ws + WS_ACT);
    bf16* sgr = (bf16*)out; bf16* sgc = sgr + (size_t)SEQ * DM;
    bf16* merged = sgr;

    for (int u = tid; u < (LDS_BYTES - LDSCTL_OFF) / 4; u += 512) ((LAS unsigned*)(lds + LDSCTL_OFF))[u] = 0u;
    __syncthreads();
    XcdBarrier bar; bar.bar = ctl + CW_BAR; bar.x = 0; bar.st = nullptr;
    if (MK_N_LAUNCHES == 1) bar = xcd_barrier_post(ctl + CW_BAR, MISC + 8);
    if (tid == 0) __hip_atomic_store(ctl + CW_XID + 64 * (bx & 63) + (bx >> 6), xb_xcc_id() + 1u, __ATOMIC_RELAXED, __HIP_MEMORY_SCOPE_AGENT);
    const int lo = args.ph_lo, hi = args.ph_hi;
    const bool tailfill = (G == 256);
#define IN(k) (lo <= (k) && (k) < hi)
#ifdef PROBE_PHASE
    int n_stamp = 0;
#define STAMP() do { if (bx == 0 && tid == 0) { ((volatile LAS unsigned long long*)(lds + MISC_OFF + 128))[n_stamp] = __builtin_amdgcn_s_memrealtime(); ((volatile LAS unsigned long long*)(lds + MISC_OFF + 256))[n_stamp] = __builtin_amdgcn_s_memtime(); } ++n_stamp; } while (0)
#define SUBSTAMP(i) do { __builtin_amdgcn_s_waitcnt(0); if (bx == 0 && tid == 0) ((volatile LAS unsigned long long*)(lds + MISC_OFF + 128))[40 + (i)] = __builtin_amdgcn_s_memrealtime(); } while (0)
#else
#define STAMP() do { } while (0)
#define SUBSTAMP(i) do { } while (0)
#endif
#define SEAM(k) do { if (IN(k) && IN((k) + 1)) xcd_barrier(bar); STAMP(); } while (0)
    const bool grp = (G == 256) && (MK_N_LAUNCHES == 1);
    const int pm_own = 8 * (bx & 7) + ((bx >> 3) & 7), jmem = bx >> 6;
    unsigned* gcnt = ctl + CW_GRP + 64 * (bx & 63); unsigned* glob = ctl + CW_GLOB; unsigned* gtmo = ctl + CW_BAR + XB_TMO;
    unsigned gepoch = 0; bool same_xcd = false;
#define GSEAM(k, extra) do { if (IN(k) && IN((k) + 1)) { if (grp) { gepoch += 4u; group_barrier(gcnt, gepoch, (extra), gtmo, same_xcd); } else xcd_barrier(bar); } STAMP(); } while (0)
    STAMP();

    const TpPtrs TP{w_in, w_attn_o, w_conv_o, w_out, w_xkv, w_xo, w_gate_up, w_down, g_ffn, WinT, WacT, WoutT, WxkvT, wxot, WguT, WdT};
    if (IN(0)) {
        LAS float* scr = (LAS float*)(lds + wave * 16384);
        const int gw = bx * 8 + wave, NGW = G * 8;
        SUBSTAMP(0);
        if (bx & 1) rms_rows_to_bf16(x, g_mix, XN, gw, SEQ, NGW, lane);
        if (tailfill) tp_run<1>(gw, TP_NEARLY - TP_MID, NGW, TP, scr, lane); else tp_run<0>(gw, TP_NITEMS, NGW, TP, scr, lane);
        SUBSTAMP(1);
        if (!(bx & 1)) rms_rows_to_bf16(x, g_mix, XN, gw, SEQ, NGW, lane);
        SUBSTAMP(2);
        rms_rows_to_bf16(mem, g_mem, memn, gw, NMEM, NGW, lane);
        for (int k = gw; k < DM; k += NGW) { const float gs = g_xattn[k] * C2X; const f32x4* src = (const f32x4*)(w_xq + (size_t)k * XW) + lane; v2u* dst = (v2u*)(wxqp + (size_t)k * XW) + lane;
#pragma unroll
            for (int j = 0; j < 2; ++j) { const f32x4 v = src[64 * j]; v2u w; w.x = cvt_pk_bf16(v.x * gs, v.y * gs); w.y = cvt_pk_bf16(v.z * gs, v.w * gs); dst[64 * j] = w; } }
        const int gt = bx * 512 + tid, NGT = G * 512;
        for (int e = gt; e < SEQ * 8; e += NGT) { const int pos = e >> 3, i = e & 7;
            const float inv_freq = (i == 0) ? 1.0f : (i == 1) ? 0.19392274f : (i == 2) ? 0.037606031f : (i == 3) ? 0.0072926646f : (i == 4) ? 0.0014142136f : (i == 5) ? 0.00027424819f : (i == 6) ? 5.3182957e-05f : 1.0313385e-05f;
            const float ang = (float)pos * inv_freq; float sn, cn; sincosf(ang, &sn, &cn);
            cs[(size_t)pos * 16 + i] = cn; cs[(size_t)pos * 16 + 8 + i] = sn; }
        for (int e = gt; e < 3 * SEQ; e += NGT) ss1[e] = 0.f;
        SUBSTAMP(3);
    }
    SEAM(0);

    if (IN(1)) {
        { pg8::Prob g{memn, WxkvT, DM, DM, DM, 0}; pg8::StaticOrder S; S.init(NMEM, 2 * XW, G, (bx >= 128 && bx < 132) ? bx - 128 : -1);
          EpiStoreBf16 E{kvb, 2 * XW};
          pg8::gemm_phase<EpiStoreBf16, pg8::StaticOrder, PG8_ALIGN, PG8_SP2>(lds, g, S, E); }
        if (tailfill && bx >= 132) { tp_run3<false, 2>((bx - 132) * 8 + wave, TP_MID + (TP_NITEMS - TP_NEARLY) - (grp ? TP_P2SHARE : 0), (256 - 132) * 8, TP, (LAS float*)(lds + wave * 16384), lane); __syncthreads(); }
        { pg8::Prob g{XN, WinT, DM, DM, DM, 0}; pg8::StaticOrder S; S.init(SEQ, NIN, G, bx, 1, true);
          EpiInProj E{qb, kb, vb, zc, sgr, sgc, cs};
          pg8::gemm_phase<EpiInProj, pg8::StaticOrder, PG8_ALIGN, PG8_SP2>(lds, g, S, E); }
    }
    SEAM(1);

    if (grp && IN(2)) {
        if (tid == 0) { unsigned* xt = ctl + CW_XID + 64 * (bx & 63); const unsigned a0 = xb_ld(xt), a1 = xb_ld(xt + 1), a2 = xb_ld(xt + 2), a3 = xb_ld(xt + 3);
            MISC[12] = (a0 != 0u && a0 == a1 && a0 == a2 && a0 == a3) ? 1u : 0u; }
        __syncthreads();
        same_xcd = __builtin_amdgcn_readfirstlane(MISC[12]) != 0u;
    }
    if (IN(2)) {
        SUBSTAMP(4);
        ConvCtx cc;
        if (grp) {
            conv_init(cc, zc, XN, conv_w, 4 * pm_own + jmem, tid);
            swa_unit<true>(lds, 2 * pm_own + ((2 * jmem) >> 2), (2 * jmem) & 3, qb, kb, vb, sinks, XN, tid, lane, wave, cc, 0);
            swa_unit<true>(lds, 2 * pm_own + ((2 * jmem + 1) >> 2), (2 * jmem + 1) & 3, qb, kb, vb, sinks, XN, tid, lane, wave, cc, 2);
        } else {
            for (int u = bx; u < (SEQ / 128) * 4; u += G) swa_unit<false>(lds, u >> 2, u & 3, qb, kb, vb, sinks, XN, tid, lane, wave, cc, 0);
            for (int ch = bx; ch < SEQ / 64; ch += G) { conv_init(cc, zc, XN, conv_w, ch, tid);
#pragma unroll 1
                for (int b = 0; b < 4; ++b) { v4u zb[4], zp[4]; conv_issue(cc, b, zb, zp); conv_finish(cc, b, zb, zp); } }
        }
        SUBSTAMP(5);
        const bool pp_all = !grp; const int pp_w = ((bx >> 4) << 3) + (bx & 7);
        for (int job = pp_all ? bx * 8 + wave : (((bx >> 3) & 1) ? pp_w * 8 + wave : 2048); job < 2048; job += (pp_all ? G * 8 : 1024)) { const int idx = job & 1023;
            if (job < 1024) { const int mt = idx >> 6, nt = idx & 63, m0 = 64 * mt, n0 = 32 * nt, hh = m0 >> 8, j0 = m0 & 255;
                wave_gemm_64x32_k128(kvb + (size_t)j0 * (2 * XW) + 128 * hh, 2 * XW, wxqp + (size_t)n0 * XW + 128 * hh, XW, WqKT + (size_t)m0 * DM + n0, DM, lane); }
            else { const int mt = idx >> 5, nt = idx & 31, m0 = 64 * mt, n0 = 32 * nt, hh = n0 >> 8, j0 = n0 & 255;
                wave_gemm_64x32_k128(wxot + (size_t)m0 * XW + 128 * hh, XW, kvb + (size_t)j0 * (2 * XW) + XW + 128 * hh, 2 * XW, VWoT + (size_t)m0 * (4 * NMEM) + n0, 4 * NMEM, lane); } }
        if (grp && ((bx >> 3) & 1)) tp_run3<true>(TP_NITEMS - TP_P2SHARE + pp_w * 8 + wave, TP_NITEMS, 1024, TP, (LAS float*)(lds + wave * 16384), lane);
    }
    SUBSTAMP(7);
    GSEAM(2, glob);

    if (IN(3)) { pg8::Prob g{XN, WacT, DM, DM, AW, AW}; pg8::StaticOrder S; S.init(SEQ, DM, G, bx, 2);
        EpiMerge E{sgr, sgc, merged};
        pg8::gemm_phase<EpiMerge, pg8::StaticOrder, PG8_ALIGN, PG8_SP2>(lds, g, S, E); }
    GSEAM(3, nullptr);

    if (IN(4)) { pg8::Prob g{merged, WoutT, DM, DM, DM, 0}; pg8::StaticOrder S; S.init(SEQ, DM, G, bx);
        EpiResid<true> E{x, XN, ss1};
        pg8::gemm_phase<EpiResid<true>, pg8::StaticOrder, PG8_ALIGN, PG8_SP2>(lds, g, S, E); }
    GSEAM(4, glob + 64);

    if (IN(5)) { if (grp) wait_global(glob, 256u, gtmo);
        pg8::Prob g{XN, WqKT, DM, DM, DM, 0}; pg8::StaticOrder S; S.init(SEQ, 4 * NMEM, G, bx);
        EpiSoftmax E{ss1, Pb};
        if ((SEQ / 256) * 4 <= G) pg8::gemm_phase<EpiSoftmax, pg8::StaticOrder, false, PG8_SP2>(lds, g, S, E); }
    GSEAM(5, nullptr);

    if (IN(6)) { pg8::Prob g{Pb, VWoT, 4 * NMEM, 4 * NMEM, 4 * NMEM, 0}; pg8::StaticOrder S; S.init(SEQ, DM, G, bx);
        EpiResid<false> E{nullptr, XN, ss2};
        pg8::gemm_phase<EpiResid<false>, pg8::StaticOrder, PG8_ALIGN, PG8_SP2>(lds, g, S, E); }
    GSEAM(6, nullptr);

    if (IN(7)) { pg8::Prob g{XN, WguT, DM, DM, DM, 0}; pg8::StaticOrder S; S.init(SEQ, 2 * DFF, G, bx, 1, true);
        EpiSwiGLU E{ss2, act};
        pg8::gemm_phase<EpiSwiGLU, pg8::StaticOrder, PG8_ALIGN, PG8_SP2>(lds, g, S, E); }
    GSEAM(7, nullptr);

    if (IN(8)) { pg8::Prob g{act, WdT, 64, DFF, DFF, 0, 256 * 64 * 2, (size_t)256 * DFF}; pg8::StaticOrder S; S.init(SEQ, DM, G, bx);
        if (grp) { EpiFinal E{XN, ss3, out, g_final, gcnt, gepoch + 4u, glob + 64, gtmo, same_xcd}; gepoch += 4u;
            pg8::gemm_phase<EpiFinal, pg8::StaticOrder, PG8_ALIGN, PG8_SP2>(lds, g, S, E); }
        else { EpiResid<false> E{nullptr, XN, ss3};
            pg8::gemm_phase<EpiResid<false>, pg8::StaticOrder, PG8_ALIGN, PG8_SP2>(lds, g, S, E); } }
    if (!grp) { GSEAM(8, nullptr); } else { STAMP(); }

    if (IN(9) && !grp) {
        if (grp) wait_global(glob + 64, 256u, gtmo);
        const int m0 = grp ? 256 * pm_own + 64 * jmem + wave : bx * 8 + wave, m_end = grp ? 256 * pm_own + 64 * jmem + 64 : SEQ, NGW = grp ? 8 : G * 8;
        f32x4 gg[4][2];
#pragma unroll
        for (int j = 0; j < 4; ++j) { gg[j][0] = ((const f32x4*)g_final + 2 * lane)[128 * j]; gg[j][1] = ((const f32x4*)g_final + 2 * lane)[128 * j + 1]; }
        v4u hv[4];
        if (m0 < m_end) {
#pragma unroll
            for (int j = 0; j < 4; ++j) hv[j] = ((const v4u*)(XN + (size_t)m0 * DM) + lane)[64 * j]; }
        for (int m = m0; m < m_end; m += NGW) { const int nx = m + NGW; const bool more = nx < m_end; v4u hn[4];
            if (more) {
#pragma unroll
                for (int j = 0; j < 4; ++j) hn[j] = ((const v4u*)(XN + (size_t)nx * DM) + lane)[64 * j]; }
            const float rs = 1.0f / sqrtf(ss3[m] * (1.0f / DM) + EPS); f32x4* o = (f32x4*)(out + (size_t)m * DM) + 2 * lane;
#pragma unroll
            for (int j = 0; j < 4; ++j) { f32x4 v0, v1; unpack8(hv[j], v0, v1); o[128 * j] = v0 * rs * gg[j][0]; o[128 * j + 1] = v1 * rs * gg[j][1]; }
            if (more) {
#pragma unroll
                for (int j = 0; j < 4; ++j) hv[j] = hn[j]; } } }
#ifdef PROBE_PHASE
    STAMP();
    if (bx == 0 && tid == 0) { volatile LAS unsigned long long* st = (volatile LAS unsigned long long*)(lds + MISC_OFF + 128);
        volatile LAS unsigned long long* sc = (volatile LAS unsigned long long*)(lds + MISC_OFF + 256);
        unsigned long long span = st[PROBE_PHASE + 1] - st[PROBE_PHASE]; const unsigned long long t0 = __builtin_amdgcn_s_memrealtime();
#ifdef PROBE_SUB
        span = st[40 + PROBE_SUB + 1] - st[40 + PROBE_SUB];
#endif
#ifdef PROBE_CLOCK
        span = (sc[PROBE_PHASE + 1] - sc[PROBE_PHASE]) * 1250ull / span;
#endif
        while (__builtin_amdgcn_s_memrealtime() - t0 < 8ull * span) __builtin_amdgcn_s_sleep(8); }
#endif
#ifdef DBG_STOP
    if (IN(10)) { const size_t gt = (size_t)bx * 512 + tid, NGT = (size_t)G * 512;
        for (size_t e = gt; e < (size_t)SEQ * DM; e += NGT) {
#if DBG_DUMP == 0
            out[e] = __builtin_bit_cast(float, (unsigned)XN[e] << 16);
#elif DBG_DUMP == 1
            out[e] = __builtin_bit_cast(float, (unsigned)XN[e] << 16);
#elif DBG_DUMP == 2
            out[e] = __builtin_bit_cast(float, (unsigned)merged[e] << 16);
#elif DBG_DUMP == 3
            { const size_t r = e / DM, c = e % DM; out[e] = __builtin_bit_cast(float, (unsigned)(c < 1024 ? qb[r * 1024 + c] : (c < 1280 ? kb[r * 256 + c - 1024] : (c < 1536 ? vb[r * 256 + c - 1280] : zc[r * 2048 + ((c - 1536) & 2047)]))) << 16); }
#elif DBG_DUMP == 5
            { const size_t n1 = (size_t)1024 * 2048, n2 = 2 * n1, n3 = n2 + 256 * 1024; out[e] = (e < n1) ? __builtin_bit_cast(float, (unsigned)WqKT[e] << 16) : (e < n2) ? __builtin_bit_cast(float, (unsigned)VWoT[e - n1] << 16) : (e < n3) ? __builtin_bit_cast(float, (unsigned)kvb[e - n2] << 16) : 0.f; }
#elif DBG_DUMP == 6
            out[e] = (e < (size_t)256 * 1024) ? __builtin_bit_cast(float, (unsigned)kvb[e] << 16) : (e < (size_t)256 * 1024 + 256 * 2048) ? __builtin_bit_cast(float, (unsigned)memn[e - 256 * 1024] << 16) : 0.f;
#elif DBG_DUMP == 7
            out[e] = (e < (size_t)2048 * 512) ? __builtin_bit_cast(float, (unsigned)wxqp[e] << 16) : (e < (size_t)2 * 2048 * 512) ? __builtin_bit_cast(float, (unsigned)wxot[e - 2048 * 512] << 16) : 0.f;
#elif DBG_DUMP == 4
            { const size_t r = e / DM, c = e % DM; out[e] = __builtin_bit_cast(float, (unsigned)(c < 1024 ? Pb[r * 1024 + c] : (bf16)0) << 16); }
#endif
        } }
#endif
#undef IN
#undef SEAM
#undef GSEAM
}

extern "C" void kernel_launch(void* const* d_in, const int* in_sizes, int n_in, void* d_out, int out_size, void* d_ws, size_t ws_size, hipStream_t stream) {
    static int grid = 0;
    if (grid == 0) {
        if (n_in != 18 || in_sizes[0] != SEQ * DM || out_size != SEQ * DM || ws_size < WS_END) { fprintf(stderr, "kernel_launch: unexpected shapes / workspace (n_in %d, in0 %d, out %d, ws %zu); nothing launched\n", n_in, n_in > 0 ? in_sizes[0] : -1, out_size, ws_size); grid = -1; return; }
        int dev = 0, cus = 0;
        if (hipGetDevice(&dev) != hipSuccess || hipDeviceGetAttribute(&cus, hipDeviceAttributeMultiprocessorCount, dev) != hipSuccess) { fprintf(stderr, "kernel_launch: device query failed\n"); grid = -1; return; }
        if (hipFuncSetAttribute((const void*)hyb_fwd, hipFuncAttributeMaxDynamicSharedMemorySize, LDS_BYTES) != hipSuccess) { fprintf(stderr, "kernel_launch: hipFuncSetAttribute failed\n"); grid = -1; return; }
        int per_cu = 0;
        if (hipOccupancyMaxActiveBlocksPerMultiprocessor(&per_cu, (const void*)hyb_fwd, 512, LDS_BYTES) != hipSuccess || per_cu < 1) fprintf(stderr, "kernel_launch: note: occupancy query reports %d workgroups per CU\n", per_cu);
        (void)hipGetLastError();
        grid = cus;
    }
    if (grid < 0) return;
    if (hipMemsetAsync((char*)d_ws + WS_CTL, 0, CTL_ZERO_BYTES, stream) != hipSuccess) { fprintf(stderr, "kernel_launch: memset failed\n"); return; }
    Args a{};
    for (int i = 0; i < 18; ++i) a.in[i] = (const float*)d_in[i];
    a.out = (float*)d_out; a.ws = (unsigned char*)d_ws;
#ifdef DBG_STOP
    const int nl = DBG_STOP + 2;
#else
    const int nl = MK_N_LAUNCHES;
#endif
    for (int li = 0; li < nl; ++li) {
        a.ph_lo = (MK_N_LAUNCHES == 1) ? 0 : li; a.ph_hi = (MK_N_LAUNCHES == 1) ? NPHASE : li + 1; a.li = li; a.pad = 0;
#ifdef DBG_STOP
        if (li == nl - 1) { a.ph_lo = 10; a.ph_hi = 11; }
#endif
        hipLaunchKernelGGL(hyb_fwd, dim3(grid), dim3(512), LDS_BYTES, stream, a);
        const hipError_t le = hipPeekAtLastError();
        if (le != hipSuccess) { fprintf(stderr, "kernel_launch: launch %d failed: %s\n", li, hipGetErrorName(le)); break; }
    }
}
```
